# Optimizing an MI355X kernel written in HIP

```python
import jax
import jax.numpy as jnp
from jax import lax
import numpy as np

D_MODEL = 1024
BATCH = 2
SEQ = 8192
DEPTH = 1

GRID_W = 64
CTX_LEN = 256
A_HEAD_DIM = 64
A_HEADS = D_MODEL // A_HEAD_DIM
D_A = A_HEADS * A_HEAD_DIM
LORA_DECAY = 64
LORA_AAA = 64
LORA_GATE = 160
GN_EPS = 64e-5
B_BLOCK_DIM = 64
B_BLOCKS = D_MODEL // B_BLOCK_DIM
D_B = B_BLOCKS * B_BLOCK_DIM
CONV_W = 5
LRU_C = 8.0
N_GROUPS = 4
EXPERTS_PER_GROUP = 8
N_EXPERTS = N_GROUPS * EXPERTS_PER_GROUP
TOP_K = 2
D_EXPERT = 512
MOE_BLOCK = 128
A_SLAB = 3 * D_A + LORA_DECAY + LORA_AAA + LORA_GATE
B_SLAB = 2 * D_B
D_IN = A_SLAB + B_SLAB + 2 * D_MODEL
RWKV_SPLITS = (D_A, 2 * D_A, 3 * D_A, 3 * D_A + LORA_DECAY, 3 * D_A + LORA_DECAY + LORA_AAA)
LN_EPS = 1e-5
ALPHA = (2 * DEPTH) ** 0.25
BETA = (8 * DEPTH) ** -0.25

kernel_name = 'hybrid_rwkv7_rglru_hmoe_flow_block'


def layer_norm(x, g=None, b=None):
    xf = x.astype(jnp.float32)
    mu = jnp.mean(xf, -1, keepdims=True)
    var = jnp.mean(jnp.square(xf - mu), -1, keepdims=True)
    y = ((xf - mu) * lax.rsqrt(var + LN_EPS)).astype(x.dtype)
    if g is not None:
        y = y * g + b
    return y


def flip(t):
    return t[:, ::-1]


def grid_shift(z):
    b_, l_, ch = z.shape
    rows = l_ // GRID_W
    zg = z.reshape(b_, rows, GRID_W, ch // 4, 4)
    left = jnp.pad(zg[:, :, :-1, :, 0], ((0, 0), (0, 0), (1, 0), (0, 0)))
    right = jnp.pad(zg[:, :, 1:, :, 1], ((0, 0), (0, 0), (0, 1), (0, 0)))
    up = jnp.pad(zg[:, :-1, :, :, 2], ((0, 0), (1, 0), (0, 0), (0, 0)))
    down = jnp.pad(zg[:, 1:, :, :, 3], ((0, 0), (0, 1), (0, 0), (0, 0)))
    return jnp.stack([left, right, up, down], -1).reshape(b_, l_, ch)


def seq_shift(z):
    b_, l_, ch = z.shape
    zs = z.reshape(b_, l_, ch // 2, 2)
    prev = jnp.pad(zs[:, :-1, :, 0], ((0, 0), (1, 0), (0, 0)))
    nxt = jnp.pad(zs[:, 1:, :, 1], ((0, 0), (0, 1), (0, 0)))
    return jnp.stack([prev, nxt], -1).reshape(b_, l_, ch)


def depthwise_conv(x, w, b):
    y = lax.conv_general_dilated(x, w[:, None, :], window_strides=(1,),
                                 padding=[(CONV_W // 2, CONV_W // 2)],
                                 dimension_numbers=('NWC', 'WIO', 'NWC'),
                                 feature_group_count=x.shape[-1])
    return y + b


def wkv7_scan(r, w, k, v, kk, a, s0):
    xs = tuple(jnp.moveaxis(t, 1, 0) for t in (r, w, k, v, kk, a))

    def step(s, inp):
        r_t, w_t, k_t, v_t, kk_t, a_t = inp
        s_kk = jnp.einsum('bhvk,bhk->bhv', s, kk_t)
        s = (s * w_t[:, :, None, :] - s_kk[..., None] * (kk_t * a_t)[:, :, None, :]
             + v_t[..., None] * k_t[:, :, None, :])
        return s, jnp.einsum('bhvk,bhk->bhv', s, r_t)

    s_final, ys = lax.scan(step, s0, xs)
    return jnp.moveaxis(ys, 0, 1), s_final


def rwkv_mix(za, shift_fn, mu_a, w0, w2, a0, a2, g2, k_k, k_a, r_k, gn_g, gn_b, s0_f, s0_b):
    b_, l_, _ = za.shape
    za = za + mu_a * (shift_fn(za) - za)
    r, k, v, wd, ad, gd = jnp.split(za, RWKV_SPLITS, axis=-1)
    g = jax.nn.sigmoid(gd) @ g2
    w_log = -jax.nn.softplus(-(w0[:, None, None, :] + jnp.einsum('blr,erd->ebld', jnp.tanh(wd), w2))) - 0.5
    decay = jnp.exp(-jnp.exp(w_log))
    a = jax.nn.sigmoid(a0[:, None, None, :] + jnp.einsum('blr,erd->ebld', ad, a2))
    k_mod = k * (1.0 + (a - 1.0) * k_a)

    def heads(t):
        return t.reshape(t.shape[:-1] + (A_HEADS, A_HEAD_DIM))

    kk32 = heads(k * k_k).astype(jnp.float32)
    kk = (kk32 * lax.rsqrt(jnp.sum(jnp.square(kk32), -1, keepdims=True) + 1e-12)).astype(k.dtype)
    r_h, v_h = heads(r), heads(v)
    decay_h, a_h, k_h = heads(decay), heads(a), heads(k_mod)
    y_f, s_f = wkv7_scan(r_h, decay_h[0], k_h[0], v_h, kk, a_h[0], s0_f)
    y_b, s_b = wkv7_scan(flip(r_h), flip(decay_h[1]), flip(k_h[1]), flip(v_h), flip(kk), flip(a_h[1]), s0_b)
    y = y_f + flip(y_b)
    y32 = y.astype(jnp.float32)
    mu = jnp.mean(y32, -1, keepdims=True)
    var = jnp.mean(jnp.square(y32 - mu), -1, keepdims=True)
    yn = ((y32 - mu) * lax.rsqrt(var + GN_EPS)).astype(y.dtype).reshape(b_, l_, D_A) * gn_g + gn_b
    bonus = jnp.sum(r_h * (k_h[0] + k_h[1]) * r_k, -1, keepdims=True) * v_h
    return (yn + bonus.reshape(b_, l_, D_A)) * g, s_f, s_b


def linear_scan(a, u, h0):
    def combine(e1, e2):
        a1, u1 = e1
        a2_, u2 = e2
        return a1 * a2_, a2_ * u1 + u2

    a_cum, h = lax.associative_scan(combine, (a, u), axis=1)
    return h + a_cum * h0[:, None, :]


def rglru_mix(zb, conv_w, conv_b, wa, ba, wx, bx, lam, h0_f, h0_b):
    b_, l_, _ = zb.shape
    xb, gb = jnp.split(zb, 2, axis=-1)
    xb = depthwise_conv(xb, conv_w, conv_b)
    gate = jax.nn.gelu(gb)
    xh = xb.reshape(b_, l_, B_BLOCKS, B_BLOCK_DIM)
    rg = jax.nn.sigmoid(jnp.einsum('blhi,ehij->eblhj', xh, wa).reshape(2, b_, l_, D_B) + ba[:, None, None, :])
    ig = jax.nn.sigmoid(jnp.einsum('blhi,ehij->eblhj', xh, wx).reshape(2, b_, l_, D_B) + bx[:, None, None, :])
    log_a = -LRU_C * rg * jax.nn.softplus(-lam)[:, None, None, :]
    a = jnp.exp(log_a)
    u = jnp.sqrt(-jnp.expm1(2.0 * log_a)) * ig * xb
    h_f = linear_scan(a[0], u[0], h0_f)
    h_b = flip(linear_scan(flip(a[1]), flip(u[1]), h0_b))
    return (h_f + h_b) * gate, h_f[:, -1], h_b[:, 0]


def token_mix(h, shift_fn, w_in, p_a, p_b, w_o, rw, lru, states):
    slab = h @ w_in
    za = slab[..., :A_SLAB]
    zb = slab[..., A_SLAB:A_SLAB + B_SLAB]
    ga, gb = jnp.split(slab[..., A_SLAB + B_SLAB:], 2, axis=-1)
    s_f, s_b, h_f, h_b = states
    y_a, s_f, s_b = rwkv_mix(za, shift_fn, *rw, s_f, s_b)
    y_b, h_f, h_b = rglru_mix(zb, *lru, h_f, h_b)
    m = jax.nn.sigmoid(ga) * (y_a @ p_a) + jax.nn.sigmoid(gb) * (y_b @ p_b)
    return m @ w_o, (s_f, s_b, h_f, h_b)


def grouped_experts(xt, eid, wts, w1, w3, w2):
    t_, d_ = xt.shape
    n_assign = eid.shape[0]
    tok = jnp.arange(n_assign) // TOP_K
    order = jnp.argsort(eid)
    e_sorted = eid[order]
    counts = jnp.bincount(eid, length=N_EXPERTS)
    padded = (counts + MOE_BLOCK - 1) // MOE_BLOCK * MOE_BLOCK
    pad_end = jnp.cumsum(padded)
    pad_start = pad_end - padded
    start = jnp.cumsum(counts) - counts
    dest = pad_start[e_sorted] + jnp.arange(n_assign) - start[e_sorted]
    n_blocks = -(-n_assign // MOE_BLOCK) + N_EXPERTS
    n_pad = n_blocks * MOE_BLOCK
    buf_tok = jnp.full((n_pad,), t_, jnp.int32).at[dest].set(tok[order].astype(jnp.int32))
    buf_w = jnp.zeros((n_pad,), xt.dtype).at[dest].set(wts[order].astype(xt.dtype))
    blk_e = jnp.minimum(jnp.searchsorted(pad_end, jnp.arange(n_blocks) * MOE_BLOCK, side='right'), N_EXPERTS - 1)
    x_pad = jnp.concatenate([xt, jnp.zeros((1, d_), xt.dtype)], 0)
    xs = x_pad[buf_tok].reshape(n_blocks, MOE_BLOCK, d_)

    def expert_block(args):
        xb, e = args
        return (jax.nn.silu(xb @ w1[e]) * (xb @ w3[e])) @ w2[e]

    ys = lax.map(expert_block, (xs, blk_e)).reshape(n_pad, d_) * buf_w[:, None]
    return jnp.zeros((t_ + 1, d_), ys.dtype).at[buf_tok].add(ys)[:t_]


def hier_moe(h, rg_w, rg_b, re_w, re_b, w1, w3, w2):
    b_, l_, d_ = h.shape
    xt = h.reshape(b_ * l_, d_)
    glog = (xt @ rg_w + rg_b).astype(jnp.float32)
    gsel = jnp.argmax(glog, -1)
    p_g = jnp.take_along_axis(jax.nn.softmax(glog, -1), gsel[:, None], -1)
    elog = (xt @ re_w + re_b).astype(jnp.float32).reshape(-1, N_GROUPS, EXPERTS_PER_GROUP)
    elog_g = jnp.take_along_axis(elog, gsel[:, None, None], 1)[:, 0]
    top_val, top_idx = lax.top_k(elog_g, TOP_K)
    wts = jax.nn.softmax(top_val, -1) * p_g
    eid = (gsel[:, None] * EXPERTS_PER_GROUP + top_idx).reshape(-1)
    y = grouped_experts(xt, eid, wts.reshape(-1), w1, w3, w2)
    return y.reshape(b_, l_, d_)


def setup_inputs(seed: int = 0) -> dict:
    key = jax.random.key(seed)
    ks = iter(jax.random.split(key, 48))

    def nrm(shape, scale):
        return scale * jax.random.normal(next(ks), shape, jnp.float32)

    L = DEPTH
    lam_u = jax.random.uniform(next(ks), (L, 2, D_B), jnp.float32, 0.9, 0.999)
    s = lam_u ** (1.0 / LRU_C)
    return {
        'x': nrm((BATCH, SEQ, D_MODEL), 1.0),
        'c': nrm((BATCH, D_MODEL), 1.0),
        'ctx': nrm((BATCH, CTX_LEN, D_MODEL), 1.0),
        'c_ctx': nrm((D_MODEL,), 1.0),
        'w_ada': nrm((L, D_MODEL, 6 * D_MODEL), 0.5 * D_MODEL ** -0.5),
        'b_ada': nrm((L, 6 * D_MODEL), 0.01),
        'w_in': nrm((L, D_MODEL, D_IN), D_MODEL ** -0.5),
        'mu_a': jax.random.uniform(next(ks), (L, A_SLAB), jnp.float32),
        'w0': jax.random.uniform(next(ks), (L, 2, D_A), jnp.float32, -6.0, 1.0),
        'w2': nrm((L, 2, LORA_DECAY, D_A), 0.5 * LORA_DECAY ** -0.5),
        'a0': nrm((L, 2, D_A), 0.5),
        'a2': nrm((L, 2, LORA_AAA, D_A), 0.5 * LORA_AAA ** -0.5),
        'g2': nrm((L, LORA_GATE, D_A), LORA_GATE ** -0.5),
        'k_k': 0.85 + nrm((L, D_A), 0.02),
        'k_a': 1.0 + nrm((L, D_A), 0.02),
        'r_k': nrm((L, A_HEADS, A_HEAD_DIM), 0.1),
        'gn_g': 1.0 + nrm((L, D_A), 0.02),
        'gn_b': nrm((L, D_A), 0.01),
        'conv_w': nrm((L, CONV_W, D_B), CONV_W ** -0.5),
        'conv_b': nrm((L, D_B), 0.01),
        'lru_wa': nrm((L, 2, B_BLOCKS, B_BLOCK_DIM, B_BLOCK_DIM), B_BLOCK_DIM ** -0.5),
        'lru_ba': nrm((L, 2, D_B), 0.01),
        'lru_wx': nrm((L, 2, B_BLOCKS, B_BLOCK_DIM, B_BLOCK_DIM), B_BLOCK_DIM ** -0.5),
        'lru_bx': nrm((L, 2, D_B), 0.01),
        'lru_lam': jnp.log(s) - jnp.log1p(-s),
        'p_a': nrm((L, D_A, D_MODEL), BETA * D_A ** -0.5),
        'p_b': nrm((L, D_B, D_MODEL), BETA * D_B ** -0.5),
        'w_o': nrm((L, D_MODEL, D_MODEL), BETA * D_MODEL ** -0.5),
        'ln1_g': 1.0 + nrm((L, D_MODEL), 0.02),
        'ln1_b': nrm((L, D_MODEL), 0.01),
        'router_g': nrm((L, D_MODEL, N_GROUPS), D_MODEL ** -0.5),
        'router_g_b': nrm((L, N_GROUPS), 0.01),
        'router_e': nrm((L, D_MODEL, N_EXPERTS), D_MODEL ** -0.5),
        'router_e_b': nrm((L, N_EXPERTS), 0.01),
        'e_w1': nrm((L, N_EXPERTS, D_MODEL, D_EXPERT), D_MODEL ** -0.5),
        'e_w3': nrm((L, N_EXPERTS, D_MODEL, D_EXPERT), D_MODEL ** -0.5),
        'e_w2': nrm((L, N_EXPERTS, D_EXPERT, D_MODEL), BETA * D_EXPERT ** -0.5),
        'ln2_g': 1.0 + nrm((L, D_MODEL), 0.02),
        'ln2_b': nrm((L, D_MODEL), 0.01),
    }


def reference(x, c, ctx, c_ctx, w_ada, b_ada, w_in, mu_a, w0, w2, a0, a2, g2, k_k, k_a, r_k,
              gn_g, gn_b, conv_w, conv_b, lru_wa, lru_ba, lru_wx, lru_bx, lru_lam,
              p_a, p_b, w_o, ln1_g, ln1_b, router_g, router_g_b, router_e, router_e_b,
              e_w1, e_w3, e_w2, ln2_g, ln2_b):
    b_ = x.shape[0]
    x = layer_norm(x)
    ctx = layer_norm(ctx)
    for l in range(DEPTH):
        mod = jax.nn.silu(c) @ w_ada[l] + b_ada[l]
        sh1, sc1, gt1, sh2, sc2, gt2 = jnp.split(mod[:, None, :], 6, axis=-1)
        mod_c = jax.nn.silu(c_ctx) @ w_ada[l] + b_ada[l]
        csh1, csc1, cgt1, csh2, csc2, cgt2 = jnp.split(mod_c, 6)
        rw = (mu_a[l], w0[l], w2[l], a0[l], a2[l], g2[l], k_k[l], k_a[l], r_k[l], gn_g[l], gn_b[l])
        lru = (conv_w[l], conv_b[l], lru_wa[l], lru_ba[l], lru_wx[l], lru_bx[l], lru_lam[l])
        moe_p = (router_g[l], router_g_b[l], router_e[l], router_e_b[l], e_w1[l], e_w3[l], e_w2[l])
        s0 = jnp.zeros((b_, A_HEADS, A_HEAD_DIM, A_HEAD_DIM), x.dtype)
        h0 = jnp.zeros((b_, D_B), x.dtype)
        mix_c, ctx_states = token_mix(ctx * (1.0 + csc1) + csh1, seq_shift, w_in[l], p_a[l], p_b[l], w_o[l],
                                      rw, lru, (s0, s0, h0, h0))
        mix_x, _ = token_mix(x * (1.0 + sc1) + sh1, grid_shift, w_in[l], p_a[l], p_b[l], w_o[l],
                             rw, lru, ctx_states)
        x = layer_norm(ALPHA * x + gt1 * mix_x, ln1_g[l], ln1_b[l])
        x = layer_norm(ALPHA * x + gt2 * hier_moe(x * (1.0 + sc2) + sh2, *moe_p), ln2_g[l], ln2_b[l])
        if l < DEPTH - 1:
            ctx = layer_norm(ALPHA * ctx + cgt1 * mix_c, ln1_g[l], ln1_b[l])
            ctx = layer_norm(ALPHA * ctx + cgt2 * hier_moe(ctx * (1.0 + csc2) + csh2, *moe_p),
                             ln2_g[l], ln2_b[l])
    return x
```

```cpp
#include <hip/hip_runtime.h>
#include <cstdio>
#include <cstdint>
namespace pg8 {
#define PG8_LAS __attribute__((address_space(3)))
typedef unsigned short bf16_t;
typedef short bf16x8 __attribute__((ext_vector_type(8)));
typedef float f32x4 __attribute__((ext_vector_type(4)));
typedef unsigned u32x4 __attribute__((ext_vector_type(4)));
constexpr int BM = 256, BK = 64, HALF = 128, HTB = HALF * BK * 2  , STAGE_BYTES = 8 * HTB, NXCD = 8, WGM = 8;

__host__ __device__ __forceinline__ int lds_byte(int r, int c) { const int st = (r >> 4) * 2 + (c >> 5), rr = r & 15, cc = c & 31, ob = rr * 64 + cc * 2; return st * 1024 + (ob ^ (((ob >> 9) & 1) << 5)); }
__host__ __device__ __forceinline__ void stage_rc(int b, int& R, int& C) { const int st = b / 1024, sb = b % 1024, swz = sb ^ (((sb >> 9) & 1) << 5); R = (st >> 1) * 16 + swz / 64; C = (st & 1) * 32 + (swz % 64) / 2; }
__host__ __device__ __forceinline__ int perm32(int rho) { const int n = rho >> 4, i = rho & 15; return 8 * (i >> 2) + 4 * n + (i & 3); }

struct Unit { int pm, pn; };
struct Gemm { const bf16_t* A; const bf16_t* Bt; int M, N, K; };

struct StaticOrder {
    int nM, nN, nwg, G, c;
    __host__ __device__ void init(int M, int N, int G_, int c_) { nM = M / BM; nN = N / BM; nwg = nM * nN; G = G_; c = c_; }
    __host__ __device__ bool next(int i, Unit& u) const {
        const long L = (long)i * G + c; if (L >= nwg) return false;
        int wgid = (int)L; { const int q = nwg / NXCD, r = nwg % NXCD, xcd = wgid % NXCD, off = wgid / NXCD; wgid = (xcd < r ? xcd * (q + 1) : r * (q + 1) + (xcd - r) * q) + off; }
        const int nig = WGM * nN, gid = wgid / nig, fm = gid * WGM, gsz = (nM - fm) < WGM ? (nM - fm) : WGM;
        u.pm = fm + ((wgid % nig) % gsz); u.pn = (wgid % nig) / gsz; return true;
    }
    __device__ __forceinline__ void a_ready(const Unit&) const {}
    __device__ __forceinline__ void done(const Unit&) const {}
};

__device__ __forceinline__ unsigned cvt_pk_bf16(float lo, float hi) { unsigned r; asm volatile("v_cvt_pk_bf16_f32 %0, %1, %2" : "=v"(r) : "v"(lo), "v"(hi)); return r; }
template <class Epi, class Sched, bool ALIGN_EPI = false, bool SP2 = false>
__device__ __forceinline__ void gemm_phase(PG8_LAS unsigned char* lds, const Gemm g, const Sched& S, const Epi& E) {
    const int tid = threadIdx.x, wid = __builtin_amdgcn_readfirstlane(tid >> 6), lane = tid & 63, wr = wid >> 2, wc = wid & 3, fr = lane & 15, fq = lane >> 4;
    const int K = g.K, nt = K / BK;
    unsigned voffA[2], voffB[2];
#pragma unroll
    for (int i = 0; i < 2; ++i) { int R, C; stage_rc(tid * 16 + i * 8192, R, C); const int Rb = Epi::PERM ? ((R & ~31) + perm32(R & 31)) : R;
        voffA[i] = (unsigned)(R * K + C) * 2u; voffB[i] = (unsigned)(Rb * K + C) * 2u; }
    const size_t kstep = (size_t)(BK * 2);
    const size_t hstep = (size_t)HALF * K * 2;
    const size_t tstep = 2 * hstep;
    const unsigned ldsw = (unsigned)wid * 1024u;
    const int aoff = lds_byte(wr * 64 + fr, fq * 8), boff = lds_byte(wc * 32 + fr, fq * 8);
#define PG8_SA(b, h) (((b) * 2 + (h)) * HTB)
#define PG8_SB(b, h) ((4 + (b) * 2 + (h)) * HTB)
#define PG8_STAGE(bufoff, gbase, voff) do { _Pragma("unroll") for (int _i = 0; _i < 2; ++_i) \
        __builtin_amdgcn_global_load_lds((const unsigned*)((const char*)(gbase) + (voff)[_i]), (PG8_LAS unsigned*)(lds + (bufoff) + ldsw + _i * 8192), 16, 0, 0); } while (0)
#define PG8_LDA(dst, b, h) do { _Pragma("unroll") for (int m = 0; m < 4; ++m) _Pragma("unroll") for (int k = 0; k < 2; ++k) dst[m][k] = *(const PG8_LAS bf16x8*)(lds + PG8_SA(b, h) + aoff + m * 2048 + k * 1024); } while (0)
#define PG8_LDB(dst, b, h) do { _Pragma("unroll") for (int n = 0; n < 2; ++n) _Pragma("unroll") for (int k = 0; k < 2; ++k) dst[n][k] = *(const PG8_LAS bf16x8*)(lds + PG8_SB(b, h) + boff + n * 2048 + k * 1024); } while (0)
#define PG8_MMA(ai, bj, At, Bt) do { __builtin_amdgcn_s_setprio(1); _Pragma("unroll") for (int m = 0; m < 4; ++m) _Pragma("unroll") for (int n = 0; n < 2; ++n) _Pragma("unroll") for (int k = 0; k < 2; ++k) \
        acc[ai][bj][m][n] = __builtin_amdgcn_mfma_f32_16x16x32_bf16(Bt[n][k], At[m][k], acc[ai][bj][m][n], 0, 0, 0); __builtin_amdgcn_s_setprio(0); } while (0)
#define PG8_WAIT_V(n) asm volatile("s_waitcnt vmcnt(" #n ")" ::: "memory")
#define PG8_WAIT_L(n) asm volatile("s_waitcnt lgkmcnt(" #n ")" ::: "memory")
#define PG8_BAR __builtin_amdgcn_s_barrier()
#define PG8_SCHED __builtin_amdgcn_sched_barrier(0)
    Unit cur, nxt; int ui = 0;
    if (!S.next(0, cur)) return;
    f32x4 acc[2][2][4][2];
#pragma unroll
    for (int a = 0; a < 2; ++a)
#pragma unroll
        for (int b = 0; b < 2; ++b)
#pragma unroll
            for (int m = 0; m < 4; ++m)
#pragma unroll
                for (int n = 0; n < 2; ++n) acc[a][b][m][n] = (f32x4){0.f, 0.f, 0.f, 0.f};
    bf16x8 At[4][2], B0[2][2], B1[2][2];
    const char* cA = (const char*)g.A + (size_t)cur.pm * tstep; const char* cB = (const char*)g.Bt + (size_t)cur.pn * tstep;
    S.a_ready(cur);
    if constexpr (SP2) {
        PG8_STAGE(PG8_SB(0, 0), cB, voffB); PG8_STAGE(PG8_SB(0, 1), cB + hstep, voffB); PG8_STAGE(PG8_SA(0, 0), cA, voffA); PG8_STAGE(PG8_SA(0, 1), cA + hstep, voffA);
        if (wr == 1) PG8_BAR;
        PG8_WAIT_V(2); PG8_BAR;
        PG8_STAGE(PG8_SB(1, 0), cB + kstep, voffB); PG8_STAGE(PG8_SA(1, 0), cA + kstep, voffA); PG8_STAGE(PG8_SB(1, 1), cB + hstep + kstep, voffB);
        PG8_WAIT_V(6); PG8_BAR;
    } else {
        PG8_STAGE(PG8_SB(0, 0), cB, voffB); PG8_STAGE(PG8_SA(0, 0), cA, voffA); PG8_STAGE(PG8_SB(0, 1), cB + hstep, voffB); PG8_STAGE(PG8_SA(0, 1), cA + hstep, voffA);
        if (wr == 1) PG8_BAR;
        PG8_WAIT_V(4); PG8_BAR;
        PG8_STAGE(PG8_SB(1, 0), cB + kstep, voffB); PG8_STAGE(PG8_SA(1, 0), cA + kstep, voffA); PG8_STAGE(PG8_SB(1, 1), cB + hstep + kstep, voffB);
        PG8_WAIT_V(6); PG8_BAR;
    }
    for (;;) {
        const bool has_next = S.next(ui + 1, nxt);
        const char* nA = has_next ? (const char*)g.A + (size_t)nxt.pm * tstep : cA; const char* nB = has_next ? (const char*)g.Bt + (size_t)nxt.pn * tstep : cB;
        for (int t = 0; t < nt; t += 2) {
            const bool last = (t == nt - 2);
            const char* a1 = cA + (size_t)(t + 1) * kstep;
            const char* a2 = last ? nA : cA + (size_t)(t + 2) * kstep; const char* b2 = last ? nB : cB + (size_t)(t + 2) * kstep;
            const char* a3 = a2 + kstep; const char* b3 = b2 + kstep;
            if (last && has_next) S.a_ready(nxt);
            if constexpr (SP2) {
            PG8_LDB(B0, 0, 0); PG8_LDB(B1, 0, 1); PG8_SCHED; PG8_LDA(At, 0, 0); PG8_STAGE(PG8_SA(1, 1), a1 + hstep, voffA);
            PG8_WAIT_V(8); PG8_WAIT_L(0); PG8_BAR; PG8_MMA(0, 0, At, B0); PG8_MMA(0, 1, At, B1); PG8_BAR; PG8_SCHED;
            PG8_LDA(At, 0, 1); PG8_STAGE(PG8_SB(0, 0), b2, voffB); PG8_STAGE(PG8_SB(0, 1), b2 + hstep, voffB); PG8_STAGE(PG8_SA(0, 0), a2, voffA);
            PG8_WAIT_V(8); PG8_WAIT_L(0); PG8_BAR; PG8_MMA(1, 0, At, B0); PG8_MMA(1, 1, At, B1); PG8_BAR; PG8_SCHED;
            PG8_LDB(B0, 1, 0); PG8_LDB(B1, 1, 1); PG8_SCHED; PG8_LDA(At, 1, 0); PG8_STAGE(PG8_SA(0, 1), a2 + hstep, voffA);
            PG8_WAIT_V(8); PG8_WAIT_L(0); PG8_BAR; PG8_MMA(0, 0, At, B0); PG8_MMA(0, 1, At, B1); PG8_BAR; PG8_SCHED;
            PG8_LDA(At, 1, 1); PG8_STAGE(PG8_SB(1, 0), b3, voffB); PG8_STAGE(PG8_SB(1, 1), b3 + hstep, voffB); PG8_STAGE(PG8_SA(1, 0), a3, voffA);
            PG8_WAIT_V(8); PG8_WAIT_L(0); PG8_BAR; PG8_MMA(1, 0, At, B0); PG8_MMA(1, 1, At, B1); PG8_BAR; PG8_SCHED;
            } else {
            PG8_LDB(B0, 0, 0); PG8_SCHED; PG8_LDA(At, 0, 0); PG8_STAGE(PG8_SA(1, 1), a1 + hstep, voffA);
            PG8_WAIT_L(8); PG8_BAR; PG8_WAIT_L(0); PG8_MMA(0, 0, At, B0); PG8_BAR; PG8_SCHED;
            PG8_LDB(B1, 0, 1); PG8_STAGE(PG8_SB(0, 0), b2, voffB);
            PG8_BAR; PG8_WAIT_L(0); PG8_MMA(0, 1, At, B1); PG8_BAR;
            PG8_LDA(At, 0, 1); PG8_STAGE(PG8_SA(0, 0), a2, voffA);
            PG8_BAR; PG8_WAIT_L(0); PG8_MMA(1, 0, At, B0); PG8_BAR; PG8_SCHED;
            PG8_STAGE(PG8_SB(0, 1), b2 + hstep, voffB);
            PG8_WAIT_V(6); PG8_BAR; PG8_MMA(1, 1, At, B1); PG8_BAR;
            PG8_LDB(B0, 1, 0); PG8_SCHED; PG8_LDA(At, 1, 0); PG8_STAGE(PG8_SA(0, 1), a2 + hstep, voffA);
            PG8_WAIT_L(8); PG8_BAR; PG8_WAIT_L(0); PG8_MMA(0, 0, At, B0); PG8_BAR; PG8_SCHED;
            PG8_LDB(B1, 1, 1); PG8_STAGE(PG8_SB(1, 0), b3, voffB);
            PG8_BAR; PG8_WAIT_L(0); PG8_MMA(0, 1, At, B1); PG8_BAR;
            PG8_LDA(At, 1, 1); PG8_STAGE(PG8_SA(1, 0), a3, voffA);
            PG8_BAR; PG8_WAIT_L(0); PG8_MMA(1, 0, At, B0); PG8_BAR; PG8_SCHED;
            PG8_STAGE(PG8_SB(1, 1), b3 + hstep, voffB);
            PG8_WAIT_V(6); PG8_BAR; PG8_MMA(1, 1, At, B1); PG8_BAR;
            }
        }
        if constexpr (ALIGN_EPI) { if (wr == 0) PG8_BAR; }
        if constexpr (!Epi::AFTER_DRAIN) { E(acc, cur, wr, wc, fr, fq); S.done(cur); }
        if (!has_next) break;
#pragma unroll
        for (int a = 0; a < 2; ++a)
#pragma unroll
            for (int b = 0; b < 2; ++b)
#pragma unroll
                for (int m = 0; m < 4; ++m)
#pragma unroll
                    for (int n = 0; n < 2; ++n) acc[a][b][m][n] = (f32x4){0.f, 0.f, 0.f, 0.f};
        cur = nxt; cA = nA; cB = nB; ++ui;
        if constexpr (ALIGN_EPI) { if (wr == 1) PG8_BAR; }
    }
    PG8_WAIT_V(0);
    if constexpr (!ALIGN_EPI) { if (wr == 0) PG8_BAR; }
    PG8_BAR;
    if constexpr (Epi::AFTER_DRAIN) { E.fused(acc, cur, wr, wc, fr, fq, lds, wid, lane); S.done(cur); }
#undef PG8_SA
#undef PG8_SB
#undef PG8_STAGE
#undef PG8_LDA
#undef PG8_LDB
#undef PG8_MMA
#undef PG8_WAIT_V
#undef PG8_WAIT_L
#undef PG8_BAR
#undef PG8_SCHED
}
}

#ifndef ONE_LAUNCH
#define ONE_LAUNCH 0
#endif
constexpr int NWAVES = 8, NTHR = 512;
constexpr int D = 1024, BATCH = 2, SEQ = 8192, CTXL = 256, GRIDW = 64;
constexpr int MX = BATCH * SEQ, MC = BATCH * CTXL, MALL = MX + MC;
constexpr int NCH = 132;
constexpr int NSLAB = 5632;
constexpr int C_R = 0, C_K = 1024, C_V = 2048, C_WD = 3072, C_AD = 3136, C_GD = 3200, C_XB = 3584, C_GBR = 4608;
constexpr int NWIN = 7680;
constexpr int NEXP = 32, DEXP = 512, MAXT = 160;
constexpr float LN_EPS = 1e-5f, GN_EPS = 64e-5f;
constexpr float ALPHA = 1.189207115002721f;
constexpr size_t MiB = 1u << 20;
constexpr size_t WS_CTL = 0, CTL_ZERO_BYTES = 1 * MiB;
constexpr size_t WS_STATS = 1 * MiB, WS_TOKE = 1 * MiB + 256 * 1024, WS_TOKSLOT = 1 * MiB + 512 * 1024, WS_TOKW = 1 * MiB + 768 * 1024, WS_ROWW = 2 * MiB;
constexpr size_t WS_S2T = 3 * MiB, WS_AGGA = 5 * MiB, WS_AGGH = 7 * MiB + 256 * 1024, WS_CIN = 9 * MiB + 512 * 1024;
constexpr size_t WS_PW = 16 * MiB;
constexpr size_t WS_SLAB = 22 * MiB;
constexpr size_t WS_YLRU = 204 * MiB, WS_YWF = 236 * MiB, WS_YWB = 268 * MiB;
constexpr size_t WS_GATES = 22 * MiB;
constexpr size_t WS_MBUF = 86 * MiB;
constexpr size_t WS_W13 = 118 * MiB, WS_W2 = 182 * MiB;
constexpr size_t WS_H2 = 214 * MiB;
constexpr size_t WS_XS = 22 * MiB;
constexpr size_t WS_HBUF = 247 * MiB;
constexpr size_t WS_END = 300 * MiB;
constexpr size_t DO_H = 0, DO_WIN = 34 * MiB;
constexpr int CW_TMO = 0, CW_BAR = 4096, CW_MOD = 8192  , CW_ECNT = 32768  ;
constexpr int LDS_BYTES = 155648;
constexpr int MISC_OFF = LDS_BYTES - 1024;
constexpr int TILE_OFF = MISC_OFF - 2048;

#define GAS __attribute__((address_space(1)))
#define LAS __attribute__((address_space(3)))
typedef unsigned short bf16;
typedef unsigned v4u __attribute__((ext_vector_type(4)));
typedef unsigned v2u __attribute__((ext_vector_type(2)));
typedef float f32x4 __attribute__((ext_vector_type(4)));
typedef GAS unsigned gu32;
#define RLX_AGENT __ATOMIC_RELAXED, __HIP_MEMORY_SCOPE_AGENT
#define LDS_WAIT() asm volatile("s_waitcnt lgkmcnt(0)" ::: "memory")
#define VM_WAIT() asm volatile("s_waitcnt vmcnt(0)" ::: "memory")
#define DI __device__ __forceinline__
DI unsigned f2bf(float f) { unsigned u = __builtin_bit_cast(unsigned, f); return (u + 0x7fffu + ((u >> 16) & 1u)) >> 16; }
DI unsigned pk2(float lo, float hi) { return f2bf(lo) | (f2bf(hi) << 16); }
DI float bf2f(unsigned short b) { return __builtin_bit_cast(float, ((unsigned)b) << 16); }
DI float bflo(unsigned w) { return __builtin_bit_cast(float, w << 16); }
DI float bfhi(unsigned w) { return __builtin_bit_cast(float, w & 0xffff0000u); }
DI float sigm(float x) { return 1.f / (1.f + __expf(-x)); }
DI float wave_sum(float v) {
#pragma unroll
    for (int o = 1; o < 64; o <<= 1) v += __shfl_xor(v, o);
    return v;
}

#define XB_TMO      128
#define XB_XCNT(j)  (256  + 64 * (j))
#define XB_XSUB(j)  (1280 + 64 * (j))
#define XB_XGEN(j)  (2304 + 64 * (j))
#define XB_TOP      3328
#define XB_TOPGEN   3392
#define XCD_BAR_WORDS 3456
#define XB_SPIN_CAP (1u << 18)

__device__ __forceinline__ unsigned xb_ld(unsigned* p)              { return __hip_atomic_load(p, __ATOMIC_RELAXED, __HIP_MEMORY_SCOPE_AGENT); }
__device__ __forceinline__ unsigned xb_add(unsigned* p, unsigned v) { return __hip_atomic_fetch_add(p, v, __ATOMIC_RELAXED, __HIP_MEMORY_SCOPE_AGENT); }
__device__ __forceinline__ unsigned xb_xcc_id() { return (unsigned)__builtin_amdgcn_s_getreg((3 << 11) | 20) & 0xFu; }
#define XB_SPIN(cond, bar) do { unsigned _sp = 0; while (cond) { __builtin_amdgcn_s_sleep(1); \
    if ((++_sp & 255u) == 0u) { if (xb_ld(&(bar)[XB_TMO])) break; if (_sp > XB_SPIN_CAP) { atomicAdd(&(bar)[XB_TMO], 1u); break; } } } } while (0)

struct XcdBarrier {
    unsigned* bar; unsigned x;
    volatile LAS unsigned* st;
};

__device__ __forceinline__ XcdBarrier xcd_barrier_post(unsigned* bar, volatile LAS unsigned* st) {
    XcdBarrier b; b.bar = bar; b.x = xb_xcc_id(); b.st = st;
    if (threadIdx.x == 0) (void)xb_add(&bar[XB_XCNT(b.x)], 1u);
    return b;
}
__device__ __forceinline__ void xcd_barrier_complete(unsigned* bar, unsigned x, unsigned& nloc, unsigned& nx) {
    const unsigned G = gridDim.x * gridDim.y * gridDim.z;
    unsigned sum, cnt, mine, sp = 0u;
    for (;;) {
        sum = 0u; cnt = 0u; mine = 0u;
#pragma unroll
        for (unsigned j = 0; j < 16; ++j) { const unsigned c = xb_ld(&bar[XB_XCNT(j)]); sum += c; cnt += (c > 0u) ? 1u : 0u; mine = (j == x) ? c : mine; }
        if (sum == G) break;
        __builtin_amdgcn_s_sleep(1);
        if ((++sp & 255u) == 0u) { if (xb_ld(&bar[XB_TMO])) break; if (sp > XB_SPIN_CAP) { atomicAdd(&bar[XB_TMO], 1u); break; } }
    }
    nloc = mine > 0u ? mine : 1u; nx = cnt > 0u ? cnt : 1u;
}

__device__ __forceinline__ void xcd_barrier(const XcdBarrier& b) {
    asm volatile("s_waitcnt vmcnt(0)" ::: "memory");
    __syncthreads();
    if (threadIdx.x == 0) {
        unsigned* bar = b.bar;
        __builtin_amdgcn_s_waitcnt(0);
        unsigned nloc = b.st[0], nx = b.st[1];
        if (nloc == 0u) { xcd_barrier_complete(bar, b.x, nloc, nx); b.st[0] = nloc; b.st[1] = nx; }
        const unsigned old = xb_add(&bar[XB_XSUB(b.x)], 1u);
        const unsigned gen = old / nloc;
        if (old + 1u == (gen + 1u) * nloc) {
            __builtin_amdgcn_fence(__ATOMIC_RELEASE, "agent");
            asm volatile("s_waitcnt vmcnt(0)" ::: "memory");
            const unsigned og = xb_add(&bar[XB_TOP], 1u);
            const unsigned tg = og / nx;
            if (og + 1u == (tg + 1u) * nx) xb_add(&bar[XB_TOPGEN], 1u);
            else XB_SPIN(xb_ld(&bar[XB_TOPGEN]) == tg, bar);
            __builtin_amdgcn_fence(__ATOMIC_ACQUIRE, "agent");
            xb_add(&bar[XB_XGEN(b.x)], 1u);
            asm volatile("s_waitcnt vmcnt(0)" ::: "memory");
        } else {
            XB_SPIN(xb_ld(&bar[XB_XGEN(b.x)]) == gen, bar);
            __builtin_amdgcn_fence(__ATOMIC_ACQUIRE, "agent");
            asm volatile("s_waitcnt vmcnt(0)" ::: "memory");
        }
    }
    __syncthreads();
}

struct Args { const float* in[39]; float* out; unsigned char* ws; int ph_lo, ph_hi; };

struct P {
    const float *x, *c, *ctx, *c_ctx, *w_ada, *b_ada, *w_in, *mu_a, *w0, *w2, *a0, *a2, *g2, *k_k, *k_a, *r_k, *gn_g, *gn_b, *conv_w, *conv_b,
        *lru_wa, *lru_ba, *lru_wx, *lru_bx, *lru_lam, *p_a, *p_b, *w_o, *ln1_g, *ln1_b, *router_g, *router_g_b, *router_e, *router_e_b, *e_w1, *e_w3, *e_w2, *ln2_g, *ln2_b;
    float* out; unsigned char* ws; unsigned char* dob;
    float* ctlf; unsigned* ctl;
};

DI float modv(const P& p, int v, int n) { return p.ctlf[CW_MOD + v * 6144 + n] + p.b_ada[n]; }

DI void transpose_item(const float* W, int ldw, bf16* WT, int ldt, int k0, int n0, int drow0, LAS float* scr, int lane) {
#pragma unroll 8
    for (int i = 0; i < 32; ++i) { const int kk = 2 * i + (lane >> 5); scr[kk * 33 + (lane & 31)] = W[(size_t)(k0 + kk) * ldw + n0 + (lane & 31)]; }
    LDS_WAIT(); asm volatile("" ::: "memory");
    const int c = lane & 7;
#pragma unroll
    for (int j = 0; j < 4; ++j) { const int n = (lane >> 3) + 8 * j; const LAS float* s = scr + (8 * c) * 33 + n;
        v4u o; o.x = pk2(s[0 * 33], s[1 * 33]); o.y = pk2(s[2 * 33], s[3 * 33]); o.z = pk2(s[4 * 33], s[5 * 33]); o.w = pk2(s[6 * 33], s[7 * 33]);
        *(GAS v4u*)(WT + (size_t)(drow0 + n) * ldt + k0 + 8 * c) = o; }
    LDS_WAIT(); asm volatile("" ::: "memory");
}

DI void phase0(const P& p, LAS unsigned char* lds, int tid, int lane, int wave, int G) {
    LAS float* s3 = (LAS float*)lds;
    for (int item = blockIdx.x; item < 256; item += G) {
        const int kc = item >> 4, nc = item & 15;
        if (tid < 192) { const int v = tid >> 6, k = tid & 63; const float cv = (v < 2) ? p.c[v * D + kc * 64 + k] : p.c_ctx[kc * 64 + k]; s3[v * 64 + k] = cv * sigm(cv); }
        __syncthreads();
        if (tid < 384) { const int n = nc * 384 + tid; float a0 = 0.f, a1 = 0.f, a2 = 0.f;
            for (int k = 0; k < 64; ++k) { const float w = p.w_ada[(size_t)(kc * 64 + k) * 6144 + n]; a0 += s3[k] * w; a1 += s3[64 + k] * w; a2 += s3[128 + k] * w; }
            atomicAdd(p.ctlf + CW_MOD + n, a0); atomicAdd(p.ctlf + CW_MOD + 6144 + n, a1); atomicAdd(p.ctlf + CW_MOD + 2 * 6144 + n, a2); }
        __syncthreads();
    }
    LAS float* scr = (LAS float*)(lds + 4096 + wave * 16384);
    const int gw = blockIdx.x * NWAVES + wave, NGW = G * NWAVES;
    bf16* win_t = (bf16*)(p.dob + DO_WIN); bf16* pw = (bf16*)(p.ws + WS_PW);
    constexpr int I_IN = 16 * 233, I_P = 16 * 32;
    for (int it = gw; it < I_IN + 3 * I_P; it += NGW) {
        int r = it;
        if (r < I_IN) { const int kb = r / 233, nb = r % 233, n0 = nb * 32; transpose_item(p.w_in, 7456, win_t, D, kb * 64, n0, n0 + (n0 >= 3360 ? 224 : 0), scr, lane); continue; }
        r -= I_IN; const int wsel = r / I_P; r %= I_P; const int kb = r / 32, nb = r % 32;
        if (wsel == 0) transpose_item(p.p_a, D, pw, D, kb * 64, nb * 32, nb * 32, scr, lane);
        else if (wsel == 1) transpose_item(p.p_b, D, pw + (size_t)D * D, D, kb * 64, nb * 32, nb * 32, scr, lane);
        else transpose_item(p.w_o, D, pw + (size_t)2 * D * D, D, kb * 64, nb * 32, nb * 32, scr, lane);
    }
    for (int i = blockIdx.x * NTHR + tid; i < 224 * D / 8; i += G * NTHR) ((GAS v4u*)(win_t + (size_t)3360 * D))[i] = (v4u){0u, 0u, 0u, 0u};
}

DI void phase1(const P& p, int lane, int wave, int G) {
    const int gw = blockIdx.x * NWAVES + wave, NGW = G * NWAVES;
    bf16* H = (bf16*)(p.dob + DO_H); float* stats = (float*)(p.ws + WS_STATS);
    for (int m = gw; m < MALL; m += NGW) {
        const float* xrow = (m < MX) ? p.x + (size_t)m * D : p.ctx + (size_t)(m - MX) * D;
        const int v = (m < MX) ? (m >> 13) : 2;
        const GAS f32x4* xr = (const GAS f32x4*)xrow + lane;
        f32x4 q[4]; float s = 0.f;
#pragma unroll
        for (int j = 0; j < 4; ++j) { q[j] = xr[64 * j]; s += (q[j].x + q[j].y) + (q[j].z + q[j].w); }
        const float mean = wave_sum(s) * (1.f / D); float s2 = 0.f;
#pragma unroll
        for (int j = 0; j < 4; ++j) { q[j] = q[j] - mean; s2 += (q[j].x * q[j].x + q[j].y * q[j].y) + (q[j].z * q[j].z + q[j].w * q[j].w); }
        const float rstd = 1.f / sqrtf(wave_sum(s2) * (1.f / D) + LN_EPS);
        if (lane == 0) { stats[2 * m] = mean; stats[2 * m + 1] = rstd; }
        GAS v2u* o8 = (GAS v2u*)(H + (size_t)m * D) + lane;
#pragma unroll
        for (int j = 0; j < 4; ++j) { const int n = 256 * j + 4 * lane; float h[4];
#pragma unroll
            for (int i = 0; i < 4; ++i) h[i] = q[j][i] * rstd * (1.f + modv(p, v, 1024 + n + i)) + modv(p, v, n + i);
            o8[64 * j] = (v2u){pk2(h[0], h[1]), pk2(h[2], h[3])}; }
    }
}

template <int ACT> struct EpiPlain {
    static constexpr bool PERM = true, AFTER_DRAIN = false;
    bf16* O; int ldc;
    DI void operator()(const pg8::f32x4 (&acc)[2][2][4][2], const pg8::Unit& u, int wr, int wc, int fr, int fq) const {
        const int row0 = u.pm * 256 + wr * 64 + fr, col0 = u.pn * 256 + wc * 32 + 8 * fq;
#pragma unroll
        for (int ai = 0; ai < 2; ++ai)
#pragma unroll
            for (int m = 0; m < 4; ++m) { bf16* rowp = O + (size_t)(row0 + ai * 128 + m * 16) * ldc + col0;
#pragma unroll
                for (int bj = 0; bj < 2; ++bj) { pg8::f32x4 v0 = acc[ai][bj][m][0], v1 = acc[ai][bj][m][1];
                    if (ACT == 1) {
#pragma unroll
                        for (int i = 0; i < 4; ++i) { v0[i] = sigm(v0[i]); v1[i] = sigm(v1[i]); } }
                    pg8::u32x4 w; w.x = pg8::cvt_pk_bf16(v0[0], v0[1]); w.y = pg8::cvt_pk_bf16(v0[2], v0[3]); w.z = pg8::cvt_pk_bf16(v1[0], v1[1]); w.w = pg8::cvt_pk_bf16(v1[2], v1[3]);
                    *(pg8::u32x4*)(rowp + bj * 128) = w; } }
    }
};
struct EpiMix {
    static constexpr bool PERM = true, AFTER_DRAIN = false;
    const bf16* gates; bf16* mbuf;
    DI void operator()(const pg8::f32x4 (&acc)[2][2][4][2], const pg8::Unit& u, int wr, int wc, int fr, int fq) const {
        const bool isa = u.pm >= 64; const int row0 = (u.pm & 63) * 256 + wr * 64 + fr, col0 = (u.pn & 3) * 256 + wc * 32 + 8 * fq;
#pragma unroll
        for (int ai = 0; ai < 2; ++ai)
#pragma unroll
            for (int m = 0; m < 4; ++m) { const int row = row0 + ai * 128 + m * 16;
#pragma unroll
                for (int bj = 0; bj < 2; ++bj) { const int col = col0 + bj * 128;
                    const pg8::u32x4 gw = *(const pg8::u32x4*)(gates + (size_t)row * 2048 + (isa ? 0 : 1024) + col);
                    bf16* mp = mbuf + (size_t)row * D + col;
                    pg8::u32x4 old = (pg8::u32x4){0u, 0u, 0u, 0u}; if (isa) old = *(const pg8::u32x4*)mp;
                    const pg8::f32x4 v0 = acc[ai][bj][m][0], v1 = acc[ai][bj][m][1];
                    float r[8];
                    r[0] = v0[0] * bflo(gw.x) + bflo(old.x); r[1] = v0[1] * bfhi(gw.x) + bfhi(old.x); r[2] = v0[2] * bflo(gw.y) + bflo(old.y); r[3] = v0[3] * bfhi(gw.y) + bfhi(old.y);
                    r[4] = v1[0] * bflo(gw.z) + bflo(old.z); r[5] = v1[1] * bfhi(gw.z) + bfhi(old.z); r[6] = v1[2] * bflo(gw.w) + bflo(old.w); r[7] = v1[3] * bfhi(gw.w) + bfhi(old.w);
                    pg8::u32x4 w; w.x = pg8::cvt_pk_bf16(r[0], r[1]); w.y = pg8::cvt_pk_bf16(r[2], r[3]); w.z = pg8::cvt_pk_bf16(r[4], r[5]); w.w = pg8::cvt_pk_bf16(r[6], r[7]);
                    *(pg8::u32x4*)mp = w; } }
    }
};
struct EpiT1 {
    static constexpr bool PERM = false, AFTER_DRAIN = false;
    const float* x; const float* stats; const float* modp; const float* b_ada; float* T1;
    DI void operator()(const pg8::f32x4 (&acc)[2][2][4][2], const pg8::Unit& u, int wr, int wc, int fr, int fq) const {
        const int row0 = u.pm * 256 + wr * 64 + fr, col0 = u.pn * 256 + wc * 32 + 4 * fq; const int b = (u.pm * 256) >> 13;
        pg8::f32x4 gt[2][2];
#pragma unroll
        for (int bj = 0; bj < 2; ++bj)
#pragma unroll
            for (int n = 0; n < 2; ++n) { const int c = col0 + bj * 128 + n * 16; gt[bj][n] = *(const pg8::f32x4*)(modp + b * 6144 + 2048 + c) + *(const pg8::f32x4*)(b_ada + 2048 + c); }
#pragma unroll
        for (int ai = 0; ai < 2; ++ai)
#pragma unroll
            for (int m = 0; m < 4; ++m) { const int row = row0 + ai * 128 + m * 16; const float mean = stats[2 * row], rstd = stats[2 * row + 1];
#pragma unroll
                for (int bj = 0; bj < 2; ++bj)
#pragma unroll
                    for (int n = 0; n < 2; ++n) { const size_t o = (size_t)row * D + col0 + bj * 128 + n * 16;
                        const pg8::f32x4 xv = *(const pg8::f32x4*)(x + o);
                        *(pg8::f32x4*)(T1 + o) = (xv - mean) * (rstd * ALPHA) + gt[bj][n] * acc[ai][bj][m][n]; } }
    }
};
struct EpiSwiGLU {
    static constexpr bool PERM = true, AFTER_DRAIN = false;
    bf16* hb;
    DI void operator()(const pg8::f32x4 (&acc)[2][2][4][2], const pg8::Unit& u, int wr, int wc, int fr, int fq) const {
        const int row0 = u.pm * 256 + wr * 64 + fr, col0 = (u.pn & 3) * 128 + wc * 32 + 8 * fq;
#pragma unroll
        for (int ai = 0; ai < 2; ++ai)
#pragma unroll
            for (int m = 0; m < 4; ++m) { float r[8];
#pragma unroll
                for (int n = 0; n < 2; ++n)
#pragma unroll
                    for (int i = 0; i < 4; ++i) { const float a = acc[ai][0][m][n][i], b = acc[ai][1][m][n][i]; r[4 * n + i] = a * sigm(a) * b; }
                pg8::u32x4 w; w.x = pg8::cvt_pk_bf16(r[0], r[1]); w.y = pg8::cvt_pk_bf16(r[2], r[3]); w.z = pg8::cvt_pk_bf16(r[4], r[5]); w.w = pg8::cvt_pk_bf16(r[6], r[7]);
                *(pg8::u32x4*)(hb + (size_t)(row0 + ai * 128 + m * 16) * DEXP + col0) = w; }
    }
};
struct EpiW2 {
    static constexpr bool PERM = true, AFTER_DRAIN = false;
    bf16* yb; const float* roww;
    DI void operator()(const pg8::f32x4 (&acc)[2][2][4][2], const pg8::Unit& u, int wr, int wc, int fr, int fq) const {
        const int row0 = u.pm * 256 + wr * 64 + fr, col0 = (u.pn & 3) * 256 + wc * 32 + 8 * fq;
#pragma unroll
        for (int ai = 0; ai < 2; ++ai)
#pragma unroll
            for (int m = 0; m < 4; ++m) { const int row = row0 + ai * 128 + m * 16; const float rw = roww[row];
#pragma unroll
                for (int bj = 0; bj < 2; ++bj) { const pg8::f32x4 v0 = acc[ai][bj][m][0] * rw, v1 = acc[ai][bj][m][1] * rw;
                    pg8::u32x4 w; w.x = pg8::cvt_pk_bf16(v0[0], v0[1]); w.y = pg8::cvt_pk_bf16(v0[2], v0[3]); w.z = pg8::cvt_pk_bf16(v1[0], v1[1]); w.w = pg8::cvt_pk_bf16(v1[2], v1[3]);
                    *(pg8::u32x4*)(yb + (size_t)row * D + col0 + bj * 128) = w; } }
    }
};
struct SchedMix : pg8::StaticOrder {
    __device__ bool next(int i, pg8::Unit& u) const { pg8::Unit t; if (!pg8::StaticOrder::next(i >> 1, t)) return false; const int w = i & 1; u.pm = t.pm + w * 64; u.pn = w ? t.pn : t.pn + 4; return true; }
};
struct SchedMoE {
    const LAS int* tile; int G, c;
    __device__ bool next(int i, pg8::Unit& u) const { const int L = i * G + c; const int NT = tile[MAXT + 40]; if (L >= NT * 4) return false; const int T = L >> 2; u.pm = T; u.pn = tile[T] * 4 + (L & 3); return true; }
    DI void a_ready(const pg8::Unit&) const {}
    DI void done(const pg8::Unit&) const {}
};

DI int chunk_row0(int b, int ci) { return ci < 4 ? MX + b * CTXL + ci * 64 : b * SEQ + (ci - 4) * 64; }
DI float mixval(const bf16* S, const float* mu, int b, int ci, int j, int c) {
    const int row = chunk_row0(b, ci) + j; const bf16* sp = S + (size_t)row * NSLAB + c; const float own = bf2f(*sp); float nb = 0.f;
    if (ci >= 4) { const int gr = ci - 4, m = c & 3;
        if (m == 0) { if (j > 0) nb = bf2f(sp[-NSLAB]); } else if (m == 1) { if (j < 63) nb = bf2f(sp[NSLAB]); }
        else if (m == 2) { if (gr > 0) nb = bf2f(sp[-(ptrdiff_t)64 * NSLAB]); } else { if (gr < 127) nb = bf2f(sp[(ptrdiff_t)64 * NSLAB]); } }
    else { const int t = ci * 64 + j; if ((c & 1) == 0) { if (t > 0) nb = bf2f(sp[-NSLAB]); } else { if (t < CTXL - 1) nb = bf2f(sp[NSLAB]); } }
    return own + mu[c] * (nb - own);
}

DI float gelu_tanh(float x) { const float u = 0.7978845608028654f * (x + 0.044715f * x * x * x); const float t = 1.f - 2.f / (1.f + __expf(2.f * u)); return 0.5f * x * (1.f + t); }
template <int PASS> DI void lru_unit(const P& p, LAS unsigned char* lds, int tid, int b, int ci, int hb) {
    const bf16* S = (const bf16*)(p.ws + WS_SLAB);
    LAS float* XB = (LAS float*)lds;
    LAS float* XC = (LAS float*)(lds + 17408);
    LAS float* AA = (LAS float*)(lds + 33792);
    LAS float* UU = (LAS float*)(lds + 66560);
    const int row0 = chunk_row0(b, ci); const int t0 = ci < 4 ? ci * 64 : (ci - 4) * 64, tlen = ci < 4 ? CTXL : SEQ;
    for (int e = tid; e < 68 * 64; e += NTHR) { const int jj = e >> 6, ch = e & 63, t = t0 + jj - 2;
        XB[e] = (t >= 0 && t < tlen) ? bf2f(S[(size_t)(row0 + jj - 2) * NSLAB + C_XB + hb * 64 + ch]) : 0.f; }
    __syncthreads();
    for (int e = tid; e < 64 * 64; e += NTHR) { const int j = e >> 6, ch = e & 63, c = hb * 64 + ch; float a = p.conv_b[c];
#pragma unroll
        for (int i = 0; i < 5; ++i) a += p.conv_w[i * D + c] * XB[(j + i) * 64 + ch];
        XC[e] = a; }
    __syncthreads();
    { const int j = tid >> 3, ng = tid & 7; float acc[4][8];
#pragma unroll
        for (int q = 0; q < 4; ++q)
#pragma unroll
            for (int i = 0; i < 8; ++i) acc[q][i] = 0.f;
        const float* w0p = p.lru_wa + (size_t)(0 * 16 + hb) * 4096 + ng * 8; const float* w1p = p.lru_wa + (size_t)(1 * 16 + hb) * 4096 + ng * 8;
        const float* w2p = p.lru_wx + (size_t)(0 * 16 + hb) * 4096 + ng * 8; const float* w3p = p.lru_wx + (size_t)(1 * 16 + hb) * 4096 + ng * 8;
#pragma unroll 2
        for (int i = 0; i < 64; ++i) { const float xv = XC[j * 64 + i];
            const f32x4 a0 = *(const f32x4*)(w0p + i * 64), a1 = *(const f32x4*)(w0p + i * 64 + 4), b0 = *(const f32x4*)(w1p + i * 64), b1 = *(const f32x4*)(w1p + i * 64 + 4);
            const f32x4 c0 = *(const f32x4*)(w2p + i * 64), c1 = *(const f32x4*)(w2p + i * 64 + 4), d0 = *(const f32x4*)(w3p + i * 64), d1 = *(const f32x4*)(w3p + i * 64 + 4);
#pragma unroll
            for (int k = 0; k < 4; ++k) { acc[0][k] += xv * a0[k]; acc[0][4 + k] += xv * a1[k]; acc[1][k] += xv * b0[k]; acc[1][4 + k] += xv * b1[k];
                acc[2][k] += xv * c0[k]; acc[2][4 + k] += xv * c1[k]; acc[3][k] += xv * d0[k]; acc[3][4 + k] += xv * d1[k]; } }
#pragma unroll
        for (int e = 0; e < 2; ++e)
#pragma unroll
            for (int i = 0; i < 8; ++i) { const int ch = ng * 8 + i, c = hb * 64 + ch;
                const float rg = sigm(acc[e][i] + p.lru_ba[e * D + c]), ig = sigm(acc[2 + e][i] + p.lru_bx[e * D + c]);
                const float lam = p.lru_lam[e * D + c]; const float sp = log1pf(__expf(-lam));
                const float la = -8.f * rg * sp; const float av = __expf(la); const float uv = sqrtf(-expm1f(2.f * la)) * ig * XC[j * 64 + ch];
                AA[(e * 64 + j) * 64 + ch] = av; UU[(e * 64 + j) * 64 + ch] = uv; } }
    __syncthreads();
    if (tid < 128) { const int e = tid >> 6, ch = tid & 63, c = hb * 64 + ch; const size_t ao = ((size_t)(b * NCH + ci) * 2 + e) * D + c;
        if (PASS == 1) { float hsum = 0.f, pr = 1.f;
            for (int s = 0; s < 64; ++s) { const int j = e ? 63 - s : s; const float a = AA[(e * 64 + j) * 64 + ch]; hsum = a * hsum + UU[(e * 64 + j) * 64 + ch]; pr *= a; }
            ((float*)(p.ws + WS_AGGA))[ao] = pr; ((float*)(p.ws + WS_AGGH))[ao] = hsum; }
        else { float h = ((const float*)(p.ws + WS_CIN))[ao];
            for (int s = 0; s < 64; ++s) { const int j = e ? 63 - s : s; const int o = (e * 64 + j) * 64 + ch; h = AA[o] * h + UU[o]; UU[o] = h; } } }
    if (PASS == 2) { __syncthreads();
        bf16* Y = (bf16*)(p.ws + WS_YLRU);
        for (int e = tid; e < 64 * 32; e += NTHR) { const int j = e >> 5, cp = (e & 31) * 2;
            const unsigned gw = *(const unsigned*)(S + (size_t)(row0 + j) * NSLAB + C_GBR + hb * 64 + cp);
            const float y0 = (UU[j * 64 + cp] + UU[(64 + j) * 64 + cp]) * gelu_tanh(bflo(gw)), y1 = (UU[j * 64 + cp + 1] + UU[(64 + j) * 64 + cp + 1]) * gelu_tanh(bfhi(gw));
            *(unsigned*)(Y + (size_t)(row0 + j) * D + hb * 64 + cp) = pk2(y0, y1); } }
    __syncthreads();
}
DI void lru_carry(const P& p, int tid, int G) {
    const float* A = (const float*)(p.ws + WS_AGGA); const float* H = (const float*)(p.ws + WS_AGGH); float* CI = (float*)(p.ws + WS_CIN);
    for (int i = blockIdx.x * NTHR + tid; i < BATCH * 2 * D; i += G * NTHR) { const int c = i & (D - 1), e = (i >> 10) & 1, b = i >> 11; float h = 0.f;
        for (int s = 0; s < NCH; ++s) { const int ci = e ? (s < 4 ? 3 - s : NCH + 3 - s) : s; const size_t o = ((size_t)(b * NCH + ci) * 2 + e) * D + c; CI[o] = h; h = A[o] * h + H[o]; } }
}

DI void wkv_scan_wg(const P& p, LAS unsigned char* lds, int tid, int lane, int wave, int unit) {
    const int rg = unit & 3, e = (unit >> 2) & 1, h = (unit >> 3) & 15, b = unit >> 7;
    const bf16* S = (const bf16*)(p.ws + WS_SLAB);
    LAS float* W2S = (LAS float*)lds; LAS float* A2S = (LAS float*)(lds + 16384);
    LAS float* KK = (LAS float*)(lds + 32768); LAS float* WW = (LAS float*)(lds + 49152); LAS float* BB = (LAS float*)(lds + 65536);
    LAS float* KM = (LAS float*)(lds + 81920); LAS float* RR = (LAS float*)(lds + 98304);
    LAS float* VV = (LAS float*)(lds + 114688); LAS float* YY = (LAS float*)(lds + 118784);
    LAS float* TW = RR; LAS float* AD = KM;
    for (int i = tid; i < 4096; i += NTHR) { const int k = i >> 6, n = i & 63; W2S[i] = p.w2[((size_t)e * 64 + k) * D + h * 64 + n]; A2S[i] = p.a2[((size_t)e * 64 + k) * D + h * 64 + n]; }
    bf16* YW = (bf16*)(p.ws + (e ? WS_YWB : WS_YWF));
    float st[4] = {0.f, 0.f, 0.f, 0.f};
    const int rr = lane >> 4, kq = lane & 15;
    for (int s = 0; s < NCH; ++s) {
        const int ci = e ? (s < 4 ? 3 - s : NCH + 3 - s) : s;
        __syncthreads();
        for (int i = tid; i < 4096; i += NTHR) { const int j = i >> 6, n = i & 63; TW[i] = tanhf(mixval(S, p.mu_a, b, ci, j, C_WD + n)); AD[i] = mixval(S, p.mu_a, b, ci, j, C_AD + n); }
        __syncthreads();
        const int j = tid >> 3, ng = tid & 7; float zw[8], za[8];
#pragma unroll
        for (int i = 0; i < 8; ++i) { zw[i] = p.w0[e * D + h * 64 + ng * 8 + i]; za[i] = p.a0[e * D + h * 64 + ng * 8 + i]; }
#pragma unroll 4
        for (int k = 0; k < 64; ++k) { const float tv = TW[j * 64 + k], av = AD[j * 64 + k];
            const f32x4 w0 = *(const LAS f32x4*)(W2S + k * 64 + ng * 8), w1 = *(const LAS f32x4*)(W2S + k * 64 + ng * 8 + 4), a0 = *(const LAS f32x4*)(A2S + k * 64 + ng * 8), a1 = *(const LAS f32x4*)(A2S + k * 64 + ng * 8 + 4);
#pragma unroll
            for (int i = 0; i < 4; ++i) { zw[i] += tv * w0[i]; zw[4 + i] += tv * w1[i]; za[i] += av * a0[i]; za[4 + i] += av * a1[i]; } }
        __syncthreads();
        { float kr[8], ss = 0.f; float aa[8];
#pragma unroll
            for (int i = 0; i < 8; ++i) { const int n = ng * 8 + i, hc = h * 64 + n; aa[i] = sigm(za[i]);
                const float kv = mixval(S, p.mu_a, b, ci, j, C_K + hc); const float rv = mixval(S, p.mu_a, b, ci, j, C_R + hc);
                KM[j * 64 + n] = kv * (1.f + (aa[i] - 1.f) * p.k_a[hc]); kr[i] = kv * p.k_k[hc]; ss += kr[i] * kr[i];
                RR[j * 64 + n] = rv; WW[j * 64 + n] = __expf(-0.6065306597126334f * sigm(zw[i])); }
            ss += __shfl_xor(ss, 1); ss += __shfl_xor(ss, 2); ss += __shfl_xor(ss, 4);
            const float inv = 1.f / sqrtf(ss + 1e-12f);
#pragma unroll
            for (int i = 0; i < 8; ++i) { const int n = ng * 8 + i; const float kk = kr[i] * inv; KK[j * 64 + n] = kk; BB[j * 64 + n] = kk * aa[i]; } }
        for (int i = tid; i < 1024; i += NTHR) { const int jj = i >> 4, r = i & 15; VV[i] = mixval(S, p.mu_a, b, ci, jj, C_V + h * 64 + rg * 16 + r); }
        __syncthreads();
        if (wave < 4) {
            for (int q = 0; q < 64; ++q) { const int jj = e ? 63 - q : q;
                const f32x4 kk = *(const LAS f32x4*)(KK + jj * 64 + kq * 4), ww = *(const LAS f32x4*)(WW + jj * 64 + kq * 4), bb = *(const LAS f32x4*)(BB + jj * 64 + kq * 4),
                            km = *(const LAS f32x4*)(KM + jj * 64 + kq * 4), rv = *(const LAS f32x4*)(RR + jj * 64 + kq * 4);
                const float vv = VV[jj * 16 + wave * 4 + rr];
                float sk = (st[0] * kk[0] + st[1] * kk[1]) + (st[2] * kk[2] + st[3] * kk[3]);
                sk += __shfl_xor(sk, 1); sk += __shfl_xor(sk, 2); sk += __shfl_xor(sk, 4); sk += __shfl_xor(sk, 8);
#pragma unroll
                for (int i = 0; i < 4; ++i) st[i] = st[i] * ww[i] - sk * bb[i] + vv * km[i];
                float y = (st[0] * rv[0] + st[1] * rv[1]) + (st[2] * rv[2] + st[3] * rv[3]);
                y += __shfl_xor(y, 1); y += __shfl_xor(y, 2); y += __shfl_xor(y, 4); y += __shfl_xor(y, 8);
                if (kq == 0) YY[jj * 16 + wave * 4 + rr] = y; }
        }
        __syncthreads();
        if (ci >= 4) { const int row0 = chunk_row0(b, ci);
            for (int i = tid; i < 512; i += NTHR) { const int jj = i >> 3, r2 = (i & 7) * 2;
                *(unsigned*)(YW + (size_t)(row0 + jj) * D + h * 64 + rg * 16 + r2) = pk2(YY[jj * 16 + r2], YY[jj * 16 + r2 + 1]); } }
    }
    __syncthreads();
}

DI void wkv_out_unit(const P& p, LAS unsigned char* lds, int tid, int b, int gr, int h) {
    const bf16* S = (const bf16*)(p.ws + WS_SLAB); const int ci = gr + 4; const int row0 = chunk_row0(b, ci);
    LAS float* AD = (LAS float*)lds;
    LAS float* GS = (LAS float*)(lds + 16384);
    for (int i = tid; i < 4096; i += NTHR) { const int j = i >> 6, n = i & 63; AD[i] = mixval(S, p.mu_a, b, ci, j, C_AD + n); }
    for (int i = tid; i < 64 * 160; i += NTHR) { const int j = i / 160, n = i % 160; GS[i] = sigm(mixval(S, p.mu_a, b, ci, j, C_GD + n)); }
    __syncthreads();
    const int j = tid >> 3, ng = tid & 7; float a0[8], a1[8], g[8];
#pragma unroll
    for (int i = 0; i < 8; ++i) { a0[i] = p.a0[h * 64 + ng * 8 + i]; a1[i] = p.a0[D + h * 64 + ng * 8 + i]; g[i] = 0.f; }
#pragma unroll 2
    for (int k = 0; k < 64; ++k) { const float av = AD[j * 64 + k]; const float* q0 = p.a2 + (size_t)k * D + h * 64 + ng * 8; const float* q1 = p.a2 + (size_t)(64 + k) * D + h * 64 + ng * 8;
        const f32x4 u0 = *(const f32x4*)q0, u1 = *(const f32x4*)(q0 + 4), v0 = *(const f32x4*)q1, v1 = *(const f32x4*)(q1 + 4);
#pragma unroll
        for (int i = 0; i < 4; ++i) { a0[i] += av * u0[i]; a0[4 + i] += av * u1[i]; a1[i] += av * v0[i]; a1[4 + i] += av * v1[i]; } }
#pragma unroll 4
    for (int k = 0; k < 160; ++k) { const float gv = GS[j * 160 + k]; const float* q = p.g2 + (size_t)k * D + h * 64 + ng * 8; const f32x4 u0 = *(const f32x4*)q, u1 = *(const f32x4*)(q + 4);
#pragma unroll
        for (int i = 0; i < 4; ++i) { g[i] += gv * u0[i]; g[4 + i] += gv * u1[i]; } }
    bf16* YF = (bf16*)(p.ws + WS_YWF); const bf16* YB = (const bf16*)(p.ws + WS_YWB);
    const size_t yo = (size_t)(row0 + j) * D + h * 64 + ng * 8;
    const v4u yf = *(const v4u*)(YF + yo), yb = *(const v4u*)(YB + yo);
    float y[8] = {bflo(yf.x) + bflo(yb.x), bfhi(yf.x) + bfhi(yb.x), bflo(yf.y) + bflo(yb.y), bfhi(yf.y) + bfhi(yb.y), bflo(yf.z) + bflo(yb.z), bfhi(yf.z) + bfhi(yb.z), bflo(yf.w) + bflo(yb.w), bfhi(yf.w) + bfhi(yb.w)};
    float s = 0.f;
#pragma unroll
    for (int i = 0; i < 8; ++i) s += y[i];
    s += __shfl_xor(s, 1); s += __shfl_xor(s, 2); s += __shfl_xor(s, 4); const float mu = s * (1.f / 64.f); float q2 = 0.f;
#pragma unroll
    for (int i = 0; i < 8; ++i) { y[i] -= mu; q2 += y[i] * y[i]; }
    q2 += __shfl_xor(q2, 1); q2 += __shfl_xor(q2, 2); q2 += __shfl_xor(q2, 4); const float rs = 1.f / sqrtf(q2 * (1.f / 64.f) + GN_EPS);
    float rho = 0.f, vv[8];
#pragma unroll
    for (int i = 0; i < 8; ++i) { const int n = ng * 8 + i, hc = h * 64 + n;
        const float kv = mixval(S, p.mu_a, b, ci, j, C_K + hc), rv = mixval(S, p.mu_a, b, ci, j, C_R + hc); vv[i] = mixval(S, p.mu_a, b, ci, j, C_V + hc);
        rho += rv * kv * (2.f + (sigm(a0[i]) + sigm(a1[i]) - 2.f) * p.k_a[hc]) * p.r_k[hc]; }
    rho += __shfl_xor(rho, 1); rho += __shfl_xor(rho, 2); rho += __shfl_xor(rho, 4);
    float o[8];
#pragma unroll
    for (int i = 0; i < 8; ++i) { const int hc = h * 64 + ng * 8 + i; o[i] = (y[i] * rs * p.gn_g[hc] + p.gn_b[hc] + rho * vv[i]) * g[i]; }
    *(v4u*)(YF + yo) = (v4u){pk2(o[0], o[1]), pk2(o[2], o[3]), pk2(o[4], o[5]), pk2(o[6], o[7])};
    __syncthreads();
}

DI void expert_weights(const P& p, LAS unsigned char* lds, int lane, int wave, int G) {
    LAS float* scr = (LAS float*)(lds + wave * 16384);
    const int gw = blockIdx.x * NWAVES + wave, NGW = G * NWAVES;
    bf16* w13 = (bf16*)(p.ws + WS_W13); bf16* w2t = (bf16*)(p.ws + WS_W2);
    constexpr int I13 = 16 * 16, I2 = 8 * 32;
    for (int it = gw; it < NEXP * (2 * I13 + I2); it += NGW) { const int ex = it / (2 * I13 + I2); int r = it % (2 * I13 + I2);
        if (r < 2 * I13) { const int which = r / I13; r %= I13; const int kb = r / 16, nb = r % 16, n0 = nb * 32;
            if (which) transpose_item(p.e_w3 + (size_t)ex * D * DEXP, DEXP, w13 + (size_t)ex * D * D, D, kb * 64, n0, 256 * (n0 >> 7) + 128 + (n0 & 127), scr, lane);
            else transpose_item(p.e_w1 + (size_t)ex * D * DEXP, DEXP, w13 + (size_t)ex * D * D, D, kb * 64, n0, 256 * (n0 >> 7) + (n0 & 127), scr, lane); }
        else { r -= 2 * I13; const int kb = r / 32, nb = r % 32; transpose_item(p.e_w2 + (size_t)ex * DEXP * D, D, w2t + (size_t)ex * D * DEXP, DEXP, kb * 64, nb * 32, nb * 32, scr, lane); } }
}

DI void phase_route(const P& p, LAS unsigned char* lds, int tid, int lane, int wave, int G) {
    LAS float* RW = (LAS float*)lds;
    LAS int* RE = (LAS int*)(lds + 36 * 4096);
    for (int i = tid; i < 36 * D; i += NTHR) { const int q = i >> 10, k = i & (D - 1); RW[i] = q < 4 ? p.router_g[k * 4 + q] : p.router_e[k * 32 + (q - 4)]; }
    float* T1 = p.out; bf16* H2 = (bf16*)(p.ws + WS_H2);
    int* TOKE = (int*)(p.ws + WS_TOKE); int* TOKSLOT = (int*)(p.ws + WS_TOKSLOT); float* TOKW = (float*)(p.ws + WS_TOKW); int* S2T = (int*)(p.ws + WS_S2T);
    if (blockIdx.x == 0) for (int i = tid; i < D / 8; i += NTHR) ((GAS v4u*)(H2 + (size_t)MX * D))[i] = (v4u){0u, 0u, 0u, 0u};
    __syncthreads();
    for (int blk = blockIdx.x; blk < MX / 64; blk += G) {
        for (int rr = 0; rr < 8; ++rr) { const int m = blk * 64 + wave * 8 + rr; const int bsel = m >> 13;
            GAS f32x4* tr = (GAS f32x4*)(T1 + (size_t)m * D) + lane; f32x4 q[4]; float s = 0.f;
#pragma unroll
            for (int j = 0; j < 4; ++j) { q[j] = tr[64 * j]; s += (q[j].x + q[j].y) + (q[j].z + q[j].w); }
            const float mean = wave_sum(s) * (1.f / D); float s2 = 0.f;
#pragma unroll
            for (int j = 0; j < 4; ++j) { q[j] = q[j] - mean; s2 += (q[j].x * q[j].x + q[j].y * q[j].y) + (q[j].z * q[j].z + q[j].w * q[j].w); }
            const float rstd = 1.f / sqrtf(wave_sum(s2) * (1.f / D) + LN_EPS);
            GAS v2u* o8 = (GAS v2u*)(H2 + (size_t)m * D) + lane;
#pragma unroll
            for (int j = 0; j < 4; ++j) { const int n = 256 * j + 4 * lane; const f32x4 g = *(const f32x4*)(p.ln1_g + n), bb = *(const f32x4*)(p.ln1_b + n);
                f32x4 x1 = q[j] * rstd * g + bb; tr[64 * j] = x1;
#pragma unroll
                for (int i = 0; i < 4; ++i) q[j][i] = x1[i] * (1.f + modv(p, bsel, 4 * 1024 + n + i)) + modv(p, bsel, 3 * 1024 + n + i);
                o8[64 * j] = (v2u){pk2(q[j][0], q[j][1]), pk2(q[j][2], q[j][3])}; }
            float lg[36];
#pragma unroll
            for (int qq = 0; qq < 36; ++qq) { float a = 0.f;
#pragma unroll
                for (int j = 0; j < 4; ++j) { const f32x4 w = *(const LAS f32x4*)(RW + qq * D + 256 * j + 4 * lane); a += (q[j][0] * w[0] + q[j][1] * w[1]) + (q[j][2] * w[2] + q[j][3] * w[3]); }
                lg[qq] = wave_sum(a) + (qq < 4 ? p.router_g_b[qq] : p.router_e_b[qq - 4]); }
            int gs = 0; float gm = lg[0];
#pragma unroll
            for (int i = 1; i < 4; ++i) if (lg[i] > gm) { gm = lg[i]; gs = i; }
            float den = 0.f;
#pragma unroll
            for (int i = 0; i < 4; ++i) den += __expf(lg[i] - gm);
            const float pg = 1.f / den;
            float ev[8];
#pragma unroll
            for (int i = 0; i < 8; ++i) ev[i] = gs == 0 ? lg[4 + i] : (gs == 1 ? lg[12 + i] : (gs == 2 ? lg[20 + i] : lg[28 + i]));
            int i1 = 0; float v1 = ev[0];
#pragma unroll
            for (int i = 1; i < 8; ++i) if (ev[i] > v1) { v1 = ev[i]; i1 = i; }
            int i2 = -1; float v2 = -3.0e38f;
#pragma unroll
            for (int i = 0; i < 8; ++i) if (i != i1 && ev[i] > v2) { v2 = ev[i]; i2 = i; }
            const float e2 = __expf(v2 - v1); const float w1 = pg / (1.f + e2), w2 = pg * e2 / (1.f + e2);
            if (lane == 0) { RE[(wave * 8 + rr) * 2] = gs * 8 + i1; RE[(wave * 8 + rr) * 2 + 1] = gs * 8 + i2; TOKW[2 * m] = w1; TOKW[2 * m + 1] = w2; TOKE[2 * m] = gs * 8 + i1; TOKE[2 * m + 1] = gs * 8 + i2; }
        }
        __syncthreads();
        if (tid < NEXP) { int cnt = 0;
            for (int i = 0; i < 128; ++i) cnt += (RE[i] == tid) ? 1 : 0;
            if (cnt) { int base = (int)atomicAdd(p.ctl + CW_ECNT + tid, (unsigned)cnt);
                for (int i = 0; i < 128; ++i) if (RE[i] == tid) { const int m = blk * 64 + (i >> 1); TOKSLOT[2 * m + (i & 1)] = base; S2T[(size_t)tid * MX + base] = 2 * m + (i & 1); ++base; } } }
        __syncthreads();
    }
}
DI void build_tiles(const P& p, LAS int* tile, int tid) {
    if (tid == 0) { int T = 0;
        for (int e = 0; e < NEXP; ++e) { tile[MAXT + e] = T; const int c = (int)__hip_atomic_load(p.ctl + CW_ECNT + e, RLX_AGENT); const int nt = (c + 255) >> 8; for (int i = 0; i < nt; ++i) tile[T + i] = e; T += nt; }
        tile[MAXT + 32] = T; tile[MAXT + 40] = T; }
    __syncthreads();
}
DI void phase_gather(const P& p, LAS int* tile, int lane, int wave, int G) {
    const int NT = tile[MAXT + 40]; const bf16* H2 = (const bf16*)(p.ws + WS_H2); bf16* XS = (bf16*)(p.ws + WS_XS); float* ROWW = (float*)(p.ws + WS_ROWW);
    const int* S2T = (const int*)(p.ws + WS_S2T); const float* TOKW = (const float*)(p.ws + WS_TOKW);
    const int gw = blockIdx.x * NWAVES + wave, NGW = G * NWAVES;
    for (int row = gw; row < NT * 256; row += NGW) { const int T = row >> 8, e = tile[T], slot = (T - tile[MAXT + e]) * 256 + (row & 255);
        const int cnt = (int)__hip_atomic_load(p.ctl + CW_ECNT + e, RLX_AGENT); int src = MX; float w = 0.f;
        if (slot < cnt) { const int tk = S2T[(size_t)e * MX + slot]; src = tk >> 1; w = TOKW[tk]; }
        const GAS v4u* sp = (const GAS v4u*)(H2 + (size_t)src * D) + lane; GAS v4u* dp = (GAS v4u*)(XS + (size_t)row * D) + lane;
        dp[0] = sp[0]; dp[64] = sp[64];
        if (lane == 0) ROWW[row] = w; }
}
DI void phase_final(const P& p, LAS int* tile, int lane, int wave, int G) {
    const int gw = blockIdx.x * NWAVES + wave, NGW = G * NWAVES; const bf16* YB = (const bf16*)(p.ws + WS_XS);
    const int* TOKE = (const int*)(p.ws + WS_TOKE); const int* TOKSLOT = (const int*)(p.ws + WS_TOKSLOT);
    for (int m = gw; m < MX; m += NGW) { const int bsel = m >> 13;
        const int r0 = tile[MAXT + TOKE[2 * m]] * 256 + TOKSLOT[2 * m], r1 = tile[MAXT + TOKE[2 * m + 1]] * 256 + TOKSLOT[2 * m + 1];
        GAS f32x4* xr = (GAS f32x4*)(p.out + (size_t)m * D) + lane; const GAS v2u* y0 = (const GAS v2u*)(YB + (size_t)r0 * D) + lane; const GAS v2u* y1 = (const GAS v2u*)(YB + (size_t)r1 * D) + lane;
        f32x4 q[4]; float s = 0.f;
#pragma unroll
        for (int j = 0; j < 4; ++j) { const int n = 256 * j + 4 * lane; const f32x4 x1 = xr[64 * j]; const v2u a = y0[64 * j], b2 = y1[64 * j];
            const f32x4 mo = (f32x4){bflo(a.x) + bflo(b2.x), bfhi(a.x) + bfhi(b2.x), bflo(a.y) + bflo(b2.y), bfhi(a.y) + bfhi(b2.y)};
#pragma unroll
            for (int i = 0; i < 4; ++i) q[j][i] = ALPHA * x1[i] + modv(p, bsel, 5 * 1024 + n + i) * mo[i];
            s += (q[j].x + q[j].y) + (q[j].z + q[j].w); }
        const float mean = wave_sum(s) * (1.f / D); float s2 = 0.f;
#pragma unroll
        for (int j = 0; j < 4; ++j) { q[j] = q[j] - mean; s2 += (q[j].x * q[j].x + q[j].y * q[j].y) + (q[j].z * q[j].z + q[j].w * q[j].w); }
        const float rstd = 1.f / sqrtf(wave_sum(s2) * (1.f / D) + LN_EPS);
#pragma unroll
        for (int j = 0; j < 4; ++j) { const int n = 256 * j + 4 * lane; xr[64 * j] = q[j] * rstd * *(const f32x4*)(p.ln2_g + n) + *(const f32x4*)(p.ln2_b + n); }
    }
}

#define MKP P p; { const float* const* in = args.in; p.x = in[0]; p.c = in[1]; p.ctx = in[2]; p.c_ctx = in[3]; p.w_ada = in[4]; p.b_ada = in[5]; p.w_in = in[6]; p.mu_a = in[7]; p.w0 = in[8]; p.w2 = in[9]; p.a0 = in[10]; p.a2 = in[11]; p.g2 = in[12]; p.k_k = in[13]; p.k_a = in[14]; p.r_k = in[15]; p.gn_g = in[16]; p.gn_b = in[17]; p.conv_w = in[18]; p.conv_b = in[19]; p.lru_wa = in[20]; p.lru_ba = in[21]; p.lru_wx = in[22]; p.lru_bx = in[23]; p.lru_lam = in[24]; p.p_a = in[25]; p.p_b = in[26]; p.w_o = in[27]; p.ln1_g = in[28]; p.ln1_b = in[29]; p.router_g = in[30]; p.router_g_b = in[31]; p.router_e = in[32]; p.router_e_b = in[33]; p.e_w1 = in[34]; p.e_w3 = in[35]; p.e_w2 = in[36]; p.ln2_g = in[37]; p.ln2_b = in[38]; } p.out = args.out; p.ws = args.ws; p.dob = (unsigned char*)args.out; p.ctlf = (float*)(args.ws + WS_CTL); p.ctl = (unsigned*)(args.ws + WS_CTL);
constexpr int NPHASE = 15;
__global__ void __launch_bounds__(NTHR, 2) fwd_kernel(Args args) {
    extern __shared__ __attribute__((aligned(16))) unsigned char lds_raw[];
    LAS unsigned char* lds = (LAS unsigned char*)lds_raw;
    const int tid = threadIdx.x, lane = tid & 63, wave = __builtin_amdgcn_readfirstlane(tid >> 6), G = gridDim.x;
    volatile LAS unsigned* MISC = (volatile LAS unsigned*)(lds + MISC_OFF);
    LAS int* tile = (LAS int*)(lds + TILE_OFF);
    for (int u = tid; u < 256; u += NTHR) ((LAS unsigned*)(lds + MISC_OFF))[u] = 0u;
    __syncthreads();
#if ONE_LAUNCH
    XcdBarrier bar = xcd_barrier_post((unsigned*)(args.ws + WS_CTL) + CW_BAR, MISC + 8);
#define GRID_BAR() xcd_barrier(bar)
#else
#define GRID_BAR() do {} while (0)
#endif
    const int lo = args.ph_lo, hi = args.ph_hi;
#define IN(k) (lo <= (k) && (k) < hi)
#define SEAM(k) do { if (IN(k) && IN((k) + 1)) GRID_BAR(); } while (0)

    if (IN(0)) { MKP; phase0(p, lds, tid, lane, wave, G); } SEAM(0);
    if (IN(1)) { MKP; phase1(p, lane, wave, G); } SEAM(1);
    if (IN(2)) { MKP;
        pg8::Gemm g{(const pg8::bf16_t*)(p.dob + DO_H), (const pg8::bf16_t*)(p.dob + DO_WIN), MALL, NSLAB, D}; pg8::StaticOrder S; S.init(MALL, NSLAB, G, (int)blockIdx.x);
        EpiPlain<0> E{(bf16*)(p.ws + WS_SLAB), NSLAB};
        pg8::gemm_phase<EpiPlain<0>, pg8::StaticOrder, true, true>(lds, g, S, E); } SEAM(2);
    if (IN(3)) { MKP; for (int u = blockIdx.x; u < BATCH * NCH * 16; u += G) { const int hb = u & 15, ci = (u >> 4) % NCH, b = (u >> 4) / NCH; lru_unit<1>(p, lds, tid, b, ci, hb); } } SEAM(3);
    if (IN(4)) { MKP; lru_carry(p, tid, G); } SEAM(4);
    if (IN(5)) { MKP; for (int u = blockIdx.x; u < BATCH * 128 * 16; u += G) { const int hb = u & 15, gr = (u >> 4) & 127, b = u >> 11; lru_unit<2>(p, lds, tid, b, gr + 4, hb); } } SEAM(5);
    if (IN(6)) { MKP; for (int u = blockIdx.x; u < 256; u += G) wkv_scan_wg(p, lds, tid, lane, wave, u); } SEAM(6);
    if (IN(7)) { MKP; for (int u = blockIdx.x; u < BATCH * 128 * 16; u += G) { const int h = u & 15, gr = (u >> 4) & 127, b = u >> 11; wkv_out_unit(p, lds, tid, b, gr, h); } } SEAM(7);
    if (IN(8)) { MKP;
        pg8::Gemm g{(const pg8::bf16_t*)(p.dob + DO_H), (const pg8::bf16_t*)(p.dob + DO_WIN) + (size_t)NSLAB * D, MX, 2048, D}; pg8::StaticOrder S; S.init(MX, 2048, G, (int)blockIdx.x);
        EpiPlain<1> E{(bf16*)(p.ws + WS_GATES), 2048};
        pg8::gemm_phase<EpiPlain<1>, pg8::StaticOrder, true, true>(lds, g, S, E); } SEAM(8);
    if (IN(9)) { MKP;
        pg8::Gemm g{(const pg8::bf16_t*)(p.ws + WS_YLRU), (const pg8::bf16_t*)(p.ws + WS_PW), 2 * MX, 2 * D, D}; SchedMix S; S.init(MX, D, G, (int)blockIdx.x);
        EpiMix E{(const bf16*)(p.ws + WS_GATES), (bf16*)(p.ws + WS_MBUF)};
        pg8::gemm_phase<EpiMix, SchedMix, true, true>(lds, g, S, E); } SEAM(9);
    if (IN(10)) { MKP;
        pg8::Gemm g{(const pg8::bf16_t*)(p.ws + WS_MBUF), (const pg8::bf16_t*)(p.ws + WS_PW) + (size_t)2 * D * D, MX, D, D}; pg8::StaticOrder S; S.init(MX, D, G, (int)blockIdx.x);
        EpiT1 E{p.x, (const float*)(p.ws + WS_STATS), p.ctlf + CW_MOD, p.b_ada, p.out};
        pg8::gemm_phase<EpiT1, pg8::StaticOrder, true, true>(lds, g, S, E);
        expert_weights(p, lds, lane, wave, G); } SEAM(10);
    if (IN(11)) { MKP; phase_route(p, lds, tid, lane, wave, G); } SEAM(11);
    if (IN(12)) { MKP; build_tiles(p, tile, tid); phase_gather(p, tile, lane, wave, G); } SEAM(12);
    if (IN(13)) { MKP;
        build_tiles(p, tile, tid);
        pg8::Gemm g{(const pg8::bf16_t*)(p.ws + WS_XS), (const pg8::bf16_t*)(p.ws + WS_W13), MAXT * 256, NEXP * D, D}; SchedMoE S{tile, G, (int)blockIdx.x};
        EpiSwiGLU E{(bf16*)(p.ws + WS_HBUF)};
        pg8::gemm_phase<EpiSwiGLU, SchedMoE, true, true>(lds, g, S, E); } SEAM(13);
    if (IN(14)) { MKP;
        build_tiles(p, tile, tid);
        pg8::Gemm g{(const pg8::bf16_t*)(p.ws + WS_HBUF), (const pg8::bf16_t*)(p.ws + WS_W2), MAXT * 256, NEXP * D, DEXP}; SchedMoE S{tile, G, (int)blockIdx.x};
        EpiW2 E{(bf16*)(p.ws + WS_XS), (const float*)(p.ws + WS_ROWW)};
        pg8::gemm_phase<EpiW2, SchedMoE, true, true>(lds, g, S, E); } SEAM(14);
    if (IN(15)) { MKP; build_tiles(p, tile, tid); phase_final(p, tile, lane, wave, G); }
#undef IN
#undef SEAM
}

extern "C" void kernel_launch(void* const* d_in, const int* in_sizes, int n_in, void* d_out, int out_size, void* d_ws, size_t ws_size, hipStream_t stream) {
    static int grid = 0;
    if (grid == 0) {
        if (n_in != 39 || out_size != MX * D || ws_size < WS_END) { fprintf(stderr, "kernel_launch: unexpected shapes (n_in %d out %d ws %zu)\n", n_in, out_size, ws_size); grid = -1; return; }
        int dev = 0, cus = 0, per_cu = 0;
        if (hipGetDevice(&dev) != hipSuccess || hipDeviceGetAttribute(&cus, hipDeviceAttributeMultiprocessorCount, dev) != hipSuccess) { grid = -1; return; }
        if (hipFuncSetAttribute((const void*)fwd_kernel, hipFuncAttributeMaxDynamicSharedMemorySize, LDS_BYTES) != hipSuccess) { fprintf(stderr, "kernel_launch: hipFuncSetAttribute failed\n"); grid = -1; return; }
        if (hipOccupancyMaxActiveBlocksPerMultiprocessor(&per_cu, (const void*)fwd_kernel, NTHR, LDS_BYTES) != hipSuccess || per_cu < 1) fprintf(stderr, "kernel_launch: occupancy query reports %d\n", per_cu);
        (void)hipGetLastError();
        grid = cus;
    }
    if (grid < 0) return;
    if (hipMemsetAsync((char*)d_ws + WS_CTL, 0, CTL_ZERO_BYTES, stream) != hipSuccess) return;
    Args a{};
    for (int i = 0; i < 39; ++i) a.in[i] = (const float*)d_in[i];
    a.out = (float*)d_out; a.ws = (unsigned char*)d_ws;
#if ONE_LAUNCH
    a.ph_lo = 0; a.ph_hi = NPHASE + 1;
    hipLaunchKernelGGL(fwd_kernel, dim3(grid), dim3(NTHR), LDS_BYTES, stream, a);
#else
    for (int ph = 0; ph <= NPHASE; ++ph) { a.ph_lo = ph; a.ph_hi = ph + 1; hipLaunchKernelGGL(fwd_kernel, dim3(grid), dim3(NTHR), LDS_BYTES, stream, a); }
#endif
}
```

```cpp
#include <hip/hip_runtime.h>
#include <cstdio>
#include <cstdint>
namespace pg8 {
#define PG8_LAS __attribute__((address_space(3)))
typedef unsigned short bf16_t;
typedef short bf16x8 __attribute__((ext_vector_type(8)));
typedef float f32x4 __attribute__((ext_vector_type(4)));
typedef unsigned u32x4 __attribute__((ext_vector_type(4)));
constexpr int BM = 256, BK = 64, HALF = 128, HTB = HALF * BK * 2  , STAGE_BYTES = 8 * HTB, NXCD = 8, WGM = 8;

__host__ __device__ __forceinline__ int lds_byte(int r, int c) { const int st = (r >> 4) * 2 + (c >> 5), rr = r & 15, cc = c & 31, ob = rr * 64 + cc * 2; return st * 1024 + (ob ^ (((ob >> 9) & 1) << 5)); }
__host__ __device__ __forceinline__ void stage_rc(int b, int& R, int& C) { const int st = b / 1024, sb = b % 1024, swz = sb ^ (((sb >> 9) & 1) << 5); R = (st >> 1) * 16 + swz / 64; C = (st & 1) * 32 + (swz % 64) / 2; }
__host__ __device__ __forceinline__ int perm32(int rho) { const int n = rho >> 4, i = rho & 15; return 8 * (i >> 2) + 4 * n + (i & 3); }

struct Unit { int pm, pn; };
struct Gemm { const bf16_t* A; const bf16_t* Bt; int M, N, K; };

struct StaticOrder {
    int nM, nN, nwg, G, c;
    __host__ __device__ void init(int M, int N, int G_, int c_) { nM = M / BM; nN = N / BM; nwg = nM * nN; G = G_; c = c_; }
    __host__ __device__ bool next(int i, Unit& u) const {
        const long L = (long)i * G + c; if (L >= nwg) return false;
        int wgid = (int)L; { const int q = nwg / NXCD, r = nwg % NXCD, xcd = wgid % NXCD, off = wgid / NXCD; wgid = (xcd < r ? xcd * (q + 1) : r * (q + 1) + (xcd - r) * q) + off; }
        const int nig = WGM * nN, gid = wgid / nig, fm = gid * WGM, gsz = (nM - fm) < WGM ? (nM - fm) : WGM;
        u.pm = fm + ((wgid % nig) % gsz); u.pn = (wgid % nig) / gsz; return true;
    }
    __device__ __forceinline__ void a_ready(const Unit&) const {}
    __device__ __forceinline__ void done(const Unit&) const {}
};

__device__ __forceinline__ unsigned cvt_pk_bf16(float lo, float hi) { unsigned r; asm volatile("v_cvt_pk_bf16_f32 %0, %1, %2" : "=v"(r) : "v"(lo), "v"(hi)); return r; }
template <class Epi, class Sched, bool ALIGN_EPI = false, bool SP2 = false, bool GATHER = false>
__device__ __forceinline__ void gemm_phase(PG8_LAS unsigned char* lds, const Gemm g, const Sched& S, const Epi& E) {
    static_assert(!GATHER || SP2, "the gathered-A path exists only in the SP2 loop");
    const int tid = threadIdx.x, wid = __builtin_amdgcn_readfirstlane(tid >> 6), lane = tid & 63, wr = wid >> 2, wc = wid & 3, fr = lane & 15, fq = lane >> 4;
    const int K = g.K, nt = K / BK;
    unsigned voffA[2], voffB[2];
#pragma unroll
    for (int i = 0; i < 2; ++i) { int R, C; stage_rc(tid * 16 + i * 8192, R, C); const int Rb = Epi::PERM ? ((R & ~31) + perm32(R & 31)) : R;
        voffA[i] = (unsigned)(R * K + C) * 2u; voffB[i] = (unsigned)(Rb * K + C) * 2u; }
    unsigned vgc[2][2] = {{0u, 0u}, {0u, 0u}}, vgn[2][2] = {{0u, 0u}, {0u, 0u}}; int gR[2] = {0, 0}, gC[2] = {0, 0};
    if constexpr (GATHER) {
#pragma unroll
        for (int i = 0; i < 2; ++i) stage_rc(tid * 16 + i * 8192, gR[i], gC[i]); }
#define PG8_GSET(dst, unit) do { _Pragma("unroll") for (int _h = 0; _h < 2; ++_h) _Pragma("unroll") for (int _i = 0; _i < 2; ++_i) dst[_h][_i] = (unsigned)(S.src_row((unit).pm, _h * 128 + gR[_i]) * K + gC[_i]) * 2u; } while (0)
    const size_t kstep = (size_t)(BK * 2);
    const size_t hstep = (size_t)HALF * K * 2;
    const size_t tstep = 2 * hstep;
    const unsigned ldsw = (unsigned)wid * 1024u;
    const int aoff = lds_byte(wr * 64 + fr, fq * 8), boff = lds_byte(wc * 32 + fr, fq * 8);
#define PG8_SA(b, h) (((b) * 2 + (h)) * HTB)
#define PG8_SB(b, h) ((4 + (b) * 2 + (h)) * HTB)
#define PG8_STAGE(bufoff, gbase, voff) do { _Pragma("unroll") for (int _i = 0; _i < 2; ++_i) \
        __builtin_amdgcn_global_load_lds((const unsigned*)((const char*)(gbase) + (voff)[_i]), (PG8_LAS unsigned*)(lds + (bufoff) + ldsw + _i * 8192), 16, 0, 0); } while (0)
#define PG8_STAGE_A(bufoff, gbase, h, usenext) do { if constexpr (GATHER) { _Pragma("unroll") for (int _i = 0; _i < 2; ++_i) { const unsigned _o = (usenext) ? vgn[h][_i] : vgc[h][_i]; \
        __builtin_amdgcn_global_load_lds((const unsigned*)((const char*)(gbase) + _o), (PG8_LAS unsigned*)(lds + (bufoff) + ldsw + _i * 8192), 16, 0, 0); } } \
        else { PG8_STAGE(bufoff, (gbase) + (h) * hstep, voffA); } } while (0)
#define PG8_LDA(dst, b, h) do { _Pragma("unroll") for (int m = 0; m < 4; ++m) _Pragma("unroll") for (int k = 0; k < 2; ++k) dst[m][k] = *(const PG8_LAS bf16x8*)(lds + PG8_SA(b, h) + aoff + m * 2048 + k * 1024); } while (0)
#define PG8_LDB(dst, b, h) do { _Pragma("unroll") for (int n = 0; n < 2; ++n) _Pragma("unroll") for (int k = 0; k < 2; ++k) dst[n][k] = *(const PG8_LAS bf16x8*)(lds + PG8_SB(b, h) + boff + n * 2048 + k * 1024); } while (0)
#define PG8_MMA(ai, bj, At, Bt) do { __builtin_amdgcn_s_setprio(1); _Pragma("unroll") for (int m = 0; m < 4; ++m) _Pragma("unroll") for (int n = 0; n < 2; ++n) _Pragma("unroll") for (int k = 0; k < 2; ++k) \
        acc[ai][bj][m][n] = __builtin_amdgcn_mfma_f32_16x16x32_bf16(Bt[n][k], At[m][k], acc[ai][bj][m][n], 0, 0, 0); __builtin_amdgcn_s_setprio(0); } while (0)
#define PG8_WAIT_V(n) asm volatile("s_waitcnt vmcnt(" #n ")" ::: "memory")
#define PG8_WAIT_L(n) asm volatile("s_waitcnt lgkmcnt(" #n ")" ::: "memory")
#define PG8_BAR __builtin_amdgcn_s_barrier()
#define PG8_SCHED __builtin_amdgcn_sched_barrier(0)
    Unit cur, nxt; int ui = 0;
    if (!S.next(0, cur)) return;
    f32x4 acc[2][2][4][2];
#pragma unroll
    for (int a = 0; a < 2; ++a)
#pragma unroll
        for (int b = 0; b < 2; ++b)
#pragma unroll
            for (int m = 0; m < 4; ++m)
#pragma unroll
                for (int n = 0; n < 2; ++n) acc[a][b][m][n] = (f32x4){0.f, 0.f, 0.f, 0.f};
    bf16x8 At[4][2], B0[2][2], B1[2][2];
    const char* cA = GATHER ? (const char*)g.A : (const char*)g.A + (size_t)cur.pm * tstep; const char* cB = (const char*)g.Bt + (size_t)cur.pn * tstep;
    if constexpr (GATHER) PG8_GSET(vgc, cur);
    S.a_ready(cur);
    if constexpr (SP2) {
        PG8_STAGE(PG8_SB(0, 0), cB, voffB); PG8_STAGE(PG8_SB(0, 1), cB + hstep, voffB); PG8_STAGE_A(PG8_SA(0, 0), cA, 0, false); PG8_STAGE_A(PG8_SA(0, 1), cA, 1, false);
        if (wr == 1) PG8_BAR;
        PG8_WAIT_V(2); PG8_BAR;
        PG8_STAGE(PG8_SB(1, 0), cB + kstep, voffB); PG8_STAGE_A(PG8_SA(1, 0), cA + kstep, 0, false); PG8_STAGE(PG8_SB(1, 1), cB + hstep + kstep, voffB);
        PG8_WAIT_V(6); PG8_BAR;
    } else {
        PG8_STAGE(PG8_SB(0, 0), cB, voffB); PG8_STAGE(PG8_SA(0, 0), cA, voffA); PG8_STAGE(PG8_SB(0, 1), cB + hstep, voffB); PG8_STAGE(PG8_SA(0, 1), cA + hstep, voffA);
        if (wr == 1) PG8_BAR;
        PG8_WAIT_V(4); PG8_BAR;
        PG8_STAGE(PG8_SB(1, 0), cB + kstep, voffB); PG8_STAGE(PG8_SA(1, 0), cA + kstep, voffA); PG8_STAGE(PG8_SB(1, 1), cB + hstep + kstep, voffB);
        PG8_WAIT_V(6); PG8_BAR;
    }
    for (;;) {
        const bool has_next = S.next(ui + 1, nxt);
        const char* nA = GATHER ? cA : (has_next ? (const char*)g.A + (size_t)nxt.pm * tstep : cA); const char* nB = has_next ? (const char*)g.Bt + (size_t)nxt.pn * tstep : cB;
        if constexpr (GATHER) { if (has_next) PG8_GSET(vgn, nxt); }
        for (int t = 0; t < nt; t += 2) {
            const bool last = (t == nt - 2);
            const char* a1 = cA + (size_t)(t + 1) * kstep;
            const char* a2 = last ? nA : cA + (size_t)(t + 2) * kstep; const char* b2 = last ? nB : cB + (size_t)(t + 2) * kstep;
            const char* a3 = a2 + kstep; const char* b3 = b2 + kstep;
            if (last && has_next) S.a_ready(nxt);
            const bool unx = last && has_next;
            if constexpr (SP2) {
            PG8_LDB(B0, 0, 0); PG8_LDB(B1, 0, 1); PG8_SCHED; PG8_LDA(At, 0, 0); PG8_STAGE_A(PG8_SA(1, 1), a1, 1, false);
            PG8_WAIT_V(8); PG8_WAIT_L(0); PG8_BAR; PG8_MMA(0, 0, At, B0); PG8_MMA(0, 1, At, B1); PG8_BAR; PG8_SCHED;
            PG8_LDA(At, 0, 1); PG8_STAGE(PG8_SB(0, 0), b2, voffB); PG8_STAGE(PG8_SB(0, 1), b2 + hstep, voffB); PG8_STAGE_A(PG8_SA(0, 0), a2, 0, unx);
            PG8_WAIT_V(8); PG8_WAIT_L(0); PG8_BAR; PG8_MMA(1, 0, At, B0); PG8_MMA(1, 1, At, B1); PG8_BAR; PG8_SCHED;
            PG8_LDB(B0, 1, 0); PG8_LDB(B1, 1, 1); PG8_SCHED; PG8_LDA(At, 1, 0); PG8_STAGE_A(PG8_SA(0, 1), a2, 1, unx);
            PG8_WAIT_V(8); PG8_WAIT_L(0); PG8_BAR; PG8_MMA(0, 0, At, B0); PG8_MMA(0, 1, At, B1); PG8_BAR; PG8_SCHED;
            PG8_LDA(At, 1, 1); PG8_STAGE(PG8_SB(1, 0), b3, voffB); PG8_STAGE(PG8_SB(1, 1), b3 + hstep, voffB); PG8_STAGE_A(PG8_SA(1, 0), a3, 0, unx);
            PG8_WAIT_V(8); PG8_WAIT_L(0); PG8_BAR; PG8_MMA(1, 0, At, B0); PG8_MMA(1, 1, At, B1); PG8_BAR; PG8_SCHED;
            } else {
            PG8_LDB(B0, 0, 0); PG8_SCHED; PG8_LDA(At, 0, 0); PG8_STAGE(PG8_SA(1, 1), a1 + hstep, voffA);
            PG8_WAIT_L(8); PG8_BAR; PG8_WAIT_L(0); PG8_MMA(0, 0, At, B0); PG8_BAR; PG8_SCHED;
            PG8_LDB(B1, 0, 1); PG8_STAGE(PG8_SB(0, 0), b2, voffB);
            PG8_BAR; PG8_WAIT_L(0); PG8_MMA(0, 1, At, B1); PG8_BAR;
            PG8_LDA(At, 0, 1); PG8_STAGE(PG8_SA(0, 0), a2, voffA);
            PG8_BAR; PG8_WAIT_L(0); PG8_MMA(1, 0, At, B0); PG8_BAR; PG8_SCHED;
            PG8_STAGE(PG8_SB(0, 1), b2 + hstep, voffB);
            PG8_WAIT_V(6); PG8_BAR; PG8_MMA(1, 1, At, B1); PG8_BAR;
            PG8_LDB(B0, 1, 0); PG8_SCHED; PG8_LDA(At, 1, 0); PG8_STAGE(PG8_SA(0, 1), a2 + hstep, voffA);
            PG8_WAIT_L(8); PG8_BAR; PG8_WAIT_L(0); PG8_MMA(0, 0, At, B0); PG8_BAR; PG8_SCHED;
            PG8_LDB(B1, 1, 1); PG8_STAGE(PG8_SB(1, 0), b3, voffB);
            PG8_BAR; PG8_WAIT_L(0); PG8_MMA(0, 1, At, B1); PG8_BAR;
            PG8_LDA(At, 1, 1); PG8_STAGE(PG8_SA(1, 0), a3, voffA);
            PG8_BAR; PG8_WAIT_L(0); PG8_MMA(1, 0, At, B0); PG8_BAR; PG8_SCHED;
            PG8_STAGE(PG8_SB(1, 1), b3 + hstep, voffB);
            PG8_WAIT_V(6); PG8_BAR; PG8_MMA(1, 1, At, B1); PG8_BAR;
            }
        }
        if constexpr (ALIGN_EPI) { if (wr == 0) PG8_BAR; }
        if constexpr (!Epi::AFTER_DRAIN) { E(acc, cur, wr, wc, fr, fq); S.done(cur); }
        if (!has_next) break;
#pragma unroll
        for (int a = 0; a < 2; ++a)
#pragma unroll
            for (int b = 0; b < 2; ++b)
#pragma unroll
                for (int m = 0; m < 4; ++m)
#pragma unroll
                    for (int n = 0; n < 2; ++n) acc[a][b][m][n] = (f32x4){0.f, 0.f, 0.f, 0.f};
        cur = nxt; cA = nA; cB = nB; ++ui;
        if constexpr (GATHER) { _Pragma("unroll") for (int _h = 0; _h < 2; ++_h) _Pragma("unroll") for (int _i = 0; _i < 2; ++_i) vgc[_h][_i] = vgn[_h][_i]; }
        if constexpr (ALIGN_EPI) { if (wr == 1) PG8_BAR; }
    }
    PG8_WAIT_V(0);
    if constexpr (!ALIGN_EPI) { if (wr == 0) PG8_BAR; }
    PG8_BAR;
    if constexpr (Epi::AFTER_DRAIN) { E.fused(acc, cur, wr, wc, fr, fq, lds, wid, lane); S.done(cur); }
#undef PG8_SA
#undef PG8_STAGE_A
#undef PG8_GSET
#undef PG8_SB
#undef PG8_STAGE
#undef PG8_LDA
#undef PG8_LDB
#undef PG8_MMA
#undef PG8_WAIT_V
#undef PG8_WAIT_L
#undef PG8_BAR
#undef PG8_SCHED
}
}

#ifndef ONE_LAUNCH
#define ONE_LAUNCH 1
#endif
constexpr int NWAVES = 8, NTHR = 512;
constexpr int D = 1024, BATCH = 2, SEQ = 8192, CTXL = 256, GRIDW = 64;
constexpr int MX = BATCH * SEQ, MC = BATCH * CTXL, MALL = MX + MC;
constexpr int NCH = 132;
constexpr int NSLAB = 5632, NS1 = 3584, NS2 = 2048;
constexpr int NZM = 4416;
constexpr int Z_R = 0, Z_K = 1024, Z_V = 2048, Z_KK = 3072, Z_TW = 4096, Z_AD = 4160, Z_GS = 4224;
constexpr int C_R = 0, C_K = 1024, C_V = 2048, C_WD = 3072, C_AD = 3136, C_GD = 3200, C_XB = 0, C_GBR = 1024;
constexpr int NWIN = 7680;
constexpr int NEXP = 32, DEXP = 512, MAXT = 160;
constexpr float LN_EPS = 1e-5f, GN_EPS = 64e-5f;
constexpr float ALPHA = 1.189207115002721f;
constexpr size_t MiB = 1u << 20;
constexpr size_t WS_CTL = 0, CTL_ZERO_BYTES = 1 * MiB;
constexpr size_t WS_STATS = 1 * MiB, WS_TOKE = 1 * MiB + 256 * 1024, WS_TOKSLOT = 1 * MiB + 512 * 1024, WS_TOKW = 1 * MiB + 768 * 1024, WS_ROWW = 2 * MiB;
constexpr size_t WS_RWT = 2 * MiB + 512 * 1024;
constexpr size_t WS_S2T = 3 * MiB, WS_AGGA = 5 * MiB, WS_AGGH = 9 * MiB + 256 * 1024, WS_CIN = 13 * MiB + 512 * 1024;
constexpr size_t WS_PW = 18 * MiB;
constexpr size_t WS_S1 = 24 * MiB;
constexpr size_t WS_S2 = 139 * MiB + 512 * 1024;
constexpr size_t WS_ZM = 139 * MiB + 512 * 1024;
constexpr size_t WS_FB = 206 * MiB;
constexpr size_t WS_YLRU = 282 * MiB, WS_YWF = 24 * MiB, WS_YWB = 56 * MiB;
constexpr size_t WS_GATES = 140 * MiB;
constexpr size_t WS_MBUF = 204 * MiB;
constexpr size_t WS_W13 = 24 * MiB, WS_W2 = 88 * MiB;
constexpr size_t WS_H2 = 120 * MiB;
constexpr size_t WS_XS = 153 * MiB;
constexpr size_t WS_HBUF = 236 * MiB;
constexpr size_t WS_END = 314 * MiB;
static_assert(WS_S1 + (size_t)MALL * NS1 * 2 <= WS_S2 && WS_S2 + (size_t)MALL * NS2 * 2 <= WS_YLRU && WS_ZM + (size_t)MALL * NZM * 2 <= WS_YLRU && WS_YLRU + (size_t)MX * D * 2 <= WS_END, "ws map");
static_assert((WS_YLRU - WS_YWF) % (512 * 1024) == 0 && WS_H2 + (size_t)(MX + 1) * D * 2 <= WS_XS && WS_XS + (size_t)MAXT * 256 * D * 2 <= WS_HBUF && WS_HBUF + (size_t)MAXT * 256 * DEXP * 2 <= WS_END, "ws map 2");
constexpr size_t DO_H = 0, DO_WIN = 34 * MiB;
constexpr int CW_TMO = 0, CW_BAR = 4096, CW_MOD = 8192  , CW_ECNT = 32768  ;
constexpr int LDS_BYTES = 155648;
constexpr int MISC_OFF = LDS_BYTES - 1024;
constexpr int TILE_OFF = MISC_OFF - 2048;

#define GAS __attribute__((address_space(1)))
#define LAS __attribute__((address_space(3)))
typedef unsigned short bf16;
typedef unsigned v4u __attribute__((ext_vector_type(4)));
typedef unsigned v2u __attribute__((ext_vector_type(2)));
typedef float f32x4 __attribute__((ext_vector_type(4)));
typedef GAS unsigned gu32;
typedef short bf16x8 __attribute__((ext_vector_type(8)));
#define RLX_AGENT __ATOMIC_RELAXED, __HIP_MEMORY_SCOPE_AGENT
#define LDS_WAIT() asm volatile("s_waitcnt lgkmcnt(0)" ::: "memory")
#define VM_WAIT() asm volatile("s_waitcnt vmcnt(0)" ::: "memory")
#define DI __device__ __forceinline__
typedef __bf16 bf16x2_t __attribute__((ext_vector_type(2)));
typedef float f32x2 __attribute__((ext_vector_type(2)));
DI unsigned cvtpk_s(float lo, float hi) { const f32x2 v = {lo, hi}; const bf16x2_t b = __builtin_convertvector(v, bf16x2_t); return __builtin_bit_cast(unsigned, b); }
DI unsigned pk2(float lo, float hi) { return cvtpk_s(lo, hi); }
DI unsigned f2bf(float f) { return cvtpk_s(f, 0.f) & 0xffffu; }
DI float bf2f(unsigned short b) { return __builtin_bit_cast(float, ((unsigned)b) << 16); }
DI float bflo(unsigned w) { return __builtin_bit_cast(float, w << 16); }
DI float bfhi(unsigned w) { return __builtin_bit_cast(float, w & 0xffff0000u); }
constexpr float NL2E = -1.4426950408889634f;
DI float frcp(float x) { return __builtin_amdgcn_rcpf(x); }
DI float sigm(float x) { return 1.f / (1.f + __expf(-x)); }
DI float sigm_fast(float x) { return frcp(1.f + __expf(-x)); }
template <int CTRL> DI float dppf(float x) { return __builtin_bit_cast(float, __builtin_amdgcn_update_dpp(0, __builtin_bit_cast(int, x), CTRL, 0xF, 0xF, true)); }
template <int CTRL> DI float dppf_one(float x) { return __builtin_bit_cast(float, __builtin_amdgcn_update_dpp(0x3f800000, __builtin_bit_cast(int, x), CTRL, 0xF, 0xF, false)); }
DI float red4(float x) { x += dppf<0xB1>(x); x += dppf<0x4E>(x); return x; }
DI float red16(float x) { x += dppf<0xB1>(x); x += dppf<0x4E>(x); x += dppf<0x141>(x); x += dppf<0x140>(x); return x; }
DI float rdl(float v, int l) { return __builtin_bit_cast(float, __builtin_amdgcn_readlane(__builtin_bit_cast(int, v), l)); }
DI float wave_sum(float v) { v = red16(v); return (rdl(v, 0) + rdl(v, 16)) + (rdl(v, 32) + rdl(v, 48)); }

#define XB_TMO      128
#define XB_XCNT(j)  (256  + 64 * (j))
#define XB_XSUB(j)  (1280 + 64 * (j))
#define XB_XGEN(j)  (2304 + 64 * (j))
#define XB_TOP      3328
#define XB_TOPGEN   3392
#define XCD_BAR_WORDS 3456
#define XB_SPIN_CAP (1u << 18)

__device__ __forceinline__ unsigned xb_ld(unsigned* p)              { return __hip_atomic_load(p, __ATOMIC_RELAXED, __HIP_MEMORY_SCOPE_AGENT); }
__device__ __forceinline__ unsigned xb_add(unsigned* p, unsigned v) { return __hip_atomic_fetch_add(p, v, __ATOMIC_RELAXED, __HIP_MEMORY_SCOPE_AGENT); }
__device__ __forceinline__ unsigned xb_xcc_id() { return (unsigned)__builtin_amdgcn_s_getreg((3 << 11) | 20) & 0xFu; }
#define XB_SPIN(cond, bar) do { unsigned _sp = 0; while (cond) { __builtin_amdgcn_s_sleep(1); \
    if ((++_sp & 255u) == 0u) { if (xb_ld(&(bar)[XB_TMO])) break; if (_sp > XB_SPIN_CAP) { atomicAdd(&(bar)[XB_TMO], 1u); break; } } } } while (0)

struct XcdBarrier {
    unsigned* bar; unsigned x;
    volatile LAS unsigned* st;
};

__device__ __forceinline__ XcdBarrier xcd_barrier_post(unsigned* bar, volatile LAS unsigned* st) {
    XcdBarrier b; b.bar = bar; b.x = xb_xcc_id(); b.st = st;
    if (threadIdx.x == 0) (void)xb_add(&bar[XB_XCNT(b.x)], 1u);
    return b;
}
__device__ __forceinline__ void xcd_barrier_complete(unsigned* bar, unsigned x, unsigned& nloc, unsigned& nx) {
    const unsigned G = gridDim.x * gridDim.y * gridDim.z;
    unsigned sum, cnt, mine, sp = 0u;
    for (;;) {
        sum = 0u; cnt = 0u; mine = 0u;
#pragma unroll
        for (unsigned j = 0; j < 16; ++j) { const unsigned c = xb_ld(&bar[XB_XCNT(j)]); sum += c; cnt += (c > 0u) ? 1u : 0u; mine = (j == x) ? c : mine; }
        if (sum == G) break;
        __builtin_amdgcn_s_sleep(1);
        if ((++sp & 255u) == 0u) { if (xb_ld(&bar[XB_TMO])) break; if (sp > XB_SPIN_CAP) { atomicAdd(&bar[XB_TMO], 1u); break; } }
    }
    nloc = mine > 0u ? mine : 1u; nx = cnt > 0u ? cnt : 1u;
}

__device__ __forceinline__ void xcd_barrier(const XcdBarrier& b) {
    asm volatile("s_waitcnt vmcnt(0)" ::: "memory");
    __syncthreads();
    if (threadIdx.x == 0) {
        unsigned* bar = b.bar;
        __builtin_amdgcn_s_waitcnt(0);
        unsigned nloc = b.st[0], nx = b.st[1];
        if (nloc == 0u) { xcd_barrier_complete(bar, b.x, nloc, nx); b.st[0] = nloc; b.st[1] = nx; }
        const unsigned old = xb_add(&bar[XB_XSUB(b.x)], 1u);
        const unsigned gen = old / nloc;
        if (old + 1u == (gen + 1u) * nloc) {
            __builtin_amdgcn_fence(__ATOMIC_RELEASE, "agent");
            asm volatile("s_waitcnt vmcnt(0)" ::: "memory");
            const unsigned og = xb_add(&bar[XB_TOP], 1u);
            const unsigned tg = og / nx;
            if (og + 1u == (tg + 1u) * nx) xb_add(&bar[XB_TOPGEN], 1u);
            else XB_SPIN(xb_ld(&bar[XB_TOPGEN]) == tg, bar);
            __builtin_amdgcn_fence(__ATOMIC_ACQUIRE, "agent");
            xb_add(&bar[XB_XGEN(b.x)], 1u);
            asm volatile("s_waitcnt vmcnt(0)" ::: "memory");
        } else {
            XB_SPIN(xb_ld(&bar[XB_XGEN(b.x)]) == gen, bar);
            __builtin_amdgcn_fence(__ATOMIC_ACQUIRE, "agent");
            asm volatile("s_waitcnt vmcnt(0)" ::: "memory");
        }
    }
    __syncthreads();
}

struct Args { const float* in[39]; float* out; unsigned char* ws; int ph_lo, ph_hi; };

struct P {
    const float *x, *c, *ctx, *c_ctx, *w_ada, *b_ada, *w_in, *mu_a, *w0, *w2, *a0, *a2, *g2, *k_k, *k_a, *r_k, *gn_g, *gn_b, *conv_w, *conv_b,
        *lru_wa, *lru_ba, *lru_wx, *lru_bx, *lru_lam, *p_a, *p_b, *w_o, *ln1_g, *ln1_b, *router_g, *router_g_b, *router_e, *router_e_b, *e_w1, *e_w3, *e_w2, *ln2_g, *ln2_b;
    float* out; unsigned char* ws; unsigned char* dob;
    float* ctlf; unsigned* ctl;
};

DI float modv(const P& p, int v, int n) { return p.ctlf[CW_MOD + v * 6144 + n] + p.b_ada[n]; }
DI f32x4 modv4(const P& p, int v, int n) { return *(const f32x4*)(p.ctlf + CW_MOD + v * 6144 + n) + *(const f32x4*)(p.b_ada + n); }

DI void transpose_item(const float* W, int ldw, bf16* WT, int ldt, int k0, int n0, int drow0, LAS float* scr, int lane) {
#pragma unroll 8
    for (int i = 0; i < 32; ++i) { const int kk = 2 * i + (lane >> 5); scr[kk * 33 + (lane & 31)] = W[(size_t)(k0 + kk) * ldw + n0 + (lane & 31)]; }
    LDS_WAIT(); asm volatile("" ::: "memory");
    const int c = lane & 7;
#pragma unroll
    for (int j = 0; j < 4; ++j) { const int n = (lane >> 3) + 8 * j; const LAS float* s = scr + (8 * c) * 33 + n;
        v4u o; o.x = pk2(s[0 * 33], s[1 * 33]); o.y = pk2(s[2 * 33], s[3 * 33]); o.z = pk2(s[4 * 33], s[5 * 33]); o.w = pk2(s[6 * 33], s[7 * 33]);
        *(GAS v4u*)(WT + (size_t)(drow0 + n) * ldt + k0 + 8 * c) = o; }
    LDS_WAIT(); asm volatile("" ::: "memory");
}

DI void phase0(const P& p, LAS unsigned char* lds, int tid, int lane, int wave, int G) {
    LAS float* s3 = (LAS float*)lds;
    for (int item = blockIdx.x; item < 256; item += G) {
        const int kc = item >> 4, nc = item & 15;
        if (tid < 192) { const int v = tid >> 6, k = tid & 63; const float cv = (v < 2) ? p.c[v * D + kc * 64 + k] : p.c_ctx[kc * 64 + k]; s3[v * 64 + k] = cv * sigm(cv); }
        __syncthreads();
        if (tid < 384) { const int n = nc * 384 + tid; float a0 = 0.f, a1 = 0.f, a2 = 0.f;
            for (int k = 0; k < 64; ++k) { const float w = p.w_ada[(size_t)(kc * 64 + k) * 6144 + n]; a0 += s3[k] * w; a1 += s3[64 + k] * w; a2 += s3[128 + k] * w; }
            atomicAdd(p.ctlf + CW_MOD + n, a0); atomicAdd(p.ctlf + CW_MOD + 6144 + n, a1); atomicAdd(p.ctlf + CW_MOD + 2 * 6144 + n, a2); }
        __syncthreads();
    }
}
DI void phase0b(const P& p, LAS unsigned char* lds, int tid, int lane, int wave, int G) {
    LAS float* scr = (LAS float*)(lds + 4096 + wave * 16384);
    const int gw = blockIdx.x * NWAVES + wave, NGW = G * NWAVES;
    bf16* win_t = (bf16*)(p.dob + DO_WIN); bf16* pw = (bf16*)(p.ws + WS_PW);
    constexpr int I_IN = 16 * 233, I_P = 16 * 32;
    for (int it = gw; it < I_IN + 3 * I_P; it += NGW) {
        int r = it;
        if (r < I_IN) { const int kb = r / 233, nb = r % 233, n0 = nb * 32; transpose_item(p.w_in, 7456, win_t, D, kb * 64, n0, n0 + (n0 >= 3360 ? 224 : 0), scr, lane); continue; }
        r -= I_IN; const int wsel = r / I_P; r %= I_P; const int kb = r / 32, nb = r % 32;
        if (wsel == 0) transpose_item(p.p_a, D, pw, D, kb * 64, nb * 32, nb * 32, scr, lane);
        else if (wsel == 1) transpose_item(p.p_b, D, pw + (size_t)D * D, D, kb * 64, nb * 32, nb * 32, scr, lane);
        else transpose_item(p.w_o, D, pw + (size_t)2 * D * D, D, kb * 64, nb * 32, nb * 32, scr, lane);
    }
    { float* rwt = (float*)(p.ws + WS_RWT);
      for (int i = blockIdx.x * NTHR + tid; i < 48 * D; i += G * NTHR) { const int n = i >> 10, k = i & (D - 1); rwt[i] = n < 4 ? p.router_g[k * 4 + n] : (n < 36 ? p.router_e[k * 32 + (n - 4)] : 0.f); } }
    for (int i = blockIdx.x * NTHR + tid; i < 224 * D / 8; i += G * NTHR) ((GAS v4u*)(win_t + (size_t)3360 * D))[i] = (v4u){0u, 0u, 0u, 0u};
}

DI void phase1(const P& p, int lane, int wave, int G) {
    const int gw = blockIdx.x * NWAVES + wave, NGW = G * NWAVES;
    bf16* H = (bf16*)(p.dob + DO_H); float* stats = (float*)(p.ws + WS_STATS);
    f32x4 sc[2][4], sh[2][4]; int cv[2] = {-1, -1};
#pragma unroll
    for (int j = 0; j < 4; ++j) { sc[0][j] = sc[1][j] = sh[0][j] = sh[1][j] = (f32x4){0.f, 0.f, 0.f, 0.f}; }
    for (int m0 = gw; m0 < MALL; m0 += 2 * NGW) {
        f32x4 q[2][4]; float s[2] = {0.f, 0.f}; int mm[2]; mm[0] = m0; mm[1] = (m0 + NGW < MALL) ? m0 + NGW : m0;
#pragma unroll
        for (int rr = 0; rr < 2; ++rr) { const int m = mm[rr]; const float* xrow = (m < MX) ? p.x + (size_t)m * D : p.ctx + (size_t)(m - MX) * D; const GAS f32x4* xr = (const GAS f32x4*)xrow + lane;
#pragma unroll
            for (int j = 0; j < 4; ++j) { q[rr][j] = xr[64 * j]; s[rr] += (q[rr][j].x + q[rr][j].y) + (q[rr][j].z + q[rr][j].w); } }
#pragma unroll
        for (int rr = 0; rr < 2; ++rr) { const int m = mm[rr]; const int v = (m < MX) ? (m >> 13) : 2;
            if (v != cv[rr]) { cv[rr] = v;
#pragma unroll
                for (int j = 0; j < 4; ++j) { const int n = 256 * j + 4 * lane; sc[rr][j] = modv4(p, v, 1024 + n) + 1.f; sh[rr][j] = modv4(p, v, n); } }
            const float mean = wave_sum(s[rr]) * (1.f / D); float s2 = 0.f;
#pragma unroll
            for (int j = 0; j < 4; ++j) { q[rr][j] = q[rr][j] - mean; s2 += (q[rr][j].x * q[rr][j].x + q[rr][j].y * q[rr][j].y) + (q[rr][j].z * q[rr][j].z + q[rr][j].w * q[rr][j].w); }
            const float rstd = 1.f / sqrtf(wave_sum(s2) * (1.f / D) + LN_EPS);
            if (rr == 0 || mm[1] != mm[0]) {
                if (lane == 0) { stats[2 * m] = mean; stats[2 * m + 1] = rstd; }
                GAS v2u* o8 = (GAS v2u*)(H + (size_t)m * D) + lane;
#pragma unroll
                for (int j = 0; j < 4; ++j) { const f32x4 h = q[rr][j] * rstd * sc[rr][j] + sh[rr][j];
                    o8[64 * j] = (v2u){pk2(h[0], h[1]), pk2(h[2], h[3])}; } } }
    }
}

template <int ACT> struct EpiPlain {
    static constexpr bool PERM = true, AFTER_DRAIN = false;
    bf16* O; int ldc; bf16* O2; int ldc2; int split_tile;
    DI void operator()(const pg8::f32x4 (&acc)[2][2][4][2], const pg8::Unit& u, int wr, int wc, int fr, int fq) const {
        const bool second = u.pn >= split_tile; bf16* Ob = second ? O2 : O; const int ld = second ? ldc2 : ldc, pn = second ? u.pn - split_tile : u.pn;
        const int row0 = u.pm * 256 + wr * 64 + fr, col0 = pn * 256 + wc * 32 + 8 * fq;
#pragma unroll
        for (int ai = 0; ai < 2; ++ai)
#pragma unroll
            for (int m = 0; m < 4; ++m) { bf16* rowp = Ob + (size_t)(row0 + ai * 128 + m * 16) * ld + col0;
#pragma unroll
                for (int bj = 0; bj < 2; ++bj) { pg8::f32x4 v0 = acc[ai][bj][m][0], v1 = acc[ai][bj][m][1];
                    if (ACT == 1) {
#pragma unroll
                        for (int i = 0; i < 4; ++i) { v0[i] = sigm_fast(v0[i]); v1[i] = sigm_fast(v1[i]); } }
                    pg8::u32x4 w;
                    if (ACT == 1) { w.x = cvtpk_s(v0[0], v0[1]); w.y = cvtpk_s(v0[2], v0[3]); w.z = cvtpk_s(v1[0], v1[1]); w.w = cvtpk_s(v1[2], v1[3]); }
                    else { w.x = pg8::cvt_pk_bf16(v0[0], v0[1]); w.y = pg8::cvt_pk_bf16(v0[2], v0[3]); w.z = pg8::cvt_pk_bf16(v1[0], v1[1]); w.w = pg8::cvt_pk_bf16(v1[2], v1[3]); }
                    *(pg8::u32x4*)(rowp + bj * 128) = w; } }
    }
};
constexpr int LRU_TOFF = (int)((WS_YLRU - WS_YWF) / (512 * 1024));
struct EpiMix {
    static constexpr bool PERM = true, AFTER_DRAIN = false;
    const bf16* gates; bf16* mbuf;
    DI void operator()(const pg8::f32x4 (&acc)[2][2][4][2], const pg8::Unit& u, int wr, int wc, int fr, int fq) const {
        const bool isa = u.pm < 64; const int row0 = (isa ? u.pm : u.pm - LRU_TOFF) * 256 + wr * 64 + fr, col0 = (u.pn & 3) * 256 + wc * 32 + 8 * fq;
#pragma unroll
        for (int ai = 0; ai < 2; ++ai)
#pragma unroll
            for (int m = 0; m < 4; ++m) { const int row = row0 + ai * 128 + m * 16;
#pragma unroll
                for (int bj = 0; bj < 2; ++bj) { const int col = col0 + bj * 128;
                    const pg8::u32x4 gw = *(const pg8::u32x4*)(gates + (size_t)row * 2048 + (isa ? 0 : 1024) + col);
                    bf16* mp = mbuf + (size_t)row * D + col;
                    pg8::u32x4 old = (pg8::u32x4){0u, 0u, 0u, 0u}; if (isa) old = *(const pg8::u32x4*)mp;
                    const pg8::f32x4 v0 = acc[ai][bj][m][0], v1 = acc[ai][bj][m][1];
                    float r[8];
                    r[0] = v0[0] * bflo(gw.x) + bflo(old.x); r[1] = v0[1] * bfhi(gw.x) + bfhi(old.x); r[2] = v0[2] * bflo(gw.y) + bflo(old.y); r[3] = v0[3] * bfhi(gw.y) + bfhi(old.y);
                    r[4] = v1[0] * bflo(gw.z) + bflo(old.z); r[5] = v1[1] * bfhi(gw.z) + bfhi(old.z); r[6] = v1[2] * bflo(gw.w) + bflo(old.w); r[7] = v1[3] * bfhi(gw.w) + bfhi(old.w);
                    pg8::u32x4 w; w.x = pg8::cvt_pk_bf16(r[0], r[1]); w.y = pg8::cvt_pk_bf16(r[2], r[3]); w.z = pg8::cvt_pk_bf16(r[4], r[5]); w.w = pg8::cvt_pk_bf16(r[6], r[7]);
                    *(pg8::u32x4*)mp = w; } }
    }
};
struct EpiT1 {
    static constexpr bool PERM = false, AFTER_DRAIN = false;
    const float* x; const float* stats; const float* modp; const float* b_ada; float* T1;
    DI void operator()(const pg8::f32x4 (&acc)[2][2][4][2], const pg8::Unit& u, int wr, int wc, int fr, int fq) const {
        const int row0 = u.pm * 256 + wr * 64 + fr, col0 = u.pn * 256 + wc * 32 + 4 * fq; const int b = (u.pm * 256) >> 13;
        pg8::f32x4 gt[2][2];
#pragma unroll
        for (int bj = 0; bj < 2; ++bj)
#pragma unroll
            for (int n = 0; n < 2; ++n) { const int c = col0 + bj * 128 + n * 16; gt[bj][n] = *(const pg8::f32x4*)(modp + b * 6144 + 2048 + c) + *(const pg8::f32x4*)(b_ada + 2048 + c); }
#pragma unroll
        for (int ai = 0; ai < 2; ++ai)
#pragma unroll
            for (int m = 0; m < 4; ++m) { const int row = row0 + ai * 128 + m * 16; const float mean = stats[2 * row], rstd = stats[2 * row + 1];
#pragma unroll
                for (int bj = 0; bj < 2; ++bj)
#pragma unroll
                    for (int n = 0; n < 2; ++n) { const size_t o = (size_t)row * D + col0 + bj * 128 + n * 16;
                        const pg8::f32x4 xv = *(const pg8::f32x4*)(x + o);
                        *(pg8::f32x4*)(T1 + o) = (xv - mean) * (rstd * ALPHA) + gt[bj][n] * acc[ai][bj][m][n]; } }
    }
};
struct EpiSwiGLU {
    static constexpr bool PERM = true, AFTER_DRAIN = false;
    bf16* hb;
    DI void operator()(const pg8::f32x4 (&acc)[2][2][4][2], const pg8::Unit& u, int wr, int wc, int fr, int fq) const {
        const int row0 = u.pm * 256 + wr * 64 + fr, col0 = (u.pn & 3) * 128 + wc * 32 + 8 * fq;
#pragma unroll
        for (int ai = 0; ai < 2; ++ai)
#pragma unroll
            for (int m = 0; m < 4; ++m) { float r[8];
#pragma unroll
                for (int n = 0; n < 2; ++n)
#pragma unroll
                    for (int i = 0; i < 4; ++i) { const float a = acc[ai][0][m][n][i], b = acc[ai][1][m][n][i]; r[4 * n + i] = a * sigm_fast(a) * b; }
                pg8::u32x4 w; w.x = pg8::cvt_pk_bf16(r[0], r[1]); w.y = pg8::cvt_pk_bf16(r[2], r[3]); w.z = pg8::cvt_pk_bf16(r[4], r[5]); w.w = pg8::cvt_pk_bf16(r[6], r[7]);
                *(pg8::u32x4*)(hb + (size_t)(row0 + ai * 128 + m * 16) * DEXP + col0) = w; }
    }
};
struct EpiW2 {
    static constexpr bool PERM = true, AFTER_DRAIN = false;
    bf16* yb; const LAS int* tile; const int* s2t; const float* tokw;
    DI void operator()(const pg8::f32x4 (&acc)[2][2][4][2], const pg8::Unit& u, int wr, int wc, int fr, int fq) const {
        const int row0 = u.pm * 256 + wr * 64 + fr, col0 = (u.pn & 3) * 256 + wc * 32 + 8 * fq;
        const int ex = tile[u.pm], slot0 = (u.pm - tile[MAXT + ex]) * 256 + wr * 64 + fr, cnt = tile[MAXT + 64 + ex];
#pragma unroll
        for (int ai = 0; ai < 2; ++ai)
#pragma unroll
            for (int m = 0; m < 4; ++m) { const int row = row0 + ai * 128 + m * 16, slot = slot0 + ai * 128 + m * 16; const float rw = slot < cnt ? tokw[s2t[(size_t)ex * MX + slot]] : 0.f;
#pragma unroll
                for (int bj = 0; bj < 2; ++bj) { const pg8::f32x4 v0 = acc[ai][bj][m][0] * rw, v1 = acc[ai][bj][m][1] * rw;
                    pg8::u32x4 w; w.x = pg8::cvt_pk_bf16(v0[0], v0[1]); w.y = pg8::cvt_pk_bf16(v0[2], v0[3]); w.z = pg8::cvt_pk_bf16(v1[0], v1[1]); w.w = pg8::cvt_pk_bf16(v1[2], v1[3]);
                    *(pg8::u32x4*)(yb + (size_t)row * D + col0 + bj * 128) = w; } }
    }
};
struct SchedMix : pg8::StaticOrder {
    __device__ bool next(int i, pg8::Unit& u) const { pg8::Unit t; if (!pg8::StaticOrder::next(i >> 1, t)) return false; const int w = i & 1; u.pm = w ? t.pm : t.pm + LRU_TOFF; u.pn = w ? t.pn : t.pn + 4; return true; }
};
struct SchedMoE {
    const LAS int* tile; int G, c; const int* s2t;
    DI int src_row(int T, int r) const { const int e = tile[T], slot = (T - tile[MAXT + e]) * 256 + r; return slot < tile[MAXT + 64 + e] ? (s2t[(size_t)e * MX + slot] >> 1) : MX; }
    __device__ bool next(int i, pg8::Unit& u) const { int L = i * G + c; const int U = tile[MAXT + 40] * 4; if (L >= U) return false;
        { const int q = U / pg8::NXCD, r = U % pg8::NXCD, xcd = L % pg8::NXCD, off = L / pg8::NXCD; L = (xcd < r ? xcd * (q + 1) : r * (q + 1) + (xcd - r) * q) + off; }
        const int T = L >> 2; u.pm = T; u.pn = tile[T] * 4 + (L & 3); return true; }
    DI void a_ready(const pg8::Unit&) const {}
    DI void done(const pg8::Unit&) const {}
};

DI int chunk_row0(int b, int ci) { return ci < 4 ? MX + b * CTXL + ci * 64 : b * SEQ + (ci - 4) * 64; }
DI float gelu_tanh(float x) { const float u = 0.7978845608028654f * (x + 0.044715f * x * x * x); const float t = 1.f - 2.f * frcp(1.f + __expf(2.f * u)); return 0.5f * x * (1.f + t); }
constexpr int NHS = 264;
constexpr int LR_WT = 0, LR_CW = 36864, LR_WV = 38400, LR_WVS = 6656;
DI void lru_setup(const P& p, LAS unsigned char* lds, int tid, int hb) {
    LAS bf16* WT = (LAS bf16*)(lds + LR_WT); LAS float* CW = (LAS float*)(lds + LR_CW);
    __syncthreads();
    for (int i = tid; i < 4 * 4096; i += NTHR) { const int m = i >> 12, k = (i >> 6) & 63, n = i & 63; const int e = m & 1;
        const float w = (m < 2 ? p.lru_wa : p.lru_wx)[((size_t)(e * 16 + hb) * 64 + k) * 64 + n]; WT[m * 4608 + n * 72 + k] = (bf16)f2bf(NL2E * w); }
    for (int i = tid; i < 6 * 64; i += NTHR) { const int r = i >> 6, c = i & 63; CW[i] = r < 5 ? p.conv_w[r * D + hb * 64 + c] : p.conv_b[hb * 64 + c]; }
    __syncthreads();
}
struct LruC { float ba[2][4], bx[2][4], sp8[2][4]; };
DI void lru_consts(const P& p, int hb, int l15, LruC& C) {
#pragma unroll
    for (int e = 0; e < 2; ++e)
#pragma unroll
        for (int nt = 0; nt < 4; ++nt) { const int c = hb * 64 + nt * 16 + l15; C.ba[e][nt] = NL2E * p.lru_ba[e * D + c]; C.bx[e][nt] = NL2E * p.lru_bx[e * D + c]; C.sp8[e][nt] = (8.f * NL2E) * log1pf(__expf(-p.lru_lam[e * D + c])); }
}
DI void hs_geom(int b, int hs, int& row0, int& tb, int& tlen) { if (hs < 8) { tb = hs * 32; row0 = MX + b * CTXL + tb; tlen = CTXL; } else { tb = (hs - 8) * 32; row0 = b * SEQ + tb; tlen = SEQ; } }
DI void lru_conv(const bf16* S, LAS unsigned char* lds, LAS unsigned char* wv, int lane, int hb, int rowb, int tb, int tlen) {
    LAS float* CW = (LAS float*)(lds + LR_CW); LAS bf16* XCB = (LAS bf16*)wv; LAS float* XC = (LAS float*)(wv + 2304);
    const int tau = lane >> 2, qd = lane & 3; const bf16* sp = S + (size_t)(rowb + tau) * NS2 + C_XB + hb * 64 + qd * 16;
    float a[16];
#pragma unroll
    for (int i4 = 0; i4 < 4; ++i4) { const f32x4 bv = *(const LAS f32x4*)(CW + 5 * 64 + qd * 16 + 4 * i4); a[4 * i4] = bv[0]; a[4 * i4 + 1] = bv[1]; a[4 * i4 + 2] = bv[2]; a[4 * i4 + 3] = bv[3]; }
    v4u w[5][2];
#pragma unroll
    for (int i = 0; i < 5; ++i) { const int t = tb + tau + i - 2; const bool ok = t >= 0 && t < tlen;
        w[i][0] = ok ? *(const v4u*)(sp + (ptrdiff_t)(i - 2) * NS2) : (v4u){0u, 0u, 0u, 0u}; w[i][1] = ok ? *(const v4u*)(sp + (ptrdiff_t)(i - 2) * NS2 + 8) : (v4u){0u, 0u, 0u, 0u}; }
#pragma unroll
    for (int i = 0; i < 5; ++i)
#pragma unroll
        for (int hh = 0; hh < 2; ++hh) { const f32x4 c0 = *(const LAS f32x4*)(CW + i * 64 + qd * 16 + hh * 8), c1 = *(const LAS f32x4*)(CW + i * 64 + qd * 16 + hh * 8 + 4); const v4u x = w[i][hh];
            a[hh * 8 + 0] += c0[0] * bflo(x.x); a[hh * 8 + 1] += c0[1] * bfhi(x.x); a[hh * 8 + 2] += c0[2] * bflo(x.y); a[hh * 8 + 3] += c0[3] * bfhi(x.y);
            a[hh * 8 + 4] += c1[0] * bflo(x.z); a[hh * 8 + 5] += c1[1] * bfhi(x.z); a[hh * 8 + 6] += c1[2] * bflo(x.w); a[hh * 8 + 7] += c1[3] * bfhi(x.w); }
#pragma unroll
    for (int i4 = 0; i4 < 4; ++i4) *(LAS f32x4*)(XC + tau * 68 + qd * 16 + 4 * i4) = (f32x4){a[4 * i4], a[4 * i4 + 1], a[4 * i4 + 2], a[4 * i4 + 3]};
    *(LAS v4u*)(XCB + tau * 72 + qd * 16) = (v4u){pk2(a[0], a[1]), pk2(a[2], a[3]), pk2(a[4], a[5]), pk2(a[6], a[7])};
    *(LAS v4u*)(XCB + tau * 72 + qd * 16 + 8) = (v4u){pk2(a[8], a[9]), pk2(a[10], a[11]), pk2(a[12], a[13]), pk2(a[14], a[15])};
}
DI void lru_gates(LAS unsigned char* lds, LAS unsigned char* wv, int lane, int e, const LruC& C, float (&av)[4][4], float (&uv)[4][4]) {
    LAS bf16* WT = (LAS bf16*)(lds + LR_WT); LAS bf16* XCB = (LAS bf16*)wv; LAS float* XC = (LAS float*)(wv + 2304);
    const int l15 = lane & 15, g = lane >> 4;
    pg8::f32x4 zr[4], zi[4];
#pragma unroll
    for (int nt = 0; nt < 4; ++nt) { zr[nt] = (pg8::f32x4){0.f, 0.f, 0.f, 0.f}; zi[nt] = (pg8::f32x4){0.f, 0.f, 0.f, 0.f}; }
#pragma unroll
    for (int ks = 0; ks < 2; ++ks) { const bf16x8 ax = *(const LAS bf16x8*)(XCB + l15 * 72 + ks * 32 + g * 8);
#pragma unroll
        for (int nt = 0; nt < 4; ++nt) { const bf16x8 br = *(const LAS bf16x8*)(WT + e * 4608 + (nt * 16 + l15) * 72 + ks * 32 + g * 8), bi = *(const LAS bf16x8*)(WT + (2 + e) * 4608 + (nt * 16 + l15) * 72 + ks * 32 + g * 8);
            zr[nt] = __builtin_amdgcn_mfma_f32_16x16x32_bf16(ax, br, zr[nt], 0, 0, 0); zi[nt] = __builtin_amdgcn_mfma_f32_16x16x32_bf16(ax, bi, zi[nt], 0, 0, 0); } }
#pragma unroll
    for (int nt = 0; nt < 4; ++nt)
#pragma unroll
        for (int i = 0; i < 4; ++i) { const float rg = frcp(1.f + __builtin_amdgcn_exp2f(zr[nt][i] + C.ba[e][nt])), ig = frcp(1.f + __builtin_amdgcn_exp2f(zi[nt][i] + C.bx[e][nt]));
            const float a = __builtin_amdgcn_exp2f(rg * C.sp8[e][nt]);
            const float em = fmaxf(__builtin_fmaf(-a, a, 1.f), 0.f);
            av[nt][i] = a; uv[nt][i] = __builtin_amdgcn_sqrtf(em) * ig * XC[(4 * g + i) * 68 + nt * 16 + l15]; }
}
DI float bperm(int srclane, float v) { return __builtin_bit_cast(float, __builtin_amdgcn_ds_bpermute(srclane * 4, __builtin_bit_cast(int, v))); }
template <int DIR> DI void lru_local(const float (&a)[4], const float (&u)[4], int l15, float (&hl)[4], float (&pl)[4], float (&PG)[4], float (&HG)[4]) {
    float h = 0.f, pr = 1.f;
#pragma unroll
    for (int q = 0; q < 4; ++q) { const int i = DIR ? 3 - q : q; h = a[i] * h + u[i]; pr *= a[i]; hl[i] = h; pl[i] = pr; }
#pragma unroll
    for (int gg = 0; gg < 4; ++gg) { PG[gg] = bperm(gg * 16 + l15, pr); HG[gg] = bperm(gg * 16 + l15, h); }
}
template <int PASS> DI void lru_unit(const P& p, LAS unsigned char* lds, int lane, int wave, int b, int hs, int hb, const LruC& C) {
    const bf16* S = (const bf16*)(p.ws + WS_S2); LAS unsigned char* wv = lds + LR_WV + wave * LR_WVS;
    const int l15 = lane & 15, g = lane >> 4; int row0, tb, tlen; hs_geom(b, hs, row0, tb, tlen);
    const size_t ao0 = ((size_t)(b * NHS + hs) * 2) * D + hb * 64 + l15;
    float av[4][4], uv[4][4], hl[4], pl[4], PG[4], HG[4];
    unsigned* FB = (unsigned*)(p.ws + WS_FB);
    if (PASS == 1) {
        float Af[4], Hf[4], Ab[4], Hb[4];
#pragma unroll
        for (int nt = 0; nt < 4; ++nt) { Af[nt] = 1.f; Hf[nt] = 0.f; Ab[nt] = 1.f; Hb[nt] = 0.f; }
#pragma unroll 1
        for (int band = 0; band < 2; ++band) { lru_conv(S, lds, wv, lane, hb, row0 + band * 16, tb + band * 16, tlen);
            lru_gates(lds, wv, lane, 0, C, av, uv);
#pragma unroll
            for (int nt = 0; nt < 4; ++nt) { lru_local<0>(av[nt], uv[nt], l15, hl, pl, PG, HG); float cc = Hf[nt], Pc = Af[nt], cm = cc, Pm = Pc;
#pragma unroll
                for (int gg = 0; gg < 4; ++gg) { if (gg == g) { cm = cc; Pm = Pc; } cc = PG[gg] * cc + HG[gg]; Pc *= PG[gg]; }
                Hf[nt] = cc; Af[nt] = Pc;
#pragma unroll
                for (int i = 0; i < 4; ++i) FB[(size_t)(row0 + band * 16 + 4 * g + i) * D + hb * 64 + nt * 16 + l15] = pk2(hl[i] + pl[i] * cm, pl[i] * Pm); }
            lru_gates(lds, wv, lane, 1, C, av, uv);
#pragma unroll
            for (int nt = 0; nt < 4; ++nt) { lru_local<1>(av[nt], uv[nt], l15, hl, pl, PG, HG); float A = PG[3], H = HG[3];
#pragma unroll
                for (int gg = 2; gg >= 0; --gg) { H = PG[gg] * H + HG[gg]; A *= PG[gg]; }
                Hb[nt] = Ab[nt] * H + Hb[nt]; Ab[nt] *= A; } }
        if (g == 0) { float* GA = (float*)(p.ws + WS_AGGA); float* GH = (float*)(p.ws + WS_AGGH);
#pragma unroll
            for (int nt = 0; nt < 4; ++nt) { GA[ao0 + nt * 16] = Af[nt]; GH[ao0 + nt * 16] = Hf[nt]; GA[ao0 + D + nt * 16] = Ab[nt]; GH[ao0 + D + nt * 16] = Hb[nt]; } }
    } else {
        const float* CI = (const float*)(p.ws + WS_CIN); bf16* Y = (bf16*)(p.ws + WS_YLRU);
        float Cf[4], Cb[4];
#pragma unroll
        for (int nt = 0; nt < 4; ++nt) { Cf[nt] = CI[ao0 + nt * 16]; Cb[nt] = CI[ao0 + D + nt * 16]; }
#pragma unroll 1
        for (int bq = 0; bq < 2; ++bq) { const int band = 1 - bq; lru_conv(S, lds, wv, lane, hb, row0 + band * 16, tb + band * 16, tlen);
            lru_gates(lds, wv, lane, 1, C, av, uv);
#pragma unroll
            for (int nt = 0; nt < 4; ++nt) { lru_local<1>(av[nt], uv[nt], l15, hl, pl, PG, HG); float c = Cb[nt], cm = c;
#pragma unroll
                for (int gg = 3; gg >= 0; --gg) { if (gg == g) cm = c; c = PG[gg] * c + HG[gg]; }
                Cb[nt] = c;
#pragma unroll
                for (int i = 0; i < 4; ++i) { const size_t yo = (size_t)(row0 + band * 16 + 4 * g + i) * D + hb * 64 + nt * 16 + l15;
                    const float gt = bf2f(S[(size_t)(row0 + band * 16 + 4 * g + i) * NS2 + C_GBR + hb * 64 + nt * 16 + l15]);
                    const unsigned fb = FB[yo];
                    Y[yo] = (bf16)f2bf((bflo(fb) + bfhi(fb) * Cf[nt] + hl[i] + pl[i] * cm) * gelu_tanh(gt)); } } }
    }
}
DI void lru_carry(const P& p, LAS unsigned char* lds, int tid, int G) {
    const float* A = (const float*)(p.ws + WS_AGGA); const float* H = (const float*)(p.ws + WS_AGGH); float* CI = (float*)(p.ws + WS_CIN);
    LAS float* XA = (LAS float*)lds; LAS float* XH = XA + 512;
    for (int wgi = blockIdx.x; wgi < 64; wgi += G) { const int seg = tid >> 6, chain = wgi * 64 + (tid & 63), c = chain & (D - 1), e = (chain >> 10) & 1, b = chain >> 11;
        float a[33], h[33]; float As = 1.f, Hs = 0.f;
#pragma unroll
        for (int k = 0; k < 33; ++k) { const int st = seg * 33 + k, hs = e ? (st < 8 ? 7 - st : 271 - st) : st; const size_t o = ((size_t)(b * NHS + hs) * 2 + e) * D + c; a[k] = A[o]; h[k] = H[o]; }
#pragma unroll
        for (int k = 0; k < 33; ++k) { Hs = a[k] * Hs + h[k]; As *= a[k]; }
        __syncthreads(); XA[tid] = As; XH[tid] = Hs; __syncthreads();
        float cy = 0.f;
        for (int sg = 0; sg < seg; ++sg) cy = XA[sg * 64 + (tid & 63)] * cy + XH[sg * 64 + (tid & 63)];
#pragma unroll
        for (int k = 0; k < 33; ++k) { const int st = seg * 33 + k, hs = e ? (st < 8 ? 7 - st : 271 - st) : st; CI[((size_t)(b * NHS + hs) * 2 + e) * D + c] = cy; cy = a[k] * cy + h[k]; } }
}

DI float tanh_fast(float x) { return 1.f - 2.f * frcp(1.f + __expf(2.f * x)); }
struct MixLd { v4u w; v4u n[4]; };
DI void mix_ld(const bf16* own, const bf16* const (&np)[4], int cb, MixLd& L) {
    L.w = *(const v4u*)(own + cb);
#pragma unroll
    for (int i = 0; i < 4; ++i) L.n[i] = *(const v4u*)(np[i] + cb);
}
DI void mix_do(const MixLd& L, const float (&nv)[4], const float* mu, int cb, float (&o)[8]) {
    const v4u w = L.w;
    const f32x4 m0 = *(const f32x4*)(mu + cb), m1 = *(const f32x4*)(mu + cb + 4);
    const float ow[8] = {bflo(w.x), bfhi(w.x), bflo(w.y), bfhi(w.y), bflo(w.z), bfhi(w.z), bflo(w.w), bfhi(w.w)};
    const float nb[8] = {bflo(L.n[0].x) * nv[0], bfhi(L.n[1].x) * nv[1], bflo(L.n[2].y) * nv[2], bfhi(L.n[3].y) * nv[3], bflo(L.n[0].z) * nv[0], bfhi(L.n[1].z) * nv[1], bflo(L.n[2].w) * nv[2], bfhi(L.n[3].w) * nv[3]};
#pragma unroll
    for (int i = 0; i < 4; ++i) { o[i] = ow[i] + m0[i] * (nb[i] - ow[i]); o[4 + i] = ow[4 + i] + m1[i] * (nb[4 + i] - ow[4 + i]); }
}
DI void mix_do2(const MixLd& L, const float (&nv)[4], const f32x4 m0, const f32x4 m1, float (&o)[8]) {
    const v4u w = L.w;
    const float ow[8] = {bflo(w.x), bfhi(w.x), bflo(w.y), bfhi(w.y), bflo(w.z), bfhi(w.z), bflo(w.w), bfhi(w.w)};
    const float nb[8] = {bflo(L.n[0].x) * nv[0], bfhi(L.n[1].x) * nv[1], bflo(L.n[2].y) * nv[2], bfhi(L.n[3].y) * nv[3], bflo(L.n[0].z) * nv[0], bfhi(L.n[1].z) * nv[1], bflo(L.n[2].w) * nv[2], bfhi(L.n[3].w) * nv[3]};
#pragma unroll
    for (int i = 0; i < 4; ++i) { o[i] = ow[i] + m0[i] * (nb[i] - ow[i]); o[4 + i] = ow[4 + i] + m1[i] * (nb[4 + i] - ow[4 + i]); }
}
DI void mix8(const bf16* own, const bf16* const (&np)[4], const float (&nv)[4], const float* mu, int cb, float (&o)[8]) { MixLd L; mix_ld(own, np, cb, L); mix_do(L, nv, mu, cb, o); }
DI void nbr_rows(const bf16* S, int b, int ci, int j, const bf16*& own, const bf16* (&np)[4], float (&nv)[4]) {
    const int row = chunk_row0(b, ci) + j; own = S + (size_t)row * NS1;
    if (ci >= 4) { const int gr = ci - 4; const bool v0 = j > 0, v1 = j < 63, v2 = gr > 0, v3 = gr < 127;
        np[0] = v0 ? own - NS1 : own; np[1] = v1 ? own + NS1 : own; np[2] = v2 ? own - (size_t)64 * NS1 : own; np[3] = v3 ? own + (size_t)64 * NS1 : own;
        nv[0] = v0 ? 1.f : 0.f; nv[1] = v1 ? 1.f : 0.f; nv[2] = v2 ? 1.f : 0.f; nv[3] = v3 ? 1.f : 0.f; }
    else { const int t = ci * 64 + j; const bool v0 = t > 0, v1 = t < CTXL - 1;
        np[0] = np[2] = v0 ? own - NS1 : own; np[1] = np[3] = v1 ? own + NS1 : own; nv[0] = nv[2] = v0 ? 1.f : 0.f; nv[1] = nv[3] = v1 ? 1.f : 0.f; }
}
DI float red8(float x) { x += dppf<0xB1>(x); x += dppf<0x4E>(x); x += dppf<0x141>(x); return x; }
DI void mix_store(bf16* zr, const f32x4 k0, const f32x4 k1, int it, int gi, int cb, const float (&o)[8]) {
    if (it < 2 || it == 4 || it == 5) { *(v4u*)(zr + cb) = (v4u){pk2(o[0], o[1]), pk2(o[2], o[3]), pk2(o[4], o[5]), pk2(o[6], o[7])}; }
    else if (it == 2 || it == 3) {
        *(v4u*)(zr + cb) = (v4u){pk2(o[0], o[1]), pk2(o[2], o[3]), pk2(o[4], o[5]), pk2(o[6], o[7])};
        float kr[8], ss = 0.f;
#pragma unroll
        for (int i = 0; i < 4; ++i) { kr[i] = o[i] * k0[i]; kr[4 + i] = o[4 + i] * k1[i]; ss += kr[i] * kr[i] + kr[4 + i] * kr[4 + i]; }
        ss = red8(ss); const float inv = __builtin_amdgcn_rsqf(ss + 1e-12f);
        *(v4u*)(zr + Z_KK + cb - C_K) = (v4u){pk2(kr[0] * inv, kr[1] * inv), pk2(kr[2] * inv, kr[3] * inv), pk2(kr[4] * inv, kr[5] * inv), pk2(kr[6] * inv, kr[7] * inv)}; }
    else if (gi < 392) { *(v4u*)(zr + Z_TW + cb - C_WD) = (v4u){pk2(tanh_fast(o[0]), tanh_fast(o[1])), pk2(tanh_fast(o[2]), tanh_fast(o[3])), pk2(tanh_fast(o[4]), tanh_fast(o[5])), pk2(tanh_fast(o[6]), tanh_fast(o[7]))}; }
    else if (gi < 400) { *(v4u*)(zr + Z_AD + cb - C_AD) = (v4u){pk2(o[0], o[1]), pk2(o[2], o[3]), pk2(o[4], o[5]), pk2(o[6], o[7])}; }
    else if (gi < 420) { *(v4u*)(zr + Z_GS + cb - C_GD) = (v4u){pk2(sigm_fast(o[0]), sigm_fast(o[1])), pk2(sigm_fast(o[2]), sigm_fast(o[3])), pk2(sigm_fast(o[4]), sigm_fast(o[5])), pk2(sigm_fast(o[6]), sigm_fast(o[7]))}; }
}
DI void mix_geom(int m, int& b, int& ci, int& j) { if (m < MX) { b = m >> 13; const int t = m & (SEQ - 1); ci = 4 + (t >> 6); j = t & 63; } else { const int t = (m - MX) & (CTXL - 1); b = (m - MX) >> 8; ci = t >> 6; j = t & 63; } }
DI void phase_mix(const P& p, int lane, int wave, int G) {
    const bf16* S = (const bf16*)(p.ws + WS_S1); bf16* Z = (bf16*)(p.ws + WS_ZM);
    const int gw = blockIdx.x * NWAVES + wave, NGW = G * NWAVES;
    f32x4 mu0[7], mu1[7], kk0[2], kk1[2];
#pragma unroll
    for (int it = 0; it < 7; ++it) { const int gi = lane + 64 * it; const int cb = (gi < 420 ? gi : 0) * 8; mu0[it] = *(const f32x4*)(p.mu_a + cb); mu1[it] = *(const f32x4*)(p.mu_a + cb + 4);
        if (it == 2 || it == 3) { kk0[it - 2] = *(const f32x4*)(p.k_k + cb - C_K); kk1[it - 2] = *(const f32x4*)(p.k_k + cb - C_K + 4); } }
    for (int m0 = gw; m0 < MALL; m0 += 2 * NGW) { const int m1 = m0 + NGW; const bool two = m1 < MALL; const int m1c = two ? m1 : m0;
        int b0, ci0, j0, b1, ci1, j1; mix_geom(m0, b0, ci0, j0); mix_geom(m1c, b1, ci1, j1);
        const bf16* own0; const bf16* np0[4]; float nv0[4]; nbr_rows(S, b0, ci0, j0, own0, np0, nv0);
        const bf16* own1; const bf16* np1[4]; float nv1[4]; nbr_rows(S, b1, ci1, j1, own1, np1, nv1);
        bf16* zr0 = Z + (size_t)m0 * NZM; bf16* zr1 = Z + (size_t)m1c * NZM;
#pragma unroll
        for (int it = 0; it < 7; ++it) { const int gi = lane + 64 * it; const int cb = (gi < 420 ? gi : 0) * 8; MixLd L0, L1; float o0[8], o1[8];
            mix_ld(own0, np0, cb, L0); mix_ld(own1, np1, cb, L1);
            mix_do2(L0, nv0, mu0[it], mu1[it], o0); mix_do2(L1, nv1, mu0[it], mu1[it], o1);
            const f32x4 kw0 = (it == 2 || it == 3) ? kk0[it == 3] : mu0[0], kw1 = (it == 2 || it == 3) ? kk1[it == 3] : mu0[0];
            mix_store(zr0, kw0, kw1, it, gi, cb, o0); if (two) mix_store(zr1, kw0, kw1, it, gi, cb, o1); }
    }
}
#define WK_BAR() do { asm volatile("s_waitcnt lgkmcnt(0)" ::: "memory"); __builtin_amdgcn_s_barrier(); asm volatile("" ::: "memory"); } while (0)
constexpr int WB_NB = NCH * 4;
constexpr int WB_AT = 0, WB_RT = 2304, WB_BC = 4608, WB_KC = 6912, WB_P4 = 9216, WB_GKT = 14336, WB_TT = 14848, WB_P5 = 15360, WB_VT = 16640, WB_PP = 17152, WB_MM = 17408, WB_SLOT = 18432;
constexpr int WB_W2T = 7 * WB_SLOT, WB_A2T = WB_W2T + 9216, WB_CST = WB_A2T + 9216, WB_FLG = WB_CST + 1024;
typedef short s16x4 __attribute__((ext_vector_type(4)));
DI v2u cvt2(float a, float b, float c, float d) { return (v2u){cvtpk_s(a, b), cvtpk_s(c, d)}; }
DI bf16x8 frag2(v2u lo, v2u hi) { return __builtin_bit_cast(bf16x8, (v4u){lo.x, lo.y, hi.x, hi.y}); }
DI float pfx16(float x) { x += dppf<0x111>(x); x += dppf<0x112>(x); x += dppf<0x114>(x); x += dppf<0x118>(x); return x; }
#define WB_LOADS(qq) do { const int sidx_ = (qq) >> 2, ci_ = e ? (sidx_ < 4 ? 3 - sidx_ : NCH + 3 - sidx_) : sidx_, pos_ = ((qq) & 3) * 16 + c, j_ = e ? 63 - pos_ : pos_; \
                    const bf16* zr = Z + (size_t)(chunk_row0(b, ci_) + j_) * NZM; \
                    _Pragma("unroll") for (int hh_ = 0; hh_ < 2; ++hh_) { const int c0 = h * 64 + 16 * g + 8 * hh_;     \
                        const v4u vk_ = *(const v4u*)(zr + Z_KK + c0), vr_ = *(const v4u*)(zr + Z_R + c0), vq_ = *(const v4u*)(zr + Z_K + c0); \
                        Lkk[2 * hh_] = (v2u){vk_.x, vk_.y}; Lkk[2 * hh_ + 1] = (v2u){vk_.z, vk_.w}; Lr[2 * hh_] = (v2u){vr_.x, vr_.y}; Lr[2 * hh_ + 1] = (v2u){vr_.z, vr_.w}; Lk[2 * hh_] = (v2u){vq_.x, vq_.y}; Lk[2 * hh_ + 1] = (v2u){vq_.z, vq_.w}; } \
                    Lv = *(const v2u*)(zr + Z_V + h * 64 + rg * 16 + 4 * g); \
                    tw[0] = *(const v4u*)(zr + Z_TW + g * 8); tw[1] = *(const v4u*)(zr + Z_TW + 32 + g * 8); ad[0] = *(const v4u*)(zr + Z_AD + g * 8); ad[1] = *(const v4u*)(zr + Z_AD + 32 + g * 8); } while (0)
DI void lds_wait_ge(volatile LAS int* f, int v, volatile LAS int* abortf) {
    int sp = 0;
    while (__builtin_amdgcn_readfirstlane(*f) < v) { __builtin_amdgcn_s_sleep(1); if (((++sp) & 63) == 0) { if (__builtin_amdgcn_readfirstlane(*abortf)) break; if (sp > (1 << 18)) { *abortf = 1; break; } } }
    asm volatile("" ::: "memory");
}
DI void wkv_blk_wg(const P& p, LAS unsigned char* lds, int tid, int lane, int wave, int unit) {
    const int xx = unit & 7, yy = unit >> 3, rg = yy & 3, scan = xx * 8 + (yy >> 2), e = scan & 1, h = (scan >> 1) & 15, b = scan >> 5;
    const bf16* Z = (const bf16*)(p.ws + WS_ZM);
    LAS bf16* W2T = (LAS bf16*)(lds + WB_W2T); LAS bf16* A2T = (LAS bf16*)(lds + WB_A2T); LAS float* CST = (LAS float*)(lds + WB_CST);
    __syncthreads();
    volatile LAS int* RDY = (volatile LAS int*)(lds + WB_FLG); volatile LAS int* CNS = RDY + 8; volatile LAS int* ABT = RDY + 16;
    if (tid < 32) RDY[tid] = 0;
    if (tid < 64) { const int ch = 16 * ((tid >> 2) & 3) + 4 * (tid >> 4) + (tid & 3);
        const float ka = p.k_a[h * 64 + ch]; CST[tid] = NL2E * p.w0[e * D + h * 64 + ch]; CST[64 + tid] = NL2E * p.a0[e * D + h * 64 + ch]; CST[128 + tid] = ka; CST[192 + tid] = 1.f - ka; }
    for (int i = tid; i < 4096; i += NTHR) { const int k = i >> 6, n = i & 63, pn = 16 * ((n >> 2) & 3) + 4 * (n >> 4) + (n & 3);     W2T[pn * 72 + k] = (bf16)f2bf(NL2E * p.w2[((size_t)e * 64 + k) * D + h * 64 + n]); A2T[pn * 72 + k] = (bf16)f2bf(NL2E * p.a2[((size_t)e * 64 + k) * D + h * 64 + n]); }
    __syncthreads();
    bf16* YW = (bf16*)(p.ws + (e ? WS_YWB : WS_YWF));
    const int c = lane & 15, g = lane >> 4;
    if (wave == 0) {
        __builtin_amdgcn_s_setprio(2);
        pg8::f32x4 Xt[4];
#pragma unroll
        for (int kt = 0; kt < 4; ++kt) Xt[kt] = (pg8::f32x4){0.f, 0.f, 0.f, 0.f};
        bf16* yp = YW + (size_t)(b * SEQ + (e ? SEQ - 1 - 4 * g : 4 * g)) * D + h * 64 + rg * 16 + c;
        int fnext = 0;
        int slot = 0, nblk = 0;
        v2u vtA, gkA, ttA, vtB, gkB, ttB; bf16x8 a1A[2], a2A[2], a1B[2], a2B[2];
#define SC_READS(S, sl_) do { const LAS bf16* AT_ = (const LAS bf16*)((sl_) + WB_AT); const LAS bf16* RT_ = (const LAS bf16*)((sl_) + WB_RT); \
            vt##S = *(const LAS v2u*)((const LAS bf16*)((sl_) + WB_VT) + c * 16 + 4 * g); gk##S = *(const LAS v2u*)((const LAS bf16*)((sl_) + WB_GKT) + c * 16 + 4 * g); \
            _Pragma("unroll") for (int sx = 0; sx < 2; ++sx) { a1##S[sx] = frag2(*(const LAS v2u*)(AT_ + c * 72 + 32 * sx + 4 * g), *(const LAS v2u*)(AT_ + c * 72 + 32 * sx + 16 + 4 * g)); \
                a2##S[sx] = frag2(*(const LAS v2u*)(RT_ + c * 72 + 32 * sx + 4 * g), *(const LAS v2u*)(RT_ + c * 72 + 32 * sx + 16 + 4 * g)); } \
            tt##S = *(const LAS v2u*)((const LAS bf16*)((sl_) + WB_TT) + c * 16 + 4 * g); } while (0)
#define SC_BODY(S, N, tt_) do { const int t = (tt_); LAS unsigned char* sl = lds + slot * WB_SLOT; \
            v2u xb[4]; \
            _Pragma("unroll") for (int kt = 0; kt < 4; ++kt) xb[kt] = cvt2(Xt[kt][0], Xt[kt][1], Xt[kt][2], Xt[kt][3]); \
            pg8::f32x4 C1 = __builtin_amdgcn_mfma_f32_16x16x16bf16_1k(__builtin_bit_cast(s16x4, gk##S), __builtin_bit_cast(s16x4, vt##S), (pg8::f32x4){0.f, 0.f, 0.f, 0.f}, 0, 0, 0); \
            pg8::f32x4 C2 = {0.f, 0.f, 0.f, 0.f}; \
            _Pragma("unroll") for (int sx = 0; sx < 2; ++sx) { const bf16x8 bx = frag2(xb[2 * sx], xb[2 * sx + 1]); C1 = __builtin_amdgcn_mfma_f32_16x16x32_bf16(a1##S[sx], bx, C1, 0, 0, 0); C2 = __builtin_amdgcn_mfma_f32_16x16x32_bf16(a2##S[sx], bx, C2, 0, 0, 0); } \
            __builtin_amdgcn_sched_barrier(0); \
              \
            bf16x8 p4f[4]; pg8::f32x4 xn[4], ppv[4]; const bf16x8 p5f = *(const LAS bf16x8*)((const LAS bf16*)(sl + WB_P5) + c * 40 + 8 * g); \
            _Pragma("unroll") for (int kt = 0; kt < 4; ++kt) p4f[kt] = *(const LAS bf16x8*)((const LAS bf16*)(sl + WB_P4) + (16 * kt + c) * 40 + 8 * g); \
            _Pragma("unroll") for (int kt = 0; kt < 4; ++kt) ppv[kt] = *(const LAS pg8::f32x4*)((const LAS float*)(sl + WB_PP) + 16 * kt + 4 * g); \
            const float v0_ = bflo(vt##S.x), v1_ = bfhi(vt##S.x), v2_ = bflo(vt##S.y), v3_ = bfhi(vt##S.y); \
            __builtin_amdgcn_sched_barrier(0); \
            const pg8::f32x4 SK = __builtin_amdgcn_mfma_f32_16x16x16bf16_1k(__builtin_bit_cast(s16x4, tt##S), __builtin_bit_cast(s16x4, cvt2(C1[0], C1[1], C1[2], C1[3])), (pg8::f32x4){0.f, 0.f, 0.f, 0.f}, 0, 0, 0); \
            const bf16x8 vs = __builtin_bit_cast(bf16x8, (v4u){cvtpk_s(v0_, SK[0]), cvtpk_s(v1_, SK[1]), cvtpk_s(v2_, SK[2]), cvtpk_s(v3_, SK[3])}); \
            _Pragma("unroll") for (int kt = 0; kt < 4; ++kt) xn[kt] = __builtin_amdgcn_mfma_f32_16x16x32_bf16(p4f[kt], vs, Xt[kt], 0, 0, 0); \
            const pg8::f32x4 Yt = __builtin_amdgcn_mfma_f32_16x16x32_bf16(p5f, vs, C2, 0, 0, 0); \
            asm volatile("s_waitcnt lgkmcnt(0)" ::: "memory"); \
            if (lane == 0) CNS[slot] = nblk + 1; \
            if (++slot == 7) { slot = 0; ++nblk; } \
            if (t + 1 < WB_NB) { \
                if (__builtin_amdgcn_readfirstlane(fnext) < nblk + 1) lds_wait_ge(RDY + slot, nblk + 1, ABT); \
                asm volatile("" ::: "memory"); \
                LAS unsigned char* sln = lds + slot * WB_SLOT; SC_READS(N, sln); fnext = RDY[slot == 6 ? 0 : slot + 1]; } \
            _Pragma("unroll") for (int kt = 0; kt < 4; ++kt) Xt[kt] = ppv[kt] * xn[kt]; \
            if (t >= 16) { \
                if (e) { yp[0] = (bf16)f2bf(Yt[0]); yp[-D] = (bf16)f2bf(Yt[1]); yp[-2 * D] = (bf16)f2bf(Yt[2]); yp[-3 * D] = (bf16)f2bf(Yt[3]); yp -= 16 * D; } \
                else { yp[0] = (bf16)f2bf(Yt[0]); yp[D] = (bf16)f2bf(Yt[1]); yp[2 * D] = (bf16)f2bf(Yt[2]); yp[3 * D] = (bf16)f2bf(Yt[3]); yp += 16 * D; } } } while (0)
        lds_wait_ge(RDY + 0, 1, ABT); SC_READS(A, lds); fnext = RDY[1];
        for (int t2 = 0; t2 < WB_NB; t2 += 2) { SC_BODY(A, B, t2); SC_BODY(B, A, t2 + 1); }
#undef SC_READS
#undef SC_BODY
        __builtin_amdgcn_s_setprio(0);
    } else {
        const int pw = wave - 1; LAS unsigned char* sl = lds + pw * WB_SLOT;
        LAS bf16* AT = (LAS bf16*)(sl + WB_AT); LAS bf16* RT = (LAS bf16*)(sl + WB_RT); LAS bf16* BC = (LAS bf16*)(sl + WB_BC); LAS bf16* KC = (LAS bf16*)(sl + WB_KC);
        LAS bf16* P4 = (LAS bf16*)(sl + WB_P4); LAS bf16* GKT = (LAS bf16*)(sl + WB_GKT); LAS bf16* TT = (LAS bf16*)(sl + WB_TT); LAS bf16* P5 = (LAS bf16*)(sl + WB_P5);
        LAS bf16* VT = (LAS bf16*)(sl + WB_VT); LAS float* PP = (LAS float*)(sl + WB_PP); LAS float* MM = (LAS float*)(sl + WB_MM);
        v2u Lkk[4], Lr[4], Lk[4], Lv; v4u tw[2], ad[2];
        { const int q = pw; WB_LOADS(q); }
        f32x4 w0v[4], a0v[4], kav[4], kbv[4];
#pragma unroll
        for (int nt = 0; nt < 4; ++nt) { w0v[nt] = *(const LAS f32x4*)(CST + 16 * nt + 4 * g); a0v[nt] = *(const LAS f32x4*)(CST + 64 + 16 * nt + 4 * g); kav[nt] = *(const LAS f32x4*)(CST + 128 + 16 * nt + 4 * g); kbv[nt] = *(const LAS f32x4*)(CST + 192 + 16 * nt + 4 * g); }
        f32x4 ltm, lem, gtm;
#pragma unroll
        for (int i = 0; i < 4; ++i) { const int ii = 4 * g + i; ltm[i] = ii < c ? 1.f : 0.f; lem[i] = ii <= c ? 1.f : 0.f; gtm[i] = c < ii ? 1.f : 0.f; }
        int nblk = 0;
        for (int q = pw; q < WB_NB; q += 7, ++nblk) {
            pg8::f32x4 zw[4], za[4];
            f32x4 ewv[4], kmv[4], bvv[4], kkf[4], rf[4];
            f32x4 at_[4], rt_[4], bc_[4], kc_[4], pp_[4];
#define WT_PRE(nt) do { zw[nt] = (pg8::f32x4){0.f, 0.f, 0.f, 0.f}; za[nt] = zw[nt]; \
                _Pragma("unroll") for (int ks = 0; ks < 2; ++ks) { const bf16x8 wa = *(const LAS bf16x8*)(W2T + ((nt) * 16 + c) * 72 + ks * 32 + g * 8), aa = *(const LAS bf16x8*)(A2T + ((nt) * 16 + c) * 72 + ks * 32 + g * 8); \
                    zw[nt] = __builtin_amdgcn_mfma_f32_16x16x32_bf16(wa, __builtin_bit_cast(bf16x8, tw[ks]), zw[nt], 0, 0, 0); za[nt] = __builtin_amdgcn_mfma_f32_16x16x32_bf16(aa, __builtin_bit_cast(bf16x8, ad[ks]), za[nt], 0, 0, 0); } \
                } while (0)
#define WT_AV(nt) do { const f32x4 kkv_ = {bflo(Lkk[nt].x), bfhi(Lkk[nt].x), bflo(Lkk[nt].y), bfhi(Lkk[nt].y)}, rv_ = {bflo(Lr[nt].x), bfhi(Lr[nt].x), bflo(Lr[nt].y), bfhi(Lr[nt].y)}, kv_ = {bflo(Lk[nt].x), bfhi(Lk[nt].x), bflo(Lk[nt].y), bfhi(Lk[nt].y)}; \
                const f32x4 xa_ = (f32x4){za[nt][0], za[nt][1], za[nt][2], za[nt][3]} + a0v[nt], xw_ = (f32x4){zw[nt][0], zw[nt][1], zw[nt][2], zw[nt][3]} + w0v[nt]; \
                const f32x4 da_ = (f32x4){__builtin_amdgcn_exp2f(xa_[0]), __builtin_amdgcn_exp2f(xa_[1]), __builtin_amdgcn_exp2f(xa_[2]), __builtin_amdgcn_exp2f(xa_[3])} + 1.f; \
                const f32x4 dw_ = (f32x4){__builtin_amdgcn_exp2f(xw_[0]), __builtin_amdgcn_exp2f(xw_[1]), __builtin_amdgcn_exp2f(xw_[2]), __builtin_amdgcn_exp2f(xw_[3])} + 1.f; \
                const f32x4 av_ = {frcp(da_[0]), frcp(da_[1]), frcp(da_[2]), frcp(da_[3])}; \
                ewv[nt] = (f32x4){frcp(dw_[0]), frcp(dw_[1]), frcp(dw_[2]), frcp(dw_[3])} * (0.6065306597126334f * NL2E);     \
                kmv[nt] = kv_ * (av_ * kav[nt] + kbv[nt]); bvv[nt] = kkv_ * av_; kkf[nt] = kkv_; rf[nt] = rv_; } while (0)
#define WT_BV(nt) do { const f32x4 inc_ = {pfx16(ewv[nt][0]), pfx16(ewv[nt][1]), pfx16(ewv[nt][2]), pfx16(ewv[nt][3])};     \
                const f32x4 E_ = {__builtin_amdgcn_exp2f(inc_[0]), __builtin_amdgcn_exp2f(inc_[1]), __builtin_amdgcn_exp2f(inc_[2]), __builtin_amdgcn_exp2f(inc_[3])};     \
                const f32x4 nEi_ = {frcp(-E_[0]), frcp(-E_[1]), frcp(-E_[2]), frcp(-E_[3])};     \
                const f32x4 Ep_ = {dppf_one<0x111>(E_[0]), dppf_one<0x111>(E_[1]), dppf_one<0x111>(E_[2]), dppf_one<0x111>(E_[3])};     \
                at_[nt] = kkf[nt] * Ep_; rt_[nt] = rf[nt] * E_; bc_[nt] = bvv[nt] * nEi_; kc_[nt] = -(kmv[nt] * nEi_); pp_[nt] = E_; } while (0)
#define WT_POST(nt) do { const int ko_ = c * 72 + 16 * (nt) + 4 * g; \
                *(LAS v2u*)(AT + ko_) = cvt2(at_[nt][0], at_[nt][1], at_[nt][2], at_[nt][3]); *(LAS v2u*)(RT + ko_) = cvt2(rt_[nt][0], rt_[nt][1], rt_[nt][2], rt_[nt][3]); \
                *(LAS v2u*)(BC + ko_) = cvt2(bc_[nt][0], bc_[nt][1], bc_[nt][2], bc_[nt][3]); *(LAS v2u*)(KC + ko_) = cvt2(kc_[nt][0], kc_[nt][1], kc_[nt][2], kc_[nt][3]); \
                const int so_ = 8 * (c >> 2) + 2 * (c & 3);                  \
                _Pragma("unroll") for (int i_ = 0; i_ < 4; ++i_) *(LAS unsigned*)(P4 + (16 * (nt) + 4 * g + i_) * 40 + so_) = cvtpk_s(kc_[nt][i_], bc_[nt][i_]);     \
                if (c == 15) *(LAS f32x4*)(PP + 16 * (nt) + 4 * g) = pp_[nt]; } while (0)
            WT_PRE(0); WT_AV(0); WT_BV(0); WT_PRE(1);
            lds_wait_ge(CNS + pw, nblk, ABT);
            WT_POST(0);
            VT[(4 * g + 0) * 16 + c] = (bf16)(Lv.x & 0xffffu); VT[(4 * g + 1) * 16 + c] = (bf16)(Lv.x >> 16); VT[(4 * g + 2) * 16 + c] = (bf16)(Lv.y & 0xffffu); VT[(4 * g + 3) * 16 + c] = (bf16)(Lv.y >> 16);
            WT_AV(1); WT_BV(1); WT_POST(1); WT_PRE(2); WT_AV(2); WT_BV(2); WT_POST(2); WT_PRE(3); WT_AV(3);
            if (q + 7 < WB_NB) WB_LOADS(q + 7);
            WT_BV(3); WT_POST(3);
#undef WT_PRE
#undef WT_AV
#undef WT_BV
#undef WT_POST
            {
                    __builtin_amdgcn_s_setprio(1);
                    pg8::f32x4 gb = {0.f, 0.f, 0.f, 0.f}, gk = gb, gbr = gb, gkr = gb, gbt = gb;
#pragma unroll
                    for (int ks = 0; ks < 2; ++ks) { const int o = c * 72 + ks * 32 + g * 8;
                        const bf16x8 fb = *(const LAS bf16x8*)(BC + o), fk = *(const LAS bf16x8*)(KC + o), fa = *(const LAS bf16x8*)(AT + o), fr = *(const LAS bf16x8*)(RT + o);
                        gb = __builtin_amdgcn_mfma_f32_16x16x32_bf16(fb, fa, gb, 0, 0, 0); gk = __builtin_amdgcn_mfma_f32_16x16x32_bf16(fk, fa, gk, 0, 0, 0);
                        gbr = __builtin_amdgcn_mfma_f32_16x16x32_bf16(fb, fr, gbr, 0, 0, 0); gkr = __builtin_amdgcn_mfma_f32_16x16x32_bf16(fk, fr, gkr, 0, 0, 0);
                        gbt = __builtin_amdgcn_mfma_f32_16x16x32_bf16(fa, fb, gbt, 0, 0, 0); }
                    const f32x4 m_ = -((f32x4){gb[0], gb[1], gb[2], gb[3]} * ltm), mt_ = -((f32x4){gbt[0], gbt[1], gbt[2], gbt[3]} * gtm), k_ = (f32x4){gk[0], gk[1], gk[2], gk[3]} * ltm,
                        kr_ = (f32x4){gkr[0], gkr[1], gkr[2], gkr[3]} * lem, br_ = (f32x4){gbr[0], gbr[1], gbr[2], gbr[3]} * lem;
                    *(LAS v2u*)(GKT + c * 16 + 4 * g) = cvt2(k_[0], k_[1], k_[2], k_[3]);
                    *(LAS v4u*)(P5 + c * 40 + 8 * g) = (v4u){cvtpk_s(kr_[0], br_[0]), cvtpk_s(kr_[1], br_[1]), cvtpk_s(kr_[2], br_[2]), cvtpk_s(kr_[3], br_[3])};
                    const v2u zq = {0u, 0u}; const pg8::f32x4 z4 = {0.f, 0.f, 0.f, 0.f};
#define MF_(a, b, acc) __builtin_amdgcn_mfma_f32_16x16x32_bf16(frag2(a, zq), frag2(b, zq), acc, 0, 0, 0)
#define CV_(x) cvt2((x)[0], (x)[1], (x)[2], (x)[3])
                    const v2u aM = cvt2(m_[0], m_[1], m_[2], m_[3]), bM = cvt2(mt_[0], mt_[1], mt_[2], mt_[3]);
                    pg8::f32x4 im;
#pragma unroll
                    for (int i = 0; i < 4; ++i) im[i] = ((4 * g + i) == c ? 1.f : 0.f) - m_[i];
                    const v2u aIM = CV_(im);
                    const pg8::f32x4 M2c = MF_(aM, bM, z4), M2a = MF_(bM, aM, z4);
                    const v2u aM2 = CV_(M2a), bM2 = CV_(M2c);
                    const pg8::f32x4 M4c = MF_(aM2, bM2, z4), M4a = MF_(bM2, aM2, z4);
                    const v2u aM4 = CV_(M4a), bM4 = CV_(M4c);
                    const pg8::f32x4 M8c = MF_(aM4, bM4, z4);
                    const v2u bM8 = CV_(M8c);
                    const pg8::f32x4 T1 = MF_(bM2, aIM, im);
                    const pg8::f32x4 T2 = MF_(bM4, CV_(T1), T1);
                    const pg8::f32x4 T3 = MF_(bM8, CV_(T2), T2);
                    *(LAS v2u*)(TT + c * 16 + 4 * g) = CV_(T3);
                    __builtin_amdgcn_s_setprio(0);
#undef MF_
#undef CV_
            }
            asm volatile("s_waitcnt lgkmcnt(0)" ::: "memory");
            if (lane == 0) RDY[pw] = nblk + 1;
        }
    }
}

constexpr int WO_RS = 0, WO_KS = 17408, WO_VS = 34816, WO_A2T = 52224, WO_G2T = 70656, WO_RHO = 92160;
DI void wkv_out_setup(const P& p, LAS unsigned char* lds, int tid, int h) {
    LAS bf16* A2T = (LAS bf16*)(lds + WO_A2T); LAS bf16* G2T = (LAS bf16*)(lds + WO_G2T);
    __syncthreads();
    for (int i = tid; i < 2 * 4096; i += NTHR) { const int e = i >> 12, k = (i >> 6) & 63, n = i & 63; A2T[e * 4608 + n * 72 + k] = (bf16)f2bf(p.a2[((size_t)e * 64 + k) * D + h * 64 + n]); }
    for (int i = tid; i < 160 * 64; i += NTHR) { const int k = i >> 6, n = i & 63; G2T[n * 168 + k] = (bf16)f2bf(p.g2[(size_t)k * D + h * 64 + n]); }
    __syncthreads();
}
struct WoPre { v4u r, k, v, a0, a1, a2, a3, a4; };
struct WoC { float c0[4], c1[4], ka[4], rk[4], gg[4], gb[4]; };
DI void wkv_out_consts(const P& p, int h, int l15, WoC& C) {
#pragma unroll
    for (int nt = 0; nt < 4; ++nt) { const int hc = h * 64 + nt * 16 + l15; C.c0[nt] = p.a0[hc]; C.c1[nt] = p.a0[D + hc]; C.ka[nt] = p.k_a[hc]; C.rk[nt] = p.r_k[hc]; C.gg[nt] = p.gn_g[hc]; C.gb[nt] = p.gn_b[hc]; }
}
DI void wkv_out_load(const P& p, int tid, int lane, int wave, int b, int gr, int h, WoPre& L) {
    const bf16* Z = (const bf16*)(p.ws + WS_ZM); const int row0 = chunk_row0(b, gr + 4);
    const int rb = wave & 3, half = wave >> 2, l15 = lane & 15, g = lane >> 4;
    const bf16* za_ = Z + (size_t)(row0 + rb * 16 + l15) * NZM;
    const v4u zz4 = {0u, 0u, 0u, 0u};
    if (half == 0) { L.a0 = *(const v4u*)(za_ + Z_AD + g * 8); L.a1 = *(const v4u*)(za_ + Z_AD + 32 + g * 8); L.a2 = zz4; L.a3 = zz4; L.a4 = zz4; }
    else { L.a0 = *(const v4u*)(za_ + Z_GS + g * 8); L.a1 = *(const v4u*)(za_ + Z_GS + 32 + g * 8); L.a2 = *(const v4u*)(za_ + Z_GS + 64 + g * 8); L.a3 = *(const v4u*)(za_ + Z_GS + 96 + g * 8); L.a4 = *(const v4u*)(za_ + Z_GS + 128 + g * 8); }
    { const int j = tid >> 3, cg = tid & 7; const bf16* zr = Z + (size_t)(row0 + j) * NZM + h * 64 + cg * 8;
        L.r = *(const v4u*)(zr + Z_R); L.k = *(const v4u*)(zr + Z_K); L.v = *(const v4u*)(zr + Z_V); }
}
DI void wkv_out_unit(const P& p, LAS unsigned char* lds, int tid, int lane, int wave, int b, int gr, int h, const WoC& C, const WoPre& L, bool has_next, int nb, int ngr, WoPre& N) {
    const int row0 = chunk_row0(b, gr + 4);
    LAS float* RS = (LAS float*)(lds + WO_RS); LAS float* KS = (LAS float*)(lds + WO_KS); LAS float* VS = (LAS float*)(lds + WO_VS);
    LAS bf16* A2T = (LAS bf16*)(lds + WO_A2T); LAS bf16* G2T = (LAS bf16*)(lds + WO_G2T); LAS float* RHO = (LAS float*)(lds + WO_RHO);
    const int rb = wave & 3, half = wave >> 2, l15 = lane & 15, g = lane >> 4;
    { const int j = tid >> 3, cg = tid & 7; const v4u r = L.r, k = L.k, v = L.v;
        *(LAS f32x4*)(RS + j * 68 + cg * 8) = (f32x4){bflo(r.x), bfhi(r.x), bflo(r.y), bfhi(r.y)}; *(LAS f32x4*)(RS + j * 68 + cg * 8 + 4) = (f32x4){bflo(r.z), bfhi(r.z), bflo(r.w), bfhi(r.w)};
        *(LAS f32x4*)(KS + j * 68 + cg * 8) = (f32x4){bflo(k.x), bfhi(k.x), bflo(k.y), bfhi(k.y)}; *(LAS f32x4*)(KS + j * 68 + cg * 8 + 4) = (f32x4){bflo(k.z), bfhi(k.z), bflo(k.w), bfhi(k.w)};
        *(LAS f32x4*)(VS + j * 68 + cg * 8) = (f32x4){bflo(v.x), bfhi(v.x), bflo(v.y), bfhi(v.y)}; *(LAS f32x4*)(VS + j * 68 + cg * 8 + 4) = (f32x4){bflo(v.z), bfhi(v.z), bflo(v.w), bfhi(v.w)}; }
    WK_BAR();
    if (has_next) wkv_out_load(p, tid, lane, wave, nb, ngr, h, N);
    bf16* YF = (bf16*)(p.ws + WS_YWF);
    float yn[4][4]; pg8::f32x4 zg[4];
    if (half == 0) {
        pg8::f32x4 z0[4], z1[4];
#pragma unroll
        for (int nt = 0; nt < 4; ++nt) { z0[nt] = (pg8::f32x4){0.f, 0.f, 0.f, 0.f}; z1[nt] = (pg8::f32x4){0.f, 0.f, 0.f, 0.f}; }
#pragma unroll
        for (int ks = 0; ks < 2; ++ks) { const bf16x8 aa = __builtin_bit_cast(bf16x8, ks == 0 ? L.a0 : L.a1);
#pragma unroll
            for (int nt = 0; nt < 4; ++nt) { const bf16x8 b0 = *(const LAS bf16x8*)(A2T + (nt * 16 + l15) * 72 + ks * 32 + g * 8), b1 = *(const LAS bf16x8*)(A2T + 4608 + (nt * 16 + l15) * 72 + ks * 32 + g * 8);
                z0[nt] = __builtin_amdgcn_mfma_f32_16x16x32_bf16(aa, b0, z0[nt], 0, 0, 0); z1[nt] = __builtin_amdgcn_mfma_f32_16x16x32_bf16(aa, b1, z1[nt], 0, 0, 0); } }
        float rho[4] = {0.f, 0.f, 0.f, 0.f};
#pragma unroll
        for (int nt = 0; nt < 4; ++nt) { const float c0 = C.c0[nt], c1 = C.c1[nt], ka = C.ka[nt], rk = C.rk[nt];
#pragma unroll
            for (int i = 0; i < 4; ++i) { const int o = (rb * 16 + 4 * g + i) * 68 + nt * 16 + l15;
                rho[i] += RS[o] * KS[o] * (2.f + (sigm_fast(z0[nt][i] + c0) + sigm_fast(z1[nt][i] + c1) - 2.f) * ka) * rk; } }
#pragma unroll
        for (int i = 0; i < 4; ++i) { const float r = red16(rho[i]); if (l15 == 0) RHO[rb * 16 + 4 * g + i] = r; }
    } else {
        const bf16* YB = (const bf16*)(p.ws + WS_YWB); unsigned short yfv[4][4], ybv[4][4];
#pragma unroll
        for (int nt = 0; nt < 4; ++nt)
#pragma unroll
            for (int i = 0; i < 4; ++i) { const size_t yo = (size_t)(row0 + rb * 16 + 4 * g + i) * D + h * 64 + nt * 16 + l15; yfv[nt][i] = YF[yo]; ybv[nt][i] = YB[yo]; }
#pragma unroll
        for (int nt = 0; nt < 4; ++nt) zg[nt] = (pg8::f32x4){0.f, 0.f, 0.f, 0.f};
#pragma unroll
        for (int ks = 0; ks < 5; ++ks) { const bf16x8 ag = __builtin_bit_cast(bf16x8, ks == 0 ? L.a0 : (ks == 1 ? L.a1 : (ks == 2 ? L.a2 : (ks == 3 ? L.a3 : L.a4))));
#pragma unroll
            for (int nt = 0; nt < 4; ++nt) { const bf16x8 bg = *(const LAS bf16x8*)(G2T + (nt * 16 + l15) * 168 + ks * 32 + g * 8); zg[nt] = __builtin_amdgcn_mfma_f32_16x16x32_bf16(ag, bg, zg[nt], 0, 0, 0); } }
        float sm[4] = {0.f, 0.f, 0.f, 0.f};
#pragma unroll
        for (int nt = 0; nt < 4; ++nt)
#pragma unroll
            for (int i = 0; i < 4; ++i) { yn[nt][i] = bf2f(yfv[nt][i]) + bf2f(ybv[nt][i]); sm[i] += yn[nt][i]; }
#pragma unroll
        for (int i = 0; i < 4; ++i) { const float mu = red16(sm[i]) * (1.f / 64.f); float q2 = 0.f;
#pragma unroll
            for (int nt = 0; nt < 4; ++nt) { yn[nt][i] -= mu; q2 += yn[nt][i] * yn[nt][i]; }
            const float rs = __builtin_amdgcn_rsqf(red16(q2) * (1.f / 64.f) + GN_EPS);
#pragma unroll
            for (int nt = 0; nt < 4; ++nt) yn[nt][i] *= rs; }
    }
    WK_BAR();
    if (half == 1) {
#pragma unroll
        for (int nt = 0; nt < 4; ++nt) { const int hc = h * 64 + nt * 16 + l15; const float gg = C.gg[nt], gb = C.gb[nt];
#pragma unroll
            for (int i = 0; i < 4; ++i) { const int tok = rb * 16 + 4 * g + i; const float ov = (yn[nt][i] * gg + gb + RHO[tok] * VS[tok * 68 + nt * 16 + l15]) * zg[nt][i];
                YF[(size_t)(row0 + tok) * D + hc] = (bf16)f2bf(ov); } }
    }
    WK_BAR();
}

DI void expert_weights(const P& p, LAS unsigned char* lds, int lane, int wave, int G) {
    LAS float* scr = (LAS float*)(lds + wave * 16384);
    const int gw = blockIdx.x * NWAVES + wave, NGW = G * NWAVES;
    bf16* w13 = (bf16*)(p.ws + WS_W13); bf16* w2t = (bf16*)(p.ws + WS_W2);
    constexpr int I13 = 16 * 16, I2 = 8 * 32;
    for (int it = gw; it < NEXP * (2 * I13 + I2); it += NGW) { const int ex = it / (2 * I13 + I2); int r = it % (2 * I13 + I2);
        if (r < 2 * I13) { const int which = r / I13; r %= I13; const int kb = r / 16, nb = r % 16, n0 = nb * 32;
            if (which) transpose_item(p.e_w3 + (size_t)ex * D * DEXP, DEXP, w13 + (size_t)ex * D * D, D, kb * 64, n0, 256 * (n0 >> 7) + 128 + (n0 & 127), scr, lane);
            else transpose_item(p.e_w1 + (size_t)ex * D * DEXP, DEXP, w13 + (size_t)ex * D * D, D, kb * 64, n0, 256 * (n0 >> 7) + (n0 & 127), scr, lane); }
        else { r -= 2 * I13; const int kb = r / 32, nb = r % 32; transpose_item(p.e_w2 + (size_t)ex * DEXP * D, D, w2t + (size_t)ex * D * DEXP, DEXP, kb * 64, nb * 32, nb * 32, scr, lane); } }
}

constexpr int RT_AX = 0, RT_AXS = 1032, RT_PART = 66048, RT_LOG = 90624, RT_RE = 92928, RT_PRM = 93696  ;
DI void phase_route(const P& p, LAS unsigned char* lds, int tid, int lane, int wave, int G) {
    LAS float* AX = (LAS float*)(lds + RT_AX); LAS float* PART = (LAS float*)(lds + RT_PART); LAS float* LOG = (LAS float*)(lds + RT_LOG); LAS int* RE = (LAS int*)(lds + RT_RE);
    float* T1 = p.out; bf16* H2 = (bf16*)(p.ws + WS_H2); float* ST2 = (float*)(p.ws + WS_ROWW);
    int* TOKE = (int*)(p.ws + WS_TOKE); int* TOKSLOT = (int*)(p.ws + WS_TOKSLOT); float* TOKW = (float*)(p.ws + WS_TOKW); int* S2T = (int*)(p.ws + WS_S2T);
    if (blockIdx.x == 0) for (int i = tid; i < D / 8; i += NTHR) ((GAS v4u*)(H2 + (size_t)MX * D))[i] = (v4u){0u, 0u, 0u, 0u};
    const int l15 = lane & 15, g = lane >> 4;
    f32x4 breg[8][3];
    { const float* rwt = (const float*)(p.ws + WS_RWT);
#pragma unroll
      for (int m = 0; m < 8; ++m)
#pragma unroll
          for (int nt = 0; nt < 3; ++nt) breg[m][nt] = *(const f32x4*)(rwt + (size_t)(nt * 16 + l15) * D + 128 * wave + 16 * m + 4 * g); }
    __syncthreads();
    LAS float* PRM = (LAS float*)(lds + RT_PRM);
    for (int blk = blockIdx.x; blk < MX / 64; blk += G) {
        f32x4 q[2][4];
        { const int bsel = (blk * 64) >> 13;
          __syncthreads();
          for (int n = tid; n < D; n += NTHR) { PRM[n] = p.ln1_g[n]; PRM[D + n] = p.ln1_b[n]; PRM[2 * D + n] = modv(p, bsel, 4 * 1024 + n) + 1.f; PRM[3 * D + n] = modv(p, bsel, 3 * 1024 + n); }
          __syncthreads(); }
#pragma unroll
        for (int rr = 0; rr < 2; ++rr) { const GAS f32x4* tr = (const GAS f32x4*)(T1 + (size_t)(blk * 64 + 2 * wave + rr) * D) + lane;
#pragma unroll
            for (int j = 0; j < 4; ++j) q[rr][j] = tr[64 * j]; }
        for (int it = 0; it < 4; ++it) {
#pragma unroll
            for (int rr = 0; rr < 2; ++rr) { const int rl = 2 * wave + rr, m = blk * 64 + it * 16 + rl; const int bsel = m >> 13;
                GAS f32x4* tr = (GAS f32x4*)(T1 + (size_t)m * D) + lane; float s = 0.f;
#pragma unroll
                for (int j = 0; j < 4; ++j) s += (q[rr][j].x + q[rr][j].y) + (q[rr][j].z + q[rr][j].w);
                const float mean = wave_sum(s) * (1.f / D); float s2 = 0.f;
#pragma unroll
                for (int j = 0; j < 4; ++j) { q[rr][j] = q[rr][j] - mean; s2 += (q[rr][j].x * q[rr][j].x + q[rr][j].y * q[rr][j].y) + (q[rr][j].z * q[rr][j].z + q[rr][j].w * q[rr][j].w); }
                const float rstd = 1.f / sqrtf(wave_sum(s2) * (1.f / D) + LN_EPS);
                if (lane == 0) { ST2[2 * m] = mean; ST2[2 * m + 1] = rstd; }
                GAS v2u* o8 = (GAS v2u*)(H2 + (size_t)m * D) + lane;
#pragma unroll
                for (int j = 0; j < 4; ++j) { const int n = 256 * j + 4 * lane; const f32x4 gg = *(const LAS f32x4*)(PRM + n), bb = *(const LAS f32x4*)(PRM + D + n);
                    const f32x4 x1 = q[rr][j] * rstd * gg + bb; const f32x4 hh = x1 * *(const LAS f32x4*)(PRM + 2 * D + n) + *(const LAS f32x4*)(PRM + 3 * D + n);
                    o8[64 * j] = (v2u){pk2(hh[0], hh[1]), pk2(hh[2], hh[3])};
                    *(LAS f32x4*)(AX + rl * RT_AXS + n) = hh; } }
            if (it < 3) {
#pragma unroll
                for (int rr = 0; rr < 2; ++rr) { const GAS f32x4* tr = (const GAS f32x4*)(T1 + (size_t)(blk * 64 + (it + 1) * 16 + 2 * wave + rr) * D) + lane;
#pragma unroll
                    for (int j = 0; j < 4; ++j) q[rr][j] = tr[64 * j]; } }
            WK_BAR();
            { f32x4 acc[3];
#pragma unroll
              for (int nt = 0; nt < 3; ++nt) acc[nt] = (f32x4){0.f, 0.f, 0.f, 0.f};
#pragma unroll
              for (int m = 0; m < 8; ++m) { const f32x4 a4 = *(const LAS f32x4*)(AX + l15 * RT_AXS + 128 * wave + 16 * m + 4 * g);
#pragma unroll
                  for (int sx = 0; sx < 4; ++sx)
#pragma unroll
                      for (int nt = 0; nt < 3; ++nt) acc[nt] = __builtin_amdgcn_mfma_f32_16x16x4f32(a4[sx], breg[m][nt][sx], acc[nt], 0, 0, 0); }
#pragma unroll
              for (int nt = 0; nt < 3; ++nt)
#pragma unroll
                  for (int i = 0; i < 4; ++i) PART[(wave * 16 + 4 * g + i) * 48 + nt * 16 + l15] = acc[nt][i]; }
            WK_BAR();
            for (int i = tid; i < 16 * 36; i += NTHR) { const int row = i / 36, qq = i % 36; float a = qq < 4 ? p.router_g_b[qq] : p.router_e_b[qq - 4];
#pragma unroll
                for (int w = 0; w < 8; ++w) a += PART[(w * 16 + row) * 48 + qq];
                LOG[row * 36 + qq] = a; }
            WK_BAR();
            if (tid < 16) { const int m = blk * 64 + it * 16 + tid; float lg[36];
#pragma unroll
                for (int i = 0; i < 36; ++i) lg[i] = LOG[tid * 36 + i];
                int gs = 0; float gm = lg[0];
#pragma unroll
                for (int i = 1; i < 4; ++i) if (lg[i] > gm) { gm = lg[i]; gs = i; }
                float den = 0.f;
#pragma unroll
                for (int i = 0; i < 4; ++i) den += __expf(lg[i] - gm);
                const float pg = 1.f / den;
                float ev[8];
#pragma unroll
                for (int i = 0; i < 8; ++i) ev[i] = gs == 0 ? lg[4 + i] : (gs == 1 ? lg[12 + i] : (gs == 2 ? lg[20 + i] : lg[28 + i]));
                int i1 = 0; float v1 = ev[0];
#pragma unroll
                for (int i = 1; i < 8; ++i) if (ev[i] > v1) { v1 = ev[i]; i1 = i; }
                int i2 = -1; float v2 = -3.0e38f;
#pragma unroll
                for (int i = 0; i < 8; ++i) if (i != i1 && ev[i] > v2) { v2 = ev[i]; i2 = i; }
                if (i2 < 0) { i2 = (i1 + 1) & 7; v2 = v1; }
                const float e2 = __expf(v2 - v1); const float w1 = pg / (1.f + e2), w2 = pg * e2 / (1.f + e2);
                RE[(it * 16 + tid) * 2] = gs * 8 + i1; RE[(it * 16 + tid) * 2 + 1] = gs * 8 + i2; TOKW[2 * m] = w1; TOKW[2 * m + 1] = w2; TOKE[2 * m] = gs * 8 + i1; TOKE[2 * m + 1] = gs * 8 + i2; }
            WK_BAR();
        }
        if (wave == 0) {
            const int e0 = RE[lane], e1 = RE[lane + 64]; int r0 = 0, r1 = 0, cex = 0;
#pragma unroll 4
            for (int ex = 0; ex < NEXP; ++ex) { const unsigned long long m0 = __builtin_amdgcn_ballot_w64(e0 == ex), m1 = __builtin_amdgcn_ballot_w64(e1 == ex);
                const int n0 = __builtin_popcountll(m0);
                const int b0 = (int)__builtin_amdgcn_mbcnt_hi((unsigned)(m0 >> 32), __builtin_amdgcn_mbcnt_lo((unsigned)m0, 0u)), b1 = (int)__builtin_amdgcn_mbcnt_hi((unsigned)(m1 >> 32), __builtin_amdgcn_mbcnt_lo((unsigned)m1, 0u));
                if (e0 == ex) r0 = b0; if (e1 == ex) r1 = n0 + b1; if (lane == ex) cex = n0 + __builtin_popcountll(m1); }
            int base = 0; if (lane < NEXP && cex) base = (int)atomicAdd(p.ctl + CW_ECNT + lane, (unsigned)cex);
            const int s0 = __builtin_amdgcn_ds_bpermute(e0 * 4, base) + r0, s1 = __builtin_amdgcn_ds_bpermute(e1 * 4, base) + r1;
            const int i0 = lane, i1 = lane + 64, m0r = blk * 64 + (i0 >> 1), m1r = blk * 64 + (i1 >> 1);
            TOKSLOT[2 * m0r + (i0 & 1)] = s0; S2T[(size_t)e0 * MX + s0] = 2 * m0r + (i0 & 1);
            TOKSLOT[2 * m1r + (i1 & 1)] = s1; S2T[(size_t)e1 * MX + s1] = 2 * m1r + (i1 & 1); }
        __syncthreads();
    }
}
DI void build_tiles(const P& p, LAS int* tile, int tid) {
    if (tid == 0) { int T = 0;
        for (int e = 0; e < NEXP; ++e) { tile[MAXT + e] = T; const int c = (int)__hip_atomic_load(p.ctl + CW_ECNT + e, RLX_AGENT); tile[MAXT + 64 + e] = c; const int nt = (c + 255) >> 8; for (int i = 0; i < nt; ++i) tile[T + i] = e; T += nt; }
        tile[MAXT + 32] = T; tile[MAXT + 40] = T; }
    __syncthreads();
}
DI void phase_final(const P& p, LAS int* tile, int lane, int wave, int G) {
    const int gw = blockIdx.x * NWAVES + wave, NGW = G * NWAVES; const bf16* YB = (const bf16*)(p.ws + WS_XS);
    const int* TOKE = (const int*)(p.ws + WS_TOKE); const int* TOKSLOT = (const int*)(p.ws + WS_TOKSLOT); const float* ST2 = (const float*)(p.ws + WS_ROWW);
    f32x4 g1[4], b1[4], g2[4], b2[4], gt[2][4]; int gv[2] = {-1, -1};
#pragma unroll
    for (int j = 0; j < 4; ++j) { const int n = 256 * j + 4 * lane; g1[j] = *(const f32x4*)(p.ln1_g + n); b1[j] = *(const f32x4*)(p.ln1_b + n); g2[j] = *(const f32x4*)(p.ln2_g + n); b2[j] = *(const f32x4*)(p.ln2_b + n); gt[0][j] = gt[1][j] = (f32x4){0.f, 0.f, 0.f, 0.f}; }
    for (int m0 = gw; m0 < MX; m0 += 2 * NGW) { int mm[2]; mm[0] = m0; mm[1] = (m0 + NGW < MX) ? m0 + NGW : m0;
        f32x4 q[2][4]; float s[2] = {0.f, 0.f};
#pragma unroll
        for (int rr = 0; rr < 2; ++rr) { const int m = mm[rr]; const int bsel = m >> 13; const float mean1 = ST2[2 * m], rstd1 = ST2[2 * m + 1];
            if (bsel != gv[rr]) { gv[rr] = bsel;
#pragma unroll
                for (int j = 0; j < 4; ++j) gt[rr][j] = modv4(p, bsel, 5 * 1024 + 256 * j + 4 * lane); }
            const int r0 = tile[MAXT + TOKE[2 * m]] * 256 + TOKSLOT[2 * m], r1 = tile[MAXT + TOKE[2 * m + 1]] * 256 + TOKSLOT[2 * m + 1];
            const GAS f32x4* xr = (const GAS f32x4*)(p.out + (size_t)m * D) + lane; const GAS v2u* y0 = (const GAS v2u*)(YB + (size_t)r0 * D) + lane; const GAS v2u* y1 = (const GAS v2u*)(YB + (size_t)r1 * D) + lane;
#pragma unroll
            for (int j = 0; j < 4; ++j) { const f32x4 x1 = (xr[64 * j] - mean1) * rstd1 * g1[j] + b1[j]; const v2u a = y0[64 * j], b2v = y1[64 * j];
                const f32x4 mo = (f32x4){bflo(a.x) + bflo(b2v.x), bfhi(a.x) + bfhi(b2v.x), bflo(a.y) + bflo(b2v.y), bfhi(a.y) + bfhi(b2v.y)};
                q[rr][j] = x1 * ALPHA + gt[rr][j] * mo;
                s[rr] += (q[rr][j].x + q[rr][j].y) + (q[rr][j].z + q[rr][j].w); } }
#pragma unroll
        for (int rr = 0; rr < 2; ++rr) { const int m = mm[rr]; GAS f32x4* xr = (GAS f32x4*)(p.out + (size_t)m * D) + lane;
            const float mean = wave_sum(s[rr]) * (1.f / D); float s2 = 0.f;
#pragma unroll
            for (int j = 0; j < 4; ++j) { q[rr][j] = q[rr][j] - mean; s2 += (q[rr][j].x * q[rr][j].x + q[rr][j].y * q[rr][j].y) + (q[rr][j].z * q[rr][j].z + q[rr][j].w * q[rr][j].w); }
            const float rstd = 1.f / sqrtf(wave_sum(s2) * (1.f / D) + LN_EPS);
#pragma unroll
            for (int j = 0; j < 4; ++j) xr[64 * j] = q[rr][j] * rstd * g2[j] + b2[j]; }
    }
}
#define MKP P p; { const float* const* in = args.in; p.x = in[0]; p.c = in[1]; p.ctx = in[2]; p.c_ctx = in[3]; p.w_ada = in[4]; p.b_ada = in[5]; p.w_in = in[6]; p.mu_a = in[7]; p.w0 = in[8]; p.w2 = in[9]; p.a0 = in[10]; p.a2 = in[11]; p.g2 = in[12]; p.k_k = in[13]; p.k_a = in[14]; p.r_k = in[15]; p.gn_g = in[16]; p.gn_b = in[17]; p.conv_w = in[18]; p.conv_b = in[19]; p.lru_wa = in[20]; p.lru_ba = in[21]; p.lru_wx = in[22]; p.lru_bx = in[23]; p.lru_lam = in[24]; p.p_a = in[25]; p.p_b = in[26]; p.w_o = in[27]; p.ln1_g = in[28]; p.ln1_b = in[29]; p.router_g = in[30]; p.router_g_b = in[31]; p.router_e = in[32]; p.router_e_b = in[33]; p.e_w1 = in[34]; p.e_w3 = in[35]; p.e_w2 = in[36]; p.ln2_g = in[37]; p.ln2_b = in[38]; } p.out = args.out; p.ws = args.ws; p.dob = (unsigned char*)args.out; p.ctlf = (float*)(args.ws + WS_CTL); p.ctl = (unsigned*)(args.ws + WS_CTL);
constexpr int NPHASE = 15;
__global__ void __launch_bounds__(NTHR, 2) fwd_kernel(Args args) {
    extern __shared__ __attribute__((aligned(16))) unsigned char lds_raw[];
    LAS unsigned char* lds = (LAS unsigned char*)lds_raw;
    const int tid = threadIdx.x, lane = tid & 63, wave = __builtin_amdgcn_readfirstlane(tid >> 6), G = gridDim.x;
    volatile LAS unsigned* MISC = (volatile LAS unsigned*)(lds + MISC_OFF);
    LAS int* tile = (LAS int*)(lds + TILE_OFF);
    for (int u = tid; u < 256; u += NTHR) ((LAS unsigned*)(lds + MISC_OFF))[u] = 0u;
    __syncthreads();
#if ONE_LAUNCH
    XcdBarrier bar = xcd_barrier_post((unsigned*)(args.ws + WS_CTL) + CW_BAR, MISC + 8);
#define GRID_BAR() xcd_barrier(bar)
#else
#define GRID_BAR() do {} while (0)
#endif
    const int lo = args.ph_lo, hi = args.ph_hi;
#define IN(k) (lo <= (k) && (k) < hi)
#define SEAM(k) do { if (IN(k) && IN((k) + 1)) GRID_BAR(); } while (0)

    if (IN(0)) { MKP; phase0(p, lds, tid, lane, wave, G); } SEAM(0);
    if (IN(1)) { MKP; phase0b(p, lds, tid, lane, wave, G); phase1(p, lane, wave, G); } SEAM(1);
    if (IN(2)) { MKP;
        pg8::Gemm g{(const pg8::bf16_t*)(p.dob + DO_H), (const pg8::bf16_t*)(p.dob + DO_WIN), MALL, NSLAB, D}; pg8::StaticOrder S; S.init(MALL, NSLAB, G, (int)blockIdx.x);
        EpiPlain<0> E{(bf16*)(p.ws + WS_S1), NS1, (bf16*)(p.ws + WS_S2), NS2, NS1 / 256};
        pg8::gemm_phase<EpiPlain<0>, pg8::StaticOrder, true, true>(lds, g, S, E); } SEAM(2);
    if (IN(3)) { MKP; const int hb = blockIdx.x & 15; lru_setup(p, lds, tid, hb); LruC C; lru_consts(p, hb, lane & 15, C);
        for (int u = (blockIdx.x >> 4) * NWAVES + wave; u < BATCH * NHS; u += (G >> 4) * NWAVES) { const int hs = u % NHS, b = u / NHS; lru_unit<1>(p, lds, lane, wave, b, hs, hb, C); } } SEAM(3);
    if (IN(4)) { MKP; lru_carry(p, lds, tid, G); } SEAM(4);
    if (IN(5)) { MKP; const int hb = blockIdx.x & 15; lru_setup(p, lds, tid, hb); LruC C; lru_consts(p, hb, lane & 15, C);
        for (int u = (blockIdx.x >> 4) * NWAVES + wave; u < BATCH * 256; u += (G >> 4) * NWAVES) { const int hs = 8 + (u & 255), b = u >> 8; lru_unit<2>(p, lds, lane, wave, b, hs, hb, C); } } SEAM(5);
    if (IN(6)) { MKP; phase_mix(p, lane, wave, G); } SEAM(6);
    if (IN(7)) { MKP; for (int u = blockIdx.x; u < 256; u += G) wkv_blk_wg(p, lds, tid, lane, wave, u); } SEAM(7);
    if (IN(8)) { MKP; const int h = blockIdx.x & 15; wkv_out_setup(p, lds, tid, h); { WoC WC; wkv_out_consts(p, h, lane & 15, WC); WoPre A, B; const int u0 = blockIdx.x >> 4, du = G >> 4; if (u0 < BATCH * 128) wkv_out_load(p, tid, lane, wave, u0 >> 7, u0 & 127, h, A);
            for (int u = u0; u < BATCH * 128; u += 2 * du) {
                const int u1 = u + du, u2 = u + 2 * du;
                wkv_out_unit(p, lds, tid, lane, wave, u >> 7, u & 127, h, WC, A, u1 < BATCH * 128, u1 >> 7, u1 & 127, B);
                if (u1 < BATCH * 128) wkv_out_unit(p, lds, tid, lane, wave, u1 >> 7, u1 & 127, h, WC, B, u2 < BATCH * 128, u2 >> 7, u2 & 127, A); } } } SEAM(8);
    if (IN(9)) { MKP;
        pg8::Gemm g{(const pg8::bf16_t*)(p.dob + DO_H), (const pg8::bf16_t*)(p.dob + DO_WIN) + (size_t)NSLAB * D, MX, 2048, D}; pg8::StaticOrder S; S.init(MX, 2048, G, (int)blockIdx.x);
        EpiPlain<1> E{(bf16*)(p.ws + WS_GATES), 2048, nullptr, 0, 1 << 20};
        pg8::gemm_phase<EpiPlain<1>, pg8::StaticOrder, true, true>(lds, g, S, E); } SEAM(9);
    if (IN(10)) { MKP;
        pg8::Gemm g{(const pg8::bf16_t*)(p.ws + WS_YWF), (const pg8::bf16_t*)(p.ws + WS_PW), 2 * MX, 2 * D, D}; SchedMix S; S.init(MX, D, G, (int)blockIdx.x);
        EpiMix E{(const bf16*)(p.ws + WS_GATES), (bf16*)(p.ws + WS_MBUF)};
        pg8::gemm_phase<EpiMix, SchedMix, true, true>(lds, g, S, E); } SEAM(10);
    if (IN(11)) { MKP;
        pg8::Gemm g{(const pg8::bf16_t*)(p.ws + WS_MBUF), (const pg8::bf16_t*)(p.ws + WS_PW) + (size_t)2 * D * D, MX, D, D}; pg8::StaticOrder S; S.init(MX, D, G, (int)blockIdx.x);
        EpiT1 E{p.x, (const float*)(p.ws + WS_STATS), p.ctlf + CW_MOD, p.b_ada, p.out};
        pg8::gemm_phase<EpiT1, pg8::StaticOrder, true, true>(lds, g, S, E);
        expert_weights(p, lds, lane, wave, G); } SEAM(11);
    if (IN(12)) { MKP; phase_route(p, lds, tid, lane, wave, G); } SEAM(12);
    if (IN(13)) { MKP;
        build_tiles(p, tile, tid);
        pg8::Gemm g{(const pg8::bf16_t*)(p.ws + WS_H2), (const pg8::bf16_t*)(p.ws + WS_W13), MAXT * 256, NEXP * D, D}; SchedMoE S{tile, G, (int)blockIdx.x, (const int*)(p.ws + WS_S2T)};
        EpiSwiGLU E{(bf16*)(p.ws + WS_HBUF)};
        pg8::gemm_phase<EpiSwiGLU, SchedMoE, true, true, true>(lds, g, S, E); } SEAM(13);
    if (IN(14)) { MKP;
        build_tiles(p, tile, tid);
        pg8::Gemm g{(const pg8::bf16_t*)(p.ws + WS_HBUF), (const pg8::bf16_t*)(p.ws + WS_W2), MAXT * 256, NEXP * D, DEXP}; SchedMoE S{tile, G, (int)blockIdx.x, (const int*)(p.ws + WS_S2T)};
        EpiW2 E{(bf16*)(p.ws + WS_XS), tile, (const int*)(p.ws + WS_S2T), (const float*)(p.ws + WS_TOKW)};
        pg8::gemm_phase<EpiW2, SchedMoE, true, true>(lds, g, S, E); } SEAM(14);
    if (IN(15)) { MKP; build_tiles(p, tile, tid); phase_final(p, tile, lane, wave, G); }
#undef IN
#undef SEAM
}

extern "C" void kernel_launch(void* const* d_in, const int* in_sizes, int n_in, void* d_out, int out_size, void* d_ws, size_t ws_size, hipStream_t stream) {
    static int grid = 0;
    if (grid == 0) {
        if (n_in != 39 || out_size != MX * D || ws_size < WS_END) { fprintf(stderr, "kernel_launch: unexpected shapes (n_in %d out %d ws %zu)\n", n_in, out_size, ws_size); grid = -1; return; }
        int dev = 0, cus = 0, per_cu = 0;
        if (hipGetDevice(&dev) != hipSuccess || hipDeviceGetAttribute(&cus, hipDeviceAttributeMultiprocessorCount, dev) != hipSuccess) { grid = -1; return; }
        if (hipFuncSetAttribute((const void*)fwd_kernel, hipFuncAttributeMaxDynamicSharedMemorySize, LDS_BYTES) != hipSuccess) { fprintf(stderr, "kernel_launch: hipFuncSetAttribute failed\n"); grid = -1; return; }
        if (hipOccupancyMaxActiveBlocksPerMultiprocessor(&per_cu, (const void*)fwd_kernel, NTHR, LDS_BYTES) != hipSuccess || per_cu < 1) fprintf(stderr, "kernel_launch: occupancy query reports %d\n", per_cu);
        (void)hipGetLastError();
        grid = cus;
    }
    if (grid < 0) return;
    if (hipMemsetAsync((char*)d_ws + WS_CTL, 0, CTL_ZERO_BYTES, stream) != hipSuccess) return;
    Args a{};
    for (int i = 0; i < 39; ++i) a.in[i] = (const float*)d_in[i];
    a.out = (float*)d_out; a.ws = (unsigned char*)d_ws;
#if ONE_LAUNCH
    a.ph_lo = 0; a.ph_hi = NPHASE + 1;
    hipLaunchKernelGGL(fwd_kernel, dim3(grid), dim3(NTHR), LDS_BYTES, stream, a);
#else
    for (int ph = 0; ph <= NPHASE; ++ph) { a.ph_lo = ph; a.ph_hi = ph + 1; hipLaunchKernelGGL(fwd_kernel, dim3(grid), dim3(NTHR), LDS_BYTES, stream, a); }
#endif
}
```

```cpp
#include <hip/hip_runtime.h>
#include <cstdio>
#include <cstdint>
namespace pg8 {
#define PG8_LAS __attribute__((address_space(3)))
typedef unsigned short bf16_t;
typedef short bf16x8 __attribute__((ext_vector_type(8)));
typedef float f32x4 __attribute__((ext_vector_type(4)));
typedef unsigned u32x4 __attribute__((ext_vector_type(4)));
constexpr int BM = 256, BK = 64, HALF = 128, HTB = HALF * BK * 2  , STAGE_BYTES = 8 * HTB, NXCD = 8, WGM = 8;

__host__ __device__ __forceinline__ int lds_byte(int r, int c) { const int st = (r >> 4) * 2 + (c >> 5), rr = r & 15, cc = c & 31, ob = rr * 64 + cc * 2; return st * 1024 + (ob ^ (((ob >> 9) & 1) << 5)); }
__host__ __device__ __forceinline__ void stage_rc(int b, int& R, int& C) { const int st = b / 1024, sb = b % 1024, swz = sb ^ (((sb >> 9) & 1) << 5); R = (st >> 1) * 16 + swz / 64; C = (st & 1) * 32 + (swz % 64) / 2; }
__host__ __device__ __forceinline__ int perm32(int rho) { const int n = rho >> 4, i = rho & 15; return 8 * (i >> 2) + 4 * n + (i & 3); }

struct Unit { int pm, pn; };
struct Gemm { const bf16_t* A; const bf16_t* Bt; int M, N, K; };

struct StaticOrder {
    int nM, nN, nwg, G, c;
    __host__ __device__ void init(int M, int N, int G_, int c_) { nM = M / BM; nN = N / BM; nwg = nM * nN; G = G_; c = c_; }
    __host__ __device__ bool next(int i, Unit& u) const {
        const long L = (long)i * G + c; if (L >= nwg) return false;
        int wgid = (int)L; { const int q = nwg / NXCD, r = nwg % NXCD, xcd = wgid % NXCD, off = wgid / NXCD; wgid = (xcd < r ? xcd * (q + 1) : r * (q + 1) + (xcd - r) * q) + off; }
        const int nig = WGM * nN, gid = wgid / nig, fm = gid * WGM, gsz = (nM - fm) < WGM ? (nM - fm) : WGM;
        u.pm = fm + ((wgid % nig) % gsz); u.pn = (wgid % nig) / gsz; return true;
    }
    __device__ __forceinline__ void a_ready(const Unit&) const {}
    __device__ __forceinline__ void done(const Unit&) const {}
};

__device__ __forceinline__ unsigned cvt_pk_bf16(float lo, float hi) { unsigned r; asm volatile("v_cvt_pk_bf16_f32 %0, %1, %2" : "=v"(r) : "v"(lo), "v"(hi)); return r; }
template <class Epi, class Sched, bool ALIGN_EPI = false, bool SP2 = false, bool GATHER = false>
__device__ __forceinline__ void gemm_phase(PG8_LAS unsigned char* lds, const Gemm g, const Sched& S, const Epi& E) {
    static_assert(!GATHER || SP2, "the gathered-A path exists only in the SP2 loop");
    const int tid = threadIdx.x, wid = __builtin_amdgcn_readfirstlane(tid >> 6), lane = tid & 63, wr = wid >> 2, wc = wid & 3, fr = lane & 15, fq = lane >> 4;
    const int K = g.K, nt = K / BK;
    unsigned voffA[2], voffB[2];
#pragma unroll
    for (int i = 0; i < 2; ++i) { int R, C; stage_rc(tid * 16 + i * 8192, R, C); const int Rb = Epi::PERM ? ((R & ~31) + perm32(R & 31)) : R;
        voffA[i] = (unsigned)(R * K + C) * 2u; voffB[i] = (unsigned)(Rb * K + C) * 2u; }
    unsigned vgc[2][2] = {{0u, 0u}, {0u, 0u}}, vgn[2][2] = {{0u, 0u}, {0u, 0u}}; int gR[2] = {0, 0}, gC[2] = {0, 0};
    if constexpr (GATHER) {
#pragma unroll
        for (int i = 0; i < 2; ++i) stage_rc(tid * 16 + i * 8192, gR[i], gC[i]); }
#define PG8_GSET(dst, unit) do { _Pragma("unroll") for (int _h = 0; _h < 2; ++_h) _Pragma("unroll") for (int _i = 0; _i < 2; ++_i) dst[_h][_i] = (unsigned)(S.src_row((unit).pm, _h * 128 + gR[_i]) * K + gC[_i]) * 2u; } while (0)
    const size_t kstep = (size_t)(BK * 2);
    const size_t hstep = (size_t)HALF * K * 2;
    const size_t tstep = 2 * hstep;
    const unsigned ldsw = (unsigned)wid * 1024u;
    const int aoff = lds_byte(wr * 64 + fr, fq * 8), boff = lds_byte(wc * 32 + fr, fq * 8);
#define PG8_SA(b, h) (((b) * 2 + (h)) * HTB)
#define PG8_SB(b, h) ((4 + (b) * 2 + (h)) * HTB)
#define PG8_STAGE(bufoff, gbase, voff) do { _Pragma("unroll") for (int _i = 0; _i < 2; ++_i) \
        __builtin_amdgcn_global_load_lds((const unsigned*)((const char*)(gbase) + (voff)[_i]), (PG8_LAS unsigned*)(lds + (bufoff) + ldsw + _i * 8192), 16, 0, 0); } while (0)
#define PG8_STAGE_A(bufoff, gbase, h, usenext) do { if constexpr (GATHER) { _Pragma("unroll") for (int _i = 0; _i < 2; ++_i) { const unsigned _o = (usenext) ? vgn[h][_i] : vgc[h][_i]; \
        __builtin_amdgcn_global_load_lds((const unsigned*)((const char*)(gbase) + _o), (PG8_LAS unsigned*)(lds + (bufoff) + ldsw + _i * 8192), 16, 0, 0); } } \
        else { PG8_STAGE(bufoff, (gbase) + (h) * hstep, voffA); } } while (0)
#define PG8_LDA(dst, b, h) do { _Pragma("unroll") for (int m = 0; m < 4; ++m) _Pragma("unroll") for (int k = 0; k < 2; ++k) dst[m][k] = *(const PG8_LAS bf16x8*)(lds + PG8_SA(b, h) + aoff + m * 2048 + k * 1024); } while (0)
#define PG8_LDB(dst, b, h) do { _Pragma("unroll") for (int n = 0; n < 2; ++n) _Pragma("unroll") for (int k = 0; k < 2; ++k) dst[n][k] = *(const PG8_LAS bf16x8*)(lds + PG8_SB(b, h) + boff + n * 2048 + k * 1024); } while (0)
#define PG8_MMA(ai, bj, At, Bt) do { __builtin_amdgcn_s_setprio(1); _Pragma("unroll") for (int m = 0; m < 4; ++m) _Pragma("unroll") for (int n = 0; n < 2; ++n) _Pragma("unroll") for (int k = 0; k < 2; ++k) \
        acc[ai][bj][m][n] = __builtin_amdgcn_mfma_f32_16x16x32_bf16(Bt[n][k], At[m][k], acc[ai][bj][m][n], 0, 0, 0); __builtin_amdgcn_s_setprio(0); } while (0)
#define PG8_WAIT_V(n) asm volatile("s_waitcnt vmcnt(" #n ")" ::: "memory")
#define PG8_WAIT_L(n) asm volatile("s_waitcnt lgkmcnt(" #n ")" ::: "memory")
#define PG8_BAR __builtin_amdgcn_s_barrier()
#define PG8_SCHED __builtin_amdgcn_sched_barrier(0)
    Unit cur, nxt; int ui = 0;
    if (!S.next(0, cur)) return;
    f32x4 acc[2][2][4][2];
#pragma unroll
    for (int a = 0; a < 2; ++a)
#pragma unroll
        for (int b = 0; b < 2; ++b)
#pragma unroll
            for (int m = 0; m < 4; ++m)
#pragma unroll
                for (int n = 0; n < 2; ++n) acc[a][b][m][n] = (f32x4){0.f, 0.f, 0.f, 0.f};
    bf16x8 At[4][2], B0[2][2], B1[2][2];
    const char* cA = GATHER ? (const char*)g.A : (const char*)g.A + (size_t)cur.pm * tstep; const char* cB = (const char*)g.Bt + (size_t)cur.pn * tstep;
    if constexpr (GATHER) PG8_GSET(vgc, cur);
    S.a_ready(cur);
    if constexpr (SP2) {
        PG8_STAGE(PG8_SB(0, 0), cB, voffB); PG8_STAGE(PG8_SB(0, 1), cB + hstep, voffB); PG8_STAGE_A(PG8_SA(0, 0), cA, 0, false); PG8_STAGE_A(PG8_SA(0, 1), cA, 1, false);
        if (wr == 1) PG8_BAR;
        PG8_WAIT_V(2); PG8_BAR;
        PG8_STAGE(PG8_SB(1, 0), cB + kstep, voffB); PG8_STAGE_A(PG8_SA(1, 0), cA + kstep, 0, false); PG8_STAGE(PG8_SB(1, 1), cB + hstep + kstep, voffB);
        PG8_WAIT_V(6); PG8_BAR;
    } else {
        PG8_STAGE(PG8_SB(0, 0), cB, voffB); PG8_STAGE(PG8_SA(0, 0), cA, voffA); PG8_STAGE(PG8_SB(0, 1), cB + hstep, voffB); PG8_STAGE(PG8_SA(0, 1), cA + hstep, voffA);
        if (wr == 1) PG8_BAR;
        PG8_WAIT_V(4); PG8_BAR;
        PG8_STAGE(PG8_SB(1, 0), cB + kstep, voffB); PG8_STAGE(PG8_SA(1, 0), cA + kstep, voffA); PG8_STAGE(PG8_SB(1, 1), cB + hstep + kstep, voffB);
        PG8_WAIT_V(6); PG8_BAR;
    }
    for (;;) {
        const bool has_next = S.next(ui + 1, nxt);
        const char* nA = GATHER ? cA : (has_next ? (const char*)g.A + (size_t)nxt.pm * tstep : cA); const char* nB = has_next ? (const char*)g.Bt + (size_t)nxt.pn * tstep : cB;
        if constexpr (GATHER) { if (has_next) PG8_GSET(vgn, nxt); }
        for (int t = 0; t < nt; t += 2) {
            const bool last = (t == nt - 2);
            const char* a1 = cA + (size_t)(t + 1) * kstep;
            const char* a2 = last ? nA : cA + (size_t)(t + 2) * kstep; const char* b2 = last ? nB : cB + (size_t)(t + 2) * kstep;
            const char* a3 = a2 + kstep; const char* b3 = b2 + kstep;
            if (last && has_next) S.a_ready(nxt);
            const bool unx = last && has_next;
            if constexpr (SP2) {
            PG8_LDB(B0, 0, 0); PG8_LDB(B1, 0, 1); PG8_SCHED; PG8_LDA(At, 0, 0); PG8_STAGE_A(PG8_SA(1, 1), a1, 1, false);
            PG8_WAIT_V(8); PG8_WAIT_L(0); PG8_BAR; PG8_MMA(0, 0, At, B0); PG8_MMA(0, 1, At, B1); PG8_BAR; PG8_SCHED;
            PG8_LDA(At, 0, 1); PG8_STAGE(PG8_SB(0, 0), b2, voffB); PG8_STAGE(PG8_SB(0, 1), b2 + hstep, voffB); PG8_STAGE_A(PG8_SA(0, 0), a2, 0, unx);
            PG8_WAIT_V(8); PG8_WAIT_L(0); PG8_BAR; PG8_MMA(1, 0, At, B0); PG8_MMA(1, 1, At, B1); PG8_BAR; PG8_SCHED;
            PG8_LDB(B0, 1, 0); PG8_LDB(B1, 1, 1); PG8_SCHED; PG8_LDA(At, 1, 0); PG8_STAGE_A(PG8_SA(0, 1), a2, 1, unx);
            PG8_WAIT_V(8); PG8_WAIT_L(0); PG8_BAR; PG8_MMA(0, 0, At, B0); PG8_MMA(0, 1, At, B1); PG8_BAR; PG8_SCHED;
            PG8_LDA(At, 1, 1); PG8_STAGE(PG8_SB(1, 0), b3, voffB); PG8_STAGE(PG8_SB(1, 1), b3 + hstep, voffB); PG8_STAGE_A(PG8_SA(1, 0), a3, 0, unx);
            PG8_WAIT_V(8); PG8_WAIT_L(0); PG8_BAR; PG8_MMA(1, 0, At, B0); PG8_MMA(1, 1, At, B1); PG8_BAR; PG8_SCHED;
            } else {
            PG8_LDB(B0, 0, 0); PG8_SCHED; PG8_LDA(At, 0, 0); PG8_STAGE(PG8_SA(1, 1), a1 + hstep, voffA);
            PG8_WAIT_L(8); PG8_BAR; PG8_WAIT_L(0); PG8_MMA(0, 0, At, B0); PG8_BAR; PG8_SCHED;
            PG8_LDB(B1, 0, 1); PG8_STAGE(PG8_SB(0, 0), b2, voffB);
            PG8_BAR; PG8_WAIT_L(0); PG8_MMA(0, 1, At, B1); PG8_BAR;
            PG8_LDA(At, 0, 1); PG8_STAGE(PG8_SA(0, 0), a2, voffA);
            PG8_BAR; PG8_WAIT_L(0); PG8_MMA(1, 0, At, B0); PG8_BAR; PG8_SCHED;
            PG8_STAGE(PG8_SB(0, 1), b2 + hstep, voffB);
            PG8_WAIT_V(6); PG8_BAR; PG8_MMA(1, 1, At, B1); PG8_BAR;
            PG8_LDB(B0, 1, 0); PG8_SCHED; PG8_LDA(At, 1, 0); PG8_STAGE(PG8_SA(0, 1), a2 + hstep, voffA);
            PG8_WAIT_L(8); PG8_BAR; PG8_WAIT_L(0); PG8_MMA(0, 0, At, B0); PG8_BAR; PG8_SCHED;
            PG8_LDB(B1, 1, 1); PG8_STAGE(PG8_SB(1, 0), b3, voffB);
            PG8_BAR; PG8_WAIT_L(0); PG8_MMA(0, 1, At, B1); PG8_BAR;
            PG8_LDA(At, 1, 1); PG8_STAGE(PG8_SA(1, 0), a3, voffA);
            PG8_BAR; PG8_WAIT_L(0); PG8_MMA(1, 0, At, B0); PG8_BAR; PG8_SCHED;
            PG8_STAGE(PG8_SB(1, 1), b3 + hstep, voffB);
            PG8_WAIT_V(6); PG8_BAR; PG8_MMA(1, 1, At, B1); PG8_BAR;
            }
        }
        if constexpr (ALIGN_EPI) { if (wr == 0) PG8_BAR; }
        if constexpr (!Epi::AFTER_DRAIN) { E(acc, cur, wr, wc, fr, fq); S.done(cur); }
        if (!has_next) break;
#pragma unroll
        for (int a = 0; a < 2; ++a)
#pragma unroll
            for (int b = 0; b < 2; ++b)
#pragma unroll
                for (int m = 0; m < 4; ++m)
#pragma unroll
                    for (int n = 0; n < 2; ++n) acc[a][b][m][n] = (f32x4){0.f, 0.f, 0.f, 0.f};
        cur = nxt; cA = nA; cB = nB; ++ui;
        if constexpr (GATHER) { _Pragma("unroll") for (int _h = 0; _h < 2; ++_h) _Pragma("unroll") for (int _i = 0; _i < 2; ++_i) vgc[_h][_i] = vgn[_h][_i]; }
        if constexpr (ALIGN_EPI) { if (wr == 1) PG8_BAR; }
    }
    PG8_WAIT_V(0);
    if constexpr (!ALIGN_EPI) { if (wr == 0) PG8_BAR; }
    PG8_BAR;
    if constexpr (Epi::AFTER_DRAIN) { E.fused(acc, cur, wr, wc, fr, fq, lds, wid, lane); S.done(cur); }
#undef PG8_SA
#undef PG8_STAGE_A
#undef PG8_GSET
#undef PG8_SB
#undef PG8_STAGE
#undef PG8_LDA
#undef PG8_LDB
#undef PG8_MMA
#undef PG8_WAIT_V
#undef PG8_WAIT_L
#undef PG8_BAR
#undef PG8_SCHED
}
}

#ifndef ONE_LAUNCH
#define ONE_LAUNCH 1
#endif
constexpr int NWAVES = 8, NTHR = 512;
constexpr int D = 1024, BATCH = 2, SEQ = 8192, CTXL = 256, GRIDW = 64;
constexpr int MX = BATCH * SEQ, MC = BATCH * CTXL, MALL = MX + MC;
constexpr int NCH = 132;
constexpr int NSLAB = 5632, NS1 = 3584, NS2 = 2048;
constexpr int NZM = 4416;
constexpr int Z_R = 0, Z_K = 1024, Z_V = 2048, Z_KK = 3072, Z_TW = 4096, Z_AD = 4160, Z_GS = 4224;
constexpr int C_R = 0, C_K = 1024, C_V = 2048, C_WD = 3072, C_AD = 3136, C_GD = 3200, C_XB = 0, C_GBR = 1024;
constexpr int NWIN = 7680;
constexpr int NEXP = 32, DEXP = 512, MAXT = 160;
constexpr float LN_EPS = 1e-5f, GN_EPS = 64e-5f;
constexpr float ALPHA = 1.189207115002721f;
constexpr size_t MiB = 1u << 20;
constexpr size_t WS_CTL = 0, CTL_ZERO_BYTES = 1 * MiB;
constexpr size_t WS_STATS = 1 * MiB, WS_TOKE = 1 * MiB + 256 * 1024, WS_TOKSLOT = 1 * MiB + 512 * 1024, WS_TOKW = 1 * MiB + 768 * 1024, WS_ROWW = 2 * MiB;
constexpr size_t WS_RWT = 2 * MiB + 512 * 1024;
constexpr size_t WS_S2T = 3 * MiB, WS_AGGA = 5 * MiB, WS_AGGH = 9 * MiB + 256 * 1024, WS_CIN = 13 * MiB + 512 * 1024;
constexpr size_t WS_PW = 18 * MiB;
constexpr size_t WS_S1 = 24 * MiB;
constexpr size_t WS_S2 = 139 * MiB + 512 * 1024;
constexpr size_t WS_ZM = 139 * MiB + 512 * 1024;
constexpr size_t WS_FB = 206 * MiB;
constexpr size_t WS_YLRU = 282 * MiB, WS_YWF = 24 * MiB, WS_YWB = 56 * MiB;
constexpr size_t WS_GATES = 140 * MiB;
constexpr size_t WS_MBUF = 204 * MiB;
constexpr size_t WS_W13 = 24 * MiB, WS_W2 = 88 * MiB;
constexpr size_t WS_H2 = 120 * MiB;
constexpr size_t WS_XS = 153 * MiB;
constexpr size_t WS_HBUF = 236 * MiB;
constexpr size_t WS_END = 314 * MiB;
static_assert(WS_S1 + (size_t)MALL * NS1 * 2 <= WS_S2 && WS_S2 + (size_t)MALL * NS2 * 2 <= WS_YLRU && WS_ZM + (size_t)MALL * NZM * 2 <= WS_YLRU && WS_YLRU + (size_t)MX * D * 2 <= WS_END, "ws map");
static_assert((WS_YLRU - WS_YWF) % (512 * 1024) == 0 && WS_H2 + (size_t)(MX + 1) * D * 2 <= WS_XS && WS_XS + (size_t)MAXT * 256 * D * 2 <= WS_HBUF && WS_HBUF + (size_t)MAXT * 256 * DEXP * 2 <= WS_END, "ws map 2");
constexpr size_t DO_H = 0, DO_WIN = 34 * MiB;
constexpr int CW_TMO = 0, CW_BAR = 4096, CW_MOD = 8192  , CW_ECNT = 32768  ;
constexpr int LDS_BYTES = 155648;
constexpr int MISC_OFF = LDS_BYTES - 1024;
constexpr int TILE_OFF = MISC_OFF - 2048;

#define GAS __attribute__((address_space(1)))
#define LAS __attribute__((address_space(3)))
typedef unsigned short bf16;
typedef unsigned v4u __attribute__((ext_vector_type(4)));
typedef unsigned v2u __attribute__((ext_vector_type(2)));
typedef float f32x4 __attribute__((ext_vector_type(4)));
typedef GAS unsigned gu32;
typedef short bf16x8 __attribute__((ext_vector_type(8)));
#define RLX_AGENT __ATOMIC_RELAXED, __HIP_MEMORY_SCOPE_AGENT
#define LDS_WAIT() asm volatile("s_waitcnt lgkmcnt(0)" ::: "memory")
#define VM_WAIT() asm volatile("s_waitcnt vmcnt(0)" ::: "memory")
#define DI __device__ __forceinline__
typedef __bf16 bf16x2_t __attribute__((ext_vector_type(2)));
typedef float f32x2 __attribute__((ext_vector_type(2)));
DI unsigned cvtpk_s(float lo, float hi) { const f32x2 v = {lo, hi}; const bf16x2_t b = __builtin_convertvector(v, bf16x2_t); return __builtin_bit_cast(unsigned, b); }
DI unsigned pk2(float lo, float hi) { return cvtpk_s(lo, hi); }
DI unsigned f2bf(float f) { return cvtpk_s(f, 0.f) & 0xffffu; }
DI float bf2f(unsigned short b) { return __builtin_bit_cast(float, ((unsigned)b) << 16); }
DI float bflo(unsigned w) { return __builtin_bit_cast(float, w << 16); }
DI float bfhi(unsigned w) { return __builtin_bit_cast(float, w & 0xffff0000u); }
constexpr float NL2E = -1.4426950408889634f;
DI float frcp(float x) { return __builtin_amdgcn_rcpf(x); }
DI float sigm(float x) { return 1.f / (1.f + __expf(-x)); }
DI float sigm_fast(float x) { return frcp(1.f + __expf(-x)); }
template <int CTRL> DI float dppf(float x) { return __builtin_bit_cast(float, __builtin_amdgcn_update_dpp(0, __builtin_bit_cast(int, x), CTRL, 0xF, 0xF, true)); }
template <int CTRL> DI float dppf_one(float x) { return __builtin_bit_cast(float, __builtin_amdgcn_update_dpp(0x3f800000, __builtin_bit_cast(int, x), CTRL, 0xF, 0xF, false)); }
DI float red4(float x) { x += dppf<0xB1>(x); x += dppf<0x4E>(x); return x; }
DI float red16(float x) { x += dppf<0xB1>(x); x += dppf<0x4E>(x); x += dppf<0x141>(x); x += dppf<0x140>(x); return x; }
DI float rdl(float v, int l) { return __builtin_bit_cast(float, __builtin_amdgcn_readlane(__builtin_bit_cast(int, v), l)); }
DI float wave_sum(float v) { v = red16(v); return (rdl(v, 0) + rdl(v, 16)) + (rdl(v, 32) + rdl(v, 48)); }

#define XB_TMO      128
#define XB_XCNT(j)  (256  + 64 * (j))
#define XB_XSUB(j)  (1280 + 64 * (j))
#define XB_XGEN(j)  (2304 + 64 * (j))
#define XB_TOP      3328
#define XB_TOPGEN   3392
#define XCD_BAR_WORDS 3456
#define XB_SPIN_CAP (1u << 18)

__device__ __forceinline__ unsigned xb_ld(unsigned* p)              { return __hip_atomic_load(p, __ATOMIC_RELAXED, __HIP_MEMORY_SCOPE_AGENT); }
__device__ __forceinline__ unsigned xb_add(unsigned* p, unsigned v) { return __hip_atomic_fetch_add(p, v, __ATOMIC_RELAXED, __HIP_MEMORY_SCOPE_AGENT); }
__device__ __forceinline__ unsigned xb_xcc_id() { return (unsigned)__builtin_amdgcn_s_getreg((3 << 11) | 20) & 0xFu; }
#define XB_SPIN(cond, bar) do { unsigned _sp = 0; while (cond) { __builtin_amdgcn_s_sleep(1); \
    if ((++_sp & 255u) == 0u) { if (xb_ld(&(bar)[XB_TMO])) break; if (_sp > XB_SPIN_CAP) { atomicAdd(&(bar)[XB_TMO], 1u); break; } } } } while (0)

struct XcdBarrier {
    unsigned* bar; unsigned x;
    volatile LAS unsigned* st;
};

__device__ __forceinline__ XcdBarrier xcd_barrier_post(unsigned* bar, volatile LAS unsigned* st) {
    XcdBarrier b; b.bar = bar; b.x = xb_xcc_id(); b.st = st;
    if (threadIdx.x == 0) (void)xb_add(&bar[XB_XCNT(b.x)], 1u);
    return b;
}
__device__ __forceinline__ void xcd_barrier_complete(unsigned* bar, unsigned x, unsigned& nloc, unsigned& nx) {
    const unsigned G = gridDim.x * gridDim.y * gridDim.z;
    unsigned sum, cnt, mine, sp = 0u;
    for (;;) {
        sum = 0u; cnt = 0u; mine = 0u;
#pragma unroll
        for (unsigned j = 0; j < 16; ++j) { const unsigned c = xb_ld(&bar[XB_XCNT(j)]); sum += c; cnt += (c > 0u) ? 1u : 0u; mine = (j == x) ? c : mine; }
        if (sum == G) break;
        __builtin_amdgcn_s_sleep(1);
        if ((++sp & 255u) == 0u) { if (xb_ld(&bar[XB_TMO])) break; if (sp > XB_SPIN_CAP) { atomicAdd(&bar[XB_TMO], 1u); break; } }
    }
    nloc = mine > 0u ? mine : 1u; nx = cnt > 0u ? cnt : 1u;
}

__device__ __forceinline__ void xcd_barrier(const XcdBarrier& b) {
    asm volatile("s_waitcnt vmcnt(0)" ::: "memory");
    __syncthreads();
    if (threadIdx.x == 0) {
        unsigned* bar = b.bar;
        __builtin_amdgcn_s_waitcnt(0);
        unsigned nloc = b.st[0], nx = b.st[1];
        if (nloc == 0u) { xcd_barrier_complete(bar, b.x, nloc, nx); b.st[0] = nloc; b.st[1] = nx; }
        const unsigned old = xb_add(&bar[XB_XSUB(b.x)], 1u);
        const unsigned gen = old / nloc;
        if (old + 1u == (gen + 1u) * nloc) {
            __builtin_amdgcn_fence(__ATOMIC_RELEASE, "agent");
            asm volatile("s_waitcnt vmcnt(0)" ::: "memory");
            const unsigned og = xb_add(&bar[XB_TOP], 1u);
            const unsigned tg = og / nx;
            if (og + 1u == (tg + 1u) * nx) xb_add(&bar[XB_TOPGEN], 1u);
            else XB_SPIN(xb_ld(&bar[XB_TOPGEN]) == tg, bar);
            __builtin_amdgcn_fence(__ATOMIC_ACQUIRE, "agent");
            xb_add(&bar[XB_XGEN(b.x)], 1u);
            asm volatile("s_waitcnt vmcnt(0)" ::: "memory");
        } else {
            XB_SPIN(xb_ld(&bar[XB_XGEN(b.x)]) == gen, bar);
            __builtin_amdgcn_fence(__ATOMIC_ACQUIRE, "agent");
            asm volatile("s_waitcnt vmcnt(0)" ::: "memory");
        }
    }
    __syncthreads();
}

struct Args { const float* in[39]; float* out; unsigned char* ws; int ph_lo, ph_hi; };

struct P {
    const float *x, *c, *ctx, *c_ctx, *w_ada, *b_ada, *w_in, *mu_a, *w0, *w2, *a0, *a2, *g2, *k_k, *k_a, *r_k, *gn_g, *gn_b, *conv_w, *conv_b,
        *lru_wa, *lru_ba, *lru_wx, *lru_bx, *lru_lam, *p_a, *p_b, *w_o, *ln1_g, *ln1_b, *router_g, *router_g_b, *router_e, *router_e_b, *e_w1, *e_w3, *e_w2, *ln2_g, *ln2_b;
    float* out; unsigned char* ws; unsigned char* dob;
    float* ctlf; unsigned* ctl;
};

DI float modv(const P& p, int v, int n) { return p.ctlf[CW_MOD + v * 6144 + n] + p.b_ada[n]; }
DI f32x4 modv4(const P& p, int v, int n) { return *(const f32x4*)(p.ctlf + CW_MOD + v * 6144 + n) + *(const f32x4*)(p.b_ada + n); }

DI void transpose_item(const float* W, int ldw, bf16* WT, int ldt, int k0, int n0, int drow0, LAS float* scr, int lane) {
#pragma unroll 8
    for (int i = 0; i < 32; ++i) { const int kk = 2 * i + (lane >> 5); scr[kk * 33 + (lane & 31)] = W[(size_t)(k0 + kk) * ldw + n0 + (lane & 31)]; }
    LDS_WAIT(); asm volatile("" ::: "memory");
    const int c = lane & 7;
#pragma unroll
    for (int j = 0; j < 4; ++j) { const int n = (lane >> 3) + 8 * j; const LAS float* s = scr + (8 * c) * 33 + n;
        v4u o; o.x = pk2(s[0 * 33], s[1 * 33]); o.y = pk2(s[2 * 33], s[3 * 33]); o.z = pk2(s[4 * 33], s[5 * 33]); o.w = pk2(s[6 * 33], s[7 * 33]);
        *(GAS v4u*)(WT + (size_t)(drow0 + n) * ldt + k0 + 8 * c) = o; }
    LDS_WAIT(); asm volatile("" ::: "memory");
}

DI void phase0(const P& p, LAS unsigned char* lds, int tid, int lane, int wave, int G) {
    LAS float* s3 = (LAS float*)lds;
    for (int item = blockIdx.x; item < 256; item += G) {
        const int kc = item >> 4, nc = item & 15;
        if (tid < 192) { const int v = tid >> 6, k = tid & 63; const float cv = (v < 2) ? p.c[v * D + kc * 64 + k] : p.c_ctx[kc * 64 + k]; s3[v * 64 + k] = cv * sigm(cv); }
        __syncthreads();
        if (tid < 384) { const int n = nc * 384 + tid; float a0 = 0.f, a1 = 0.f, a2 = 0.f;
            for (int k = 0; k < 64; ++k) { const float w = p.w_ada[(size_t)(kc * 64 + k) * 6144 + n]; a0 += s3[k] * w; a1 += s3[64 + k] * w; a2 += s3[128 + k] * w; }
            atomicAdd(p.ctlf + CW_MOD + n, a0); atomicAdd(p.ctlf + CW_MOD + 6144 + n, a1); atomicAdd(p.ctlf + CW_MOD + 2 * 6144 + n, a2); }
        __syncthreads();
    }
}
DI void phase0b(const P& p, LAS unsigned char* lds, int tid, int lane, int wave, int G) {
    LAS float* scr = (LAS float*)(lds + 4096 + wave * 16384);
    const int gw = blockIdx.x * NWAVES + wave, NGW = G * NWAVES;
    bf16* win_t = (bf16*)(p.dob + DO_WIN); bf16* pw = (bf16*)(p.ws + WS_PW);
    constexpr int I_IN = 16 * 233, I_P = 16 * 32;
    for (int it = gw; it < I_IN + 3 * I_P; it += NGW) {
        int r = it;
        if (r < I_IN) { const int kb = r / 233, nb = r % 233, n0 = nb * 32; transpose_item(p.w_in, 7456, win_t, D, kb * 64, n0, n0 + (n0 >= 3360 ? 224 : 0), scr, lane); continue; }
        r -= I_IN; const int wsel = r / I_P; r %= I_P; const int kb = r / 32, nb = r % 32;
        if (wsel == 0) transpose_item(p.p_a, D, pw, D, kb * 64, nb * 32, nb * 32, scr, lane);
        else if (wsel == 1) transpose_item(p.p_b, D, pw + (size_t)D * D, D, kb * 64, nb * 32, nb * 32, scr, lane);
        else transpose_item(p.w_o, D, pw + (size_t)2 * D * D, D, kb * 64, nb * 32, nb * 32, scr, lane);
    }
    { float* rwt = (float*)(p.ws + WS_RWT);
      for (int i = blockIdx.x * NTHR + tid; i < 48 * D; i += G * NTHR) { const int n = i >> 10, k = i & (D - 1); rwt[i] = n < 4 ? p.router_g[k * 4 + n] : (n < 36 ? p.router_e[k * 32 + (n - 4)] : 0.f); } }
    for (int i = blockIdx.x * NTHR + tid; i < 224 * D / 8; i += G * NTHR) ((GAS v4u*)(win_t + (size_t)3360 * D))[i] = (v4u){0u, 0u, 0u, 0u};
}

DI void phase1(const P& p, int lane, int wave, int G) {
    const int gw = blockIdx.x * NWAVES + wave, NGW = G * NWAVES;
    bf16* H = (bf16*)(p.dob + DO_H); float* stats = (float*)(p.ws + WS_STATS);
    f32x4 sc[2][4], sh[2][4]; int cv[2] = {-1, -1};
#pragma unroll
    for (int j = 0; j < 4; ++j) { sc[0][j] = sc[1][j] = sh[0][j] = sh[1][j] = (f32x4){0.f, 0.f, 0.f, 0.f}; }
    for (int m0 = gw; m0 < MALL; m0 += 2 * NGW) {
        f32x4 q[2][4]; float s[2] = {0.f, 0.f}; int mm[2]; mm[0] = m0; mm[1] = (m0 + NGW < MALL) ? m0 + NGW : m0;
#pragma unroll
        for (int rr = 0; rr < 2; ++rr) { const int m = mm[rr]; const float* xrow = (m < MX) ? p.x + (size_t)m * D : p.ctx + (size_t)(m - MX) * D; const GAS f32x4* xr = (const GAS f32x4*)xrow + lane;
#pragma unroll
            for (int j = 0; j < 4; ++j) { q[rr][j] = xr[64 * j]; s[rr] += (q[rr][j].x + q[rr][j].y) + (q[rr][j].z + q[rr][j].w); } }
#pragma unroll
        for (int rr = 0; rr < 2; ++rr) { const int m = mm[rr]; const int v = (m < MX) ? (m >> 13) : 2;
            if (v != cv[rr]) { cv[rr] = v;
#pragma unroll
                for (int j = 0; j < 4; ++j) { const int n = 256 * j + 4 * lane; sc[rr][j] = modv4(p, v, 1024 + n) + 1.f; sh[rr][j] = modv4(p, v, n); } }
            const float mean = wave_sum(s[rr]) * (1.f / D); float s2 = 0.f;
#pragma unroll
            for (int j = 0; j < 4; ++j) { q[rr][j] = q[rr][j] - mean; s2 += (q[rr][j].x * q[rr][j].x + q[rr][j].y * q[rr][j].y) + (q[rr][j].z * q[rr][j].z + q[rr][j].w * q[rr][j].w); }
            const float rstd = 1.f / sqrtf(wave_sum(s2) * (1.f / D) + LN_EPS);
            if (rr == 0 || mm[1] != mm[0]) {
                if (lane == 0) { stats[2 * m] = mean; stats[2 * m + 1] = rstd; }
                GAS v2u* o8 = (GAS v2u*)(H + (size_t)m * D) + lane;
#pragma unroll
                for (int j = 0; j < 4; ++j) { const f32x4 h = q[rr][j] * rstd * sc[rr][j] + sh[rr][j];
                    o8[64 * j] = (v2u){pk2(h[0], h[1]), pk2(h[2], h[3])}; } } }
    }
}

template <int ACT> struct EpiPlain {
    static constexpr bool PERM = true, AFTER_DRAIN = false;
    bf16* O; int ldc; bf16* O2; int ldc2; int split_tile;
    DI void operator()(const pg8::f32x4 (&acc)[2][2][4][2], const pg8::Unit& u, int wr, int wc, int fr, int fq) const {
        const bool second = u.pn >= split_tile; bf16* Ob = second ? O2 : O; const int ld = second ? ldc2 : ldc, pn = second ? u.pn - split_tile : u.pn;
        const int row0 = u.pm * 256 + wr * 64 + fr, col0 = pn * 256 + wc * 32 + 8 * fq;
#pragma unroll
        for (int ai = 0; ai < 2; ++ai)
#pragma unroll
            for (int m = 0; m < 4; ++m) { bf16* rowp = Ob + (size_t)(row0 + ai * 128 + m * 16) * ld + col0;
#pragma unroll
                for (int bj = 0; bj < 2; ++bj) { pg8::f32x4 v0 = acc[ai][bj][m][0], v1 = acc[ai][bj][m][1];
                    if (ACT == 1) {
#pragma unroll
                        for (int i = 0; i < 4; ++i) { v0[i] = sigm_fast(v0[i]); v1[i] = sigm_fast(v1[i]); } }
                    pg8::u32x4 w;
                    if (ACT == 1) { w.x = cvtpk_s(v0[0], v0[1]); w.y = cvtpk_s(v0[2], v0[3]); w.z = cvtpk_s(v1[0], v1[1]); w.w = cvtpk_s(v1[2], v1[3]); }
                    else { w.x = pg8::cvt_pk_bf16(v0[0], v0[1]); w.y = pg8::cvt_pk_bf16(v0[2], v0[3]); w.z = pg8::cvt_pk_bf16(v1[0], v1[1]); w.w = pg8::cvt_pk_bf16(v1[2], v1[3]); }
                    *(pg8::u32x4*)(rowp + bj * 128) = w; } }
    }
};
constexpr int LRU_TOFF = (int)((WS_YLRU - WS_YWF) / (512 * 1024));
struct EpiMix {
    static constexpr bool PERM = true, AFTER_DRAIN = false;
    const bf16* gates; bf16* mbuf;
    DI void operator()(const pg8::f32x4 (&acc)[2][2][4][2], const pg8::Unit& u, int wr, int wc, int fr, int fq) const {
        const bool isa = u.pm < 64; const int row0 = (isa ? u.pm : u.pm - LRU_TOFF) * 256 + wr * 64 + fr, col0 = (u.pn & 3) * 256 + wc * 32 + 8 * fq;
#pragma unroll
        for (int ai = 0; ai < 2; ++ai) {
            pg8::u32x4 gwv[4][2], oldv[4][2];
#pragma unroll
            for (int m = 0; m < 4; ++m)
#pragma unroll
                for (int bj = 0; bj < 2; ++bj) { const int row = row0 + ai * 128 + m * 16, col = col0 + bj * 128;
                    gwv[m][bj] = *(const pg8::u32x4*)(gates + (size_t)row * 2048 + (isa ? 0 : 1024) + col);
                    oldv[m][bj] = (pg8::u32x4){0u, 0u, 0u, 0u}; if (isa) oldv[m][bj] = *(const pg8::u32x4*)(mbuf + (size_t)row * D + col); }
#pragma unroll
            for (int m = 0; m < 4; ++m) { const int row = row0 + ai * 128 + m * 16;
#pragma unroll
                for (int bj = 0; bj < 2; ++bj) { const int col = col0 + bj * 128;
                    const pg8::u32x4 gw = gwv[m][bj];
                    bf16* mp = mbuf + (size_t)row * D + col;
                    const pg8::u32x4 old = oldv[m][bj];
                    const pg8::f32x4 v0 = acc[ai][bj][m][0], v1 = acc[ai][bj][m][1];
                    float r[8];
                    r[0] = v0[0] * bflo(gw.x) + bflo(old.x); r[1] = v0[1] * bfhi(gw.x) + bfhi(old.x); r[2] = v0[2] * bflo(gw.y) + bflo(old.y); r[3] = v0[3] * bfhi(gw.y) + bfhi(old.y);
                    r[4] = v1[0] * bflo(gw.z) + bflo(old.z); r[5] = v1[1] * bfhi(gw.z) + bfhi(old.z); r[6] = v1[2] * bflo(gw.w) + bflo(old.w); r[7] = v1[3] * bfhi(gw.w) + bfhi(old.w);
                    pg8::u32x4 w; w.x = pg8::cvt_pk_bf16(r[0], r[1]); w.y = pg8::cvt_pk_bf16(r[2], r[3]); w.z = pg8::cvt_pk_bf16(r[4], r[5]); w.w = pg8::cvt_pk_bf16(r[6], r[7]);
                    *(pg8::u32x4*)mp = w; } } }
    }
};
struct EpiT1 {
    static constexpr bool PERM = false, AFTER_DRAIN = false;
    const float* x; const float* stats; const float* modp; const float* b_ada; float* T1;
    DI void operator()(const pg8::f32x4 (&acc)[2][2][4][2], const pg8::Unit& u, int wr, int wc, int fr, int fq) const {
        const int row0 = u.pm * 256 + wr * 64 + fr, col0 = u.pn * 256 + wc * 32 + 4 * fq; const int b = (u.pm * 256) >> 13;
        pg8::f32x4 gt[2][2];
#pragma unroll
        for (int bj = 0; bj < 2; ++bj)
#pragma unroll
            for (int n = 0; n < 2; ++n) { const int c = col0 + bj * 128 + n * 16; gt[bj][n] = *(const pg8::f32x4*)(modp + b * 6144 + 2048 + c) + *(const pg8::f32x4*)(b_ada + 2048 + c); }
#pragma unroll
        for (int ai = 0; ai < 2; ++ai)
#pragma unroll
            for (int mh = 0; mh < 2; ++mh) {
                float mean[2], rs[2]; pg8::f32x4 xv[2][2][2];
#pragma unroll
                for (int mm = 0; mm < 2; ++mm) { const int row = row0 + ai * 128 + (2 * mh + mm) * 16; mean[mm] = stats[2 * row]; rs[mm] = stats[2 * row + 1] * ALPHA;
#pragma unroll
                    for (int bj = 0; bj < 2; ++bj)
#pragma unroll
                        for (int n = 0; n < 2; ++n) xv[mm][bj][n] = *(const pg8::f32x4*)(x + (size_t)row * D + col0 + bj * 128 + n * 16); }
#pragma unroll
                for (int mm = 0; mm < 2; ++mm) { const int m = 2 * mh + mm; const int row = row0 + ai * 128 + m * 16;
#pragma unroll
                    for (int bj = 0; bj < 2; ++bj)
#pragma unroll
                        for (int n = 0; n < 2; ++n) *(pg8::f32x4*)(T1 + (size_t)row * D + col0 + bj * 128 + n * 16) = (xv[mm][bj][n] - mean[mm]) * rs[mm] + gt[bj][n] * acc[ai][bj][m][n]; } }
    }
};
struct EpiSwiGLU {
    static constexpr bool PERM = true, AFTER_DRAIN = false;
    bf16* hb;
    DI void operator()(const pg8::f32x4 (&acc)[2][2][4][2], const pg8::Unit& u, int wr, int wc, int fr, int fq) const {
        const int row0 = u.pm * 256 + wr * 64 + fr, col0 = (u.pn & 3) * 128 + wc * 32 + 8 * fq;
#pragma unroll
        for (int ai = 0; ai < 2; ++ai)
#pragma unroll
            for (int m = 0; m < 4; ++m) { float r[8];
#pragma unroll
                for (int n = 0; n < 2; ++n)
#pragma unroll
                    for (int i = 0; i < 4; ++i) { const float a = acc[ai][0][m][n][i], b = acc[ai][1][m][n][i]; r[4 * n + i] = a * sigm_fast(a) * b; }
                pg8::u32x4 w; w.x = pg8::cvt_pk_bf16(r[0], r[1]); w.y = pg8::cvt_pk_bf16(r[2], r[3]); w.z = pg8::cvt_pk_bf16(r[4], r[5]); w.w = pg8::cvt_pk_bf16(r[6], r[7]);
                *(pg8::u32x4*)(hb + (size_t)(row0 + ai * 128 + m * 16) * DEXP + col0) = w; }
    }
};
struct EpiW2 {
    static constexpr bool PERM = true, AFTER_DRAIN = false;
    bf16* yb; const LAS int* tile; const int* s2t; const float* tokw;
    DI void operator()(const pg8::f32x4 (&acc)[2][2][4][2], const pg8::Unit& u, int wr, int wc, int fr, int fq) const {
        const int row0 = u.pm * 256 + wr * 64 + fr, col0 = (u.pn & 3) * 256 + wc * 32 + 8 * fq;
        const int ex = tile[u.pm], slot0 = (u.pm - tile[MAXT + ex]) * 256 + wr * 64 + fr, cnt = tile[MAXT + 64 + ex];
        int si[2][4]; float rwv[2][4];
#pragma unroll
        for (int ai = 0; ai < 2; ++ai)
#pragma unroll
            for (int m = 0; m < 4; ++m) { const int slot = slot0 + ai * 128 + m * 16; si[ai][m] = slot < cnt ? s2t[(size_t)ex * MX + slot] : -1; }
#pragma unroll
        for (int ai = 0; ai < 2; ++ai)
#pragma unroll
            for (int m = 0; m < 4; ++m) rwv[ai][m] = si[ai][m] >= 0 ? tokw[si[ai][m]] : 0.f;
#pragma unroll
        for (int ai = 0; ai < 2; ++ai)
#pragma unroll
            for (int m = 0; m < 4; ++m) { const int row = row0 + ai * 128 + m * 16; const float rw = rwv[ai][m];
#pragma unroll
                for (int bj = 0; bj < 2; ++bj) { const pg8::f32x4 v0 = acc[ai][bj][m][0] * rw, v1 = acc[ai][bj][m][1] * rw;
                    pg8::u32x4 w; w.x = pg8::cvt_pk_bf16(v0[0], v0[1]); w.y = pg8::cvt_pk_bf16(v0[2], v0[3]); w.z = pg8::cvt_pk_bf16(v1[0], v1[1]); w.w = pg8::cvt_pk_bf16(v1[2], v1[3]);
                    *(pg8::u32x4*)(yb + (size_t)row * D + col0 + bj * 128) = w; } }
    }
};
struct SchedMix : pg8::StaticOrder {
    __device__ bool next(int i, pg8::Unit& u) const { pg8::Unit t; if (!pg8::StaticOrder::next(i >> 1, t)) return false; const int w = i & 1; u.pm = w ? t.pm : t.pm + LRU_TOFF; u.pn = w ? t.pn : t.pn + 4; return true; }
};
struct SchedMoE {
    const LAS int* tile; int G, c; const int* s2t;
    DI int src_row(int T, int r) const { const int e = tile[T], slot = (T - tile[MAXT + e]) * 256 + r; return slot < tile[MAXT + 64 + e] ? (s2t[(size_t)e * MX + slot] >> 1) : MX; }
    __device__ bool next(int i, pg8::Unit& u) const { int L = i * G + c; const int U = tile[MAXT + 40] * 4; if (L >= U) return false;
        { const int q = U / pg8::NXCD, r = U % pg8::NXCD, xcd = L % pg8::NXCD, off = L / pg8::NXCD; L = (xcd < r ? xcd * (q + 1) : r * (q + 1) + (xcd - r) * q) + off; }
        const int T = L >> 2; u.pm = T; u.pn = tile[T] * 4 + (L & 3); return true; }
    DI void a_ready(const pg8::Unit&) const {}
    DI void done(const pg8::Unit&) const {}
};

DI int chunk_row0(int b, int ci) { return ci < 4 ? MX + b * CTXL + ci * 64 : b * SEQ + (ci - 4) * 64; }
DI float gelu_tanh(float x) { const float u = 0.7978845608028654f * (x + 0.044715f * x * x * x); const float t = 1.f - 2.f * frcp(1.f + __expf(2.f * u)); return 0.5f * x * (1.f + t); }
constexpr int NHS = 264;
constexpr int LR_WT = 0, LR_CW = 36864, LR_WV = 38400, LR_WVS = 6656;
DI void lru_setup(const P& p, LAS unsigned char* lds, int tid, int hb) {
    LAS bf16* WT = (LAS bf16*)(lds + LR_WT); LAS float* CW = (LAS float*)(lds + LR_CW);
    __syncthreads();
    for (int i = tid; i < 4 * 4096; i += NTHR) { const int m = i >> 12, k = (i >> 6) & 63, n = i & 63; const int e = m & 1;
        const float w = (m < 2 ? p.lru_wa : p.lru_wx)[((size_t)(e * 16 + hb) * 64 + k) * 64 + n]; WT[m * 4608 + n * 72 + k] = (bf16)f2bf(NL2E * w); }
    for (int i = tid; i < 6 * 64; i += NTHR) { const int r = i >> 6, c = i & 63; CW[i] = r < 5 ? p.conv_w[r * D + hb * 64 + c] : p.conv_b[hb * 64 + c]; }
    __syncthreads();
}
struct LruC { float ba[2][4], bx[2][4], sp8[2][4]; };
DI void lru_consts(const P& p, int hb, int l15, LruC& C) {
#pragma unroll
    for (int e = 0; e < 2; ++e)
#pragma unroll
        for (int nt = 0; nt < 4; ++nt) { const int c = hb * 64 + nt * 16 + l15; C.ba[e][nt] = NL2E * p.lru_ba[e * D + c]; C.bx[e][nt] = NL2E * p.lru_bx[e * D + c]; C.sp8[e][nt] = (8.f * NL2E) * log1pf(__expf(-p.lru_lam[e * D + c])); }
}
DI void hs_geom(int b, int hs, int& row0, int& tb, int& tlen) { if (hs < 8) { tb = hs * 32; row0 = MX + b * CTXL + tb; tlen = CTXL; } else { tb = (hs - 8) * 32; row0 = b * SEQ + tb; tlen = SEQ; } }
DI void lru_conv(const bf16* S, LAS unsigned char* lds, LAS unsigned char* wv, int lane, int hb, int rowb, int tb, int tlen) {
    LAS float* CW = (LAS float*)(lds + LR_CW); LAS bf16* XCB = (LAS bf16*)wv; LAS float* XC = (LAS float*)(wv + 2304);
    const int tau = lane >> 2, qd = lane & 3; const bf16* sp = S + (size_t)(rowb + tau) * NS2 + C_XB + hb * 64 + qd * 16;
    float a[16];
#pragma unroll
    for (int i4 = 0; i4 < 4; ++i4) { const f32x4 bv = *(const LAS f32x4*)(CW + 5 * 64 + qd * 16 + 4 * i4); a[4 * i4] = bv[0]; a[4 * i4 + 1] = bv[1]; a[4 * i4 + 2] = bv[2]; a[4 * i4 + 3] = bv[3]; }
    v4u w[5][2];
#pragma unroll
    for (int i = 0; i < 5; ++i) { const int t = tb + tau + i - 2; const bool ok = t >= 0 && t < tlen;
        w[i][0] = ok ? *(const v4u*)(sp + (ptrdiff_t)(i - 2) * NS2) : (v4u){0u, 0u, 0u, 0u}; w[i][1] = ok ? *(const v4u*)(sp + (ptrdiff_t)(i - 2) * NS2 + 8) : (v4u){0u, 0u, 0u, 0u}; }
#pragma unroll
    for (int i = 0; i < 5; ++i)
#pragma unroll
        for (int hh = 0; hh < 2; ++hh) { const f32x4 c0 = *(const LAS f32x4*)(CW + i * 64 + qd * 16 + hh * 8), c1 = *(const LAS f32x4*)(CW + i * 64 + qd * 16 + hh * 8 + 4); const v4u x = w[i][hh];
            a[hh * 8 + 0] += c0[0] * bflo(x.x); a[hh * 8 + 1] += c0[1] * bfhi(x.x); a[hh * 8 + 2] += c0[2] * bflo(x.y); a[hh * 8 + 3] += c0[3] * bfhi(x.y);
            a[hh * 8 + 4] += c1[0] * bflo(x.z); a[hh * 8 + 5] += c1[1] * bfhi(x.z); a[hh * 8 + 6] += c1[2] * bflo(x.w); a[hh * 8 + 7] += c1[3] * bfhi(x.w); }
#pragma unroll
    for (int i4 = 0; i4 < 4; ++i4) *(LAS f32x4*)(XC + tau * 68 + qd * 16 + 4 * i4) = (f32x4){a[4 * i4], a[4 * i4 + 1], a[4 * i4 + 2], a[4 * i4 + 3]};
    *(LAS v4u*)(XCB + tau * 72 + qd * 16) = (v4u){pk2(a[0], a[1]), pk2(a[2], a[3]), pk2(a[4], a[5]), pk2(a[6], a[7])};
    *(LAS v4u*)(XCB + tau * 72 + qd * 16 + 8) = (v4u){pk2(a[8], a[9]), pk2(a[10], a[11]), pk2(a[12], a[13]), pk2(a[14], a[15])};
}
DI void lru_gates(LAS unsigned char* lds, LAS unsigned char* wv, int lane, int e, const LruC& C, float (&av)[4][4], float (&uv)[4][4]) {
    LAS bf16* WT = (LAS bf16*)(lds + LR_WT); LAS bf16* XCB = (LAS bf16*)wv; LAS float* XC = (LAS float*)(wv + 2304);
    const int l15 = lane & 15, g = lane >> 4;
    pg8::f32x4 zr[4], zi[4];
#pragma unroll
    for (int nt = 0; nt < 4; ++nt) { zr[nt] = (pg8::f32x4){0.f, 0.f, 0.f, 0.f}; zi[nt] = (pg8::f32x4){0.f, 0.f, 0.f, 0.f}; }
#pragma unroll
    for (int ks = 0; ks < 2; ++ks) { const bf16x8 ax = *(const LAS bf16x8*)(XCB + l15 * 72 + ks * 32 + g * 8);
#pragma unroll
        for (int nt = 0; nt < 4; ++nt) { const bf16x8 br = *(const LAS bf16x8*)(WT + e * 4608 + (nt * 16 + l15) * 72 + ks * 32 + g * 8), bi = *(const LAS bf16x8*)(WT + (2 + e) * 4608 + (nt * 16 + l15) * 72 + ks * 32 + g * 8);
            zr[nt] = __builtin_amdgcn_mfma_f32_16x16x32_bf16(ax, br, zr[nt], 0, 0, 0); zi[nt] = __builtin_amdgcn_mfma_f32_16x16x32_bf16(ax, bi, zi[nt], 0, 0, 0); } }
#pragma unroll
    for (int nt = 0; nt < 4; ++nt)
#pragma unroll
        for (int i = 0; i < 4; ++i) { const float rg = frcp(1.f + __builtin_amdgcn_exp2f(zr[nt][i] + C.ba[e][nt])), ig = frcp(1.f + __builtin_amdgcn_exp2f(zi[nt][i] + C.bx[e][nt]));
            const float a = __builtin_amdgcn_exp2f(rg * C.sp8[e][nt]);
            const float em = fmaxf(__builtin_fmaf(-a, a, 1.f), 0.f);
            av[nt][i] = a; uv[nt][i] = __builtin_amdgcn_sqrtf(em) * ig * XC[(4 * g + i) * 68 + nt * 16 + l15]; }
}
DI float bperm(int srclane, float v) { return __builtin_bit_cast(float, __builtin_amdgcn_ds_bpermute(srclane * 4, __builtin_bit_cast(int, v))); }
template <int DIR> DI void lru_local(const float (&a)[4], const float (&u)[4], int l15, float (&hl)[4], float (&pl)[4], float (&PG)[4], float (&HG)[4]) {
    float h = 0.f, pr = 1.f;
#pragma unroll
    for (int q = 0; q < 4; ++q) { const int i = DIR ? 3 - q : q; h = a[i] * h + u[i]; pr *= a[i]; hl[i] = h; pl[i] = pr; }
#pragma unroll
    for (int gg = 0; gg < 4; ++gg) { PG[gg] = bperm(gg * 16 + l15, pr); HG[gg] = bperm(gg * 16 + l15, h); }
}
template <int PASS> DI void lru_unit(const P& p, LAS unsigned char* lds, int lane, int wave, int b, int hs, int hb, const LruC& C) {
    const bf16* S = (const bf16*)(p.ws + WS_S2); LAS unsigned char* wv = lds + LR_WV + wave * LR_WVS;
    const int l15 = lane & 15, g = lane >> 4; int row0, tb, tlen; hs_geom(b, hs, row0, tb, tlen);
    const size_t ao0 = ((size_t)(b * NHS + hs) * 2) * D + hb * 64 + l15;
    float av[4][4], uv[4][4], hl[4], pl[4], PG[4], HG[4];
    unsigned* FB = (unsigned*)(p.ws + WS_FB);
    if (PASS == 1) {
        float Af[4], Hf[4], Ab[4], Hb[4];
#pragma unroll
        for (int nt = 0; nt < 4; ++nt) { Af[nt] = 1.f; Hf[nt] = 0.f; Ab[nt] = 1.f; Hb[nt] = 0.f; }
#pragma unroll 1
        for (int band = 0; band < 2; ++band) { lru_conv(S, lds, wv, lane, hb, row0 + band * 16, tb + band * 16, tlen);
            lru_gates(lds, wv, lane, 0, C, av, uv);
#pragma unroll
            for (int nt = 0; nt < 4; ++nt) { lru_local<0>(av[nt], uv[nt], l15, hl, pl, PG, HG); float cc = Hf[nt], Pc = Af[nt], cm = cc, Pm = Pc;
#pragma unroll
                for (int gg = 0; gg < 4; ++gg) { if (gg == g) { cm = cc; Pm = Pc; } cc = PG[gg] * cc + HG[gg]; Pc *= PG[gg]; }
                Hf[nt] = cc; Af[nt] = Pc;
#pragma unroll
                for (int i = 0; i < 4; ++i) FB[(size_t)(row0 + band * 16 + 4 * g + i) * D + hb * 64 + nt * 16 + l15] = pk2(hl[i] + pl[i] * cm, pl[i] * Pm); }
            lru_gates(lds, wv, lane, 1, C, av, uv);
#pragma unroll
            for (int nt = 0; nt < 4; ++nt) { lru_local<1>(av[nt], uv[nt], l15, hl, pl, PG, HG); float A = PG[3], H = HG[3];
#pragma unroll
                for (int gg = 2; gg >= 0; --gg) { H = PG[gg] * H + HG[gg]; A *= PG[gg]; }
                Hb[nt] = Ab[nt] * H + Hb[nt]; Ab[nt] *= A; } }
        if (g == 0) { float* GA = (float*)(p.ws + WS_AGGA); float* GH = (float*)(p.ws + WS_AGGH);
#pragma unroll
            for (int nt = 0; nt < 4; ++nt) { GA[ao0 + nt * 16] = Af[nt]; GH[ao0 + nt * 16] = Hf[nt]; GA[ao0 + D + nt * 16] = Ab[nt]; GH[ao0 + D + nt * 16] = Hb[nt]; } }
    } else {
        const float* CI = (const float*)(p.ws + WS_CIN); bf16* Y = (bf16*)(p.ws + WS_YLRU);
        float Cf[4], Cb[4];
#pragma unroll
        for (int nt = 0; nt < 4; ++nt) { Cf[nt] = CI[ao0 + nt * 16]; Cb[nt] = CI[ao0 + D + nt * 16]; }
#pragma unroll 1
        for (int bq = 0; bq < 2; ++bq) { const int band = 1 - bq; lru_conv(S, lds, wv, lane, hb, row0 + band * 16, tb + band * 16, tlen);
            lru_gates(lds, wv, lane, 1, C, av, uv);
#pragma unroll
            for (int nt = 0; nt < 4; ++nt) { lru_local<1>(av[nt], uv[nt], l15, hl, pl, PG, HG); float c = Cb[nt], cm = c;
#pragma unroll
                for (int gg = 3; gg >= 0; --gg) { if (gg == g) cm = c; c = PG[gg] * c + HG[gg]; }
                Cb[nt] = c;
#pragma unroll
                for (int i = 0; i < 4; ++i) { const size_t yo = (size_t)(row0 + band * 16 + 4 * g + i) * D + hb * 64 + nt * 16 + l15;
                    const float gt = bf2f(S[(size_t)(row0 + band * 16 + 4 * g + i) * NS2 + C_GBR + hb * 64 + nt * 16 + l15]);
                    const unsigned fb = FB[yo];
                    Y[yo] = (bf16)f2bf((bflo(fb) + bfhi(fb) * Cf[nt] + hl[i] + pl[i] * cm) * gelu_tanh(gt)); } } }
    }
}
DI void lru_carry(const P& p, LAS unsigned char* lds, int tid, int G) {
    const float* A = (const float*)(p.ws + WS_AGGA); const float* H = (const float*)(p.ws + WS_AGGH); float* CI = (float*)(p.ws + WS_CIN);
    LAS float* XA = (LAS float*)lds; LAS float* XH = XA + 512;
    for (int wgi = blockIdx.x; wgi < 64; wgi += G) { const int seg = tid >> 6, chain = wgi * 64 + (tid & 63), c = chain & (D - 1), e = (chain >> 10) & 1, b = chain >> 11;
        float a[33], h[33]; float As = 1.f, Hs = 0.f;
#pragma unroll
        for (int k = 0; k < 33; ++k) { const int st = seg * 33 + k, hs = e ? (st < 8 ? 7 - st : 271 - st) : st; const size_t o = ((size_t)(b * NHS + hs) * 2 + e) * D + c; a[k] = A[o]; h[k] = H[o]; }
#pragma unroll
        for (int k = 0; k < 33; ++k) { Hs = a[k] * Hs + h[k]; As *= a[k]; }
        __syncthreads(); XA[tid] = As; XH[tid] = Hs; __syncthreads();
        float cy = 0.f;
        for (int sg = 0; sg < seg; ++sg) cy = XA[sg * 64 + (tid & 63)] * cy + XH[sg * 64 + (tid & 63)];
#pragma unroll
        for (int k = 0; k < 33; ++k) { const int st = seg * 33 + k, hs = e ? (st < 8 ? 7 - st : 271 - st) : st; CI[((size_t)(b * NHS + hs) * 2 + e) * D + c] = cy; cy = a[k] * cy + h[k]; } }
}

DI float tanh_fast(float x) { return 1.f - 2.f * frcp(1.f + __expf(2.f * x)); }
struct MixLd { v4u w; v4u n[4]; };
DI void mix_ld(const bf16* own, const bf16* const (&np)[4], int cb, MixLd& L) {
    L.w = *(const v4u*)(own + cb);
#pragma unroll
    for (int i = 0; i < 4; ++i) L.n[i] = *(const v4u*)(np[i] + cb);
}
DI void mix_do(const MixLd& L, const float (&nv)[4], const float* mu, int cb, float (&o)[8]) {
    const v4u w = L.w;
    const f32x4 m0 = *(const f32x4*)(mu + cb), m1 = *(const f32x4*)(mu + cb + 4);
    const float ow[8] = {bflo(w.x), bfhi(w.x), bflo(w.y), bfhi(w.y), bflo(w.z), bfhi(w.z), bflo(w.w), bfhi(w.w)};
    const float nb[8] = {bflo(L.n[0].x) * nv[0], bfhi(L.n[1].x) * nv[1], bflo(L.n[2].y) * nv[2], bfhi(L.n[3].y) * nv[3], bflo(L.n[0].z) * nv[0], bfhi(L.n[1].z) * nv[1], bflo(L.n[2].w) * nv[2], bfhi(L.n[3].w) * nv[3]};
#pragma unroll
    for (int i = 0; i < 4; ++i) { o[i] = ow[i] + m0[i] * (nb[i] - ow[i]); o[4 + i] = ow[4 + i] + m1[i] * (nb[4 + i] - ow[4 + i]); }
}
DI void mix_do2(const MixLd& L, const float (&nv)[4], const f32x4 m0, const f32x4 m1, float (&o)[8]) {
    const v4u w = L.w;
    const float ow[8] = {bflo(w.x), bfhi(w.x), bflo(w.y), bfhi(w.y), bflo(w.z), bfhi(w.z), bflo(w.w), bfhi(w.w)};
    const float nb[8] = {bflo(L.n[0].x) * nv[0], bfhi(L.n[1].x) * nv[1], bflo(L.n[2].y) * nv[2], bfhi(L.n[3].y) * nv[3], bflo(L.n[0].z) * nv[0], bfhi(L.n[1].z) * nv[1], bflo(L.n[2].w) * nv[2], bfhi(L.n[3].w) * nv[3]};
#pragma unroll
    for (int i = 0; i < 4; ++i) { o[i] = ow[i] + m0[i] * (nb[i] - ow[i]); o[4 + i] = ow[4 + i] + m1[i] * (nb[4 + i] - ow[4 + i]); }
}
DI void mix8(const bf16* own, const bf16* const (&np)[4], const float (&nv)[4], const float* mu, int cb, float (&o)[8]) { MixLd L; mix_ld(own, np, cb, L); mix_do(L, nv, mu, cb, o); }
DI void nbr_rows(const bf16* S, int b, int ci, int j, const bf16*& own, const bf16* (&np)[4], float (&nv)[4]) {
    const int row = chunk_row0(b, ci) + j; own = S + (size_t)row * NS1;
    if (ci >= 4) { const int gr = ci - 4; const bool v0 = j > 0, v1 = j < 63, v2 = gr > 0, v3 = gr < 127;
        np[0] = v0 ? own - NS1 : own; np[1] = v1 ? own + NS1 : own; np[2] = v2 ? own - (size_t)64 * NS1 : own; np[3] = v3 ? own + (size_t)64 * NS1 : own;
        nv[0] = v0 ? 1.f : 0.f; nv[1] = v1 ? 1.f : 0.f; nv[2] = v2 ? 1.f : 0.f; nv[3] = v3 ? 1.f : 0.f; }
    else { const int t = ci * 64 + j; const bool v0 = t > 0, v1 = t < CTXL - 1;
        np[0] = np[2] = v0 ? own - NS1 : own; np[1] = np[3] = v1 ? own + NS1 : own; nv[0] = nv[2] = v0 ? 1.f : 0.f; nv[1] = nv[3] = v1 ? 1.f : 0.f; }
}
DI float red8(float x) { x += dppf<0xB1>(x); x += dppf<0x4E>(x); x += dppf<0x141>(x); return x; }
DI void mix_store(bf16* zr, const f32x4 k0, const f32x4 k1, int it, int gi, int cb, const float (&o)[8]) {
    if (it < 2 || it == 4 || it == 5) { *(v4u*)(zr + cb) = (v4u){pk2(o[0], o[1]), pk2(o[2], o[3]), pk2(o[4], o[5]), pk2(o[6], o[7])}; }
    else if (it == 2 || it == 3) {
        *(v4u*)(zr + cb) = (v4u){pk2(o[0], o[1]), pk2(o[2], o[3]), pk2(o[4], o[5]), pk2(o[6], o[7])};
        float kr[8], ss = 0.f;
#pragma unroll
        for (int i = 0; i < 4; ++i) { kr[i] = o[i] * k0[i]; kr[4 + i] = o[4 + i] * k1[i]; ss += kr[i] * kr[i] + kr[4 + i] * kr[4 + i]; }
        ss = red8(ss); const float inv = __builtin_amdgcn_rsqf(ss + 1e-12f);
        *(v4u*)(zr + Z_KK + cb - C_K) = (v4u){pk2(kr[0] * inv, kr[1] * inv), pk2(kr[2] * inv, kr[3] * inv), pk2(kr[4] * inv, kr[5] * inv), pk2(kr[6] * inv, kr[7] * inv)}; }
    else if (gi < 392) { *(v4u*)(zr + Z_TW + cb - C_WD) = (v4u){pk2(tanh_fast(o[0]), tanh_fast(o[1])), pk2(tanh_fast(o[2]), tanh_fast(o[3])), pk2(tanh_fast(o[4]), tanh_fast(o[5])), pk2(tanh_fast(o[6]), tanh_fast(o[7]))}; }
    else if (gi < 400) { *(v4u*)(zr + Z_AD + cb - C_AD) = (v4u){pk2(o[0], o[1]), pk2(o[2], o[3]), pk2(o[4], o[5]), pk2(o[6], o[7])}; }
    else if (gi < 420) { *(v4u*)(zr + Z_GS + cb - C_GD) = (v4u){pk2(sigm_fast(o[0]), sigm_fast(o[1])), pk2(sigm_fast(o[2]), sigm_fast(o[3])), pk2(sigm_fast(o[4]), sigm_fast(o[5])), pk2(sigm_fast(o[6]), sigm_fast(o[7]))}; }
}
DI void mix_geom(int m, int& b, int& ci, int& j) { if (m < MX) { b = m >> 13; const int t = m & (SEQ - 1); ci = 4 + (t >> 6); j = t & 63; } else { const int t = (m - MX) & (CTXL - 1); b = (m - MX) >> 8; ci = t >> 6; j = t & 63; } }
DI void phase_mix(const P& p, int lane, int wave, int G) {
    const bf16* S = (const bf16*)(p.ws + WS_S1); bf16* Z = (bf16*)(p.ws + WS_ZM);
    const int gw = blockIdx.x * NWAVES + wave, NGW = G * NWAVES;
    f32x4 mu0[7], mu1[7], kk0[2], kk1[2];
#pragma unroll
    for (int it = 0; it < 7; ++it) { const int gi = lane + 64 * it; const int cb = (gi < 420 ? gi : 0) * 8; mu0[it] = *(const f32x4*)(p.mu_a + cb); mu1[it] = *(const f32x4*)(p.mu_a + cb + 4);
        if (it == 2 || it == 3) { kk0[it - 2] = *(const f32x4*)(p.k_k + cb - C_K); kk1[it - 2] = *(const f32x4*)(p.k_k + cb - C_K + 4); } }
    for (int m0 = gw; m0 < MALL; m0 += 2 * NGW) { const int m1 = m0 + NGW; const bool two = m1 < MALL; const int m1c = two ? m1 : m0;
        int b0, ci0, j0, b1, ci1, j1; mix_geom(m0, b0, ci0, j0); mix_geom(m1c, b1, ci1, j1);
        const bf16* own0; const bf16* np0[4]; float nv0[4]; nbr_rows(S, b0, ci0, j0, own0, np0, nv0);
        const bf16* own1; const bf16* np1[4]; float nv1[4]; nbr_rows(S, b1, ci1, j1, own1, np1, nv1);
        bf16* zr0 = Z + (size_t)m0 * NZM; bf16* zr1 = Z + (size_t)m1c * NZM;
#pragma unroll
        for (int it = 0; it < 7; ++it) { const int gi = lane + 64 * it; const int cb = (gi < 420 ? gi : 0) * 8; MixLd L0, L1; float o0[8], o1[8];
            mix_ld(own0, np0, cb, L0); mix_ld(own1, np1, cb, L1);
            mix_do2(L0, nv0, mu0[it], mu1[it], o0); mix_do2(L1, nv1, mu0[it], mu1[it], o1);
            const f32x4 kw0 = (it == 2 || it == 3) ? kk0[it == 3] : mu0[0], kw1 = (it == 2 || it == 3) ? kk1[it == 3] : mu0[0];
            mix_store(zr0, kw0, kw1, it, gi, cb, o0); if (two) mix_store(zr1, kw0, kw1, it, gi, cb, o1); }
    }
}
#define WK_BAR() do { asm volatile("s_waitcnt lgkmcnt(0)" ::: "memory"); __builtin_amdgcn_s_barrier(); asm volatile("" ::: "memory"); } while (0)
constexpr int WB_NB = NCH * 4;
constexpr int WB_AT = 0, WB_RT = 2304, WB_BC = 4608, WB_KC = 6912, WB_P4 = 9216, WB_GKT = 14336, WB_TT = 14848, WB_P5 = 15360, WB_VT = 16640, WB_PP = 17152, WB_MM = 17408, WB_SLOT = 18432;
constexpr int WB_W2T = 7 * WB_SLOT, WB_A2T = WB_W2T + 9216, WB_CST = WB_A2T + 9216, WB_FLG = WB_CST + 1024;
typedef short s16x4 __attribute__((ext_vector_type(4)));
DI v2u cvt2(float a, float b, float c, float d) { return (v2u){cvtpk_s(a, b), cvtpk_s(c, d)}; }
DI bf16x8 frag2(v2u lo, v2u hi) { return __builtin_bit_cast(bf16x8, (v4u){lo.x, lo.y, hi.x, hi.y}); }
DI float pfx16(float x) { x += dppf<0x111>(x); x += dppf<0x112>(x); x += dppf<0x114>(x); x += dppf<0x118>(x); return x; }
#define WB_LOADS(qq) do { const int sidx_ = (qq) >> 2, ci_ = e ? (sidx_ < 4 ? 3 - sidx_ : NCH + 3 - sidx_) : sidx_, pos_ = ((qq) & 3) * 16 + c, j_ = e ? 63 - pos_ : pos_; \
                    const bf16* zr = Z + (size_t)(chunk_row0(b, ci_) + j_) * NZM; \
                    _Pragma("unroll") for (int hh_ = 0; hh_ < 2; ++hh_) { const int c0 = h * 64 + 16 * g + 8 * hh_;     \
                        const v4u vk_ = *(const v4u*)(zr + Z_KK + c0), vr_ = *(const v4u*)(zr + Z_R + c0), vq_ = *(const v4u*)(zr + Z_K + c0); \
                        Lkk[2 * hh_] = (v2u){vk_.x, vk_.y}; Lkk[2 * hh_ + 1] = (v2u){vk_.z, vk_.w}; Lr[2 * hh_] = (v2u){vr_.x, vr_.y}; Lr[2 * hh_ + 1] = (v2u){vr_.z, vr_.w}; Lk[2 * hh_] = (v2u){vq_.x, vq_.y}; Lk[2 * hh_ + 1] = (v2u){vq_.z, vq_.w}; } \
                    Lv = *(const v2u*)(zr + Z_V + h * 64 + rg * 16 + 4 * g); \
                    tw[0] = *(const v4u*)(zr + Z_TW + g * 8); tw[1] = *(const v4u*)(zr + Z_TW + 32 + g * 8); ad[0] = *(const v4u*)(zr + Z_AD + g * 8); ad[1] = *(const v4u*)(zr + Z_AD + 32 + g * 8); } while (0)
DI void lds_wait_ge(volatile LAS int* f, int v, volatile LAS int* abortf) {
    int sp = 0;
    while (__builtin_amdgcn_readfirstlane(*f) < v) { __builtin_amdgcn_s_sleep(1); if (((++sp) & 63) == 0) { if (__builtin_amdgcn_readfirstlane(*abortf)) break; if (sp > (1 << 18)) { *abortf = 1; break; } } }
    asm volatile("" ::: "memory");
}
DI void wkv_blk_wg(const P& p, LAS unsigned char* lds, int tid, int lane, int wave, int unit) {
    const int xx = unit & 7, yy = unit >> 3, rg = yy & 3, scan = xx * 8 + (yy >> 2), e = scan & 1, h = (scan >> 1) & 15, b = scan >> 5;
    const bf16* Z = (const bf16*)(p.ws + WS_ZM);
    LAS bf16* W2T = (LAS bf16*)(lds + WB_W2T); LAS bf16* A2T = (LAS bf16*)(lds + WB_A2T); LAS float* CST = (LAS float*)(lds + WB_CST);
    __syncthreads();
    volatile LAS int* RDY = (volatile LAS int*)(lds + WB_FLG); volatile LAS int* CNS = RDY + 8; volatile LAS int* ABT = RDY + 16;
    if (tid < 32) RDY[tid] = 0;
    if (tid < 64) { const int ch = 16 * ((tid >> 2) & 3) + 4 * (tid >> 4) + (tid & 3);
        const float ka = p.k_a[h * 64 + ch]; CST[tid] = NL2E * p.w0[e * D + h * 64 + ch]; CST[64 + tid] = NL2E * p.a0[e * D + h * 64 + ch]; CST[128 + tid] = ka; CST[192 + tid] = 1.f - ka; }
    for (int i = tid; i < 4096; i += NTHR) { const int k = i >> 6, n = i & 63, pn = 16 * ((n >> 2) & 3) + 4 * (n >> 4) + (n & 3);     W2T[pn * 72 + k] = (bf16)f2bf(NL2E * p.w2[((size_t)e * 64 + k) * D + h * 64 + n]); A2T[pn * 72 + k] = (bf16)f2bf(NL2E * p.a2[((size_t)e * 64 + k) * D + h * 64 + n]); }
    __syncthreads();
    bf16* YW = (bf16*)(p.ws + (e ? WS_YWB : WS_YWF));
    const int c = lane & 15, g = lane >> 4;
    if (wave == 0) {
        __builtin_amdgcn_s_setprio(2);
        pg8::f32x4 Xt[4];
#pragma unroll
        for (int kt = 0; kt < 4; ++kt) Xt[kt] = (pg8::f32x4){0.f, 0.f, 0.f, 0.f};
        bf16* yp = YW + (size_t)(b * SEQ + (e ? SEQ - 1 - 4 * g : 4 * g)) * D + h * 64 + rg * 16 + c;
        int fnext = 0;
        int slot = 0, nblk = 0;
        v2u vtA, gkA, ttA, vtB, gkB, ttB; bf16x8 a1A[2], a2A[2], a1B[2], a2B[2];
#define SC_READS(S, sl_) do { const LAS bf16* AT_ = (const LAS bf16*)((sl_) + WB_AT); const LAS bf16* RT_ = (const LAS bf16*)((sl_) + WB_RT); \
            vt##S = *(const LAS v2u*)((const LAS bf16*)((sl_) + WB_VT) + c * 16 + 4 * g); gk##S = *(const LAS v2u*)((const LAS bf16*)((sl_) + WB_GKT) + c * 16 + 4 * g); \
            _Pragma("unroll") for (int sx = 0; sx < 2; ++sx) { a1##S[sx] = frag2(*(const LAS v2u*)(AT_ + c * 72 + 32 * sx + 4 * g), *(const LAS v2u*)(AT_ + c * 72 + 32 * sx + 16 + 4 * g)); \
                a2##S[sx] = frag2(*(const LAS v2u*)(RT_ + c * 72 + 32 * sx + 4 * g), *(const LAS v2u*)(RT_ + c * 72 + 32 * sx + 16 + 4 * g)); } \
            tt##S = *(const LAS v2u*)((const LAS bf16*)((sl_) + WB_TT) + c * 16 + 4 * g); } while (0)
#define SC_BODY(S, N, tt_) do { const int t = (tt_); LAS unsigned char* sl = lds + slot * WB_SLOT; \
            v2u xb[4]; \
            _Pragma("unroll") for (int kt = 0; kt < 4; ++kt) xb[kt] = cvt2(Xt[kt][0], Xt[kt][1], Xt[kt][2], Xt[kt][3]); \
            pg8::f32x4 C1 = __builtin_amdgcn_mfma_f32_16x16x16bf16_1k(__builtin_bit_cast(s16x4, gk##S), __builtin_bit_cast(s16x4, vt##S), (pg8::f32x4){0.f, 0.f, 0.f, 0.f}, 0, 0, 0); \
            pg8::f32x4 C2 = {0.f, 0.f, 0.f, 0.f}; \
            _Pragma("unroll") for (int sx = 0; sx < 2; ++sx) { const bf16x8 bx = frag2(xb[2 * sx], xb[2 * sx + 1]); C1 = __builtin_amdgcn_mfma_f32_16x16x32_bf16(a1##S[sx], bx, C1, 0, 0, 0); C2 = __builtin_amdgcn_mfma_f32_16x16x32_bf16(a2##S[sx], bx, C2, 0, 0, 0); } \
            __builtin_amdgcn_sched_barrier(0); \
              \
            bf16x8 p4f[4]; pg8::f32x4 xn[4], ppv[4]; const bf16x8 p5f = *(const LAS bf16x8*)((const LAS bf16*)(sl + WB_P5) + c * 40 + 8 * g); \
            _Pragma("unroll") for (int kt = 0; kt < 4; ++kt) p4f[kt] = *(const LAS bf16x8*)((const LAS bf16*)(sl + WB_P4) + (16 * kt + c) * 40 + 8 * g); \
            _Pragma("unroll") for (int kt = 0; kt < 4; ++kt) ppv[kt] = *(const LAS pg8::f32x4*)((const LAS float*)(sl + WB_PP) + 16 * kt + 4 * g); \
            const float v0_ = bflo(vt##S.x), v1_ = bfhi(vt##S.x), v2_ = bflo(vt##S.y), v3_ = bfhi(vt##S.y); \
            __builtin_amdgcn_sched_barrier(0); \
            const pg8::f32x4 SK = __builtin_amdgcn_mfma_f32_16x16x16bf16_1k(__builtin_bit_cast(s16x4, tt##S), __builtin_bit_cast(s16x4, cvt2(C1[0], C1[1], C1[2], C1[3])), (pg8::f32x4){0.f, 0.f, 0.f, 0.f}, 0, 0, 0); \
            const bf16x8 vs = __builtin_bit_cast(bf16x8, (v4u){cvtpk_s(v0_, SK[0]), cvtpk_s(v1_, SK[1]), cvtpk_s(v2_, SK[2]), cvtpk_s(v3_, SK[3])}); \
            _Pragma("unroll") for (int kt = 0; kt < 4; ++kt) xn[kt] = __builtin_amdgcn_mfma_f32_16x16x32_bf16(p4f[kt], vs, Xt[kt], 0, 0, 0); \
            const pg8::f32x4 Yt = __builtin_amdgcn_mfma_f32_16x16x32_bf16(p5f, vs, C2, 0, 0, 0); \
            asm volatile("s_waitcnt lgkmcnt(0)" ::: "memory"); \
            if (lane == 0) CNS[slot] = nblk + 1; \
            if (++slot == 7) { slot = 0; ++nblk; } \
            if (t + 1 < WB_NB) { \
                if (__builtin_amdgcn_readfirstlane(fnext) < nblk + 1) lds_wait_ge(RDY + slot, nblk + 1, ABT); \
                asm volatile("" ::: "memory"); \
                LAS unsigned char* sln = lds + slot * WB_SLOT; SC_READS(N, sln); fnext = RDY[slot == 6 ? 0 : slot + 1]; } \
            _Pragma("unroll") for (int kt = 0; kt < 4; ++kt) Xt[kt] = ppv[kt] * xn[kt]; \
            if (t >= 16) { \
                if (e) { yp[0] = (bf16)f2bf(Yt[0]); yp[-D] = (bf16)f2bf(Yt[1]); yp[-2 * D] = (bf16)f2bf(Yt[2]); yp[-3 * D] = (bf16)f2bf(Yt[3]); yp -= 16 * D; } \
                else { yp[0] = (bf16)f2bf(Yt[0]); yp[D] = (bf16)f2bf(Yt[1]); yp[2 * D] = (bf16)f2bf(Yt[2]); yp[3 * D] = (bf16)f2bf(Yt[3]); yp += 16 * D; } } } while (0)
        lds_wait_ge(RDY + 0, 1, ABT); SC_READS(A, lds); fnext = RDY[1];
        for (int t2 = 0; t2 < WB_NB; t2 += 2) { SC_BODY(A, B, t2); SC_BODY(B, A, t2 + 1); }
#undef SC_READS
#undef SC_BODY
        __builtin_amdgcn_s_setprio(0);
    } else {
        const int pw = wave - 1; LAS unsigned char* sl = lds + pw * WB_SLOT;
        LAS bf16* AT = (LAS bf16*)(sl + WB_AT); LAS bf16* RT = (LAS bf16*)(sl + WB_RT); LAS bf16* BC = (LAS bf16*)(sl + WB_BC); LAS bf16* KC = (LAS bf16*)(sl + WB_KC);
        LAS bf16* P4 = (LAS bf16*)(sl + WB_P4); LAS bf16* GKT = (LAS bf16*)(sl + WB_GKT); LAS bf16* TT = (LAS bf16*)(sl + WB_TT); LAS bf16* P5 = (LAS bf16*)(sl + WB_P5);
        LAS bf16* VT = (LAS bf16*)(sl + WB_VT); LAS float* PP = (LAS float*)(sl + WB_PP); LAS float* MM = (LAS float*)(sl + WB_MM);
        v2u Lkk[4], Lr[4], Lk[4], Lv; v4u tw[2], ad[2];
        { const int q = pw; WB_LOADS(q); }
        f32x4 w0v[4], a0v[4], kav[4], kbv[4];
#pragma unroll
        for (int nt = 0; nt < 4; ++nt) { w0v[nt] = *(const LAS f32x4*)(CST + 16 * nt + 4 * g); a0v[nt] = *(const LAS f32x4*)(CST + 64 + 16 * nt + 4 * g); kav[nt] = *(const LAS f32x4*)(CST + 128 + 16 * nt + 4 * g); kbv[nt] = *(const LAS f32x4*)(CST + 192 + 16 * nt + 4 * g); }
        f32x4 ltm, lem, gtm;
#pragma unroll
        for (int i = 0; i < 4; ++i) { const int ii = 4 * g + i; ltm[i] = ii < c ? 1.f : 0.f; lem[i] = ii <= c ? 1.f : 0.f; gtm[i] = c < ii ? 1.f : 0.f; }
        int nblk = 0;
        for (int q = pw; q < WB_NB; q += 7, ++nblk) {
            pg8::f32x4 zw[4], za[4];
            f32x4 ewv[4], kmv[4], bvv[4], kkf[4], rf[4];
            f32x4 at_[4], rt_[4], bc_[4], kc_[4], pp_[4];
#define WT_PRE(nt) do { zw[nt] = (pg8::f32x4){0.f, 0.f, 0.f, 0.f}; za[nt] = zw[nt]; \
                _Pragma("unroll") for (int ks = 0; ks < 2; ++ks) { const bf16x8 wa = *(const LAS bf16x8*)(W2T + ((nt) * 16 + c) * 72 + ks * 32 + g * 8), aa = *(const LAS bf16x8*)(A2T + ((nt) * 16 + c) * 72 + ks * 32 + g * 8); \
                    zw[nt] = __builtin_amdgcn_mfma_f32_16x16x32_bf16(wa, __builtin_bit_cast(bf16x8, tw[ks]), zw[nt], 0, 0, 0); za[nt] = __builtin_amdgcn_mfma_f32_16x16x32_bf16(aa, __builtin_bit_cast(bf16x8, ad[ks]), za[nt], 0, 0, 0); } \
                } while (0)
#define WT_AV(nt) do { const f32x4 kkv_ = {bflo(Lkk[nt].x), bfhi(Lkk[nt].x), bflo(Lkk[nt].y), bfhi(Lkk[nt].y)}, rv_ = {bflo(Lr[nt].x), bfhi(Lr[nt].x), bflo(Lr[nt].y), bfhi(Lr[nt].y)}, kv_ = {bflo(Lk[nt].x), bfhi(Lk[nt].x), bflo(Lk[nt].y), bfhi(Lk[nt].y)}; \
                const f32x4 xa_ = (f32x4){za[nt][0], za[nt][1], za[nt][2], za[nt][3]} + a0v[nt], xw_ = (f32x4){zw[nt][0], zw[nt][1], zw[nt][2], zw[nt][3]} + w0v[nt]; \
                const f32x4 da_ = (f32x4){__builtin_amdgcn_exp2f(xa_[0]), __builtin_amdgcn_exp2f(xa_[1]), __builtin_amdgcn_exp2f(xa_[2]), __builtin_amdgcn_exp2f(xa_[3])} + 1.f; \
                const f32x4 dw_ = (f32x4){__builtin_amdgcn_exp2f(xw_[0]), __builtin_amdgcn_exp2f(xw_[1]), __builtin_amdgcn_exp2f(xw_[2]), __builtin_amdgcn_exp2f(xw_[3])} + 1.f; \
                const f32x4 av_ = {frcp(da_[0]), frcp(da_[1]), frcp(da_[2]), frcp(da_[3])}; \
                ewv[nt] = (f32x4){frcp(dw_[0]), frcp(dw_[1]), frcp(dw_[2]), frcp(dw_[3])} * (0.6065306597126334f * NL2E);     \
                kmv[nt] = kv_ * (av_ * kav[nt] + kbv[nt]); bvv[nt] = kkv_ * av_; kkf[nt] = kkv_; rf[nt] = rv_; } while (0)
#define WT_BV(nt) do { const f32x4 inc_ = {pfx16(ewv[nt][0]), pfx16(ewv[nt][1]), pfx16(ewv[nt][2]), pfx16(ewv[nt][3])};     \
                const f32x4 E_ = {__builtin_amdgcn_exp2f(inc_[0]), __builtin_amdgcn_exp2f(inc_[1]), __builtin_amdgcn_exp2f(inc_[2]), __builtin_amdgcn_exp2f(inc_[3])};     \
                const f32x4 nEi_ = {frcp(-E_[0]), frcp(-E_[1]), frcp(-E_[2]), frcp(-E_[3])};     \
                const f32x4 Ep_ = {dppf_one<0x111>(E_[0]), dppf_one<0x111>(E_[1]), dppf_one<0x111>(E_[2]), dppf_one<0x111>(E_[3])};     \
                at_[nt] = kkf[nt] * Ep_; rt_[nt] = rf[nt] * E_; bc_[nt] = bvv[nt] * nEi_; kc_[nt] = -(kmv[nt] * nEi_); pp_[nt] = E_; } while (0)
#define WT_POST(nt) do { const int ko_ = c * 72 + 16 * (nt) + 4 * g; \
                *(LAS v2u*)(AT + ko_) = cvt2(at_[nt][0], at_[nt][1], at_[nt][2], at_[nt][3]); *(LAS v2u*)(RT + ko_) = cvt2(rt_[nt][0], rt_[nt][1], rt_[nt][2], rt_[nt][3]); \
                *(LAS v2u*)(BC + ko_) = cvt2(bc_[nt][0], bc_[nt][1], bc_[nt][2], bc_[nt][3]); *(LAS v2u*)(KC + ko_) = cvt2(kc_[nt][0], kc_[nt][1], kc_[nt][2], kc_[nt][3]); \
                const int so_ = 8 * (c >> 2) + 2 * (c & 3);                  \
                _Pragma("unroll") for (int i_ = 0; i_ < 4; ++i_) *(LAS unsigned*)(P4 + (16 * (nt) + 4 * g + i_) * 40 + so_) = cvtpk_s(kc_[nt][i_], bc_[nt][i_]);     \
                if (c == 15) *(LAS f32x4*)(PP + 16 * (nt) + 4 * g) = pp_[nt]; } while (0)
            WT_PRE(0); WT_AV(0); WT_BV(0); WT_PRE(1);
            lds_wait_ge(CNS + pw, nblk, ABT);
            WT_POST(0);
            VT[(4 * g + 0) * 16 + c] = (bf16)(Lv.x & 0xffffu); VT[(4 * g + 1) * 16 + c] = (bf16)(Lv.x >> 16); VT[(4 * g + 2) * 16 + c] = (bf16)(Lv.y & 0xffffu); VT[(4 * g + 3) * 16 + c] = (bf16)(Lv.y >> 16);
            WT_AV(1); WT_BV(1); WT_POST(1); WT_PRE(2); WT_AV(2); WT_BV(2); WT_POST(2); WT_PRE(3); WT_AV(3);
            if (q + 7 < WB_NB) WB_LOADS(q + 7);
            WT_BV(3); WT_POST(3);
#undef WT_PRE
#undef WT_AV
#undef WT_BV
#undef WT_POST
            {
                    __builtin_amdgcn_s_setprio(1);
                    pg8::f32x4 gb = {0.f, 0.f, 0.f, 0.f}, gk = gb, gbr = gb, gkr = gb, gbt = gb;
#pragma unroll
                    for (int ks = 0; ks < 2; ++ks) { const int o = c * 72 + ks * 32 + g * 8;
                        const bf16x8 fb = *(const LAS bf16x8*)(BC + o), fk = *(const LAS bf16x8*)(KC + o), fa = *(const LAS bf16x8*)(AT + o), fr = *(const LAS bf16x8*)(RT + o);
                        gb = __builtin_amdgcn_mfma_f32_16x16x32_bf16(fb, fa, gb, 0, 0, 0); gk = __builtin_amdgcn_mfma_f32_16x16x32_bf16(fk, fa, gk, 0, 0, 0);
                        gbr = __builtin_amdgcn_mfma_f32_16x16x32_bf16(fb, fr, gbr, 0, 0, 0); gkr = __builtin_amdgcn_mfma_f32_16x16x32_bf16(fk, fr, gkr, 0, 0, 0);
                        gbt = __builtin_amdgcn_mfma_f32_16x16x32_bf16(fa, fb, gbt, 0, 0, 0); }
                    const f32x4 m_ = -((f32x4){gb[0], gb[1], gb[2], gb[3]} * ltm), mt_ = -((f32x4){gbt[0], gbt[1], gbt[2], gbt[3]} * gtm), k_ = (f32x4){gk[0], gk[1], gk[2], gk[3]} * ltm,
                        kr_ = (f32x4){gkr[0], gkr[1], gkr[2], gkr[3]} * lem, br_ = (f32x4){gbr[0], gbr[1], gbr[2], gbr[3]} * lem;
                    *(LAS v2u*)(GKT + c * 16 + 4 * g) = cvt2(k_[0], k_[1], k_[2], k_[3]);
                    *(LAS v4u*)(P5 + c * 40 + 8 * g) = (v4u){cvtpk_s(kr_[0], br_[0]), cvtpk_s(kr_[1], br_[1]), cvtpk_s(kr_[2], br_[2]), cvtpk_s(kr_[3], br_[3])};
                    const v2u zq = {0u, 0u}; const pg8::f32x4 z4 = {0.f, 0.f, 0.f, 0.f};
#define MF_(a, b, acc) __builtin_amdgcn_mfma_f32_16x16x32_bf16(frag2(a, zq), frag2(b, zq), acc, 0, 0, 0)
#define CV_(x) cvt2((x)[0], (x)[1], (x)[2], (x)[3])
                    const v2u aM = cvt2(m_[0], m_[1], m_[2], m_[3]), bM = cvt2(mt_[0], mt_[1], mt_[2], mt_[3]);
                    pg8::f32x4 im;
#pragma unroll
                    for (int i = 0; i < 4; ++i) im[i] = ((4 * g + i) == c ? 1.f : 0.f) - m_[i];
                    const v2u aIM = CV_(im);
                    const pg8::f32x4 M2c = MF_(aM, bM, z4), M2a = MF_(bM, aM, z4);
                    const v2u aM2 = CV_(M2a), bM2 = CV_(M2c);
                    const pg8::f32x4 M4c = MF_(aM2, bM2, z4), M4a = MF_(bM2, aM2, z4);
                    const v2u aM4 = CV_(M4a), bM4 = CV_(M4c);
                    const pg8::f32x4 M8c = MF_(aM4, bM4, z4);
                    const v2u bM8 = CV_(M8c);
                    const pg8::f32x4 T1 = MF_(bM2, aIM, im);
                    const pg8::f32x4 T2 = MF_(bM4, CV_(T1), T1);
                    const pg8::f32x4 T3 = MF_(bM8, CV_(T2), T2);
                    *(LAS v2u*)(TT + c * 16 + 4 * g) = CV_(T3);
                    __builtin_amdgcn_s_setprio(0);
#undef MF_
#undef CV_
            }
            asm volatile("s_waitcnt lgkmcnt(0)" ::: "memory");
            if (lane == 0) RDY[pw] = nblk + 1;
        }
    }
}

constexpr int WO_RS = 0, WO_KS = 17408, WO_VS = 34816, WO_A2T = 52224, WO_G2T = 70656, WO_RHO = 92160;
DI void wkv_out_setup(const P& p, LAS unsigned char* lds, int tid, int h) {
    LAS bf16* A2T = (LAS bf16*)(lds + WO_A2T); LAS bf16* G2T = (LAS bf16*)(lds + WO_G2T);
    __syncthreads();
    for (int i = tid; i < 2 * 4096; i += NTHR) { const int e = i >> 12, k = (i >> 6) & 63, n = i & 63; A2T[e * 4608 + n * 72 + k] = (bf16)f2bf(p.a2[((size_t)e * 64 + k) * D + h * 64 + n]); }
    for (int i = tid; i < 160 * 64; i += NTHR) { const int k = i >> 6, n = i & 63; G2T[n * 168 + k] = (bf16)f2bf(p.g2[(size_t)k * D + h * 64 + n]); }
    __syncthreads();
}
struct WoPre { v4u r, k, v, a0, a1, a2, a3, a4; };
struct WoC { float c0[4], c1[4], ka[4], rk[4], gg[4], gb[4]; };
DI void wkv_out_consts(const P& p, int h, int l15, WoC& C) {
#pragma unroll
    for (int nt = 0; nt < 4; ++nt) { const int hc = h * 64 + nt * 16 + l15; C.c0[nt] = p.a0[hc]; C.c1[nt] = p.a0[D + hc]; C.ka[nt] = p.k_a[hc]; C.rk[nt] = p.r_k[hc]; C.gg[nt] = p.gn_g[hc]; C.gb[nt] = p.gn_b[hc]; }
}
DI void wkv_out_load(const P& p, int tid, int lane, int wave, int b, int gr, int h, WoPre& L) {
    const bf16* Z = (const bf16*)(p.ws + WS_ZM); const int row0 = chunk_row0(b, gr + 4);
    const int rb = wave & 3, half = wave >> 2, l15 = lane & 15, g = lane >> 4;
    const bf16* za_ = Z + (size_t)(row0 + rb * 16 + l15) * NZM;
    const v4u zz4 = {0u, 0u, 0u, 0u};
    if (half == 0) { L.a0 = *(const v4u*)(za_ + Z_AD + g * 8); L.a1 = *(const v4u*)(za_ + Z_AD + 32 + g * 8); L.a2 = zz4; L.a3 = zz4; L.a4 = zz4; }
    else { L.a0 = *(const v4u*)(za_ + Z_GS + g * 8); L.a1 = *(const v4u*)(za_ + Z_GS + 32 + g * 8); L.a2 = *(const v4u*)(za_ + Z_GS + 64 + g * 8); L.a3 = *(const v4u*)(za_ + Z_GS + 96 + g * 8); L.a4 = *(const v4u*)(za_ + Z_GS + 128 + g * 8); }
    { const int j = tid >> 3, cg = tid & 7; const bf16* zr = Z + (size_t)(row0 + j) * NZM + h * 64 + cg * 8;
        L.r = *(const v4u*)(zr + Z_R); L.k = *(const v4u*)(zr + Z_K); L.v = *(const v4u*)(zr + Z_V); }
}
DI void wkv_out_unit(const P& p, LAS unsigned char* lds, int tid, int lane, int wave, int b, int gr, int h, const WoC& C, const WoPre& L, bool has_next, int nb, int ngr, WoPre& N) {
    const int row0 = chunk_row0(b, gr + 4);
    LAS float* RS = (LAS float*)(lds + WO_RS); LAS float* KS = (LAS float*)(lds + WO_KS); LAS float* VS = (LAS float*)(lds + WO_VS);
    LAS bf16* A2T = (LAS bf16*)(lds + WO_A2T); LAS bf16* G2T = (LAS bf16*)(lds + WO_G2T); LAS float* RHO = (LAS float*)(lds + WO_RHO);
    const int rb = wave & 3, half = wave >> 2, l15 = lane & 15, g = lane >> 4;
    { const int j = tid >> 3, cg = tid & 7; const v4u r = L.r, k = L.k, v = L.v;
        *(LAS f32x4*)(RS + j * 68 + cg * 8) = (f32x4){bflo(r.x), bfhi(r.x), bflo(r.y), bfhi(r.y)}; *(LAS f32x4*)(RS + j * 68 + cg * 8 + 4) = (f32x4){bflo(r.z), bfhi(r.z), bflo(r.w), bfhi(r.w)};
        *(LAS f32x4*)(KS + j * 68 + cg * 8) = (f32x4){bflo(k.x), bfhi(k.x), bflo(k.y), bfhi(k.y)}; *(LAS f32x4*)(KS + j * 68 + cg * 8 + 4) = (f32x4){bflo(k.z), bfhi(k.z), bflo(k.w), bfhi(k.w)};
        *(LAS f32x4*)(VS + j * 68 + cg * 8) = (f32x4){bflo(v.x), bfhi(v.x), bflo(v.y), bfhi(v.y)}; *(LAS f32x4*)(VS + j * 68 + cg * 8 + 4) = (f32x4){bflo(v.z), bfhi(v.z), bflo(v.w), bfhi(v.w)}; }
    WK_BAR();
    if (has_next) wkv_out_load(p, tid, lane, wave, nb, ngr, h, N);
    bf16* YF = (bf16*)(p.ws + WS_YWF);
    float yn[4][4]; pg8::f32x4 zg[4];
    if (half == 0) {
        pg8::f32x4 z0[4], z1[4];
#pragma unroll
        for (int nt = 0; nt < 4; ++nt) { z0[nt] = (pg8::f32x4){0.f, 0.f, 0.f, 0.f}; z1[nt] = (pg8::f32x4){0.f, 0.f, 0.f, 0.f}; }
#pragma unroll
        for (int ks = 0; ks < 2; ++ks) { const bf16x8 aa = __builtin_bit_cast(bf16x8, ks == 0 ? L.a0 : L.a1);
#pragma unroll
            for (int nt = 0; nt < 4; ++nt) { const bf16x8 b0 = *(const LAS bf16x8*)(A2T + (nt * 16 + l15) * 72 + ks * 32 + g * 8), b1 = *(const LAS bf16x8*)(A2T + 4608 + (nt * 16 + l15) * 72 + ks * 32 + g * 8);
                z0[nt] = __builtin_amdgcn_mfma_f32_16x16x32_bf16(aa, b0, z0[nt], 0, 0, 0); z1[nt] = __builtin_amdgcn_mfma_f32_16x16x32_bf16(aa, b1, z1[nt], 0, 0, 0); } }
        float rho[4] = {0.f, 0.f, 0.f, 0.f};
#pragma unroll
        for (int nt = 0; nt < 4; ++nt) { const float c0 = C.c0[nt], c1 = C.c1[nt], ka = C.ka[nt], rk = C.rk[nt];
#pragma unroll
            for (int i = 0; i < 4; ++i) { const int o = (rb * 16 + 4 * g + i) * 68 + nt * 16 + l15;
                rho[i] += RS[o] * KS[o] * (2.f + (sigm_fast(z0[nt][i] + c0) + sigm_fast(z1[nt][i] + c1) - 2.f) * ka) * rk; } }
#pragma unroll
        for (int i = 0; i < 4; ++i) { const float r = red16(rho[i]); if (l15 == 0) RHO[rb * 16 + 4 * g + i] = r; }
    } else {
        const bf16* YB = (const bf16*)(p.ws + WS_YWB); unsigned short yfv[4][4], ybv[4][4];
#pragma unroll
        for (int nt = 0; nt < 4; ++nt)
#pragma unroll
            for (int i = 0; i < 4; ++i) { const size_t yo = (size_t)(row0 + rb * 16 + 4 * g + i) * D + h * 64 + nt * 16 + l15; yfv[nt][i] = YF[yo]; ybv[nt][i] = YB[yo]; }
#pragma unroll
        for (int nt = 0; nt < 4; ++nt) zg[nt] = (pg8::f32x4){0.f, 0.f, 0.f, 0.f};
#pragma unroll
        for (int ks = 0; ks < 5; ++ks) { const bf16x8 ag = __builtin_bit_cast(bf16x8, ks == 0 ? L.a0 : (ks == 1 ? L.a1 : (ks == 2 ? L.a2 : (ks == 3 ? L.a3 : L.a4))));
#pragma unroll
            for (int nt = 0; nt < 4; ++nt) { const bf16x8 bg = *(const LAS bf16x8*)(G2T + (nt * 16 + l15) * 168 + ks * 32 + g * 8); zg[nt] = __builtin_amdgcn_mfma_f32_16x16x32_bf16(ag, bg, zg[nt], 0, 0, 0); } }
        float sm[4] = {0.f, 0.f, 0.f, 0.f};
#pragma unroll
        for (int nt = 0; nt < 4; ++nt)
#pragma unroll
            for (int i = 0; i < 4; ++i) { yn[nt][i] = bf2f(yfv[nt][i]) + bf2f(ybv[nt][i]); sm[i] += yn[nt][i]; }
#pragma unroll
        for (int i = 0; i < 4; ++i) { const float mu = red16(sm[i]) * (1.f / 64.f); float q2 = 0.f;
#pragma unroll
            for (int nt = 0; nt < 4; ++nt) { yn[nt][i] -= mu; q2 += yn[nt][i] * yn[nt][i]; }
            const float rs = __builtin_amdgcn_rsqf(red16(q2) * (1.f / 64.f) + GN_EPS);
#pragma unroll
            for (int nt = 0; nt < 4; ++nt) yn[nt][i] *= rs; }
    }
    WK_BAR();
    if (half == 1) {
#pragma unroll
        for (int nt = 0; nt < 4; ++nt) { const int hc = h * 64 + nt * 16 + l15; const float gg = C.gg[nt], gb = C.gb[nt];
#pragma unroll
            for (int i = 0; i < 4; ++i) { const int tok = rb * 16 + 4 * g + i; const float ov = (yn[nt][i] * gg + gb + RHO[tok] * VS[tok * 68 + nt * 16 + l15]) * zg[nt][i];
                YF[(size_t)(row0 + tok) * D + hc] = (bf16)f2bf(ov); } }
    }
    WK_BAR();
}

DI void expert_weights(const P& p, LAS unsigned char* lds, int lane, int wave, int G) {
    LAS float* scr = (LAS float*)(lds + wave * 16384);
    const int gw = blockIdx.x * NWAVES + wave, NGW = G * NWAVES;
    bf16* w13 = (bf16*)(p.ws + WS_W13); bf16* w2t = (bf16*)(p.ws + WS_W2);
    constexpr int I13 = 16 * 16, I2 = 8 * 32;
    for (int it = gw; it < NEXP * (2 * I13 + I2); it += NGW) { const int ex = it / (2 * I13 + I2); int r = it % (2 * I13 + I2);
        if (r < 2 * I13) { const int which = r / I13; r %= I13; const int kb = r / 16, nb = r % 16, n0 = nb * 32;
            if (which) transpose_item(p.e_w3 + (size_t)ex * D * DEXP, DEXP, w13 + (size_t)ex * D * D, D, kb * 64, n0, 256 * (n0 >> 7) + 128 + (n0 & 127), scr, lane);
            else transpose_item(p.e_w1 + (size_t)ex * D * DEXP, DEXP, w13 + (size_t)ex * D * D, D, kb * 64, n0, 256 * (n0 >> 7) + (n0 & 127), scr, lane); }
        else { r -= 2 * I13; const int kb = r / 32, nb = r % 32; transpose_item(p.e_w2 + (size_t)ex * DEXP * D, D, w2t + (size_t)ex * D * DEXP, DEXP, kb * 64, nb * 32, nb * 32, scr, lane); } }
}

constexpr int RT_AX = 0, RT_AXS = 1032, RT_PART = 66048, RT_LOG = 90624, RT_RE = 92928, RT_PRM = 93696  ;
DI void phase_route(const P& p, LAS unsigned char* lds, int tid, int lane, int wave, int G) {
    LAS float* AX = (LAS float*)(lds + RT_AX); LAS float* PART = (LAS float*)(lds + RT_PART); LAS float* LOG = (LAS float*)(lds + RT_LOG); LAS int* RE = (LAS int*)(lds + RT_RE);
    float* T1 = p.out; bf16* H2 = (bf16*)(p.ws + WS_H2); float* ST2 = (float*)(p.ws + WS_ROWW);
    int* TOKE = (int*)(p.ws + WS_TOKE); int* TOKSLOT = (int*)(p.ws + WS_TOKSLOT); float* TOKW = (float*)(p.ws + WS_TOKW); int* S2T = (int*)(p.ws + WS_S2T);
    if (blockIdx.x == 0) for (int i = tid; i < D / 8; i += NTHR) ((GAS v4u*)(H2 + (size_t)MX * D))[i] = (v4u){0u, 0u, 0u, 0u};
    const int l15 = lane & 15, g = lane >> 4;
    f32x4 breg[8][3];
    { const float* rwt = (const float*)(p.ws + WS_RWT);
#pragma unroll
      for (int m = 0; m < 8; ++m)
#pragma unroll
          for (int nt = 0; nt < 3; ++nt) breg[m][nt] = *(const f32x4*)(rwt + (size_t)(nt * 16 + l15) * D + 128 * wave + 16 * m + 4 * g); }
    __syncthreads();
    LAS float* PRM = (LAS float*)(lds + RT_PRM);
    for (int blk = blockIdx.x; blk < MX / 64; blk += G) {
        f32x4 q[2][4];
        { const int bsel = (blk * 64) >> 13;
          __syncthreads();
          for (int n = tid; n < D; n += NTHR) { PRM[n] = p.ln1_g[n]; PRM[D + n] = p.ln1_b[n]; PRM[2 * D + n] = modv(p, bsel, 4 * 1024 + n) + 1.f; PRM[3 * D + n] = modv(p, bsel, 3 * 1024 + n); }
          __syncthreads(); }
#pragma unroll
        for (int rr = 0; rr < 2; ++rr) { const GAS f32x4* tr = (const GAS f32x4*)(T1 + (size_t)(blk * 64 + 2 * wave + rr) * D) + lane;
#pragma unroll
            for (int j = 0; j < 4; ++j) q[rr][j] = tr[64 * j]; }
        for (int it = 0; it < 4; ++it) {
#pragma unroll
            for (int rr = 0; rr < 2; ++rr) { const int rl = 2 * wave + rr, m = blk * 64 + it * 16 + rl; const int bsel = m >> 13;
                GAS f32x4* tr = (GAS f32x4*)(T1 + (size_t)m * D) + lane; float s = 0.f;
#pragma unroll
                for (int j = 0; j < 4; ++j) s += (q[rr][j].x + q[rr][j].y) + (q[rr][j].z + q[rr][j].w);
                const float mean = wave_sum(s) * (1.f / D); float s2 = 0.f;
#pragma unroll
                for (int j = 0; j < 4; ++j) { q[rr][j] = q[rr][j] - mean; s2 += (q[rr][j].x * q[rr][j].x + q[rr][j].y * q[rr][j].y) + (q[rr][j].z * q[rr][j].z + q[rr][j].w * q[rr][j].w); }
                const float rstd = 1.f / sqrtf(wave_sum(s2) * (1.f / D) + LN_EPS);
                if (lane == 0) { ST2[2 * m] = mean; ST2[2 * m + 1] = rstd; }
                GAS v2u* o8 = (GAS v2u*)(H2 + (size_t)m * D) + lane;
#pragma unroll
                for (int j = 0; j < 4; ++j) { const int n = 256 * j + 4 * lane; const f32x4 gg = *(const LAS f32x4*)(PRM + n), bb = *(const LAS f32x4*)(PRM + D + n);
                    const f32x4 x1 = q[rr][j] * rstd * gg + bb; const f32x4 hh = x1 * *(const LAS f32x4*)(PRM + 2 * D + n) + *(const LAS f32x4*)(PRM + 3 * D + n);
                    o8[64 * j] = (v2u){pk2(hh[0], hh[1]), pk2(hh[2], hh[3])};
                    *(LAS f32x4*)(AX + rl * RT_AXS + n) = hh; } }
            if (it < 3) {
#pragma unroll
                for (int rr = 0; rr < 2; ++rr) { const GAS f32x4* tr = (const GAS f32x4*)(T1 + (size_t)(blk * 64 + (it + 1) * 16 + 2 * wave + rr) * D) + lane;
#pragma unroll
                    for (int j = 0; j < 4; ++j) q[rr][j] = tr[64 * j]; } }
            WK_BAR();
            { f32x4 acc[3];
#pragma unroll
              for (int nt = 0; nt < 3; ++nt) acc[nt] = (f32x4){0.f, 0.f, 0.f, 0.f};
#pragma unroll
              for (int m = 0; m < 8; ++m) { const f32x4 a4 = *(const LAS f32x4*)(AX + l15 * RT_AXS + 128 * wave + 16 * m + 4 * g);
#pragma unroll
                  for (int sx = 0; sx < 4; ++sx)
#pragma unroll
                      for (int nt = 0; nt < 3; ++nt) acc[nt] = __builtin_amdgcn_mfma_f32_16x16x4f32(a4[sx], breg[m][nt][sx], acc[nt], 0, 0, 0); }
#pragma unroll
              for (int nt = 0; nt < 3; ++nt)
#pragma unroll
                  for (int i = 0; i < 4; ++i) PART[(wave * 16 + 4 * g + i) * 48 + nt * 16 + l15] = acc[nt][i]; }
            WK_BAR();
            for (int i = tid; i < 16 * 36; i += NTHR) { const int row = i / 36, qq = i % 36; float a = qq < 4 ? p.router_g_b[qq] : p.router_e_b[qq - 4];
#pragma unroll
                for (int w = 0; w < 8; ++w) a += PART[(w * 16 + row) * 48 + qq];
                LOG[row * 36 + qq] = a; }
            WK_BAR();
            if (tid < 16) { const int m = blk * 64 + it * 16 + tid; float lg[36];
#pragma unroll
                for (int i = 0; i < 36; ++i) lg[i] = LOG[tid * 36 + i];
                int gs = 0; float gm = lg[0];
#pragma unroll
                for (int i = 1; i < 4; ++i) if (lg[i] > gm) { gm = lg[i]; gs = i; }
                float den = 0.f;
#pragma unroll
                for (int i = 0; i < 4; ++i) den += __expf(lg[i] - gm);
                const float pg = 1.f / den;
                float ev[8];
#pragma unroll
                for (int i = 0; i < 8; ++i) ev[i] = gs == 0 ? lg[4 + i] : (gs == 1 ? lg[12 + i] : (gs == 2 ? lg[20 + i] : lg[28 + i]));
                int i1 = 0; float v1 = ev[0];
#pragma unroll
                for (int i = 1; i < 8; ++i) if (ev[i] > v1) { v1 = ev[i]; i1 = i; }
                int i2 = -1; float v2 = -3.0e38f;
#pragma unroll
                for (int i = 0; i < 8; ++i) if (i != i1 && ev[i] > v2) { v2 = ev[i]; i2 = i; }
                if (i2 < 0) { i2 = (i1 + 1) & 7; v2 = v1; }
                const float e2 = __expf(v2 - v1); const float w1 = pg / (1.f + e2), w2 = pg * e2 / (1.f + e2);
                RE[(it * 16 + tid) * 2] = gs * 8 + i1; RE[(it * 16 + tid) * 2 + 1] = gs * 8 + i2; TOKW[2 * m] = w1; TOKW[2 * m + 1] = w2; TOKE[2 * m] = gs * 8 + i1; TOKE[2 * m + 1] = gs * 8 + i2; }
            WK_BAR();
        }
        if (wave == 0) {
            const int e0 = RE[lane], e1 = RE[lane + 64]; int r0 = 0, r1 = 0, cex = 0;
#pragma unroll 4
            for (int ex = 0; ex < NEXP; ++ex) { const unsigned long long m0 = __builtin_amdgcn_ballot_w64(e0 == ex), m1 = __builtin_amdgcn_ballot_w64(e1 == ex);
                const int n0 = __builtin_popcountll(m0);
                const int b0 = (int)__builtin_amdgcn_mbcnt_hi((unsigned)(m0 >> 32), __builtin_amdgcn_mbcnt_lo((unsigned)m0, 0u)), b1 = (int)__builtin_amdgcn_mbcnt_hi((unsigned)(m1 >> 32), __builtin_amdgcn_mbcnt_lo((unsigned)m1, 0u));
                if (e0 == ex) r0 = b0; if (e1 == ex) r1 = n0 + b1; if (lane == ex) cex = n0 + __builtin_popcountll(m1); }
            int base = 0; if (lane < NEXP && cex) base = (int)atomicAdd(p.ctl + CW_ECNT + lane, (unsigned)cex);
            const int s0 = __builtin_amdgcn_ds_bpermute(e0 * 4, base) + r0, s1 = __builtin_amdgcn_ds_bpermute(e1 * 4, base) + r1;
            const int i0 = lane, i1 = lane + 64, m0r = blk * 64 + (i0 >> 1), m1r = blk * 64 + (i1 >> 1);
            TOKSLOT[2 * m0r + (i0 & 1)] = s0; S2T[(size_t)e0 * MX + s0] = 2 * m0r + (i0 & 1);
            TOKSLOT[2 * m1r + (i1 & 1)] = s1; S2T[(size_t)e1 * MX + s1] = 2 * m1r + (i1 & 1); }
        __syncthreads();
    }
}
DI void build_tiles(const P& p, LAS int* tile, int tid) {
    if (tid == 0) { int T = 0;
        for (int e = 0; e < NEXP; ++e) { tile[MAXT + e] = T; const int c = (int)__hip_atomic_load(p.ctl + CW_ECNT + e, RLX_AGENT); tile[MAXT + 64 + e] = c; const int nt = (c + 255) >> 8; for (int i = 0; i < nt; ++i) tile[T + i] = e; T += nt; }
        tile[MAXT + 32] = T; tile[MAXT + 40] = T; }
    __syncthreads();
}
DI void phase_final(const P& p, LAS int* tile, int lane, int wave, int G) {
    const int gw = blockIdx.x * NWAVES + wave, NGW = G * NWAVES; const bf16* YB = (const bf16*)(p.ws + WS_XS);
    const int* TOKE = (const int*)(p.ws + WS_TOKE); const int* TOKSLOT = (const int*)(p.ws + WS_TOKSLOT); const float* ST2 = (const float*)(p.ws + WS_ROWW);
    f32x4 g1[4], b1[4], g2[4], b2[4], gt[2][4]; int gv[2] = {-1, -1};
#pragma unroll
    for (int j = 0; j < 4; ++j) { const int n = 256 * j + 4 * lane; g1[j] = *(const f32x4*)(p.ln1_g + n); b1[j] = *(const f32x4*)(p.ln1_b + n); g2[j] = *(const f32x4*)(p.ln2_g + n); b2[j] = *(const f32x4*)(p.ln2_b + n); gt[0][j] = gt[1][j] = (f32x4){0.f, 0.f, 0.f, 0.f}; }
    for (int m0 = gw; m0 < MX; m0 += 2 * NGW) { int mm[2]; mm[0] = m0; mm[1] = (m0 + NGW < MX) ? m0 + NGW : m0;
        f32x4 q[2][4]; float s[2] = {0.f, 0.f};
#pragma unroll
        for (int rr = 0; rr < 2; ++rr) { const int m = mm[rr]; const int bsel = m >> 13; const float mean1 = ST2[2 * m], rstd1 = ST2[2 * m + 1];
            if (bsel != gv[rr]) { gv[rr] = bsel;
#pragma unroll
                for (int j = 0; j < 4; ++j) gt[rr][j] = modv4(p, bsel, 5 * 1024 + 256 * j + 4 * lane); }
            const int r0 = tile[MAXT + TOKE[2 * m]] * 256 + TOKSLOT[2 * m], r1 = tile[MAXT + TOKE[2 * m + 1]] * 256 + TOKSLOT[2 * m + 1];
            const GAS f32x4* xr = (const GAS f32x4*)(p.out + (size_t)m * D) + lane; const GAS v2u* y0 = (const GAS v2u*)(YB + (size_t)r0 * D) + lane; const GAS v2u* y1 = (const GAS v2u*)(YB + (size_t)r1 * D) + lane;
#pragma unroll
            for (int j = 0; j < 4; ++j) { const f32x4 x1 = (xr[64 * j] - mean1) * rstd1 * g1[j] + b1[j]; const v2u a = y0[64 * j], b2v = y1[64 * j];
                const f32x4 mo = (f32x4){bflo(a.x) + bflo(b2v.x), bfhi(a.x) + bfhi(b2v.x), bflo(a.y) + bflo(b2v.y), bfhi(a.y) + bfhi(b2v.y)};
                q[rr][j] = x1 * ALPHA + gt[rr][j] * mo;
                s[rr] += (q[rr][j].x + q[rr][j].y) + (q[rr][j].z + q[rr][j].w); } }
#pragma unroll
        for (int rr = 0; rr < 2; ++rr) { const int m = mm[rr]; GAS f32x4* xr = (GAS f32x4*)(p.out + (size_t)m * D) + lane;
            const float mean = wave_sum(s[rr]) * (1.f / D); float s2 = 0.f;
#pragma unroll
            for (int j = 0; j < 4; ++j) { q[rr][j] = q[rr][j] - mean; s2 += (q[rr][j].x * q[rr][j].x + q[rr][j].y * q[rr][j].y) + (q[rr][j].z * q[rr][j].z + q[rr][j].w * q[rr][j].w); }
            const float rstd = 1.f / sqrtf(wave_sum(s2) * (1.f / D) + LN_EPS);
#pragma unroll
            for (int j = 0; j < 4; ++j) xr[64 * j] = q[rr][j] * rstd * g2[j] + b2[j]; }
    }
}
#define MKP P p; { const float* const* in = args.in; p.x = in[0]; p.c = in[1]; p.ctx = in[2]; p.c_ctx = in[3]; p.w_ada = in[4]; p.b_ada = in[5]; p.w_in = in[6]; p.mu_a = in[7]; p.w0 = in[8]; p.w2 = in[9]; p.a0 = in[10]; p.a2 = in[11]; p.g2 = in[12]; p.k_k = in[13]; p.k_a = in[14]; p.r_k = in[15]; p.gn_g = in[16]; p.gn_b = in[17]; p.conv_w = in[18]; p.conv_b = in[19]; p.lru_wa = in[20]; p.lru_ba = in[21]; p.lru_wx = in[22]; p.lru_bx = in[23]; p.lru_lam = in[24]; p.p_a = in[25]; p.p_b = in[26]; p.w_o = in[27]; p.ln1_g = in[28]; p.ln1_b = in[29]; p.router_g = in[30]; p.router_g_b = in[31]; p.router_e = in[32]; p.router_e_b = in[33]; p.e_w1 = in[34]; p.e_w3 = in[35]; p.e_w2 = in[36]; p.ln2_g = in[37]; p.ln2_b = in[38]; } p.out = args.out; p.ws = args.ws; p.dob = (unsigned char*)args.out; p.ctlf = (float*)(args.ws + WS_CTL); p.ctl = (unsigned*)(args.ws + WS_CTL);
constexpr int NPHASE = 15;
__global__ void __launch_bounds__(NTHR, 2) fwd_kernel(Args args) {
    extern __shared__ __attribute__((aligned(16))) unsigned char lds_raw[];
    LAS unsigned char* lds = (LAS unsigned char*)lds_raw;
    const int tid = threadIdx.x, lane = tid & 63, wave = __builtin_amdgcn_readfirstlane(tid >> 6), G = gridDim.x;
    volatile LAS unsigned* MISC = (volatile LAS unsigned*)(lds + MISC_OFF);
    LAS int* tile = (LAS int*)(lds + TILE_OFF);
    for (int u = tid; u < 256; u += NTHR) ((LAS unsigned*)(lds + MISC_OFF))[u] = 0u;
    __syncthreads();
#if ONE_LAUNCH
    XcdBarrier bar = xcd_barrier_post((unsigned*)(args.ws + WS_CTL) + CW_BAR, MISC + 8);
#define GRID_BAR() xcd_barrier(bar)
#else
#define GRID_BAR() do {} while (0)
#endif
    const int lo = args.ph_lo, hi = args.ph_hi;
#define IN(k) (lo <= (k) && (k) < hi)
#define SEAM(k) do { if (IN(k) && IN((k) + 1)) GRID_BAR(); } while (0)

    if (IN(0)) { MKP; phase0(p, lds, tid, lane, wave, G); } SEAM(0);
    if (IN(1)) { MKP; phase0b(p, lds, tid, lane, wave, G); phase1(p, lane, wave, G); } SEAM(1);
    if (IN(2)) { MKP;
        pg8::Gemm g{(const pg8::bf16_t*)(p.dob + DO_H), (const pg8::bf16_t*)(p.dob + DO_WIN), MALL, NSLAB, D}; pg8::StaticOrder S; S.init(MALL, NSLAB, G, (int)blockIdx.x);
        EpiPlain<0> E{(bf16*)(p.ws + WS_S1), NS1, (bf16*)(p.ws + WS_S2), NS2, NS1 / 256};
        pg8::gemm_phase<EpiPlain<0>, pg8::StaticOrder, true, true>(lds, g, S, E); } SEAM(2);
    if (IN(3)) { MKP; const int hb = blockIdx.x & 15; lru_setup(p, lds, tid, hb); LruC C; lru_consts(p, hb, lane & 15, C);
        for (int u = (blockIdx.x >> 4) * NWAVES + wave; u < BATCH * NHS; u += (G >> 4) * NWAVES) { const int hs = u % NHS, b = u / NHS; lru_unit<1>(p, lds, lane, wave, b, hs, hb, C); } } SEAM(3);
    if (IN(4)) { MKP; lru_carry(p, lds, tid, G); } SEAM(4);
    if (IN(5)) { MKP; const int hb = blockIdx.x & 15; lru_setup(p, lds, tid, hb); LruC C; lru_consts(p, hb, lane & 15, C);
        for (int u = (blockIdx.x >> 4) * NWAVES + wave; u < BATCH * 256; u += (G >> 4) * NWAVES) { const int hs = 8 + (u & 255), b = u >> 8; lru_unit<2>(p, lds, lane, wave, b, hs, hb, C); } } SEAM(5);
    if (IN(6)) { MKP; phase_mix(p, lane, wave, G); } SEAM(6);
    if (IN(7)) { MKP; for (int u = blockIdx.x; u < 256; u += G) wkv_blk_wg(p, lds, tid, lane, wave, u); } SEAM(7);
    if (IN(8)) { MKP; const int h = blockIdx.x & 15; wkv_out_setup(p, lds, tid, h); { WoC WC; wkv_out_consts(p, h, lane & 15, WC); WoPre A, B; const int u0 = blockIdx.x >> 4, du = G >> 4; if (u0 < BATCH * 128) wkv_out_load(p, tid, lane, wave, u0 >> 7, u0 & 127, h, A);
            for (int u = u0; u < BATCH * 128; u += 2 * du) {
                const int u1 = u + du, u2 = u + 2 * du;
                wkv_out_unit(p, lds, tid, lane, wave, u >> 7, u & 127, h, WC, A, u1 < BATCH * 128, u1 >> 7, u1 & 127, B);
                if (u1 < BATCH * 128) wkv_out_unit(p, lds, tid, lane, wave, u1 >> 7, u1 & 127, h, WC, B, u2 < BATCH * 128, u2 >> 7, u2 & 127, A); } } } SEAM(8);
    if (IN(9)) { MKP;
        pg8::Gemm g{(const pg8::bf16_t*)(p.dob + DO_H), (const pg8::bf16_t*)(p.dob + DO_WIN) + (size_t)NSLAB * D, MX, 2048, D}; pg8::StaticOrder S; S.init(MX, 2048, G, (int)blockIdx.x);
        EpiPlain<1> E{(bf16*)(p.ws + WS_GATES), 2048, nullptr, 0, 1 << 20};
        pg8::gemm_phase<EpiPlain<1>, pg8::StaticOrder, true, true>(lds, g, S, E); } SEAM(9);
    if (IN(10)) { MKP;
        pg8::Gemm g{(const pg8::bf16_t*)(p.ws + WS_YWF), (const pg8::bf16_t*)(p.ws + WS_PW), 2 * MX, 2 * D, D}; SchedMix S; S.init(MX, D, G, (int)blockIdx.x);
        EpiMix E{(const bf16*)(p.ws + WS_GATES), (bf16*)(p.ws + WS_MBUF)};
        pg8::gemm_phase<EpiMix, SchedMix, true, true>(lds, g, S, E); } SEAM(10);
    if (IN(11)) { MKP;
        pg8::Gemm g{(const pg8::bf16_t*)(p.ws + WS_MBUF), (const pg8::bf16_t*)(p.ws + WS_PW) + (size_t)2 * D * D, MX, D, D}; pg8::StaticOrder S; S.init(MX, D, G, (int)blockIdx.x);
        EpiT1 E{p.x, (const float*)(p.ws + WS_STATS), p.ctlf + CW_MOD, p.b_ada, p.out};
        pg8::gemm_phase<EpiT1, pg8::StaticOrder, true, true>(lds, g, S, E);
        expert_weights(p, lds, lane, wave, G); } SEAM(11);
    if (IN(12)) { MKP; phase_route(p, lds, tid, lane, wave, G); } SEAM(12);
    if (IN(13)) { MKP;
        build_tiles(p, tile, tid);
        pg8::Gemm g{(const pg8::bf16_t*)(p.ws + WS_H2), (const pg8::bf16_t*)(p.ws + WS_W13), MAXT * 256, NEXP * D, D}; SchedMoE S{tile, G, (int)blockIdx.x, (const int*)(p.ws + WS_S2T)};
        EpiSwiGLU E{(bf16*)(p.ws + WS_HBUF)};
        pg8::gemm_phase<EpiSwiGLU, SchedMoE, true, true, true>(lds, g, S, E); } SEAM(13);
    if (IN(14)) { MKP;
        build_tiles(p, tile, tid);
        pg8::Gemm g{(const pg8::bf16_t*)(p.ws + WS_HBUF), (const pg8::bf16_t*)(p.ws + WS_W2), MAXT * 256, NEXP * D, DEXP}; SchedMoE S{tile, G, (int)blockIdx.x, (const int*)(p.ws + WS_S2T)};
        EpiW2 E{(bf16*)(p.ws + WS_XS), tile, (const int*)(p.ws + WS_S2T), (const float*)(p.ws + WS_TOKW)};
        pg8::gemm_phase<EpiW2, SchedMoE, true, true>(lds, g, S, E); } SEAM(14);
    if (IN(15)) { MKP; build_tiles(p, tile, tid); phase_final(p, tile, lane, wave, G); }
#undef IN
#undef SEAM
}

extern "C" void kernel_launch(void* const* d_in, const int* in_sizes, int n_in, void* d_out, int out_size, void* d_ws, size_t ws_size, hipStream_t stream) {
    static int grid = 0;
    if (grid == 0) {
        if (n_in != 39 || out_size != MX * D || ws_size < WS_END) { fprintf(stderr, "kernel_launch: unexpected shapes (n_in %d out %d ws %zu)\n", n_in, out_size, ws_size); grid = -1; return; }
        int dev = 0, cus = 0, per_cu = 0;
        if (hipGetDevice(&dev) != hipSuccess || hipDeviceGetAttribute(&cus, hipDeviceAttributeMultiprocessorCount, dev) != hipSuccess) { grid = -1; return; }
        if (hipFuncSetAttribute((const void*)fwd_kernel, hipFuncAttributeMaxDynamicSharedMemorySize, LDS_BYTES) != hipSuccess) { fprintf(stderr, "kernel_launch: hipFuncSetAttribute failed\n"); grid = -1; return; }
        if (hipOccupancyMaxActiveBlocksPerMultiprocessor(&per_cu, (const void*)fwd_kernel, NTHR, LDS_BYTES) != hipSuccess || per_cu < 1) fprintf(stderr, "kernel_launch: occupancy query reports %d\n", per_cu);
        (void)hipGetLastError();
        grid = cus;
    }
    if (grid < 0) return;
    if (hipMemsetAsync((char*)d_ws + WS_CTL, 0, CTL_ZERO_BYTES, stream) != hipSuccess) return;
    Args a{};
    for (int i = 0; i < 39; ++i) a.in[i] = (const float*)d_in[i];
    a.out = (float*)d_out; a.ws = (unsigned char*)d_ws;
#if ONE_LAUNCH
    a.ph_lo = 0; a.ph_hi = NPHASE + 1;
    hipLaunchKernelGGL(fwd_kernel, dim3(grid), dim3(NTHR), LDS_BYTES, stream, a);
#else
    for (int ph = 0; ph <= NPHASE; ++ph) { a.ph_lo = ph; a.ph_hi = ph + 1; hipLaunchKernelGGL(fwd_kernel, dim3(grid), dim3(NTHR), LDS_BYTES, stream, a); }
#endif
}
```

```cpp
#include <hip/hip_runtime.h>
#include <cstdio>
#include <cstdint>
namespace pg8 {
#define PG8_LAS __attribute__((address_space(3)))
typedef unsigned short bf16_t;
typedef short bf16x8 __attribute__((ext_vector_type(8)));
typedef float f32x4 __attribute__((ext_vector_type(4)));
typedef unsigned u32x4 __attribute__((ext_vector_type(4)));
constexpr int BM = 256, BK = 64, HALF = 128, HTB = HALF * BK * 2  , STAGE_BYTES = 8 * HTB, NXCD = 8, WGM = 8;

__host__ __device__ __forceinline__ int lds_byte(int r, int c) { const int st = (r >> 4) * 2 + (c >> 5), rr = r & 15, cc = c & 31, ob = rr * 64 + cc * 2; return st * 1024 + (ob ^ (((ob >> 9) & 1) << 5)); }
__host__ __device__ __forceinline__ void stage_rc(int b, int& R, int& C) { const int st = b / 1024, sb = b % 1024, swz = sb ^ (((sb >> 9) & 1) << 5); R = (st >> 1) * 16 + swz / 64; C = (st & 1) * 32 + (swz % 64) / 2; }
__host__ __device__ __forceinline__ int perm32(int rho) { const int n = rho >> 4, i = rho & 15; return 8 * (i >> 2) + 4 * n + (i & 3); }

struct Unit { int pm, pn; };
struct Gemm { const bf16_t* A; const bf16_t* Bt; int M, N, K; };

struct StaticOrder {
    int nM, nN, nwg, G, c;
    __host__ __device__ void init(int M, int N, int G_, int c_) { nM = M / BM; nN = N / BM; nwg = nM * nN; G = G_; c = c_; }
    __host__ __device__ bool next(int i, Unit& u) const {
        const long L = (long)i * G + c; if (L >= nwg) return false;
        int wgid = (int)L; { const int q = nwg / NXCD, r = nwg % NXCD, xcd = wgid % NXCD, off = wgid / NXCD; wgid = (xcd < r ? xcd * (q + 1) : r * (q + 1) + (xcd - r) * q) + off; }
        const int nig = WGM * nN, gid = wgid / nig, fm = gid * WGM, gsz = (nM - fm) < WGM ? (nM - fm) : WGM;
        u.pm = fm + ((wgid % nig) % gsz); u.pn = (wgid % nig) / gsz; return true;
    }
    __device__ __forceinline__ void a_ready(const Unit&) const {}
    __device__ __forceinline__ void done(const Unit&) const {}
};

__device__ __forceinline__ unsigned cvt_pk_bf16(float lo, float hi) { unsigned r; asm volatile("v_cvt_pk_bf16_f32 %0, %1, %2" : "=v"(r) : "v"(lo), "v"(hi)); return r; }
template <class Epi, class Sched, bool ALIGN_EPI = false, bool SP2 = false, bool GATHER = false>
__device__ __forceinline__ void gemm_phase(PG8_LAS unsigned char* lds, const Gemm g, const Sched& S, const Epi& E) {
    static_assert(!GATHER || SP2, "the gathered-A path exists only in the SP2 loop");
    const int tid = threadIdx.x, wid = __builtin_amdgcn_readfirstlane(tid >> 6), lane = tid & 63, wr = wid >> 2, wc = wid & 3, fr = lane & 15, fq = lane >> 4;
    const int K = g.K, nt = K / BK;
    unsigned voffA[2], voffB[2];
#pragma unroll
    for (int i = 0; i < 2; ++i) { int R, C; stage_rc(tid * 16 + i * 8192, R, C); const int Rb = Epi::PERM ? ((R & ~31) + perm32(R & 31)) : R;
        voffA[i] = (unsigned)(R * K + C) * 2u; voffB[i] = (unsigned)(Rb * K + C) * 2u; }
    unsigned vgc[2][2] = {{0u, 0u}, {0u, 0u}}, vgn[2][2] = {{0u, 0u}, {0u, 0u}}; int gR[2] = {0, 0}, gC[2] = {0, 0};
    if constexpr (GATHER) {
#pragma unroll
        for (int i = 0; i < 2; ++i) stage_rc(tid * 16 + i * 8192, gR[i], gC[i]); }
#define PG8_GSET(dst, unit) do { _Pragma("unroll") for (int _h = 0; _h < 2; ++_h) _Pragma("unroll") for (int _i = 0; _i < 2; ++_i) dst[_h][_i] = (unsigned)(S.src_row((unit).pm, _h * 128 + gR[_i]) * K + gC[_i]) * 2u; } while (0)
    const size_t kstep = (size_t)(BK * 2);
    const size_t hstep = (size_t)HALF * K * 2;
    const size_t tstep = 2 * hstep;
    const unsigned ldsw = (unsigned)wid * 1024u;
    const int aoff = lds_byte(wr * 64 + fr, fq * 8), boff = lds_byte(wc * 32 + fr, fq * 8);
#define PG8_SA(b, h) (((b) * 2 + (h)) * HTB)
#define PG8_SB(b, h) ((4 + (b) * 2 + (h)) * HTB)
#define PG8_STAGE(bufoff, gbase, voff) do { _Pragma("unroll") for (int _i = 0; _i < 2; ++_i) \
        __builtin_amdgcn_global_load_lds((const unsigned*)((const char*)(gbase) + (voff)[_i]), (PG8_LAS unsigned*)(lds + (bufoff) + ldsw + _i * 8192), 16, 0, 0); } while (0)
#define PG8_STAGE_A(bufoff, gbase, h, usenext) do { if constexpr (GATHER) { _Pragma("unroll") for (int _i = 0; _i < 2; ++_i) { const unsigned _o = (usenext) ? vgn[h][_i] : vgc[h][_i]; \
        __builtin_amdgcn_global_load_lds((const unsigned*)((const char*)(gbase) + _o), (PG8_LAS unsigned*)(lds + (bufoff) + ldsw + _i * 8192), 16, 0, 0); } } \
        else { PG8_STAGE(bufoff, (gbase) + (h) * hstep, voffA); } } while (0)
#define PG8_LDA(dst, b, h) do { _Pragma("unroll") for (int m = 0; m < 4; ++m) _Pragma("unroll") for (int k = 0; k < 2; ++k) dst[m][k] = *(const PG8_LAS bf16x8*)(lds + PG8_SA(b, h) + aoff + m * 2048 + k * 1024); } while (0)
#define PG8_LDB(dst, b, h) do { _Pragma("unroll") for (int n = 0; n < 2; ++n) _Pragma("unroll") for (int k = 0; k < 2; ++k) dst[n][k] = *(const PG8_LAS bf16x8*)(lds + PG8_SB(b, h) + boff + n * 2048 + k * 1024); } while (0)
#define PG8_MMA(ai, bj, At, Bt) do { __builtin_amdgcn_s_setprio(1); _Pragma("unroll") for (int m = 0; m < 4; ++m) _Pragma("unroll") for (int n = 0; n < 2; ++n) _Pragma("unroll") for (int k = 0; k < 2; ++k) \
        acc[ai][bj][m][n] = __builtin_amdgcn_mfma_f32_16x16x32_bf16(Bt[n][k], At[m][k], acc[ai][bj][m][n], 0, 0, 0); __builtin_amdgcn_s_setprio(0); } while (0)
#define PG8_WAIT_V(n) asm volatile("s_waitcnt vmcnt(" #n ")" ::: "memory")
#define PG8_WAIT_L(n) asm volatile("s_waitcnt lgkmcnt(" #n ")" ::: "memory")
#define PG8_BAR __builtin_amdgcn_s_barrier()
#define PG8_SCHED __builtin_amdgcn_sched_barrier(0)
    Unit cur, nxt; int ui = 0;
    if (!S.next(0, cur)) return;
    f32x4 acc[2][2][4][2];
#pragma unroll
    for (int a = 0; a < 2; ++a)
#pragma unroll
        for (int b = 0; b < 2; ++b)
#pragma unroll
            for (int m = 0; m < 4; ++m)
#pragma unroll
                for (int n = 0; n < 2; ++n) acc[a][b][m][n] = (f32x4){0.f, 0.f, 0.f, 0.f};
    bf16x8 At[4][2], B0[2][2], B1[2][2];
    const char* cA = GATHER ? (const char*)g.A : (const char*)g.A + (size_t)cur.pm * tstep; const char* cB = (const char*)g.Bt + (size_t)cur.pn * tstep;
    if constexpr (GATHER) PG8_GSET(vgc, cur);
    S.a_ready(cur);
    if constexpr (SP2) {
        PG8_STAGE(PG8_SB(0, 0), cB, voffB); PG8_STAGE(PG8_SB(0, 1), cB + hstep, voffB); PG8_STAGE_A(PG8_SA(0, 0), cA, 0, false); PG8_STAGE_A(PG8_SA(0, 1), cA, 1, false);
        if (wr == 1) PG8_BAR;
        PG8_WAIT_V(2); PG8_BAR;
        PG8_STAGE(PG8_SB(1, 0), cB + kstep, voffB); PG8_STAGE_A(PG8_SA(1, 0), cA + kstep, 0, false); PG8_STAGE(PG8_SB(1, 1), cB + hstep + kstep, voffB);
        PG8_WAIT_V(6); PG8_BAR;
    } else {
        PG8_STAGE(PG8_SB(0, 0), cB, voffB); PG8_STAGE(PG8_SA(0, 0), cA, voffA); PG8_STAGE(PG8_SB(0, 1), cB + hstep, voffB); PG8_STAGE(PG8_SA(0, 1), cA + hstep, voffA);
        if (wr == 1) PG8_BAR;
        PG8_WAIT_V(4); PG8_BAR;
        PG8_STAGE(PG8_SB(1, 0), cB + kstep, voffB); PG8_STAGE(PG8_SA(1, 0), cA + kstep, voffA); PG8_STAGE(PG8_SB(1, 1), cB + hstep + kstep, voffB);
        PG8_WAIT_V(6); PG8_BAR;
    }
    for (;;) {
        const bool has_next = S.next(ui + 1, nxt);
        const char* nA = GATHER ? cA : (has_next ? (const char*)g.A + (size_t)nxt.pm * tstep : cA); const char* nB = has_next ? (const char*)g.Bt + (size_t)nxt.pn * tstep : cB;
        if constexpr (GATHER) { if (has_next) PG8_GSET(vgn, nxt); }
        for (int t = 0; t < nt; t += 2) {
            const bool last = (t == nt - 2);
            const char* a1 = cA + (size_t)(t + 1) * kstep;
            const char* a2 = last ? nA : cA + (size_t)(t + 2) * kstep; const char* b2 = last ? nB : cB + (size_t)(t + 2) * kstep;
            const char* a3 = a2 + kstep; const char* b3 = b2 + kstep;
            if (last && has_next) S.a_ready(nxt);
            const bool unx = last && has_next;
            if constexpr (SP2) {
            PG8_LDB(B0, 0, 0); PG8_LDB(B1, 0, 1); PG8_SCHED; PG8_LDA(At, 0, 0); PG8_STAGE_A(PG8_SA(1, 1), a1, 1, false);
            PG8_WAIT_V(8); PG8_WAIT_L(0); PG8_BAR; PG8_MMA(0, 0, At, B0); PG8_MMA(0, 1, At, B1); PG8_BAR; PG8_SCHED;
            PG8_LDA(At, 0, 1); PG8_STAGE(PG8_SB(0, 0), b2, voffB); PG8_STAGE(PG8_SB(0, 1), b2 + hstep, voffB); PG8_STAGE_A(PG8_SA(0, 0), a2, 0, unx);
            PG8_WAIT_V(8); PG8_WAIT_L(0); PG8_BAR; PG8_MMA(1, 0, At, B0); PG8_MMA(1, 1, At, B1); PG8_BAR; PG8_SCHED;
            PG8_LDB(B0, 1, 0); PG8_LDB(B1, 1, 1); PG8_SCHED; PG8_LDA(At, 1, 0); PG8_STAGE_A(PG8_SA(0, 1), a2, 1, unx);
            PG8_WAIT_V(8); PG8_WAIT_L(0); PG8_BAR; PG8_MMA(0, 0, At, B0); PG8_MMA(0, 1, At, B1); PG8_BAR; PG8_SCHED;
            PG8_LDA(At, 1, 1); PG8_STAGE(PG8_SB(1, 0), b3, voffB); PG8_STAGE(PG8_SB(1, 1), b3 + hstep, voffB); PG8_STAGE_A(PG8_SA(1, 0), a3, 0, unx);
            PG8_WAIT_V(8); PG8_WAIT_L(0); PG8_BAR; PG8_MMA(1, 0, At, B0); PG8_MMA(1, 1, At, B1); PG8_BAR; PG8_SCHED;
            } else {
            PG8_LDB(B0, 0, 0); PG8_SCHED; PG8_LDA(At, 0, 0); PG8_STAGE(PG8_SA(1, 1), a1 + hstep, voffA);
            PG8_WAIT_L(8); PG8_BAR; PG8_WAIT_L(0); PG8_MMA(0, 0, At, B0); PG8_BAR; PG8_SCHED;
            PG8_LDB(B1, 0, 1); PG8_STAGE(PG8_SB(0, 0), b2, voffB);
            PG8_BAR; PG8_WAIT_L(0); PG8_MMA(0, 1, At, B1); PG8_BAR;
            PG8_LDA(At, 0, 1); PG8_STAGE(PG8_SA(0, 0), a2, voffA);
            PG8_BAR; PG8_WAIT_L(0); PG8_MMA(1, 0, At, B0); PG8_BAR; PG8_SCHED;
            PG8_STAGE(PG8_SB(0, 1), b2 + hstep, voffB);
            PG8_WAIT_V(6); PG8_BAR; PG8_MMA(1, 1, At, B1); PG8_BAR;
            PG8_LDB(B0, 1, 0); PG8_SCHED; PG8_LDA(At, 1, 0); PG8_STAGE(PG8_SA(0, 1), a2 + hstep, voffA);
            PG8_WAIT_L(8); PG8_BAR; PG8_WAIT_L(0); PG8_MMA(0, 0, At, B0); PG8_BAR; PG8_SCHED;
            PG8_LDB(B1, 1, 1); PG8_STAGE(PG8_SB(1, 0), b3, voffB);
            PG8_BAR; PG8_WAIT_L(0); PG8_MMA(0, 1, At, B1); PG8_BAR;
            PG8_LDA(At, 1, 1); PG8_STAGE(PG8_SA(1, 0), a3, voffA);
            PG8_BAR; PG8_WAIT_L(0); PG8_MMA(1, 0, At, B0); PG8_BAR; PG8_SCHED;
            PG8_STAGE(PG8_SB(1, 1), b3 + hstep, voffB);
            PG8_WAIT_V(6); PG8_BAR; PG8_MMA(1, 1, At, B1); PG8_BAR;
            }
        }
        if constexpr (ALIGN_EPI) { if (wr == 0) PG8_BAR; }
        if constexpr (!Epi::AFTER_DRAIN) { E(acc, cur, wr, wc, fr, fq); S.done(cur); }
        if (!has_next) break;
#pragma unroll
        for (int a = 0; a < 2; ++a)
#pragma unroll
            for (int b = 0; b < 2; ++b)
#pragma unroll
                for (int m = 0; m < 4; ++m)
#pragma unroll
                    for (int n = 0; n < 2; ++n) acc[a][b][m][n] = (f32x4){0.f, 0.f, 0.f, 0.f};
        cur = nxt; cA = nA; cB = nB; ++ui;
        if constexpr (GATHER) { _Pragma("unroll") for (int _h = 0; _h < 2; ++_h) _Pragma("unroll") for (int _i = 0; _i < 2; ++_i) vgc[_h][_i] = vgn[_h][_i]; }
        if constexpr (ALIGN_EPI) { if (wr == 1) PG8_BAR; }
    }
    PG8_WAIT_V(0);
    if constexpr (!ALIGN_EPI) { if (wr == 0) PG8_BAR; }
    PG8_BAR;
    if constexpr (Epi::AFTER_DRAIN) { E.fused(acc, cur, wr, wc, fr, fq, lds, wid, lane); S.done(cur); }
#undef PG8_SA
#undef PG8_STAGE_A
#undef PG8_GSET
#undef PG8_SB
#undef PG8_STAGE
#undef PG8_LDA
#undef PG8_LDB
#undef PG8_MMA
#undef PG8_WAIT_V
#undef PG8_WAIT_L
#undef PG8_BAR
#undef PG8_SCHED
}
}

#ifndef ONE_LAUNCH
#define ONE_LAUNCH 1
#endif
constexpr int NWAVES = 8, NTHR = 512;
constexpr int D = 1024, BATCH = 2, SEQ = 8192, CTXL = 256, GRIDW = 64;
constexpr int MX = BATCH * SEQ, MC = BATCH * CTXL, MALL = MX + MC;
constexpr int NCH = 132;
constexpr int NSLAB = 5632, NS1 = 3584, NS2 = 2048;
constexpr int NZM = 4416;
constexpr int Z_R = 0, Z_K = 1024, Z_V = 2048, Z_KK = 3072, Z_TW = 4096, Z_AD = 4160, Z_GS = 4224;
constexpr int C_R = 0, C_K = 1024, C_V = 2048, C_WD = 3072, C_AD = 3136, C_GD = 3200, C_XB = 0, C_GBR = 1024;
constexpr int NWIN = 7680;
constexpr int NEXP = 32, DEXP = 512, MAXT = 160;
constexpr float LN_EPS = 1e-5f, GN_EPS = 64e-5f;
constexpr float ALPHA = 1.189207115002721f;
constexpr size_t MiB = 1u << 20;
constexpr size_t WS_CTL = 0, CTL_ZERO_BYTES = 1 * MiB;
constexpr size_t WS_STATS = 1 * MiB, WS_TOKE = 1 * MiB + 256 * 1024, WS_TOKSLOT = 1 * MiB + 512 * 1024, WS_TOKW = 1 * MiB + 768 * 1024, WS_ROWW = 2 * MiB;
constexpr size_t WS_RWT = 2 * MiB + 512 * 1024;
constexpr size_t WS_S2T = 3 * MiB, WS_AGGA = 5 * MiB, WS_AGGH = 9 * MiB + 256 * 1024, WS_CIN = 13 * MiB + 512 * 1024;
constexpr size_t WS_PW = 18 * MiB;
constexpr size_t WS_S1 = 24 * MiB;
constexpr size_t WS_S2 = 139 * MiB + 512 * 1024;
constexpr size_t WS_ZM = 139 * MiB + 512 * 1024;
constexpr size_t WS_FB = 206 * MiB;
constexpr size_t WS_YLRU = 282 * MiB, WS_YWF = 24 * MiB, WS_YWB = 56 * MiB;
constexpr size_t WS_GATES = 140 * MiB;
constexpr size_t WS_MBUF = 204 * MiB;
constexpr size_t WS_W13 = 24 * MiB, WS_W2 = 88 * MiB;
constexpr size_t WS_H2 = 120 * MiB;
constexpr size_t WS_XS = 153 * MiB;
constexpr size_t WS_HBUF = 236 * MiB;
constexpr size_t WS_END = 314 * MiB;
static_assert(WS_S1 + (size_t)MALL * NS1 * 2 <= WS_S2 && WS_S2 + (size_t)MALL * NS2 * 2 <= WS_YLRU && WS_ZM + (size_t)MALL * NZM * 2 <= WS_YLRU && WS_YLRU + (size_t)MX * D * 2 <= WS_END, "ws map");
static_assert((WS_YLRU - WS_YWF) % (512 * 1024) == 0 && WS_H2 + (size_t)(MX + 1) * D * 2 <= WS_XS && WS_XS + (size_t)MAXT * 256 * D * 2 <= WS_HBUF && WS_HBUF + (size_t)MAXT * 256 * DEXP * 2 <= WS_END, "ws map 2");
constexpr size_t DO_H = 0, DO_WIN = 34 * MiB;
constexpr int CW_TMO = 0, CW_BAR = 4096, CW_MOD = 8192  , CW_ECNT = 32768  ;
constexpr int LDS_BYTES = 155648;
constexpr int MISC_OFF = LDS_BYTES - 1024;
constexpr int TILE_OFF = MISC_OFF - 2048;

#define GAS __attribute__((address_space(1)))
#define LAS __attribute__((address_space(3)))
typedef unsigned short bf16;
typedef unsigned v4u __attribute__((ext_vector_type(4)));
typedef unsigned v2u __attribute__((ext_vector_type(2)));
typedef float f32x4 __attribute__((ext_vector_type(4)));
typedef GAS unsigned gu32;
typedef short bf16x8 __attribute__((ext_vector_type(8)));
#define RLX_AGENT __ATOMIC_RELAXED, __HIP_MEMORY_SCOPE_AGENT
#define LDS_WAIT() asm volatile("s_waitcnt lgkmcnt(0)" ::: "memory")
#define VM_WAIT() asm volatile("s_waitcnt vmcnt(0)" ::: "memory")
#define DI __device__ __forceinline__
typedef __bf16 bf16x2_t __attribute__((ext_vector_type(2)));
typedef float f32x2 __attribute__((ext_vector_type(2)));
DI unsigned cvtpk_s(float lo, float hi) { const f32x2 v = {lo, hi}; const bf16x2_t b = __builtin_convertvector(v, bf16x2_t); return __builtin_bit_cast(unsigned, b); }
DI unsigned pk2(float lo, float hi) { return cvtpk_s(lo, hi); }
DI unsigned f2bf(float f) { return cvtpk_s(f, 0.f) & 0xffffu; }
DI float bf2f(unsigned short b) { return __builtin_bit_cast(float, ((unsigned)b) << 16); }
DI float bflo(unsigned w) { return __builtin_bit_cast(float, w << 16); }
DI float bfhi(unsigned w) { return __builtin_bit_cast(float, w & 0xffff0000u); }
constexpr float NL2E = -1.4426950408889634f;
DI float frcp(float x) { return __builtin_amdgcn_rcpf(x); }
DI float sigm(float x) { return 1.f / (1.f + __expf(-x)); }
DI float sigm_fast(float x) { return frcp(1.f + __expf(-x)); }
template <int CTRL> DI float dppf(float x) { return __builtin_bit_cast(float, __builtin_amdgcn_update_dpp(0, __builtin_bit_cast(int, x), CTRL, 0xF, 0xF, true)); }
template <int CTRL> DI float dppf_one(float x) { return __builtin_bit_cast(float, __builtin_amdgcn_update_dpp(0x3f800000, __builtin_bit_cast(int, x), CTRL, 0xF, 0xF, false)); }
DI float red4(float x) { x += dppf<0xB1>(x); x += dppf<0x4E>(x); return x; }
DI float red16(float x) { x += dppf<0xB1>(x); x += dppf<0x4E>(x); x += dppf<0x141>(x); x += dppf<0x140>(x); return x; }
DI float rdl(float v, int l) { return __builtin_bit_cast(float, __builtin_amdgcn_readlane(__builtin_bit_cast(int, v), l)); }
DI float wave_sum(float v) { v = red16(v); return (rdl(v, 0) + rdl(v, 16)) + (rdl(v, 32) + rdl(v, 48)); }

#define XB_TMO      128
#define XB_XCNT(j)  (256  + 64 * (j))
#define XB_XSUB(j)  (1280 + 64 * (j))
#define XB_XGEN(j)  (2304 + 64 * (j))
#define XB_TOP      3328
#define XB_TOPGEN   3392
#define XCD_BAR_WORDS 3456
#define XB_SPIN_CAP (1u << 18)

__device__ __forceinline__ unsigned xb_ld(unsigned* p)              { return __hip_atomic_load(p, __ATOMIC_RELAXED, __HIP_MEMORY_SCOPE_AGENT); }
__device__ __forceinline__ unsigned xb_add(unsigned* p, unsigned v) { return __hip_atomic_fetch_add(p, v, __ATOMIC_RELAXED, __HIP_MEMORY_SCOPE_AGENT); }
__device__ __forceinline__ unsigned xb_xcc_id() { return (unsigned)__builtin_amdgcn_s_getreg((3 << 11) | 20) & 0xFu; }
#define XB_SPIN(cond, bar) do { unsigned _sp = 0; while (cond) { __builtin_amdgcn_s_sleep(1); \
    if ((++_sp & 255u) == 0u) { if (xb_ld(&(bar)[XB_TMO])) break; if (_sp > XB_SPIN_CAP) { atomicAdd(&(bar)[XB_TMO], 1u); break; } } } } while (0)

struct XcdBarrier {
    unsigned* bar; unsigned x;
    volatile LAS unsigned* st;
};

__device__ __forceinline__ XcdBarrier xcd_barrier_post(unsigned* bar, volatile LAS unsigned* st) {
    XcdBarrier b; b.bar = bar; b.x = xb_xcc_id(); b.st = st;
    if (threadIdx.x == 0) (void)xb_add(&bar[XB_XCNT(b.x)], 1u);
    return b;
}
__device__ __forceinline__ void xcd_barrier_complete(unsigned* bar, unsigned x, unsigned& nloc, unsigned& nx) {
    const unsigned G = gridDim.x * gridDim.y * gridDim.z;
    unsigned sum, cnt, mine, sp = 0u;
    for (;;) {
        sum = 0u; cnt = 0u; mine = 0u;
#pragma unroll
        for (unsigned j = 0; j < 16; ++j) { const unsigned c = xb_ld(&bar[XB_XCNT(j)]); sum += c; cnt += (c > 0u) ? 1u : 0u; mine = (j == x) ? c : mine; }
        if (sum == G) break;
        __builtin_amdgcn_s_sleep(1);
        if ((++sp & 255u) == 0u) { if (xb_ld(&bar[XB_TMO])) break; if (sp > XB_SPIN_CAP) { atomicAdd(&bar[XB_TMO], 1u); break; } }
    }
    nloc = mine > 0u ? mine : 1u; nx = cnt > 0u ? cnt : 1u;
}

__device__ __forceinline__ void xcd_barrier(const XcdBarrier& b) {
    asm volatile("s_waitcnt vmcnt(0)" ::: "memory");
    __syncthreads();
    if (threadIdx.x == 0) {
        unsigned* bar = b.bar;
        __builtin_amdgcn_s_waitcnt(0);
        unsigned nloc = b.st[0], nx = b.st[1];
        if (nloc == 0u) { xcd_barrier_complete(bar, b.x, nloc, nx); b.st[0] = nloc; b.st[1] = nx; }
        const unsigned old = xb_add(&bar[XB_XSUB(b.x)], 1u);
        const unsigned gen = old / nloc;
        if (old + 1u == (gen + 1u) * nloc) {
            __builtin_amdgcn_fence(__ATOMIC_RELEASE, "agent");
            asm volatile("s_waitcnt vmcnt(0)" ::: "memory");
            const unsigned og = xb_add(&bar[XB_TOP], 1u);
            const unsigned tg = og / nx;
            if (og + 1u == (tg + 1u) * nx) xb_add(&bar[XB_TOPGEN], 1u);
            else XB_SPIN(xb_ld(&bar[XB_TOPGEN]) == tg, bar);
            __builtin_amdgcn_fence(__ATOMIC_ACQUIRE, "agent");
            xb_add(&bar[XB_XGEN(b.x)], 1u);
            asm volatile("s_waitcnt vmcnt(0)" ::: "memory");
        } else {
            XB_SPIN(xb_ld(&bar[XB_XGEN(b.x)]) == gen, bar);
            __builtin_amdgcn_fence(__ATOMIC_ACQUIRE, "agent");
            asm volatile("s_waitcnt vmcnt(0)" ::: "memory");
        }
    }
    __syncthreads();
}

struct Args { const float* in[39]; float* out; unsigned char* ws; int ph_lo, ph_hi; };

struct P {
    const float *x, *c, *ctx, *c_ctx, *w_ada, *b_ada, *w_in, *mu_a, *w0, *w2, *a0, *a2, *g2, *k_k, *k_a, *r_k, *gn_g, *gn_b, *conv_w, *conv_b,
        *lru_wa, *lru_ba, *lru_wx, *lru_bx, *lru_lam, *p_a, *p_b, *w_o, *ln1_g, *ln1_b, *router_g, *router_g_b, *router_e, *router_e_b, *e_w1, *e_w3, *e_w2, *ln2_g, *ln2_b;
    float* out; unsigned char* ws; unsigned char* dob;
    float* ctlf; unsigned* ctl;
};

DI float modv(const P& p, int v, int n) { return p.ctlf[CW_MOD + v * 6144 + n] + p.b_ada[n]; }
DI f32x4 modv4(const P& p, int v, int n) { return *(const f32x4*)(p.ctlf + CW_MOD + v * 6144 + n) + *(const f32x4*)(p.b_ada + n); }

DI void transpose_item(const float* W, int ldw, bf16* WT, int ldt, int k0, int n0, int drow0, LAS float* scr, int lane) {
#pragma unroll 8
    for (int i = 0; i < 32; ++i) { const int kk = 2 * i + (lane >> 5); scr[kk * 33 + (lane & 31)] = W[(size_t)(k0 + kk) * ldw + n0 + (lane & 31)]; }
    LDS_WAIT(); asm volatile("" ::: "memory");
    const int c = lane & 7;
#pragma unroll
    for (int j = 0; j < 4; ++j) { const int n = (lane >> 3) + 8 * j; const LAS float* s = scr + (8 * c) * 33 + n;
        v4u o; o.x = pk2(s[0 * 33], s[1 * 33]); o.y = pk2(s[2 * 33], s[3 * 33]); o.z = pk2(s[4 * 33], s[5 * 33]); o.w = pk2(s[6 * 33], s[7 * 33]);
        *(GAS v4u*)(WT + (size_t)(drow0 + n) * ldt + k0 + 8 * c) = o; }
    LDS_WAIT(); asm volatile("" ::: "memory");
}

DI void phase0(const P& p, LAS unsigned char* lds, int tid, int lane, int wave, int G) {
    LAS float* s3 = (LAS float*)lds;
    for (int item = blockIdx.x; item < 256; item += G) {
        const int kc = item >> 4, nc = item & 15;
        if (tid < 192) { const int v = tid >> 6, k = tid & 63; const float cv = (v < 2) ? p.c[v * D + kc * 64 + k] : p.c_ctx[kc * 64 + k]; s3[v * 64 + k] = cv * sigm(cv); }
        __syncthreads();
        if (tid < 384) { const int n = nc * 384 + tid; float a0 = 0.f, a1 = 0.f, a2 = 0.f;
            for (int k = 0; k < 64; ++k) { const float w = p.w_ada[(size_t)(kc * 64 + k) * 6144 + n]; a0 += s3[k] * w; a1 += s3[64 + k] * w; a2 += s3[128 + k] * w; }
            atomicAdd(p.ctlf + CW_MOD + n, a0); atomicAdd(p.ctlf + CW_MOD + 6144 + n, a1); atomicAdd(p.ctlf + CW_MOD + 2 * 6144 + n, a2); }
        __syncthreads();
    }
}
DI void phase0b(const P& p, LAS unsigned char* lds, int tid, int lane, int wave, int G) {
    LAS float* scr = (LAS float*)(lds + 4096 + wave * 16384);
    const int gw = blockIdx.x * NWAVES + wave, NGW = G * NWAVES;
    bf16* win_t = (bf16*)(p.dob + DO_WIN); bf16* pw = (bf16*)(p.ws + WS_PW);
    constexpr int I_IN = 16 * 233, I_P = 16 * 32;
    for (int it = gw; it < I_IN + 3 * I_P; it += NGW) {
        int r = it;
        if (r < I_IN) { const int kb = r / 233, nb = r % 233, n0 = nb * 32; transpose_item(p.w_in, 7456, win_t, D, kb * 64, n0, n0 + (n0 >= 3360 ? 224 : 0), scr, lane); continue; }
        r -= I_IN; const int wsel = r / I_P; r %= I_P; const int kb = r / 32, nb = r % 32;
        if (wsel == 0) transpose_item(p.p_a, D, pw, D, kb * 64, nb * 32, nb * 32, scr, lane);
        else if (wsel == 1) transpose_item(p.p_b, D, pw + (size_t)D * D, D, kb * 64, nb * 32, nb * 32, scr, lane);
        else transpose_item(p.w_o, D, pw + (size_t)2 * D * D, D, kb * 64, nb * 32, nb * 32, scr, lane);
    }
    { float* rwt = (float*)(p.ws + WS_RWT);
      for (int i = blockIdx.x * NTHR + tid; i < 48 * D; i += G * NTHR) { const int n = i >> 10, k = i & (D - 1); rwt[i] = n < 4 ? p.router_g[k * 4 + n] : (n < 36 ? p.router_e[k * 32 + (n - 4)] : 0.f); } }
    for (int i = blockIdx.x * NTHR + tid; i < 224 * D / 8; i += G * NTHR) ((GAS v4u*)(win_t + (size_t)3360 * D))[i] = (v4u){0u, 0u, 0u, 0u};
}

DI void phase1(const P& p, int lane, int wave, int G) {
    const int gw = blockIdx.x * NWAVES + wave, NGW = G * NWAVES;
    bf16* H = (bf16*)(p.dob + DO_H); float* stats = (float*)(p.ws + WS_STATS);
    f32x4 sc[2][4], sh[2][4]; int cv[2] = {-1, -1};
#pragma unroll
    for (int j = 0; j < 4; ++j) { sc[0][j] = sc[1][j] = sh[0][j] = sh[1][j] = (f32x4){0.f, 0.f, 0.f, 0.f}; }
    for (int m0 = gw; m0 < MALL; m0 += 2 * NGW) {
        f32x4 q[2][4]; float s[2] = {0.f, 0.f}; int mm[2]; mm[0] = m0; mm[1] = (m0 + NGW < MALL) ? m0 + NGW : m0;
#pragma unroll
        for (int rr = 0; rr < 2; ++rr) { const int m = mm[rr]; const float* xrow = (m < MX) ? p.x + (size_t)m * D : p.ctx + (size_t)(m - MX) * D; const GAS f32x4* xr = (const GAS f32x4*)xrow + lane;
#pragma unroll
            for (int j = 0; j < 4; ++j) { q[rr][j] = xr[64 * j]; s[rr] += (q[rr][j].x + q[rr][j].y) + (q[rr][j].z + q[rr][j].w); } }
#pragma unroll
        for (int rr = 0; rr < 2; ++rr) { const int m = mm[rr]; const int v = (m < MX) ? (m >> 13) : 2;
            if (v != cv[rr]) { cv[rr] = v;
#pragma unroll
                for (int j = 0; j < 4; ++j) { const int n = 256 * j + 4 * lane; sc[rr][j] = modv4(p, v, 1024 + n) + 1.f; sh[rr][j] = modv4(p, v, n); } }
            const float mean = wave_sum(s[rr]) * (1.f / D); float s2 = 0.f;
#pragma unroll
            for (int j = 0; j < 4; ++j) { q[rr][j] = q[rr][j] - mean; s2 += (q[rr][j].x * q[rr][j].x + q[rr][j].y * q[rr][j].y) + (q[rr][j].z * q[rr][j].z + q[rr][j].w * q[rr][j].w); }
            const float rstd = 1.f / sqrtf(wave_sum(s2) * (1.f / D) + LN_EPS);
            if (rr == 0 || mm[1] != mm[0]) {
                if (lane == 0) { stats[2 * m] = mean; stats[2 * m + 1] = rstd; }
                GAS v2u* o8 = (GAS v2u*)(H + (size_t)m * D) + lane;
#pragma unroll
                for (int j = 0; j < 4; ++j) { const f32x4 h = q[rr][j] * rstd * sc[rr][j] + sh[rr][j];
                    o8[64 * j] = (v2u){pk2(h[0], h[1]), pk2(h[2], h[3])}; } } }
    }
}

template <int ACT> struct EpiPlain {
    static constexpr bool PERM = true, AFTER_DRAIN = false;
    bf16* O; int ldc; bf16* O2; int ldc2; int split_tile;
    DI void operator()(const pg8::f32x4 (&acc)[2][2][4][2], const pg8::Unit& u, int wr, int wc, int fr, int fq) const {
        const bool second = u.pn >= split_tile; bf16* Ob = second ? O2 : O; const int ld = second ? ldc2 : ldc, pn = second ? u.pn - split_tile : u.pn;
        const int row0 = u.pm * 256 + wr * 64 + fr, col0 = pn * 256 + wc * 32 + 8 * fq;
#pragma unroll
        for (int ai = 0; ai < 2; ++ai)
#pragma unroll
            for (int m = 0; m < 4; ++m) { bf16* rowp = Ob + (size_t)(row0 + ai * 128 + m * 16) * ld + col0;
#pragma unroll
                for (int bj = 0; bj < 2; ++bj) { pg8::f32x4 v0 = acc[ai][bj][m][0], v1 = acc[ai][bj][m][1];
                    if (ACT == 1) {
#pragma unroll
                        for (int i = 0; i < 4; ++i) { v0[i] = sigm_fast(v0[i]); v1[i] = sigm_fast(v1[i]); } }
                    pg8::u32x4 w;
                    if (ACT == 1) { w.x = cvtpk_s(v0[0], v0[1]); w.y = cvtpk_s(v0[2], v0[3]); w.z = cvtpk_s(v1[0], v1[1]); w.w = cvtpk_s(v1[2], v1[3]); }
                    else { w.x = pg8::cvt_pk_bf16(v0[0], v0[1]); w.y = pg8::cvt_pk_bf16(v0[2], v0[3]); w.z = pg8::cvt_pk_bf16(v1[0], v1[1]); w.w = pg8::cvt_pk_bf16(v1[2], v1[3]); }
                    *(pg8::u32x4*)(rowp + bj * 128) = w; } }
    }
};
constexpr int LRU_TOFF = (int)((WS_YLRU - WS_YWF) / (512 * 1024));
struct EpiMix {
    static constexpr bool PERM = true, AFTER_DRAIN = false;
    const bf16* gates; bf16* mbuf;
    DI void operator()(const pg8::f32x4 (&acc)[2][2][4][2], const pg8::Unit& u, int wr, int wc, int fr, int fq) const {
        const bool isa = u.pm < 64; const int row0 = (isa ? u.pm : u.pm - LRU_TOFF) * 256 + wr * 64 + fr, col0 = (u.pn & 3) * 256 + wc * 32 + 8 * fq;
#pragma unroll
        for (int ai = 0; ai < 2; ++ai) {
            pg8::u32x4 gwv[4][2], oldv[4][2];
#pragma unroll
            for (int m = 0; m < 4; ++m)
#pragma unroll
                for (int bj = 0; bj < 2; ++bj) { const int row = row0 + ai * 128 + m * 16, col = col0 + bj * 128;
                    gwv[m][bj] = *(const pg8::u32x4*)(gates + (size_t)row * 2048 + (isa ? 0 : 1024) + col);
                    oldv[m][bj] = (pg8::u32x4){0u, 0u, 0u, 0u}; if (isa) oldv[m][bj] = *(const pg8::u32x4*)(mbuf + (size_t)row * D + col); }
#pragma unroll
            for (int m = 0; m < 4; ++m) { const int row = row0 + ai * 128 + m * 16;
#pragma unroll
                for (int bj = 0; bj < 2; ++bj) { const int col = col0 + bj * 128;
                    const pg8::u32x4 gw = gwv[m][bj];
                    bf16* mp = mbuf + (size_t)row * D + col;
                    const pg8::u32x4 old = oldv[m][bj];
                    const pg8::f32x4 v0 = acc[ai][bj][m][0], v1 = acc[ai][bj][m][1];
                    float r[8];
                    r[0] = v0[0] * bflo(gw.x) + bflo(old.x); r[1] = v0[1] * bfhi(gw.x) + bfhi(old.x); r[2] = v0[2] * bflo(gw.y) + bflo(old.y); r[3] = v0[3] * bfhi(gw.y) + bfhi(old.y);
                    r[4] = v1[0] * bflo(gw.z) + bflo(old.z); r[5] = v1[1] * bfhi(gw.z) + bfhi(old.z); r[6] = v1[2] * bflo(gw.w) + bflo(old.w); r[7] = v1[3] * bfhi(gw.w) + bfhi(old.w);
                    pg8::u32x4 w; w.x = pg8::cvt_pk_bf16(r[0], r[1]); w.y = pg8::cvt_pk_bf16(r[2], r[3]); w.z = pg8::cvt_pk_bf16(r[4], r[5]); w.w = pg8::cvt_pk_bf16(r[6], r[7]);
                    *(pg8::u32x4*)mp = w; } } }
    }
};
struct EpiT1 {
    static constexpr bool PERM = false, AFTER_DRAIN = false;
    const float* x; const float* stats; const float* modp; const float* b_ada; float* T1;
    DI void operator()(const pg8::f32x4 (&acc)[2][2][4][2], const pg8::Unit& u, int wr, int wc, int fr, int fq) const {
        const int row0 = u.pm * 256 + wr * 64 + fr, col0 = u.pn * 256 + wc * 32 + 4 * fq; const int b = (u.pm * 256) >> 13;
        pg8::f32x4 gt[2][2];
#pragma unroll
        for (int bj = 0; bj < 2; ++bj)
#pragma unroll
            for (int n = 0; n < 2; ++n) { const int c = col0 + bj * 128 + n * 16; gt[bj][n] = *(const pg8::f32x4*)(modp + b * 6144 + 2048 + c) + *(const pg8::f32x4*)(b_ada + 2048 + c); }
#pragma unroll
        for (int ai = 0; ai < 2; ++ai)
#pragma unroll
            for (int mh = 0; mh < 2; ++mh) {
                float mean[2], rs[2]; pg8::f32x4 xv[2][2][2];
#pragma unroll
                for (int mm = 0; mm < 2; ++mm) { const int row = row0 + ai * 128 + (2 * mh + mm) * 16; mean[mm] = stats[2 * row]; rs[mm] = stats[2 * row + 1] * ALPHA;
#pragma unroll
                    for (int bj = 0; bj < 2; ++bj)
#pragma unroll
                        for (int n = 0; n < 2; ++n) xv[mm][bj][n] = *(const pg8::f32x4*)(x + (size_t)row * D + col0 + bj * 128 + n * 16); }
#pragma unroll
                for (int mm = 0; mm < 2; ++mm) { const int m = 2 * mh + mm; const int row = row0 + ai * 128 + m * 16;
#pragma unroll
                    for (int bj = 0; bj < 2; ++bj)
#pragma unroll
                        for (int n = 0; n < 2; ++n) *(pg8::f32x4*)(T1 + (size_t)row * D + col0 + bj * 128 + n * 16) = (xv[mm][bj][n] - mean[mm]) * rs[mm] + gt[bj][n] * acc[ai][bj][m][n]; } }
    }
};
struct EpiSwiGLU {
    static constexpr bool PERM = true, AFTER_DRAIN = false;
    bf16* hb;
    DI void operator()(const pg8::f32x4 (&acc)[2][2][4][2], const pg8::Unit& u, int wr, int wc, int fr, int fq) const {
        const int row0 = u.pm * 256 + wr * 64 + fr, col0 = (u.pn & 3) * 128 + wc * 32 + 8 * fq;
#pragma unroll
        for (int ai = 0; ai < 2; ++ai)
#pragma unroll
            for (int m = 0; m < 4; ++m) { float r[8];
#pragma unroll
                for (int n = 0; n < 2; ++n)
#pragma unroll
                    for (int i = 0; i < 4; ++i) { const float a = acc[ai][0][m][n][i], b = acc[ai][1][m][n][i]; r[4 * n + i] = a * sigm_fast(a) * b; }
                pg8::u32x4 w; w.x = pg8::cvt_pk_bf16(r[0], r[1]); w.y = pg8::cvt_pk_bf16(r[2], r[3]); w.z = pg8::cvt_pk_bf16(r[4], r[5]); w.w = pg8::cvt_pk_bf16(r[6], r[7]);
                *(pg8::u32x4*)(hb + (size_t)(row0 + ai * 128 + m * 16) * DEXP + col0) = w; }
    }
};
struct EpiW2 {
    static constexpr bool PERM = true, AFTER_DRAIN = false;
    bf16* yb; const LAS int* tile; const int* s2t; const float* tokw;
    DI void operator()(const pg8::f32x4 (&acc)[2][2][4][2], const pg8::Unit& u, int wr, int wc, int fr, int fq) const {
        const int row0 = u.pm * 256 + wr * 64 + fr, col0 = (u.pn & 3) * 256 + wc * 32 + 8 * fq;
        const int ex = tile[u.pm], slot0 = (u.pm - tile[MAXT + ex]) * 256 + wr * 64 + fr, cnt = tile[MAXT + 64 + ex];
        int si[2][4]; float rwv[2][4];
#pragma unroll
        for (int ai = 0; ai < 2; ++ai)
#pragma unroll
            for (int m = 0; m < 4; ++m) { const int slot = slot0 + ai * 128 + m * 16; si[ai][m] = slot < cnt ? s2t[(size_t)ex * MX + slot] : -1; }
#pragma unroll
        for (int ai = 0; ai < 2; ++ai)
#pragma unroll
            for (int m = 0; m < 4; ++m) rwv[ai][m] = si[ai][m] >= 0 ? tokw[si[ai][m]] : 0.f;
#pragma unroll
        for (int ai = 0; ai < 2; ++ai)
#pragma unroll
            for (int m = 0; m < 4; ++m) { const int row = row0 + ai * 128 + m * 16; const float rw = rwv[ai][m];
#pragma unroll
                for (int bj = 0; bj < 2; ++bj) { const pg8::f32x4 v0 = acc[ai][bj][m][0] * rw, v1 = acc[ai][bj][m][1] * rw;
                    pg8::u32x4 w; w.x = pg8::cvt_pk_bf16(v0[0], v0[1]); w.y = pg8::cvt_pk_bf16(v0[2], v0[3]); w.z = pg8::cvt_pk_bf16(v1[0], v1[1]); w.w = pg8::cvt_pk_bf16(v1[2], v1[3]);
                    *(pg8::u32x4*)(yb + (size_t)row * D + col0 + bj * 128) = w; } }
    }
};
struct SchedMix : pg8::StaticOrder {
    __device__ bool next(int i, pg8::Unit& u) const { pg8::Unit t; if (!pg8::StaticOrder::next(i >> 1, t)) return false; const int w = i & 1; u.pm = w ? t.pm : t.pm + LRU_TOFF; u.pn = w ? t.pn : t.pn + 4; return true; }
};
struct SchedMoE {
    const LAS int* tile; int G, c; const int* s2t;
    DI int src_row(int T, int r) const { const int e = tile[T], slot = (T - tile[MAXT + e]) * 256 + r; return slot < tile[MAXT + 64 + e] ? (s2t[(size_t)e * MX + slot] >> 1) : MX; }
    __device__ bool next(int i, pg8::Unit& u) const { int L = i * G + c; const int U = tile[MAXT + 40] * 4; if (L >= U) return false;
        { const int q = U / pg8::NXCD, r = U % pg8::NXCD, xcd = L % pg8::NXCD, off = L / pg8::NXCD; L = (xcd < r ? xcd * (q + 1) : r * (q + 1) + (xcd - r) * q) + off; }
        const int T = L >> 2; u.pm = T; u.pn = tile[T] * 4 + (L & 3); return true; }
    DI void a_ready(const pg8::Unit&) const {}
    DI void done(const pg8::Unit&) const {}
};

DI int chunk_row0(int b, int ci) { return ci < 4 ? MX + b * CTXL + ci * 64 : b * SEQ + (ci - 4) * 64; }
DI float gelu_tanh(float x) { const float u = 0.7978845608028654f * (x + 0.044715f * x * x * x); const float t = 1.f - 2.f * frcp(1.f + __expf(2.f * u)); return 0.5f * x * (1.f + t); }
constexpr int NHS = 264;
constexpr int LR_WT = 0, LR_CW = 36864, LR_WV = 38400, LR_WVS = 6656;
DI void lru_setup(const P& p, LAS unsigned char* lds, int tid, int hb) {
    LAS bf16* WT = (LAS bf16*)(lds + LR_WT); LAS float* CW = (LAS float*)(lds + LR_CW);
    __syncthreads();
    for (int i = tid; i < 4 * 4096; i += NTHR) { const int m = i >> 12, k = (i >> 6) & 63, n = i & 63; const int e = m & 1;
        const float w = (m < 2 ? p.lru_wa : p.lru_wx)[((size_t)(e * 16 + hb) * 64 + k) * 64 + n]; WT[m * 4608 + n * 72 + k] = (bf16)f2bf(NL2E * w); }
    for (int i = tid; i < 6 * 64; i += NTHR) { const int r = i >> 6, c = i & 63; CW[i] = r < 5 ? p.conv_w[r * D + hb * 64 + c] : p.conv_b[hb * 64 + c]; }
    __syncthreads();
}
struct LruC { float ba[2][4], bx[2][4], sp8[2][4]; };
DI void lru_consts(const P& p, int hb, int l15, LruC& C) {
#pragma unroll
    for (int e = 0; e < 2; ++e)
#pragma unroll
        for (int nt = 0; nt < 4; ++nt) { const int c = hb * 64 + nt * 16 + l15; C.ba[e][nt] = NL2E * p.lru_ba[e * D + c]; C.bx[e][nt] = NL2E * p.lru_bx[e * D + c]; C.sp8[e][nt] = (8.f * NL2E) * log1pf(__expf(-p.lru_lam[e * D + c])); }
}
DI void hs_geom(int b, int hs, int& row0, int& tb, int& tlen) { if (hs < 8) { tb = hs * 32; row0 = MX + b * CTXL + tb; tlen = CTXL; } else { tb = (hs - 8) * 32; row0 = b * SEQ + tb; tlen = SEQ; } }
DI void lru_conv(const bf16* S, LAS unsigned char* lds, LAS unsigned char* wv, int lane, int hb, int rowb, int tb, int tlen) {
    LAS float* CW = (LAS float*)(lds + LR_CW); LAS bf16* XCB = (LAS bf16*)wv; LAS float* XC = (LAS float*)(wv + 2304);
    const int tau = lane >> 2, qd = lane & 3; const bf16* sp = S + (size_t)(rowb + tau) * NS2 + C_XB + hb * 64 + qd * 16;
    float a[16];
#pragma unroll
    for (int i4 = 0; i4 < 4; ++i4) { const f32x4 bv = *(const LAS f32x4*)(CW + 5 * 64 + qd * 16 + 4 * i4); a[4 * i4] = bv[0]; a[4 * i4 + 1] = bv[1]; a[4 * i4 + 2] = bv[2]; a[4 * i4 + 3] = bv[3]; }
    v4u w[5][2];
#pragma unroll
    for (int i = 0; i < 5; ++i) { const int t = tb + tau + i - 2; const bool ok = t >= 0 && t < tlen;
        w[i][0] = ok ? *(const v4u*)(sp + (ptrdiff_t)(i - 2) * NS2) : (v4u){0u, 0u, 0u, 0u}; w[i][1] = ok ? *(const v4u*)(sp + (ptrdiff_t)(i - 2) * NS2 + 8) : (v4u){0u, 0u, 0u, 0u}; }
#pragma unroll
    for (int i = 0; i < 5; ++i)
#pragma unroll
        for (int hh = 0; hh < 2; ++hh) { const f32x4 c0 = *(const LAS f32x4*)(CW + i * 64 + qd * 16 + hh * 8), c1 = *(const LAS f32x4*)(CW + i * 64 + qd * 16 + hh * 8 + 4); const v4u x = w[i][hh];
            a[hh * 8 + 0] += c0[0] * bflo(x.x); a[hh * 8 + 1] += c0[1] * bfhi(x.x); a[hh * 8 + 2] += c0[2] * bflo(x.y); a[hh * 8 + 3] += c0[3] * bfhi(x.y);
            a[hh * 8 + 4] += c1[0] * bflo(x.z); a[hh * 8 + 5] += c1[1] * bfhi(x.z); a[hh * 8 + 6] += c1[2] * bflo(x.w); a[hh * 8 + 7] += c1[3] * bfhi(x.w); }
#pragma unroll
    for (int i4 = 0; i4 < 4; ++i4) *(LAS f32x4*)(XC + tau * 68 + qd * 16 + 4 * i4) = (f32x4){a[4 * i4], a[4 * i4 + 1], a[4 * i4 + 2], a[4 * i4 + 3]};
    *(LAS v4u*)(XCB + tau * 72 + qd * 16) = (v4u){pk2(a[0], a[1]), pk2(a[2], a[3]), pk2(a[4], a[5]), pk2(a[6], a[7])};
    *(LAS v4u*)(XCB + tau * 72 + qd * 16 + 8) = (v4u){pk2(a[8], a[9]), pk2(a[10], a[11]), pk2(a[12], a[13]), pk2(a[14], a[15])};
}
DI void lru_gates(LAS unsigned char* lds, LAS unsigned char* wv, int lane, int e, const LruC& C, float (&av)[4][4], float (&uv)[4][4]) {
    LAS bf16* WT = (LAS bf16*)(lds + LR_WT); LAS bf16* XCB = (LAS bf16*)wv; LAS float* XC = (LAS float*)(wv + 2304);
    const int l15 = lane & 15, g = lane >> 4;
    pg8::f32x4 zr[4], zi[4];
#pragma unroll
    for (int nt = 0; nt < 4; ++nt) { zr[nt] = (pg8::f32x4){0.f, 0.f, 0.f, 0.f}; zi[nt] = (pg8::f32x4){0.f, 0.f, 0.f, 0.f}; }
#pragma unroll
    for (int ks = 0; ks < 2; ++ks) { const bf16x8 ax = *(const LAS bf16x8*)(XCB + l15 * 72 + ks * 32 + g * 8);
#pragma unroll
        for (int nt = 0; nt < 4; ++nt) { const bf16x8 br = *(const LAS bf16x8*)(WT + e * 4608 + (nt * 16 + l15) * 72 + ks * 32 + g * 8), bi = *(const LAS bf16x8*)(WT + (2 + e) * 4608 + (nt * 16 + l15) * 72 + ks * 32 + g * 8);
            zr[nt] = __builtin_amdgcn_mfma_f32_16x16x32_bf16(ax, br, zr[nt], 0, 0, 0); zi[nt] = __builtin_amdgcn_mfma_f32_16x16x32_bf16(ax, bi, zi[nt], 0, 0, 0); } }
#pragma unroll
    for (int nt = 0; nt < 4; ++nt)
#pragma unroll
        for (int i = 0; i < 4; ++i) { const float rg = frcp(1.f + __builtin_amdgcn_exp2f(zr[nt][i] + C.ba[e][nt])), ig = frcp(1.f + __builtin_amdgcn_exp2f(zi[nt][i] + C.bx[e][nt]));
            const float a = __builtin_amdgcn_exp2f(rg * C.sp8[e][nt]);
            const float em = fmaxf(__builtin_fmaf(-a, a, 1.f), 0.f);
            av[nt][i] = a; uv[nt][i] = __builtin_amdgcn_sqrtf(em) * ig * XC[(4 * g + i) * 68 + nt * 16 + l15]; }
}
DI float bperm(int srclane, float v) { return __builtin_bit_cast(float, __builtin_amdgcn_ds_bpermute(srclane * 4, __builtin_bit_cast(int, v))); }
template <int DIR> DI void lru_local(const float (&a)[4], const float (&u)[4], int l15, float (&hl)[4], float (&pl)[4], float (&PG)[4], float (&HG)[4]) {
    float h = 0.f, pr = 1.f;
#pragma unroll
    for (int q = 0; q < 4; ++q) { const int i = DIR ? 3 - q : q; h = a[i] * h + u[i]; pr *= a[i]; hl[i] = h; pl[i] = pr; }
#pragma unroll
    for (int gg = 0; gg < 4; ++gg) { PG[gg] = bperm(gg * 16 + l15, pr); HG[gg] = bperm(gg * 16 + l15, h); }
}
template <int PASS> DI void lru_unit(const P& p, LAS unsigned char* lds, int lane, int wave, int b, int hs, int hb, const LruC& C) {
    const bf16* S = (const bf16*)(p.ws + WS_S2); LAS unsigned char* wv = lds + LR_WV + wave * LR_WVS;
    const int l15 = lane & 15, g = lane >> 4; int row0, tb, tlen; hs_geom(b, hs, row0, tb, tlen);
    const size_t ao0 = ((size_t)(b * NHS + hs) * 2) * D + hb * 64 + l15;
    float av[4][4], uv[4][4], hl[4], pl[4], PG[4], HG[4];
    unsigned* FB = (unsigned*)(p.ws + WS_FB);
    if (PASS == 1) {
        float Af[4], Hf[4], Ab[4], Hb[4];
#pragma unroll
        for (int nt = 0; nt < 4; ++nt) { Af[nt] = 1.f; Hf[nt] = 0.f; Ab[nt] = 1.f; Hb[nt] = 0.f; }
#pragma unroll 1
        for (int band = 0; band < 2; ++band) { lru_conv(S, lds, wv, lane, hb, row0 + band * 16, tb + band * 16, tlen);
            lru_gates(lds, wv, lane, 0, C, av, uv);
#pragma unroll
            for (int nt = 0; nt < 4; ++nt) { lru_local<0>(av[nt], uv[nt], l15, hl, pl, PG, HG); float cc = Hf[nt], Pc = Af[nt], cm = cc, Pm = Pc;
#pragma unroll
                for (int gg = 0; gg < 4; ++gg) { if (gg == g) { cm = cc; Pm = Pc; } cc = PG[gg] * cc + HG[gg]; Pc *= PG[gg]; }
                Hf[nt] = cc; Af[nt] = Pc;
#pragma unroll
                for (int i = 0; i < 4; ++i) FB[(size_t)(row0 + band * 16 + 4 * g + i) * D + hb * 64 + nt * 16 + l15] = pk2(hl[i] + pl[i] * cm, pl[i] * Pm); }
            lru_gates(lds, wv, lane, 1, C, av, uv);
#pragma unroll
            for (int nt = 0; nt < 4; ++nt) { lru_local<1>(av[nt], uv[nt], l15, hl, pl, PG, HG); float A = PG[3], H = HG[3];
#pragma unroll
                for (int gg = 2; gg >= 0; --gg) { H = PG[gg] * H + HG[gg]; A *= PG[gg]; }
                Hb[nt] = Ab[nt] * H + Hb[nt]; Ab[nt] *= A; } }
        if (g == 0) { float* GA = (float*)(p.ws + WS_AGGA); float* GH = (float*)(p.ws + WS_AGGH);
#pragma unroll
            for (int nt = 0; nt < 4; ++nt) { GA[ao0 + nt * 16] = Af[nt]; GH[ao0 + nt * 16] = Hf[nt]; GA[ao0 + D + nt * 16] = Ab[nt]; GH[ao0 + D + nt * 16] = Hb[nt]; } }
    } else {
        const float* CI = (const float*)(p.ws + WS_CIN); bf16* Y = (bf16*)(p.ws + WS_YLRU);
        float Cf[4], Cb[4];
#pragma unroll
        for (int nt = 0; nt < 4; ++nt) { Cf[nt] = CI[ao0 + nt * 16]; Cb[nt] = CI[ao0 + D + nt * 16]; }
#pragma unroll 1
        for (int bq = 0; bq < 2; ++bq) { const int band = 1 - bq; lru_conv(S, lds, wv, lane, hb, row0 + band * 16, tb + band * 16, tlen);
            lru_gates(lds, wv, lane, 1, C, av, uv);
#pragma unroll
            for (int nt = 0; nt < 4; ++nt) { lru_local<1>(av[nt], uv[nt], l15, hl, pl, PG, HG); float c = Cb[nt], cm = c;
#pragma unroll
                for (int gg = 3; gg >= 0; --gg) { if (gg == g) cm = c; c = PG[gg] * c + HG[gg]; }
                Cb[nt] = c;
#pragma unroll
                for (int i = 0; i < 4; ++i) { const size_t yo = (size_t)(row0 + band * 16 + 4 * g + i) * D + hb * 64 + nt * 16 + l15;
                    const float gt = bf2f(S[(size_t)(row0 + band * 16 + 4 * g + i) * NS2 + C_GBR + hb * 64 + nt * 16 + l15]);
                    const unsigned fb = FB[yo];
                    Y[yo] = (bf16)f2bf((bflo(fb) + bfhi(fb) * Cf[nt] + hl[i] + pl[i] * cm) * gelu_tanh(gt)); } } }
    }
}
DI void lru_carry(const P& p, LAS unsigned char* lds, int tid, int G) {
    const float* A = (const float*)(p.ws + WS_AGGA); const float* H = (const float*)(p.ws + WS_AGGH); float* CI = (float*)(p.ws + WS_CIN);
    LAS float* XA = (LAS float*)lds; LAS float* XH = XA + 512;
    for (int wgi = blockIdx.x; wgi < 64; wgi += G) { const int seg = tid >> 6, chain = wgi * 64 + (tid & 63), c = chain & (D - 1), e = (chain >> 10) & 1, b = chain >> 11;
        float a[33], h[33]; float As = 1.f, Hs = 0.f;
#pragma unroll
        for (int k = 0; k < 33; ++k) { const int st = seg * 33 + k, hs = e ? (st < 8 ? 7 - st : 271 - st) : st; const size_t o = ((size_t)(b * NHS + hs) * 2 + e) * D + c; a[k] = A[o]; h[k] = H[o]; }
#pragma unroll
        for (int k = 0; k < 33; ++k) { Hs = a[k] * Hs + h[k]; As *= a[k]; }
        __syncthreads(); XA[tid] = As; XH[tid] = Hs; __syncthreads();
        float cy = 0.f;
        for (int sg = 0; sg < seg; ++sg) cy = XA[sg * 64 + (tid & 63)] * cy + XH[sg * 64 + (tid & 63)];
#pragma unroll
        for (int k = 0; k < 33; ++k) { const int st = seg * 33 + k, hs = e ? (st < 8 ? 7 - st : 271 - st) : st; CI[((size_t)(b * NHS + hs) * 2 + e) * D + c] = cy; cy = a[k] * cy + h[k]; } }
}

DI float tanh_fast(float x) { return 1.f - 2.f * frcp(1.f + __expf(2.f * x)); }
struct MixLd { v4u w; v4u n[4]; };
DI void mix_ld(const bf16* own, const bf16* const (&np)[4], int cb, MixLd& L) {
    L.w = *(const v4u*)(own + cb);
#pragma unroll
    for (int i = 0; i < 4; ++i) L.n[i] = *(const v4u*)(np[i] + cb);
}
DI void mix_do(const MixLd& L, const float (&nv)[4], const float* mu, int cb, float (&o)[8]) {
    const v4u w = L.w;
    const f32x4 m0 = *(const f32x4*)(mu + cb), m1 = *(const f32x4*)(mu + cb + 4);
    const float ow[8] = {bflo(w.x), bfhi(w.x), bflo(w.y), bfhi(w.y), bflo(w.z), bfhi(w.z), bflo(w.w), bfhi(w.w)};
    const float nb[8] = {bflo(L.n[0].x) * nv[0], bfhi(L.n[1].x) * nv[1], bflo(L.n[2].y) * nv[2], bfhi(L.n[3].y) * nv[3], bflo(L.n[0].z) * nv[0], bfhi(L.n[1].z) * nv[1], bflo(L.n[2].w) * nv[2], bfhi(L.n[3].w) * nv[3]};
#pragma unroll
    for (int i = 0; i < 4; ++i) { o[i] = ow[i] + m0[i] * (nb[i] - ow[i]); o[4 + i] = ow[4 + i] + m1[i] * (nb[4 + i] - ow[4 + i]); }
}
DI void mix_do2(const MixLd& L, const float (&nv)[4], const f32x4 m0, const f32x4 m1, float (&o)[8]) {
    const v4u w = L.w;
    const float ow[8] = {bflo(w.x), bfhi(w.x), bflo(w.y), bfhi(w.y), bflo(w.z), bfhi(w.z), bflo(w.w), bfhi(w.w)};
    const float nb[8] = {bflo(L.n[0].x) * nv[0], bfhi(L.n[1].x) * nv[1], bflo(L.n[2].y) * nv[2], bfhi(L.n[3].y) * nv[3], bflo(L.n[0].z) * nv[0], bfhi(L.n[1].z) * nv[1], bflo(L.n[2].w) * nv[2], bfhi(L.n[3].w) * nv[3]};
#pragma unroll
    for (int i = 0; i < 4; ++i) { o[i] = ow[i] + m0[i] * (nb[i] - ow[i]); o[4 + i] = ow[4 + i] + m1[i] * (nb[4 + i] - ow[4 + i]); }
}
DI void mix8(const bf16* own, const bf16* const (&np)[4], const float (&nv)[4], const float* mu, int cb, float (&o)[8]) { MixLd L; mix_ld(own, np, cb, L); mix_do(L, nv, mu, cb, o); }
DI void nbr_rows(const bf16* S, int b, int ci, int j, const bf16*& own, const bf16* (&np)[4], float (&nv)[4]) {
    const int row = chunk_row0(b, ci) + j; own = S + (size_t)row * NS1;
    if (ci >= 4) { const int gr = ci - 4; const bool v0 = j > 0, v1 = j < 63, v2 = gr > 0, v3 = gr < 127;
        np[0] = v0 ? own - NS1 : own; np[1] = v1 ? own + NS1 : own; np[2] = v2 ? own - (size_t)64 * NS1 : own; np[3] = v3 ? own + (size_t)64 * NS1 : own;
        nv[0] = v0 ? 1.f : 0.f; nv[1] = v1 ? 1.f : 0.f; nv[2] = v2 ? 1.f : 0.f; nv[3] = v3 ? 1.f : 0.f; }
    else { const int t = ci * 64 + j; const bool v0 = t > 0, v1 = t < CTXL - 1;
        np[0] = np[2] = v0 ? own - NS1 : own; np[1] = np[3] = v1 ? own + NS1 : own; nv[0] = nv[2] = v0 ? 1.f : 0.f; nv[1] = nv[3] = v1 ? 1.f : 0.f; }
}
DI float red8(float x) { x += dppf<0xB1>(x); x += dppf<0x4E>(x); x += dppf<0x141>(x); return x; }
DI void mix_store(bf16* zr, const f32x4 k0, const f32x4 k1, int it, int gi, int cb, const float (&o)[8]) {
    if (it < 2 || it == 4 || it == 5) { *(v4u*)(zr + cb) = (v4u){pk2(o[0], o[1]), pk2(o[2], o[3]), pk2(o[4], o[5]), pk2(o[6], o[7])}; }
    else if (it == 2 || it == 3) {
        *(v4u*)(zr + cb) = (v4u){pk2(o[0], o[1]), pk2(o[2], o[3]), pk2(o[4], o[5]), pk2(o[6], o[7])};
        float kr[8], ss = 0.f;
#pragma unroll
        for (int i = 0; i < 4; ++i) { kr[i] = o[i] * k0[i]; kr[4 + i] = o[4 + i] * k1[i]; ss += kr[i] * kr[i] + kr[4 + i] * kr[4 + i]; }
        ss = red8(ss); const float inv = __builtin_amdgcn_rsqf(ss + 1e-12f);
        *(v4u*)(zr + Z_KK + cb - C_K) = (v4u){pk2(kr[0] * inv, kr[1] * inv), pk2(kr[2] * inv, kr[3] * inv), pk2(kr[4] * inv, kr[5] * inv), pk2(kr[6] * inv, kr[7] * inv)}; }
    else if (gi < 392) { *(v4u*)(zr + Z_TW + cb - C_WD) = (v4u){pk2(tanh_fast(o[0]), tanh_fast(o[1])), pk2(tanh_fast(o[2]), tanh_fast(o[3])), pk2(tanh_fast(o[4]), tanh_fast(o[5])), pk2(tanh_fast(o[6]), tanh_fast(o[7]))}; }
    else if (gi < 400) { *(v4u*)(zr + Z_AD + cb - C_AD) = (v4u){pk2(o[0], o[1]), pk2(o[2], o[3]), pk2(o[4], o[5]), pk2(o[6], o[7])}; }
    else if (gi < 420) { *(v4u*)(zr + Z_GS + cb - C_GD) = (v4u){pk2(sigm_fast(o[0]), sigm_fast(o[1])), pk2(sigm_fast(o[2]), sigm_fast(o[3])), pk2(sigm_fast(o[4]), sigm_fast(o[5])), pk2(sigm_fast(o[6]), sigm_fast(o[7]))}; }
}
DI void mix_geom(int m, int& b, int& ci, int& j) { if (m < MX) { b = m >> 13; const int t = m & (SEQ - 1); ci = 4 + (t >> 6); j = t & 63; } else { const int t = (m - MX) & (CTXL - 1); b = (m - MX) >> 8; ci = t >> 6; j = t & 63; } }
DI void phase_mix(const P& p, int lane, int wave, int G) {
    const bf16* S = (const bf16*)(p.ws + WS_S1); bf16* Z = (bf16*)(p.ws + WS_ZM);
    const int gw = blockIdx.x * NWAVES + wave, NGW = G * NWAVES;
    f32x4 mu0[7], mu1[7], kk0[2], kk1[2];
#pragma unroll
    for (int it = 0; it < 7; ++it) { const int gi = lane + 64 * it; const int cb = (gi < 420 ? gi : 0) * 8; mu0[it] = *(const f32x4*)(p.mu_a + cb); mu1[it] = *(const f32x4*)(p.mu_a + cb + 4);
        if (it == 2 || it == 3) { kk0[it - 2] = *(const f32x4*)(p.k_k + cb - C_K); kk1[it - 2] = *(const f32x4*)(p.k_k + cb - C_K + 4); } }
    for (int m0 = gw; m0 < MALL; m0 += 2 * NGW) { const int m1 = m0 + NGW; const bool two = m1 < MALL; const int m1c = two ? m1 : m0;
        int b0, ci0, j0, b1, ci1, j1; mix_geom(m0, b0, ci0, j0); mix_geom(m1c, b1, ci1, j1);
        const bf16* own0; const bf16* np0[4]; float nv0[4]; nbr_rows(S, b0, ci0, j0, own0, np0, nv0);
        const bf16* own1; const bf16* np1[4]; float nv1[4]; nbr_rows(S, b1, ci1, j1, own1, np1, nv1);
        bf16* zr0 = Z + (size_t)m0 * NZM; bf16* zr1 = Z + (size_t)m1c * NZM;
#pragma unroll
        for (int it = 0; it < 7; ++it) { const int gi = lane + 64 * it; const int cb = (gi < 420 ? gi : 0) * 8; MixLd L0, L1; float o0[8], o1[8];
            mix_ld(own0, np0, cb, L0); mix_ld(own1, np1, cb, L1);
            mix_do2(L0, nv0, mu0[it], mu1[it], o0); mix_do2(L1, nv1, mu0[it], mu1[it], o1);
            const f32x4 kw0 = (it == 2 || it == 3) ? kk0[it == 3] : mu0[0], kw1 = (it == 2 || it == 3) ? kk1[it == 3] : mu0[0];
            mix_store(zr0, kw0, kw1, it, gi, cb, o0); if (two) mix_store(zr1, kw0, kw1, it, gi, cb, o1); }
    }
}
#define WK_BAR() do { asm volatile("s_waitcnt lgkmcnt(0)" ::: "memory"); __builtin_amdgcn_s_barrier(); asm volatile("" ::: "memory"); } while (0)
constexpr int WB_NB = NCH * 4;
constexpr int WB_AT = 0, WB_RT = 2304, WB_BC = 4608, WB_KC = 6912, WB_P4 = 9216, WB_GKT = 14336, WB_TT = 14848, WB_P5 = 15360, WB_VT = 16640, WB_PP = 17152, WB_MM = 17408, WB_SLOT = 18432;
constexpr int WB_W2T = 7 * WB_SLOT, WB_A2T = WB_W2T + 9216, WB_CST = WB_A2T + 9216, WB_FLG = WB_CST + 1024;
typedef short s16x4 __attribute__((ext_vector_type(4)));
DI v2u cvt2(float a, float b, float c, float d) { return (v2u){cvtpk_s(a, b), cvtpk_s(c, d)}; }
DI bf16x8 frag2(v2u lo, v2u hi) { return __builtin_bit_cast(bf16x8, (v4u){lo.x, lo.y, hi.x, hi.y}); }
DI float pfx16(float x) { x += dppf<0x111>(x); x += dppf<0x112>(x); x += dppf<0x114>(x); x += dppf<0x118>(x); return x; }
#define WB_LOADS(qq) do { const int sidx_ = (qq) >> 2, ci_ = e ? (sidx_ < 4 ? 3 - sidx_ : NCH + 3 - sidx_) : sidx_, pos_ = ((qq) & 3) * 16 + c, j_ = e ? 63 - pos_ : pos_; \
                    const bf16* zr = Z + (size_t)(chunk_row0(b, ci_) + j_) * NZM; \
                    _Pragma("unroll") for (int hh_ = 0; hh_ < 2; ++hh_) { const int c0 = h * 64 + 16 * g + 8 * hh_;     \
                        const v4u vk_ = *(const v4u*)(zr + Z_KK + c0), vr_ = *(const v4u*)(zr + Z_R + c0), vq_ = *(const v4u*)(zr + Z_K + c0); \
                        Lkk[2 * hh_] = (v2u){vk_.x, vk_.y}; Lkk[2 * hh_ + 1] = (v2u){vk_.z, vk_.w}; Lr[2 * hh_] = (v2u){vr_.x, vr_.y}; Lr[2 * hh_ + 1] = (v2u){vr_.z, vr_.w}; Lk[2 * hh_] = (v2u){vq_.x, vq_.y}; Lk[2 * hh_ + 1] = (v2u){vq_.z, vq_.w}; } \
                    Lv = *(const v2u*)(zr + Z_V + h * 64 + rg * 16 + 4 * g); \
                    tw[0] = *(const v4u*)(zr + Z_TW + g * 8); tw[1] = *(const v4u*)(zr + Z_TW + 32 + g * 8); ad[0] = *(const v4u*)(zr + Z_AD + g * 8); ad[1] = *(const v4u*)(zr + Z_AD + 32 + g * 8); } while (0)
DI void lds_wait_ge(volatile LAS int* f, int v, volatile LAS int* abortf) {
    int sp = 0;
    while (__builtin_amdgcn_readfirstlane(*f) < v) { __builtin_amdgcn_s_sleep(1); if (((++sp) & 63) == 0) { if (__builtin_amdgcn_readfirstlane(*abortf)) break; if (sp > (1 << 18)) { *abortf = 1; break; } } }
    asm volatile("" ::: "memory");
}
DI void wkv_blk_wg(const P& p, LAS unsigned char* lds, int tid, int lane, int wave, int unit) {
    const int xx = unit & 7, yy = unit >> 3, rg = yy & 3, scan = xx * 8 + (yy >> 2), e = scan & 1, h = (scan >> 1) & 15, b = scan >> 5;
    const bf16* Z = (const bf16*)(p.ws + WS_ZM);
    LAS bf16* W2T = (LAS bf16*)(lds + WB_W2T); LAS bf16* A2T = (LAS bf16*)(lds + WB_A2T); LAS float* CST = (LAS float*)(lds + WB_CST);
    __syncthreads();
    volatile LAS int* RDY = (volatile LAS int*)(lds + WB_FLG); volatile LAS int* CNS = RDY + 8; volatile LAS int* ABT = RDY + 16;
    if (tid < 32) RDY[tid] = 0;
    if (tid < 64) { const int ch = 16 * ((tid >> 2) & 3) + 4 * (tid >> 4) + (tid & 3);
        const float ka = p.k_a[h * 64 + ch]; CST[tid] = NL2E * p.w0[e * D + h * 64 + ch]; CST[64 + tid] = NL2E * p.a0[e * D + h * 64 + ch]; CST[128 + tid] = ka; CST[192 + tid] = 1.f - ka; }
    for (int i = tid; i < 4096; i += NTHR) { const int k = i >> 6, n = i & 63, pn = 16 * ((n >> 2) & 3) + 4 * (n >> 4) + (n & 3);     W2T[pn * 72 + k] = (bf16)f2bf(NL2E * p.w2[((size_t)e * 64 + k) * D + h * 64 + n]); A2T[pn * 72 + k] = (bf16)f2bf(NL2E * p.a2[((size_t)e * 64 + k) * D + h * 64 + n]); }
    __syncthreads();
    bf16* YW = (bf16*)(p.ws + (e ? WS_YWB : WS_YWF));
    const int c = lane & 15, g = lane >> 4;
    if (wave == 0) {
        __builtin_amdgcn_s_setprio(2);
        pg8::f32x4 Xt[4];
#pragma unroll
        for (int kt = 0; kt < 4; ++kt) Xt[kt] = (pg8::f32x4){0.f, 0.f, 0.f, 0.f};
        bf16* yp = YW + (size_t)(b * SEQ + (e ? SEQ - 1 - 4 * g : 4 * g)) * D + h * 64 + rg * 16 + c;
        int fnext = 0;
        int slot = 0, nblk = 0;
        v2u vtA, gkA, ttA, vtB, gkB, ttB; bf16x8 a1A[2], a2A[2], a1B[2], a2B[2];
#define SC_READS(S, sl_) do { const LAS bf16* AT_ = (const LAS bf16*)((sl_) + WB_AT); const LAS bf16* RT_ = (const LAS bf16*)((sl_) + WB_RT); \
            vt##S = *(const LAS v2u*)((const LAS bf16*)((sl_) + WB_VT) + c * 16 + 4 * g); gk##S = *(const LAS v2u*)((const LAS bf16*)((sl_) + WB_GKT) + c * 16 + 4 * g); \
            _Pragma("unroll") for (int sx = 0; sx < 2; ++sx) { a1##S[sx] = frag2(*(const LAS v2u*)(AT_ + c * 72 + 32 * sx + 4 * g), *(const LAS v2u*)(AT_ + c * 72 + 32 * sx + 16 + 4 * g)); \
                a2##S[sx] = frag2(*(const LAS v2u*)(RT_ + c * 72 + 32 * sx + 4 * g), *(const LAS v2u*)(RT_ + c * 72 + 32 * sx + 16 + 4 * g)); } \
            tt##S = *(const LAS v2u*)((const LAS bf16*)((sl_) + WB_TT) + c * 16 + 4 * g); } while (0)
#define SC_BODY(S, N, tt_) do { const int t = (tt_); LAS unsigned char* sl = lds + slot * WB_SLOT; \
            v2u xb[4]; \
            _Pragma("unroll") for (int kt = 0; kt < 4; ++kt) xb[kt] = cvt2(Xt[kt][0], Xt[kt][1], Xt[kt][2], Xt[kt][3]); \
            pg8::f32x4 C1 = __builtin_amdgcn_mfma_f32_16x16x16bf16_1k(__builtin_bit_cast(s16x4, gk##S), __builtin_bit_cast(s16x4, vt##S), (pg8::f32x4){0.f, 0.f, 0.f, 0.f}, 0, 0, 0); \
            pg8::f32x4 C2 = {0.f, 0.f, 0.f, 0.f}; \
            _Pragma("unroll") for (int sx = 0; sx < 2; ++sx) { const bf16x8 bx = frag2(xb[2 * sx], xb[2 * sx + 1]); C1 = __builtin_amdgcn_mfma_f32_16x16x32_bf16(a1##S[sx], bx, C1, 0, 0, 0); C2 = __builtin_amdgcn_mfma_f32_16x16x32_bf16(a2##S[sx], bx, C2, 0, 0, 0); } \
            __builtin_amdgcn_sched_barrier(0); \
              \
            bf16x8 p4f[4]; pg8::f32x4 xn[4], ppv[4]; const bf16x8 p5f = *(const LAS bf16x8*)((const LAS bf16*)(sl + WB_P5) + c * 40 + 8 * g); \
            _Pragma("unroll") for (int kt = 0; kt < 4; ++kt) p4f[kt] = *(const LAS bf16x8*)((const LAS bf16*)(sl + WB_P4) + (16 * kt + c) * 40 + 8 * g); \
            _Pragma("unroll") for (int kt = 0; kt < 4; ++kt) ppv[kt] = *(const LAS pg8::f32x4*)((const LAS float*)(sl + WB_PP) + 16 * kt + 4 * g); \
            const float v0_ = bflo(vt##S.x), v1_ = bfhi(vt##S.x), v2_ = bflo(vt##S.y), v3_ = bfhi(vt##S.y); \
            __builtin_amdgcn_sched_barrier(0); \
            const pg8::f32x4 SK = __builtin_amdgcn_mfma_f32_16x16x16bf16_1k(__builtin_bit_cast(s16x4, tt##S), __builtin_bit_cast(s16x4, cvt2(C1[0], C1[1], C1[2], C1[3])), (pg8::f32x4){0.f, 0.f, 0.f, 0.f}, 0, 0, 0); \
            const bf16x8 vs = __builtin_bit_cast(bf16x8, (v4u){cvtpk_s(v0_, SK[0]), cvtpk_s(v1_, SK[1]), cvtpk_s(v2_, SK[2]), cvtpk_s(v3_, SK[3])}); \
            _Pragma("unroll") for (int kt = 0; kt < 4; ++kt) xn[kt] = __builtin_amdgcn_mfma_f32_16x16x32_bf16(p4f[kt], vs, Xt[kt], 0, 0, 0); \
            const pg8::f32x4 Yt = __builtin_amdgcn_mfma_f32_16x16x32_bf16(p5f, vs, C2, 0, 0, 0); \
            asm volatile("s_waitcnt lgkmcnt(0)" ::: "memory"); \
            if (lane == 0) CNS[slot] = nblk + 1; \
            if (++slot == 7) { slot = 0; ++nblk; } \
            if (t + 1 < WB_NB) { \
                if (__builtin_amdgcn_readfirstlane(fnext) < nblk + 1) lds_wait_ge(RDY + slot, nblk + 1, ABT); \
                asm volatile("" ::: "memory"); \
                LAS unsigned char* sln = lds + slot * WB_SLOT; SC_READS(N, sln); fnext = RDY[slot == 6 ? 0 : slot + 1]; } \
            _Pragma("unroll") for (int kt = 0; kt < 4; ++kt) Xt[kt] = ppv[kt] * xn[kt]; \
            if (t >= 16) { \
                if (e) { yp[0] = (bf16)f2bf(Yt[0]); yp[-D] = (bf16)f2bf(Yt[1]); yp[-2 * D] = (bf16)f2bf(Yt[2]); yp[-3 * D] = (bf16)f2bf(Yt[3]); yp -= 16 * D; } \
                else { yp[0] = (bf16)f2bf(Yt[0]); yp[D] = (bf16)f2bf(Yt[1]); yp[2 * D] = (bf16)f2bf(Yt[2]); yp[3 * D] = (bf16)f2bf(Yt[3]); yp += 16 * D; } } } while (0)
        lds_wait_ge(RDY + 0, 1, ABT); SC_READS(A, lds); fnext = RDY[1];
        for (int t2 = 0; t2 < WB_NB; t2 += 2) { SC_BODY(A, B, t2); SC_BODY(B, A, t2 + 1); }
#undef SC_READS
#undef SC_BODY
        __builtin_amdgcn_s_setprio(0);
    } else {
        const int pw = wave - 1; LAS unsigned char* sl = lds + pw * WB_SLOT;
        LAS bf16* AT = (LAS bf16*)(sl + WB_AT); LAS bf16* RT = (LAS bf16*)(sl + WB_RT); LAS bf16* BC = (LAS bf16*)(sl + WB_BC); LAS bf16* KC = (LAS bf16*)(sl + WB_KC);
        LAS bf16* P4 = (LAS bf16*)(sl + WB_P4); LAS bf16* GKT = (LAS bf16*)(sl + WB_GKT); LAS bf16* TT = (LAS bf16*)(sl + WB_TT); LAS bf16* P5 = (LAS bf16*)(sl + WB_P5);
        LAS bf16* VT = (LAS bf16*)(sl + WB_VT); LAS float* PP = (LAS float*)(sl + WB_PP); LAS float* MM = (LAS float*)(sl + WB_MM);
        v2u Lkk[4], Lr[4], Lk[4], Lv; v4u tw[2], ad[2];
        { const int q = pw; WB_LOADS(q); }
        f32x4 w0v[4], a0v[4], kav[4], kbv[4];
#pragma unroll
        for (int nt = 0; nt < 4; ++nt) { w0v[nt] = *(const LAS f32x4*)(CST + 16 * nt + 4 * g); a0v[nt] = *(const LAS f32x4*)(CST + 64 + 16 * nt + 4 * g); kav[nt] = *(const LAS f32x4*)(CST + 128 + 16 * nt + 4 * g); kbv[nt] = *(const LAS f32x4*)(CST + 192 + 16 * nt + 4 * g); }
        f32x4 ltm, lem, gtm;
#pragma unroll
        for (int i = 0; i < 4; ++i) { const int ii = 4 * g + i; ltm[i] = ii < c ? 1.f : 0.f; lem[i] = ii <= c ? 1.f : 0.f; gtm[i] = c < ii ? 1.f : 0.f; }
        int nblk = 0;
        for (int q = pw; q < WB_NB; q += 7, ++nblk) {
            pg8::f32x4 zw[4], za[4];
            f32x4 ewv[4], kmv[4], bvv[4], kkf[4], rf[4];
            f32x4 at_[4], rt_[4], bc_[4], kc_[4], pp_[4];
#define WT_PRE(nt) do { zw[nt] = (pg8::f32x4){0.f, 0.f, 0.f, 0.f}; za[nt] = zw[nt]; \
                _Pragma("unroll") for (int ks = 0; ks < 2; ++ks) { const bf16x8 wa = *(const LAS bf16x8*)(W2T + ((nt) * 16 + c) * 72 + ks * 32 + g * 8), aa = *(const LAS bf16x8*)(A2T + ((nt) * 16 + c) * 72 + ks * 32 + g * 8); \
                    zw[nt] = __builtin_amdgcn_mfma_f32_16x16x32_bf16(wa, __builtin_bit_cast(bf16x8, tw[ks]), zw[nt], 0, 0, 0); za[nt] = __builtin_amdgcn_mfma_f32_16x16x32_bf16(aa, __builtin_bit_cast(bf16x8, ad[ks]), za[nt], 0, 0, 0); } \
                } while (0)
#define WT_AV(nt) do { const f32x4 kkv_ = {bflo(Lkk[nt].x), bfhi(Lkk[nt].x), bflo(Lkk[nt].y), bfhi(Lkk[nt].y)}, rv_ = {bflo(Lr[nt].x), bfhi(Lr[nt].x), bflo(Lr[nt].y), bfhi(Lr[nt].y)}, kv_ = {bflo(Lk[nt].x), bfhi(Lk[nt].x), bflo(Lk[nt].y), bfhi(Lk[nt].y)}; \
                const f32x4 xa_ = (f32x4){za[nt][0], za[nt][1], za[nt][2], za[nt][3]} + a0v[nt], xw_ = (f32x4){zw[nt][0], zw[nt][1], zw[nt][2], zw[nt][3]} + w0v[nt]; \
                const f32x4 da_ = (f32x4){__builtin_amdgcn_exp2f(xa_[0]), __builtin_amdgcn_exp2f(xa_[1]), __builtin_amdgcn_exp2f(xa_[2]), __builtin_amdgcn_exp2f(xa_[3])} + 1.f; \
                const f32x4 dw_ = (f32x4){__builtin_amdgcn_exp2f(xw_[0]), __builtin_amdgcn_exp2f(xw_[1]), __builtin_amdgcn_exp2f(xw_[2]), __builtin_amdgcn_exp2f(xw_[3])} + 1.f; \
                const f32x4 av_ = {frcp(da_[0]), frcp(da_[1]), frcp(da_[2]), frcp(da_[3])}; \
                ewv[nt] = (f32x4){frcp(dw_[0]), frcp(dw_[1]), frcp(dw_[2]), frcp(dw_[3])} * (0.6065306597126334f * NL2E);     \
                kmv[nt] = kv_ * (av_ * kav[nt] + kbv[nt]); bvv[nt] = kkv_ * av_; kkf[nt] = kkv_; rf[nt] = rv_; } while (0)
#define WT_BV(nt) do { const f32x4 inc_ = {pfx16(ewv[nt][0]), pfx16(ewv[nt][1]), pfx16(ewv[nt][2]), pfx16(ewv[nt][3])};     \
                const f32x4 E_ = {__builtin_amdgcn_exp2f(inc_[0]), __builtin_amdgcn_exp2f(inc_[1]), __builtin_amdgcn_exp2f(inc_[2]), __builtin_amdgcn_exp2f(inc_[3])};     \
                const f32x4 nEi_ = {frcp(-E_[0]), frcp(-E_[1]), frcp(-E_[2]), frcp(-E_[3])};     \
                const f32x4 Ep_ = {dppf_one<0x111>(E_[0]), dppf_one<0x111>(E_[1]), dppf_one<0x111>(E_[2]), dppf_one<0x111>(E_[3])};     \
                at_[nt] = kkf[nt] * Ep_; rt_[nt] = rf[nt] * E_; bc_[nt] = bvv[nt] * nEi_; kc_[nt] = -(kmv[nt] * nEi_); pp_[nt] = E_; } while (0)
#define WT_POST(nt) do { const int ko_ = c * 72 + 16 * (nt) + 4 * g; \
                *(LAS v2u*)(AT + ko_) = cvt2(at_[nt][0], at_[nt][1], at_[nt][2], at_[nt][3]); *(LAS v2u*)(RT + ko_) = cvt2(rt_[nt][0], rt_[nt][1], rt_[nt][2], rt_[nt][3]); \
                *(LAS v2u*)(BC + ko_) = cvt2(bc_[nt][0], bc_[nt][1], bc_[nt][2], bc_[nt][3]); *(LAS v2u*)(KC + ko_) = cvt2(kc_[nt][0], kc_[nt][1], kc_[nt][2], kc_[nt][3]); \
                const int so_ = 8 * (c >> 2) + 2 * (c & 3);                  \
                _Pragma("unroll") for (int i_ = 0; i_ < 4; ++i_) *(LAS unsigned*)(P4 + (16 * (nt) + 4 * g + i_) * 40 + so_) = cvtpk_s(kc_[nt][i_], bc_[nt][i_]);     \
                if (c == 15) *(LAS f32x4*)(PP + 16 * (nt) + 4 * g) = pp_[nt]; } while (0)
            WT_PRE(0); WT_AV(0); WT_BV(0); WT_PRE(1);
            lds_wait_ge(CNS + pw, nblk, ABT);
            WT_POST(0);
            VT[(4 * g + 0) * 16 + c] = (bf16)(Lv.x & 0xffffu); VT[(4 * g + 1) * 16 + c] = (bf16)(Lv.x >> 16); VT[(4 * g + 2) * 16 + c] = (bf16)(Lv.y & 0xffffu); VT[(4 * g + 3) * 16 + c] = (bf16)(Lv.y >> 16);
            WT_AV(1); WT_BV(1); WT_POST(1); WT_PRE(2); WT_AV(2); WT_BV(2); WT_POST(2); WT_PRE(3); WT_AV(3);
            if (q + 7 < WB_NB) WB_LOADS(q + 7);
            WT_BV(3); WT_POST(3);
#undef WT_PRE
#undef WT_AV
#undef WT_BV
#undef WT_POST
            {
                    __builtin_amdgcn_s_setprio(1);
                    pg8::f32x4 gb = {0.f, 0.f, 0.f, 0.f}, gk = gb, gbr = gb, gkr = gb, gbt = gb;
#pragma unroll
                    for (int ks = 0; ks < 2; ++ks) { const int o = c * 72 + ks * 32 + g * 8;
                        const bf16x8 fb = *(const LAS bf16x8*)(BC + o), fk = *(const LAS bf16x8*)(KC + o), fa = *(const LAS bf16x8*)(AT + o), fr = *(const LAS bf16x8*)(RT + o);
                        gb = __builtin_amdgcn_mfma_f32_16x16x32_bf16(fb, fa, gb, 0, 0, 0); gk = __builtin_amdgcn_mfma_f32_16x16x32_bf16(fk, fa, gk, 0, 0, 0);
                        gbr = __builtin_amdgcn_mfma_f32_16x16x32_bf16(fb, fr, gbr, 0, 0, 0); gkr = __builtin_amdgcn_mfma_f32_16x16x32_bf16(fk, fr, gkr, 0, 0, 0);
                        gbt = __builtin_amdgcn_mfma_f32_16x16x32_bf16(fa, fb, gbt, 0, 0, 0); }
                    const f32x4 m_ = -((f32x4){gb[0], gb[1], gb[2], gb[3]} * ltm), mt_ = -((f32x4){gbt[0], gbt[1], gbt[2], gbt[3]} * gtm), k_ = (f32x4){gk[0], gk[1], gk[2], gk[3]} * ltm,
                        kr_ = (f32x4){gkr[0], gkr[1], gkr[2], gkr[3]} * lem, br_ = (f32x4){gbr[0], gbr[1], gbr[2], gbr[3]} * lem;
                    *(LAS v2u*)(GKT + c * 16 + 4 * g) = cvt2(k_[0], k_[1], k_[2], k_[3]);
                    *(LAS v4u*)(P5 + c * 40 + 8 * g) = (v4u){cvtpk_s(kr_[0], br_[0]), cvtpk_s(kr_[1], br_[1]), cvtpk_s(kr_[2], br_[2]), cvtpk_s(kr_[3], br_[3])};
                    const v2u zq = {0u, 0u}; const pg8::f32x4 z4 = {0.f, 0.f, 0.f, 0.f};
#define MF_(a, b, acc) __builtin_amdgcn_mfma_f32_16x16x32_bf16(frag2(a, zq), frag2(b, zq), acc, 0, 0, 0)
#define CV_(x) cvt2((x)[0], (x)[1], (x)[2], (x)[3])
                    const v2u aM = cvt2(m_[0], m_[1], m_[2], m_[3]), bM = cvt2(mt_[0], mt_[1], mt_[2], mt_[3]);
                    pg8::f32x4 im;
#pragma unroll
                    for (int i = 0; i < 4; ++i) im[i] = ((4 * g + i) == c ? 1.f : 0.f) - m_[i];
                    const v2u aIM = CV_(im);
                    const pg8::f32x4 M2c = MF_(aM, bM, z4), M2a = MF_(bM, aM, z4);
                    const v2u aM2 = CV_(M2a), bM2 = CV_(M2c);
                    const pg8::f32x4 M4c = MF_(aM2, bM2, z4), M4a = MF_(bM2, aM2, z4);
                    const v2u aM4 = CV_(M4a), bM4 = CV_(M4c);
                    const pg8::f32x4 M8c = MF_(aM4, bM4, z4);
                    const v2u bM8 = CV_(M8c);
                    const pg8::f32x4 T1 = MF_(bM2, aIM, im);
                    const pg8::f32x4 T2 = MF_(bM4, CV_(T1), T1);
                    const pg8::f32x4 T3 = MF_(bM8, CV_(T2), T2);
                    *(LAS v2u*)(TT + c * 16 + 4 * g) = CV_(T3);
                    __builtin_amdgcn_s_setprio(0);
#undef MF_
#undef CV_
            }
            asm volatile("s_waitcnt lgkmcnt(0)" ::: "memory");
            if (lane == 0) RDY[pw] = nblk + 1;
        }
    }
}

constexpr int WO_RS = 0, WO_KS = 17408, WO_VS = 34816, WO_A2T = 52224, WO_G2T = 70656, WO_RHO = 92160;
DI void wkv_out_setup(const P& p, LAS unsigned char* lds, int tid, int h) {
    LAS bf16* A2T = (LAS bf16*)(lds + WO_A2T); LAS bf16* G2T = (LAS bf16*)(lds + WO_G2T);
    __syncthreads();
    for (int i = tid; i < 2 * 4096; i += NTHR) { const int e = i >> 12, k = (i >> 6) & 63, n = i & 63; A2T[e * 4608 + n * 72 + k] = (bf16)f2bf(p.a2[((size_t)e * 64 + k) * D + h * 64 + n]); }
    for (int i = tid; i < 160 * 64; i += NTHR) { const int k = i >> 6, n = i & 63; G2T[n * 168 + k] = (bf16)f2bf(p.g2[(size_t)k * D + h * 64 + n]); }
    __syncthreads();
}
struct WoPre { v4u r, k, v, a0, a1, a2, a3, a4; };
struct WoC { float c0[4], c1[4], ka[4], rk[4], gg[4], gb[4]; };
DI void wkv_out_consts(const P& p, int h, int l15, WoC& C) {
#pragma unroll
    for (int nt = 0; nt < 4; ++nt) { const int hc = h * 64 + nt * 16 + l15; C.c0[nt] = p.a0[hc]; C.c1[nt] = p.a0[D + hc]; C.ka[nt] = p.k_a[hc]; C.rk[nt] = p.r_k[hc]; C.gg[nt] = p.gn_g[hc]; C.gb[nt] = p.gn_b[hc]; }
}
DI void wkv_out_load(const P& p, int tid, int lane, int wave, int b, int gr, int h, WoPre& L) {
    const bf16* Z = (const bf16*)(p.ws + WS_ZM); const int row0 = chunk_row0(b, gr + 4);
    const int rb = wave & 3, half = wave >> 2, l15 = lane & 15, g = lane >> 4;
    const bf16* za_ = Z + (size_t)(row0 + rb * 16 + l15) * NZM;
    const v4u zz4 = {0u, 0u, 0u, 0u};
    if (half == 0) { L.a0 = *(const v4u*)(za_ + Z_AD + g * 8); L.a1 = *(const v4u*)(za_ + Z_AD + 32 + g * 8); L.a2 = zz4; L.a3 = zz4; L.a4 = zz4; }
    else { L.a0 = *(const v4u*)(za_ + Z_GS + g * 8); L.a1 = *(const v4u*)(za_ + Z_GS + 32 + g * 8); L.a2 = *(const v4u*)(za_ + Z_GS + 64 + g * 8); L.a3 = *(const v4u*)(za_ + Z_GS + 96 + g * 8); L.a4 = *(const v4u*)(za_ + Z_GS + 128 + g * 8); }
    { const int j = tid >> 3, cg = tid & 7; const bf16* zr = Z + (size_t)(row0 + j) * NZM + h * 64 + cg * 8;
        L.r = *(const v4u*)(zr + Z_R); L.k = *(const v4u*)(zr + Z_K); L.v = *(const v4u*)(zr + Z_V); }
}
DI void wkv_out_unit(const P& p, LAS unsigned char* lds, int tid, int lane, int wave, int b, int gr, int h, const WoC& C, const WoPre& L, bool has_next, int nb, int ngr, WoPre& N) {
    const int row0 = chunk_row0(b, gr + 4);
    LAS float* RS = (LAS float*)(lds + WO_RS); LAS float* KS = (LAS float*)(lds + WO_KS); LAS float* VS = (LAS float*)(lds + WO_VS);
    LAS bf16* A2T = (LAS bf16*)(lds + WO_A2T); LAS bf16* G2T = (LAS bf16*)(lds + WO_G2T); LAS float* RHO = (LAS float*)(lds + WO_RHO);
    const int rb = wave & 3, half = wave >> 2, l15 = lane & 15, g = lane >> 4;
    { const int j = tid >> 3, cg = tid & 7; const v4u r = L.r, k = L.k, v = L.v;
        *(LAS f32x4*)(RS + j * 68 + cg * 8) = (f32x4){bflo(r.x), bfhi(r.x), bflo(r.y), bfhi(r.y)}; *(LAS f32x4*)(RS + j * 68 + cg * 8 + 4) = (f32x4){bflo(r.z), bfhi(r.z), bflo(r.w), bfhi(r.w)};
        *(LAS f32x4*)(KS + j * 68 + cg * 8) = (f32x4){bflo(k.x), bfhi(k.x), bflo(k.y), bfhi(k.y)}; *(LAS f32x4*)(KS + j * 68 + cg * 8 + 4) = (f32x4){bflo(k.z), bfhi(k.z), bflo(k.w), bfhi(k.w)};
        *(LAS f32x4*)(VS + j * 68 + cg * 8) = (f32x4){bflo(v.x), bfhi(v.x), bflo(v.y), bfhi(v.y)}; *(LAS f32x4*)(VS + j * 68 + cg * 8 + 4) = (f32x4){bflo(v.z), bfhi(v.z), bflo(v.w), bfhi(v.w)}; }
    WK_BAR();
    if (has_next) wkv_out_load(p, tid, lane, wave, nb, ngr, h, N);
    bf16* YF = (bf16*)(p.ws + WS_YWF);
    float yn[4][4]; pg8::f32x4 zg[4];
    if (half == 0) {
        pg8::f32x4 z0[4], z1[4];
#pragma unroll
        for (int nt = 0; nt < 4; ++nt) { z0[nt] = (pg8::f32x4){0.f, 0.f, 0.f, 0.f}; z1[nt] = (pg8::f32x4){0.f, 0.f, 0.f, 0.f}; }
#pragma unroll
        for (int ks = 0; ks < 2; ++ks) { const bf16x8 aa = __builtin_bit_cast(bf16x8, ks == 0 ? L.a0 : L.a1);
#pragma unroll
            for (int nt = 0; nt < 4; ++nt) { const bf16x8 b0 = *(const LAS bf16x8*)(A2T + (nt * 16 + l15) * 72 + ks * 32 + g * 8), b1 = *(const LAS bf16x8*)(A2T + 4608 + (nt * 16 + l15) * 72 + ks * 32 + g * 8);
                z0[nt] = __builtin_amdgcn_mfma_f32_16x16x32_bf16(aa, b0, z0[nt], 0, 0, 0); z1[nt] = __builtin_amdgcn_mfma_f32_16x16x32_bf16(aa, b1, z1[nt], 0, 0, 0); } }
        float rho[4] = {0.f, 0.f, 0.f, 0.f};
#pragma unroll
        for (int nt = 0; nt < 4; ++nt) { const float c0 = C.c0[nt], c1 = C.c1[nt], ka = C.ka[nt], rk = C.rk[nt];
#pragma unroll
            for (int i = 0; i < 4; ++i) { const int o = (rb * 16 + 4 * g + i) * 68 + nt * 16 + l15;
                rho[i] += RS[o] * KS[o] * (2.f + (sigm_fast(z0[nt][i] + c0) + sigm_fast(z1[nt][i] + c1) - 2.f) * ka) * rk; } }
#pragma unroll
        for (int i = 0; i < 4; ++i) { const float r = red16(rho[i]); if (l15 == 0) RHO[rb * 16 + 4 * g + i] = r; }
    } else {
        const bf16* YB = (const bf16*)(p.ws + WS_YWB); unsigned short yfv[4][4], ybv[4][4];
#pragma unroll
        for (int nt = 0; nt < 4; ++nt)
#pragma unroll
            for (int i = 0; i < 4; ++i) { const size_t yo = (size_t)(row0 + rb * 16 + 4 * g + i) * D + h * 64 + nt * 16 + l15; yfv[nt][i] = YF[yo]; ybv[nt][i] = YB[yo]; }
#pragma unroll
        for (int nt = 0; nt < 4; ++nt) zg[nt] = (pg8::f32x4){0.f, 0.f, 0.f, 0.f};
#pragma unroll
        for (int ks = 0; ks < 5; ++ks) { const bf16x8 ag = __builtin_bit_cast(bf16x8, ks == 0 ? L.a0 : (ks == 1 ? L.a1 : (ks == 2 ? L.a2 : (ks == 3 ? L.a3 : L.a4))));
#pragma unroll
            for (int nt = 0; nt < 4; ++nt) { const bf16x8 bg = *(const LAS bf16x8*)(G2T + (nt * 16 + l15) * 168 + ks * 32 + g * 8); zg[nt] = __builtin_amdgcn_mfma_f32_16x16x32_bf16(ag, bg, zg[nt], 0, 0, 0); } }
        float sm[4] = {0.f, 0.f, 0.f, 0.f};
#pragma unroll
        for (int nt = 0; nt < 4; ++nt)
#pragma unroll
            for (int i = 0; i < 4; ++i) { yn[nt][i] = bf2f(yfv[nt][i]) + bf2f(ybv[nt][i]); sm[i] += yn[nt][i]; }
#pragma unroll
        for (int i = 0; i < 4; ++i) { const float mu = red16(sm[i]) * (1.f / 64.f); float q2 = 0.f;
#pragma unroll
            for (int nt = 0; nt < 4; ++nt) { yn[nt][i] -= mu; q2 += yn[nt][i] * yn[nt][i]; }
            const float rs = __builtin_amdgcn_rsqf(red16(q2) * (1.f / 64.f) + GN_EPS);
#pragma unroll
            for (int nt = 0; nt < 4; ++nt) yn[nt][i] *= rs; }
    }
    WK_BAR();
    if (half == 1) {
#pragma unroll
        for (int nt = 0; nt < 4; ++nt) { const int hc = h * 64 + nt * 16 + l15; const float gg = C.gg[nt], gb = C.gb[nt];
#pragma unroll
            for (int i = 0; i < 4; ++i) { const int tok = rb * 16 + 4 * g + i; const float ov = (yn[nt][i] * gg + gb + RHO[tok] * VS[tok * 68 + nt * 16 + l15]) * zg[nt][i];
                YF[(size_t)(row0 + tok) * D + hc] = (bf16)f2bf(ov); } }
    }
    WK_BAR();
}

DI void expert_weights(const P& p, LAS unsigned char* lds, int lane, int wave, int G) {
    LAS float* scr = (LAS float*)(lds + wave * 16384);
    const int gw = blockIdx.x * NWAVES + wave, NGW = G * NWAVES;
    bf16* w13 = (bf16*)(p.ws + WS_W13); bf16* w2t = (bf16*)(p.ws + WS_W2);
    constexpr int I13 = 16 * 16, I2 = 8 * 32;
    for (int it = gw; it < NEXP * (2 * I13 + I2); it += NGW) { const int ex = it / (2 * I13 + I2); int r = it % (2 * I13 + I2);
        if (r < 2 * I13) { const int which = r / I13; r %= I13; const int kb = r / 16, nb = r % 16, n0 = nb * 32;
            if (which) transpose_item(p.e_w3 + (size_t)ex * D * DEXP, DEXP, w13 + (size_t)ex * D * D, D, kb * 64, n0, 256 * (n0 >> 7) + 128 + (n0 & 127), scr, lane);
            else transpose_item(p.e_w1 + (size_t)ex * D * DEXP, DEXP, w13 + (size_t)ex * D * D, D, kb * 64, n0, 256 * (n0 >> 7) + (n0 & 127), scr, lane); }
        else { r -= 2 * I13; const int kb = r / 32, nb = r % 32; transpose_item(p.e_w2 + (size_t)ex * DEXP * D, D, w2t + (size_t)ex * D * DEXP, DEXP, kb * 64, nb * 32, nb * 32, scr, lane); } }
}

constexpr int RT_AX = 0, RT_AXS = 1032, RT_PART = 66048, RT_LOG = 90624, RT_RE = 92928, RT_PRM = 93696  ;
DI void phase_route(const P& p, LAS unsigned char* lds, int tid, int lane, int wave, int G) {
    LAS float* AX = (LAS float*)(lds + RT_AX); LAS float* PART = (LAS float*)(lds + RT_PART); LAS float* LOG = (LAS float*)(lds + RT_LOG); LAS int* RE = (LAS int*)(lds + RT_RE);
    float* T1 = p.out; bf16* H2 = (bf16*)(p.ws + WS_H2); float* ST2 = (float*)(p.ws + WS_ROWW);
    int* TOKE = (int*)(p.ws + WS_TOKE); int* TOKSLOT = (int*)(p.ws + WS_TOKSLOT); float* TOKW = (float*)(p.ws + WS_TOKW); int* S2T = (int*)(p.ws + WS_S2T);
    if (blockIdx.x == 0) for (int i = tid; i < D / 8; i += NTHR) ((GAS v4u*)(H2 + (size_t)MX * D))[i] = (v4u){0u, 0u, 0u, 0u};
    const int l15 = lane & 15, g = lane >> 4;
    f32x4 breg[8][3];
    { const float* rwt = (const float*)(p.ws + WS_RWT);
#pragma unroll
      for (int m = 0; m < 8; ++m)
#pragma unroll
          for (int nt = 0; nt < 3; ++nt) breg[m][nt] = *(const f32x4*)(rwt + (size_t)(nt * 16 + l15) * D + 128 * wave + 16 * m + 4 * g); }
    __syncthreads();
    LAS float* PRM = (LAS float*)(lds + RT_PRM);
    for (int blk = blockIdx.x; blk < MX / 64; blk += G) {
        f32x4 q[2][4];
        { const int bsel = (blk * 64) >> 13;
          __syncthreads();
          for (int n = tid; n < D; n += NTHR) { PRM[n] = p.ln1_g[n]; PRM[D + n] = p.ln1_b[n]; PRM[2 * D + n] = modv(p, bsel, 4 * 1024 + n) + 1.f; PRM[3 * D + n] = modv(p, bsel, 3 * 1024 + n); }
          __syncthreads(); }
#pragma unroll
        for (int rr = 0; rr < 2; ++rr) { const GAS f32x4* tr = (const GAS f32x4*)(T1 + (size_t)(blk * 64 + 2 * wave + rr) * D) + lane;
#pragma unroll
            for (int j = 0; j < 4; ++j) q[rr][j] = tr[64 * j]; }
        for (int it = 0; it < 4; ++it) {
#pragma unroll
            for (int rr = 0; rr < 2; ++rr) { const int rl = 2 * wave + rr, m = blk * 64 + it * 16 + rl; const int bsel = m >> 13;
                GAS f32x4* tr = (GAS f32x4*)(T1 + (size_t)m * D) + lane; float s = 0.f;
#pragma unroll
                for (int j = 0; j < 4; ++j) s += (q[rr][j].x + q[rr][j].y) + (q[rr][j].z + q[rr][j].w);
                const float mean = wave_sum(s) * (1.f / D); float s2 = 0.f;
#pragma unroll
                for (int j = 0; j < 4; ++j) { q[rr][j] = q[rr][j] - mean; s2 += (q[rr][j].x * q[rr][j].x + q[rr][j].y * q[rr][j].y) + (q[rr][j].z * q[rr][j].z + q[rr][j].w * q[rr][j].w); }
                const float rstd = 1.f / sqrtf(wave_sum(s2) * (1.f / D) + LN_EPS);
                if (lane == 0) { ST2[2 * m] = mean; ST2[2 * m + 1] = rstd; }
                GAS v2u* o8 = (GAS v2u*)(H2 + (size_t)m * D) + lane;
#pragma unroll
                for (int j = 0; j < 4; ++j) { const int n = 256 * j + 4 * lane; const f32x4 gg = *(const LAS f32x4*)(PRM + n), bb = *(const LAS f32x4*)(PRM + D + n);
                    const f32x4 x1 = q[rr][j] * rstd * gg + bb; const f32x4 hh = x1 * *(const LAS f32x4*)(PRM + 2 * D + n) + *(const LAS f32x4*)(PRM + 3 * D + n);
                    o8[64 * j] = (v2u){pk2(hh[0], hh[1]), pk2(hh[2], hh[3])};
                    *(LAS f32x4*)(AX + rl * RT_AXS + n) = hh; } }
            if (it < 3) {
#pragma unroll
                for (int rr = 0; rr < 2; ++rr) { const GAS f32x4* tr = (const GAS f32x4*)(T1 + (size_t)(blk * 64 + (it + 1) * 16 + 2 * wave + rr) * D) + lane;
#pragma unroll
                    for (int j = 0; j < 4; ++j) q[rr][j] = tr[64 * j]; } }
            WK_BAR();
            { f32x4 acc[3];
#pragma unroll
              for (int nt = 0; nt < 3; ++nt) acc[nt] = (f32x4){0.f, 0.f, 0.f, 0.f};
#pragma unroll
              for (int m = 0; m < 8; ++m) { const f32x4 a4 = *(const LAS f32x4*)(AX + l15 * RT_AXS + 128 * wave + 16 * m + 4 * g);
#pragma unroll
                  for (int sx = 0; sx < 4; ++sx)
#pragma unroll
                      for (int nt = 0; nt < 3; ++nt) acc[nt] = __builtin_amdgcn_mfma_f32_16x16x4f32(a4[sx], breg[m][nt][sx], acc[nt], 0, 0, 0); }
#pragma unroll
              for (int nt = 0; nt < 3; ++nt)
#pragma unroll
                  for (int i = 0; i < 4; ++i) PART[(wave * 16 + 4 * g + i) * 48 + nt * 16 + l15] = acc[nt][i]; }
            WK_BAR();
            for (int i = tid; i < 16 * 36; i += NTHR) { const int row = i / 36, qq = i % 36; float a = qq < 4 ? p.router_g_b[qq] : p.router_e_b[qq - 4];
#pragma unroll
                for (int w = 0; w < 8; ++w) a += PART[(w * 16 + row) * 48 + qq];
                LOG[row * 36 + qq] = a; }
            WK_BAR();
            if (tid < 16) { const int m = blk * 64 + it * 16 + tid; float lg[36];
#pragma unroll
                for (int i = 0; i < 36; ++i) lg[i] = LOG[tid * 36 + i];
                int gs = 0; float gm = lg[0];
#pragma unroll
                for (int i = 1; i < 4; ++i) if (lg[i] > gm) { gm = lg[i]; gs = i; }
                float den = 0.f;
#pragma unroll
                for (int i = 0; i < 4; ++i) den += __expf(lg[i] - gm);
                const float pg = 1.f / den;
                float ev[8];
#pragma unroll
                for (int i = 0; i < 8; ++i) ev[i] = gs == 0 ? lg[4 + i] : (gs == 1 ? lg[12 + i] : (gs == 2 ? lg[20 + i] : lg[28 + i]));
                int i1 = 0; float v1 = ev[0];
#pragma unroll
                for (int i = 1; i < 8; ++i) if (ev[i] > v1) { v1 = ev[i]; i1 = i; }
                int i2 = -1; float v2 = -3.0e38f;
#pragma unroll
                for (int i = 0; i < 8; ++i) if (i != i1 && ev[i] > v2) { v2 = ev[i]; i2 = i; }
                if (i2 < 0) { i2 = (i1 + 1) & 7; v2 = v1; }
                const float e2 = __expf(v2 - v1); const float w1 = pg / (1.f + e2), w2 = pg * e2 / (1.f + e2);
                RE[(it * 16 + tid) * 2] = gs * 8 + i1; RE[(it * 16 + tid) * 2 + 1] = gs * 8 + i2; TOKW[2 * m] = w1; TOKW[2 * m + 1] = w2; TOKE[2 * m] = gs * 8 + i1; TOKE[2 * m + 1] = gs * 8 + i2; }
            WK_BAR();
        }
        if (wave == 0) {
            const int e0 = RE[lane], e1 = RE[lane + 64]; int r0 = 0, r1 = 0, cex = 0;
#pragma unroll 4
            for (int ex = 0; ex < NEXP; ++ex) { const unsigned long long m0 = __builtin_amdgcn_ballot_w64(e0 == ex), m1 = __builtin_amdgcn_ballot_w64(e1 == ex);
                const int n0 = __builtin_popcountll(m0);
                const int b0 = (int)__builtin_amdgcn_mbcnt_hi((unsigned)(m0 >> 32), __builtin_amdgcn_mbcnt_lo((unsigned)m0, 0u)), b1 = (int)__builtin_amdgcn_mbcnt_hi((unsigned)(m1 >> 32), __builtin_amdgcn_mbcnt_lo((unsigned)m1, 0u));
                if (e0 == ex) r0 = b0; if (e1 == ex) r1 = n0 + b1; if (lane == ex) cex = n0 + __builtin_popcountll(m1); }
            int base = 0; if (lane < NEXP && cex) base = (int)atomicAdd(p.ctl + CW_ECNT + lane, (unsigned)cex);
            const int s0 = __builtin_amdgcn_ds_bpermute(e0 * 4, base) + r0, s1 = __builtin_amdgcn_ds_bpermute(e1 * 4, base) + r1;
            const int i0 = lane, i1 = lane + 64, m0r = blk * 64 + (i0 >> 1), m1r = blk * 64 + (i1 >> 1);
            TOKSLOT[2 * m0r + (i0 & 1)] = s0; S2T[(size_t)e0 * MX + s0] = 2 * m0r + (i0 & 1);
            TOKSLOT[2 * m1r + (i1 & 1)] = s1; S2T[(size_t)e1 * MX + s1] = 2 * m1r + (i1 & 1); }
        __syncthreads();
    }
}
DI void build_tiles(const P& p, LAS int* tile, int tid) {
    if (tid == 0) { int T = 0;
        for (int e = 0; e < NEXP; ++e) { tile[MAXT + e] = T; const int c = (int)__hip_atomic_load(p.ctl + CW_ECNT + e, RLX_AGENT); tile[MAXT + 64 + e] = c; const int nt = (c + 255) >> 8; for (int i = 0; i < nt; ++i) tile[T + i] = e; T += nt; }
        tile[MAXT + 32] = T; tile[MAXT + 40] = T; }
    __syncthreads();
}
DI void phase_final(const P& p, LAS int* tile, int lane, int wave, int G) {
    const int gw = blockIdx.x * NWAVES + wave, NGW = G * NWAVES; const bf16* YB = (const bf16*)(p.ws + WS_XS);
    const int* TOKE = (const int*)(p.ws + WS_TOKE); const int* TOKSLOT = (const int*)(p.ws + WS_TOKSLOT); const float* ST2 = (const float*)(p.ws + WS_ROWW);
    f32x4 g1[4], b1[4], g2[4], b2[4], gt[2][4]; int gv[2] = {-1, -1};
#pragma unroll
    for (int j = 0; j < 4; ++j) { const int n = 256 * j + 4 * lane; g1[j] = *(const f32x4*)(p.ln1_g + n); b1[j] = *(const f32x4*)(p.ln1_b + n); g2[j] = *(const f32x4*)(p.ln2_g + n); b2[j] = *(const f32x4*)(p.ln2_b + n); gt[0][j] = gt[1][j] = (f32x4){0.f, 0.f, 0.f, 0.f}; }
    for (int m0 = gw; m0 < MX; m0 += 2 * NGW) { int mm[2]; mm[0] = m0; mm[1] = (m0 + NGW < MX) ? m0 + NGW : m0;
        f32x4 q[2][4]; float s[2] = {0.f, 0.f};
#pragma unroll
        for (int rr = 0; rr < 2; ++rr) { const int m = mm[rr]; const int bsel = m >> 13; const float mean1 = ST2[2 * m], rstd1 = ST2[2 * m + 1];
            if (bsel != gv[rr]) { gv[rr] = bsel;
#pragma unroll
                for (int j = 0; j < 4; ++j) gt[rr][j] = modv4(p, bsel, 5 * 1024 + 256 * j + 4 * lane); }
            const int r0 = tile[MAXT + TOKE[2 * m]] * 256 + TOKSLOT[2 * m], r1 = tile[MAXT + TOKE[2 * m + 1]] * 256 + TOKSLOT[2 * m + 1];
            const GAS f32x4* xr = (const GAS f32x4*)(p.out + (size_t)m * D) + lane; const GAS v2u* y0 = (const GAS v2u*)(YB + (size_t)r0 * D) + lane; const GAS v2u* y1 = (const GAS v2u*)(YB + (size_t)r1 * D) + lane;
#pragma unroll
            for (int j = 0; j < 4; ++j) { const f32x4 x1 = (xr[64 * j] - mean1) * rstd1 * g1[j] + b1[j]; const v2u a = y0[64 * j], b2v = y1[64 * j];
                const f32x4 mo = (f32x4){bflo(a.x) + bflo(b2v.x), bfhi(a.x) + bfhi(b2v.x), bflo(a.y) + bflo(b2v.y), bfhi(a.y) + bfhi(b2v.y)};
                q[rr][j] = x1 * ALPHA + gt[rr][j] * mo;
                s[rr] += (q[rr][j].x + q[rr][j].y) + (q[rr][j].z + q[rr][j].w); } }
#pragma unroll
        for (int rr = 0; rr < 2; ++rr) { const int m = mm[rr]; GAS f32x4* xr = (GAS f32x4*)(p.out + (size_t)m * D) + lane;
            const float mean = wave_sum(s[rr]) * (1.f / D); float s2 = 0.f;
#pragma unroll
            for (int j = 0; j < 4; ++j) { q[rr][j] = q[rr][j] - mean; s2 += (q[rr][j].x * q[rr][j].x + q[rr][j].y * q[rr][j].y) + (q[rr][j].z * q[rr][j].z + q[rr][j].w * q[rr][j].w); }
            const float rstd = 1.f / sqrtf(wave_sum(s2) * (1.f / D) + LN_EPS);
#pragma unroll
            for (int j = 0; j < 4; ++j) xr[64 * j] = q[rr][j] * rstd * g2[j] + b2[j]; }
    }
}
#define MKP P p; { const float* const* in = args.in; p.x = in[0]; p.c = in[1]; p.ctx = in[2]; p.c_ctx = in[3]; p.w_ada = in[4]; p.b_ada = in[5]; p.w_in = in[6]; p.mu_a = in[7]; p.w0 = in[8]; p.w2 = in[9]; p.a0 = in[10]; p.a2 = in[11]; p.g2 = in[12]; p.k_k = in[13]; p.k_a = in[14]; p.r_k = in[15]; p.gn_g = in[16]; p.gn_b = in[17]; p.conv_w = in[18]; p.conv_b = in[19]; p.lru_wa = in[20]; p.lru_ba = in[21]; p.lru_wx = in[22]; p.lru_bx = in[23]; p.lru_lam = in[24]; p.p_a = in[25]; p.p_b = in[26]; p.w_o = in[27]; p.ln1_g = in[28]; p.ln1_b = in[29]; p.router_g = in[30]; p.router_g_b = in[31]; p.router_e = in[32]; p.router_e_b = in[33]; p.e_w1 = in[34]; p.e_w3 = in[35]; p.e_w2 = in[36]; p.ln2_g = in[37]; p.ln2_b = in[38]; } p.out = args.out; p.ws = args.ws; p.dob = (unsigned char*)args.out; p.ctlf = (float*)(args.ws + WS_CTL); p.ctl = (unsigned*)(args.ws + WS_CTL);
constexpr int NPHASE = 15;
__global__ void __launch_bounds__(NTHR, 2) fwd_kernel(Args args) {
    extern __shared__ __attribute__((aligned(16))) unsigned char lds_raw[];
    LAS unsigned char* lds = (LAS unsigned char*)lds_raw;
    const int tid = threadIdx.x, lane = tid & 63, wave = __builtin_amdgcn_readfirstlane(tid >> 6), G = gridDim.x;
    volatile LAS unsigned* MISC = (volatile LAS unsigned*)(lds + MISC_OFF);
    LAS int* tile = (LAS int*)(lds + TILE_OFF);
    for (int u = tid; u < 256; u += NTHR) ((LAS unsigned*)(lds + MISC_OFF))[u] = 0u;
    __syncthreads();
#if ONE_LAUNCH
    XcdBarrier bar = xcd_barrier_post((unsigned*)(args.ws + WS_CTL) + CW_BAR, MISC + 8);
#define GRID_BAR() xcd_barrier(bar)
#else
#define GRID_BAR() do {} while (0)
#endif
    const int lo = args.ph_lo, hi = args.ph_hi;
#define IN(k) (lo <= (k) && (k) < hi)
#define SEAM(k) do { if (IN(k) && IN((k) + 1)) GRID_BAR(); } while (0)

    if (IN(0)) { MKP; phase0(p, lds, tid, lane, wave, G); } SEAM(0);
    if (IN(1)) { MKP; phase0b(p, lds, tid, lane, wave, G); phase1(p, lane, wave, G); } SEAM(1);
    if (IN(2)) { MKP;
        pg8::Gemm g{(const pg8::bf16_t*)(p.dob + DO_H), (const pg8::bf16_t*)(p.dob + DO_WIN), MALL, NSLAB, D}; pg8::StaticOrder S; S.init(MALL, NSLAB, G, (int)blockIdx.x);
        EpiPlain<0> E{(bf16*)(p.ws + WS_S1), NS1, (bf16*)(p.ws + WS_S2), NS2, NS1 / 256};
        pg8::gemm_phase<EpiPlain<0>, pg8::StaticOrder, true, true>(lds, g, S, E); } SEAM(2);
    if (IN(3)) { MKP; const int hb = blockIdx.x & 15; lru_setup(p, lds, tid, hb); LruC C; lru_consts(p, hb, lane & 15, C);
        for (int u = (blockIdx.x >> 4) * NWAVES + wave; u < BATCH * NHS; u += (G >> 4) * NWAVES) { const int hs = u % NHS, b = u / NHS; lru_unit<1>(p, lds, lane, wave, b, hs, hb, C); } } SEAM(3);
    if (IN(4)) { MKP; lru_carry(p, lds, tid, G); } SEAM(4);
    if (IN(5)) { MKP; const int hb = blockIdx.x & 15; lru_setup(p, lds, tid, hb); LruC C; lru_consts(p, hb, lane & 15, C);
        for (int u = (blockIdx.x >> 4) * NWAVES + wave; u < BATCH * 256; u += (G >> 4) * NWAVES) { const int hs = 8 + (u & 255), b = u >> 8; lru_unit<2>(p, lds, lane, wave, b, hs, hb, C); } } SEAM(5);
    if (IN(6)) { MKP; phase_mix(p, lane, wave, G); } SEAM(6);
    if (IN(7)) { MKP; for (int u = blockIdx.x; u < 256; u += G) wkv_blk_wg(p, lds, tid, lane, wave, u); } SEAM(7);
    if (IN(8)) { MKP; const int h = blockIdx.x & 15; wkv_out_setup(p, lds, tid, h); { WoC WC; wkv_out_consts(p, h, lane & 15, WC); WoPre A, B; const int u0 = blockIdx.x >> 4, du = G >> 4; if (u0 < BATCH * 128) wkv_out_load(p, tid, lane, wave, u0 >> 7, u0 & 127, h, A);
            for (int u = u0; u < BATCH * 128; u += 2 * du) {
                const int u1 = u + du, u2 = u + 2 * du;
                wkv_out_unit(p, lds, tid, lane, wave, u >> 7, u & 127, h, WC, A, u1 < BATCH * 128, u1 >> 7, u1 & 127, B);
                if (u1 < BATCH * 128) wkv_out_unit(p, lds, tid, lane, wave, u1 >> 7, u1 & 127, h, WC, B, u2 < BATCH * 128, u2 >> 7, u2 & 127, A); } } } SEAM(8);
    if (IN(9)) { MKP;
        pg8::Gemm g{(const pg8::bf16_t*)(p.dob + DO_H), (const pg8::bf16_t*)(p.dob + DO_WIN) + (size_t)NSLAB * D, MX, 2048, D}; pg8::StaticOrder S; S.init(MX, 2048, G, (int)blockIdx.x);
        EpiPlain<1> E{(bf16*)(p.ws + WS_GATES), 2048, nullptr, 0, 1 << 20};
        pg8::gemm_phase<EpiPlain<1>, pg8::StaticOrder, true, true>(lds, g, S, E); } SEAM(9);
    if (IN(10)) { MKP;
        pg8::Gemm g{(const pg8::bf16_t*)(p.ws + WS_YWF), (const pg8::bf16_t*)(p.ws + WS_PW), 2 * MX, 2 * D, D}; SchedMix S; S.init(MX, D, G, (int)blockIdx.x);
        EpiMix E{(const bf16*)(p.ws + WS_GATES), (bf16*)(p.ws + WS_MBUF)};
        pg8::gemm_phase<EpiMix, SchedMix, true, true>(lds, g, S, E); } SEAM(10);
    if (IN(11)) { MKP;
        pg8::Gemm g{(const pg8::bf16_t*)(p.ws + WS_MBUF), (const pg8::bf16_t*)(p.ws + WS_PW) + (size_t)2 * D * D, MX, D, D}; pg8::StaticOrder S; S.init(MX, D, G, (int)blockIdx.x);
        EpiT1 E{p.x, (const float*)(p.ws + WS_STATS), p.ctlf + CW_MOD, p.b_ada, p.out};
        const bool wfirst = ((blockIdx.x >> 3) & 1) != 0;
        if (wfirst) { expert_weights(p, lds, lane, wave, G); __syncthreads(); }
        pg8::gemm_phase<EpiT1, pg8::StaticOrder, true, true>(lds, g, S, E);
        if (!wfirst) expert_weights(p, lds, lane, wave, G); } SEAM(11);
    if (IN(12)) { MKP; phase_route(p, lds, tid, lane, wave, G); } SEAM(12);
    if (IN(13)) { MKP;
        build_tiles(p, tile, tid);
        pg8::Gemm g{(const pg8::bf16_t*)(p.ws + WS_H2), (const pg8::bf16_t*)(p.ws + WS_W13), MAXT * 256, NEXP * D, D}; SchedMoE S{tile, G, (int)blockIdx.x, (const int*)(p.ws + WS_S2T)};
        EpiSwiGLU E{(bf16*)(p.ws + WS_HBUF)};
        pg8::gemm_phase<EpiSwiGLU, SchedMoE, true, true, true>(lds, g, S, E); } SEAM(13);
    if (IN(14)) { MKP;
        build_tiles(p, tile, tid);
        pg8::Gemm g{(const pg8::bf16_t*)(p.ws + WS_HBUF), (const pg8::bf16_t*)(p.ws + WS_W2), MAXT * 256, NEXP * D, DEXP}; SchedMoE S{tile, G, (int)blockIdx.x, (const int*)(p.ws + WS_S2T)};
        EpiW2 E{(bf16*)(p.ws + WS_XS), tile, (const int*)(p.ws + WS_S2T), (const float*)(p.ws + WS_TOKW)};
        pg8::gemm_phase<EpiW2, SchedMoE, true, true>(lds, g, S, E); } SEAM(14);
    if (IN(15)) { MKP; build_tiles(p, tile, tid); phase_final(p, tile, lane, wave, G); }
#undef IN
#undef SEAM
}

extern "C" void kernel_launch(void* const* d_in, const int* in_sizes, int n_in, void* d_out, int out_size, void* d_ws, size_t ws_size, hipStream_t stream) {
    static int grid = 0;
    if (grid == 0) {
        if (n_in != 39 || out_size != MX * D || ws_size < WS_END) { fprintf(stderr, "kernel_launch: unexpected shapes (n_in %d out %d ws %zu)\n", n_in, out_size, ws_size); grid = -1; return; }
        int dev = 0, cus = 0, per_cu = 0;
        if (hipGetDevice(&dev) != hipSuccess || hipDeviceGetAttribute(&cus, hipDeviceAttributeMultiprocessorCount, dev) != hipSuccess) { grid = -1; return; }
        if (hipFuncSetAttribute((const void*)fwd_kernel, hipFuncAttributeMaxDynamicSharedMemorySize, LDS_BYTES) != hipSuccess) { fprintf(stderr, "kernel_launch: hipFuncSetAttribute failed\n"); grid = -1; return; }
        if (hipOccupancyMaxActiveBlocksPerMultiprocessor(&per_cu, (const void*)fwd_kernel, NTHR, LDS_BYTES) != hipSuccess || per_cu < 1) fprintf(stderr, "kernel_launch: occupancy query reports %d\n", per_cu);
        (void)hipGetLastError();
        grid = cus;
    }
    if (grid < 0) return;
    if (hipMemsetAsync((char*)d_ws + WS_CTL, 0, CTL_ZERO_BYTES, stream) != hipSuccess) return;
    Args a{};
    for (int i = 0; i < 39; ++i) a.in[i] = (const float*)d_in[i];
    a.out = (float*)d_out; a.ws = (unsigned char*)d_ws;
#if ONE_LAUNCH
    a.ph_lo = 0; a.ph_hi = NPHASE + 1;
    hipLaunchKernelGGL(fwd_kernel, dim3(grid), dim3(NTHR), LDS_BYTES, stream, a);
#else
    for (int ph = 0; ph <= NPHASE; ++ph) { a.ph_lo = ph; a.ph_hi = ph + 1; hipLaunchKernelGGL(fwd_kernel, dim3(grid), dim3(NTHR), LDS_BYTES, stream, a); }
#endif
}
```

```cpp
#include <hip/hip_runtime.h>
#include <cstdio>
#include <cstdint>
namespace pg8 {
#define PG8_LAS __attribute__((address_space(3)))
typedef unsigned short bf16_t;
typedef short bf16x8 __attribute__((ext_vector_type(8)));
typedef float f32x4 __attribute__((ext_vector_type(4)));
typedef unsigned u32x4 __attribute__((ext_vector_type(4)));
constexpr int BM = 256, BK = 64, HALF = 128, HTB = HALF * BK * 2  , STAGE_BYTES = 8 * HTB, NXCD = 8, WGM = 8;

__host__ __device__ __forceinline__ int lds_byte(int r, int c) { const int st = (r >> 4) * 2 + (c >> 5), rr = r & 15, cc = c & 31, ob = rr * 64 + cc * 2; return st * 1024 + (ob ^ (((ob >> 9) & 1) << 5)); }
__host__ __device__ __forceinline__ void stage_rc(int b, int& R, int& C) { const int st = b / 1024, sb = b % 1024, swz = sb ^ (((sb >> 9) & 1) << 5); R = (st >> 1) * 16 + swz / 64; C = (st & 1) * 32 + (swz % 64) / 2; }
__host__ __device__ __forceinline__ int perm32(int rho) { const int n = rho >> 4, i = rho & 15; return 8 * (i >> 2) + 4 * n + (i & 3); }

struct Unit { int pm, pn; };
struct Gemm { const bf16_t* A; const bf16_t* Bt; int M, N, K; };

struct StaticOrder {
    int nM, nN, nwg, G, c;
    __host__ __device__ void init(int M, int N, int G_, int c_) { nM = M / BM; nN = N / BM; nwg = nM * nN; G = G_; c = c_; }
    __host__ __device__ bool next(int i, Unit& u) const {
        const long L = (long)i * G + c; if (L >= nwg) return false;
        int wgid = (int)L; { const int q = nwg / NXCD, r = nwg % NXCD, xcd = wgid % NXCD, off = wgid / NXCD; wgid = (xcd < r ? xcd * (q + 1) : r * (q + 1) + (xcd - r) * q) + off; }
        const int nig = WGM * nN, gid = wgid / nig, fm = gid * WGM, gsz = (nM - fm) < WGM ? (nM - fm) : WGM;
        u.pm = fm + ((wgid % nig) % gsz); u.pn = (wgid % nig) / gsz; return true;
    }
    __device__ __forceinline__ void a_ready(const Unit&) const {}
    __device__ __forceinline__ void done(const Unit&) const {}
};

__device__ __forceinline__ unsigned cvt_pk_bf16(float lo, float hi) { unsigned r; asm volatile("v_cvt_pk_bf16_f32 %0, %1, %2" : "=v"(r) : "v"(lo), "v"(hi)); return r; }
template <class Epi, class Sched, bool ALIGN_EPI = false, bool SP2 = false, bool GATHER = false>
__device__ __forceinline__ void gemm_phase(PG8_LAS unsigned char* lds, const Gemm g, const Sched& S, const Epi& E) {
    static_assert(!GATHER || SP2, "the gathered-A path exists only in the SP2 loop");
    const int tid = threadIdx.x, wid = __builtin_amdgcn_readfirstlane(tid >> 6), lane = tid & 63, wr = wid >> 2, wc = wid & 3, fr = lane & 15, fq = lane >> 4;
    const int K = g.K, nt = K / BK;
    unsigned voffA[2], voffB[2];
#pragma unroll
    for (int i = 0; i < 2; ++i) { int R, C; stage_rc(tid * 16 + i * 8192, R, C); const int Rb = Epi::PERM ? ((R & ~31) + perm32(R & 31)) : R;
        voffA[i] = (unsigned)(R * K + C) * 2u; voffB[i] = (unsigned)(Rb * K + C) * 2u; }
    unsigned vgc[2][2] = {{0u, 0u}, {0u, 0u}}, vgn[2][2] = {{0u, 0u}, {0u, 0u}}; int gR[2] = {0, 0}, gC[2] = {0, 0};
    if constexpr (GATHER) {
#pragma unroll
        for (int i = 0; i < 2; ++i) stage_rc(tid * 16 + i * 8192, gR[i], gC[i]); }
#define PG8_GSET(dst, unit) do { _Pragma("unroll") for (int _h = 0; _h < 2; ++_h) _Pragma("unroll") for (int _i = 0; _i < 2; ++_i) dst[_h][_i] = (unsigned)(S.src_row((unit).pm, _h * 128 + gR[_i]) * K + gC[_i]) * 2u; } while (0)
    const size_t kstep = (size_t)(BK * 2);
    const size_t hstep = (size_t)HALF * K * 2;
    const size_t tstep = 2 * hstep;
    const unsigned ldsw = (unsigned)wid * 1024u;
    const int aoff = lds_byte(wr * 64 + fr, fq * 8), boff = lds_byte(wc * 32 + fr, fq * 8);
#define PG8_SA(b, h) (((b) * 2 + (h)) * HTB)
#define PG8_SB(b, h) ((4 + (b) * 2 + (h)) * HTB)
#define PG8_STAGE(bufoff, gbase, voff) do { _Pragma("unroll") for (int _i = 0; _i < 2; ++_i) \
        __builtin_amdgcn_global_load_lds((const unsigned*)((const char*)(gbase) + (voff)[_i]), (PG8_LAS unsigned*)(lds + (bufoff) + ldsw + _i * 8192), 16, 0, 0); } while (0)
#define PG8_STAGE_A(bufoff, gbase, h, usenext) do { if constexpr (GATHER) { _Pragma("unroll") for (int _i = 0; _i < 2; ++_i) { const unsigned _o = (usenext) ? vgn[h][_i] : vgc[h][_i]; \
        __builtin_amdgcn_global_load_lds((const unsigned*)((const char*)(gbase) + _o), (PG8_LAS unsigned*)(lds + (bufoff) + ldsw + _i * 8192), 16, 0, 0); } } \
        else { PG8_STAGE(bufoff, (gbase) + (h) * hstep, voffA); } } while (0)
#define PG8_LDA(dst, b, h) do { _Pragma("unroll") for (int m = 0; m < 4; ++m) _Pragma("unroll") for (int k = 0; k < 2; ++k) dst[m][k] = *(const PG8_LAS bf16x8*)(lds + PG8_SA(b, h) + aoff + m * 2048 + k * 1024); } while (0)
#define PG8_LDB(dst, b, h) do { _Pragma("unroll") for (int n = 0; n < 2; ++n) _Pragma("unroll") for (int k = 0; k < 2; ++k) dst[n][k] = *(const PG8_LAS bf16x8*)(lds + PG8_SB(b, h) + boff + n * 2048 + k * 1024); } while (0)
#define PG8_MMA(ai, bj, At, Bt) do { __builtin_amdgcn_s_setprio(1); _Pragma("unroll") for (int m = 0; m < 4; ++m) _Pragma("unroll") for (int n = 0; n < 2; ++n) _Pragma("unroll") for (int k = 0; k < 2; ++k) \
        acc[ai][bj][m][n] = __builtin_amdgcn_mfma_f32_16x16x32_bf16(Bt[n][k], At[m][k], acc[ai][bj][m][n], 0, 0, 0); __builtin_amdgcn_s_setprio(0); } while (0)
#define PG8_WAIT_V(n) asm volatile("s_waitcnt vmcnt(" #n ")" ::: "memory")
#define PG8_WAIT_L(n) asm volatile("s_waitcnt lgkmcnt(" #n ")" ::: "memory")
#define PG8_BAR __builtin_amdgcn_s_barrier()
#define PG8_SCHED __builtin_amdgcn_sched_barrier(0)
    Unit cur, nxt; int ui = 0;
    if (!S.next(0, cur)) return;
    f32x4 acc[2][2][4][2];
#pragma unroll
    for (int a = 0; a < 2; ++a)
#pragma unroll
        for (int b = 0; b < 2; ++b)
#pragma unroll
            for (int m = 0; m < 4; ++m)
#pragma unroll
                for (int n = 0; n < 2; ++n) acc[a][b][m][n] = (f32x4){0.f, 0.f, 0.f, 0.f};
    bf16x8 At[4][2], B0[2][2], B1[2][2];
    const char* cA = GATHER ? (const char*)g.A : (const char*)g.A + (size_t)cur.pm * tstep; const char* cB = (const char*)g.Bt + (size_t)cur.pn * tstep;
    if constexpr (GATHER) PG8_GSET(vgc, cur);
    S.a_ready(cur);
    if constexpr (SP2) {
        PG8_STAGE(PG8_SB(0, 0), cB, voffB); PG8_STAGE(PG8_SB(0, 1), cB + hstep, voffB); PG8_STAGE_A(PG8_SA(0, 0), cA, 0, false); PG8_STAGE_A(PG8_SA(0, 1), cA, 1, false);
        if (wr == 1) PG8_BAR;
        PG8_WAIT_V(2); PG8_BAR;
        PG8_STAGE(PG8_SB(1, 0), cB + kstep, voffB); PG8_STAGE_A(PG8_SA(1, 0), cA + kstep, 0, false); PG8_STAGE(PG8_SB(1, 1), cB + hstep + kstep, voffB);
        PG8_WAIT_V(6); PG8_BAR;
    } else {
        PG8_STAGE(PG8_SB(0, 0), cB, voffB); PG8_STAGE(PG8_SA(0, 0), cA, voffA); PG8_STAGE(PG8_SB(0, 1), cB + hstep, voffB); PG8_STAGE(PG8_SA(0, 1), cA + hstep, voffA);
        if (wr == 1) PG8_BAR;
        PG8_WAIT_V(4); PG8_BAR;
        PG8_STAGE(PG8_SB(1, 0), cB + kstep, voffB); PG8_STAGE(PG8_SA(1, 0), cA + kstep, voffA); PG8_STAGE(PG8_SB(1, 1), cB + hstep + kstep, voffB);
        PG8_WAIT_V(6); PG8_BAR;
    }
    for (;;) {
        const bool has_next = S.next(ui + 1, nxt);
        const char* nA = GATHER ? cA : (has_next ? (const char*)g.A + (size_t)nxt.pm * tstep : cA); const char* nB = has_next ? (const char*)g.Bt + (size_t)nxt.pn * tstep : cB;
        if constexpr (GATHER) { if (has_next) PG8_GSET(vgn, nxt); }
        for (int t = 0; t < nt; t += 2) {
            const bool last = (t == nt - 2);
            const char* a1 = cA + (size_t)(t + 1) * kstep;
            const char* a2 = last ? nA : cA + (size_t)(t + 2) * kstep; const char* b2 = last ? nB : cB + (size_t)(t + 2) * kstep;
            const char* a3 = a2 + kstep; const char* b3 = b2 + kstep;
            if (last && has_next) S.a_ready(nxt);
            const bool unx = last && has_next;
            if constexpr (SP2) {
            PG8_LDB(B0, 0, 0); PG8_LDB(B1, 0, 1); PG8_SCHED; PG8_LDA(At, 0, 0); PG8_STAGE_A(PG8_SA(1, 1), a1, 1, false);
            PG8_WAIT_V(8); PG8_WAIT_L(0); PG8_BAR; PG8_MMA(0, 0, At, B0); PG8_MMA(0, 1, At, B1); PG8_BAR; PG8_SCHED;
            PG8_LDA(At, 0, 1); PG8_STAGE(PG8_SB(0, 0), b2, voffB); PG8_STAGE(PG8_SB(0, 1), b2 + hstep, voffB); PG8_STAGE_A(PG8_SA(0, 0), a2, 0, unx);
            PG8_WAIT_V(8); PG8_WAIT_L(0); PG8_BAR; PG8_MMA(1, 0, At, B0); PG8_MMA(1, 1, At, B1); PG8_BAR; PG8_SCHED;
            PG8_LDB(B0, 1, 0); PG8_LDB(B1, 1, 1); PG8_SCHED; PG8_LDA(At, 1, 0); PG8_STAGE_A(PG8_SA(0, 1), a2, 1, unx);
            PG8_WAIT_V(8); PG8_WAIT_L(0); PG8_BAR; PG8_MMA(0, 0, At, B0); PG8_MMA(0, 1, At, B1); PG8_BAR; PG8_SCHED;
            PG8_LDA(At, 1, 1); PG8_STAGE(PG8_SB(1, 0), b3, voffB); PG8_STAGE(PG8_SB(1, 1), b3 + hstep, voffB); PG8_STAGE_A(PG8_SA(1, 0), a3, 0, unx);
            PG8_WAIT_V(8); PG8_WAIT_L(0); PG8_BAR; PG8_MMA(1, 0, At, B0); PG8_MMA(1, 1, At, B1); PG8_BAR; PG8_SCHED;
            } else {
            PG8_LDB(B0, 0, 0); PG8_SCHED; PG8_LDA(At, 0, 0); PG8_STAGE(PG8_SA(1, 1), a1 + hstep, voffA);
            PG8_WAIT_L(8); PG8_BAR; PG8_WAIT_L(0); PG8_MMA(0, 0, At, B0); PG8_BAR; PG8_SCHED;
            PG8_LDB(B1, 0, 1); PG8_STAGE(PG8_SB(0, 0), b2, voffB);
            PG8_BAR; PG8_WAIT_L(0); PG8_MMA(0, 1, At, B1); PG8_BAR;
            PG8_LDA(At, 0, 1); PG8_STAGE(PG8_SA(0, 0), a2, voffA);
            PG8_BAR; PG8_WAIT_L(0); PG8_MMA(1, 0, At, B0); PG8_BAR; PG8_SCHED;
            PG8_STAGE(PG8_SB(0, 1), b2 + hstep, voffB);
            PG8_WAIT_V(6); PG8_BAR; PG8_MMA(1, 1, At, B1); PG8_BAR;
            PG8_LDB(B0, 1, 0); PG8_SCHED; PG8_LDA(At, 1, 0); PG8_STAGE(PG8_SA(0, 1), a2 + hstep, voffA);
            PG8_WAIT_L(8); PG8_BAR; PG8_WAIT_L(0); PG8_MMA(0, 0, At, B0); PG8_BAR; PG8_SCHED;
            PG8_LDB(B1, 1, 1); PG8_STAGE(PG8_SB(1, 0), b3, voffB);
            PG8_BAR; PG8_WAIT_L(0); PG8_MMA(0, 1, At, B1); PG8_BAR;
            PG8_LDA(At, 1, 1); PG8_STAGE(PG8_SA(1, 0), a3, voffA);
            PG8_BAR; PG8_WAIT_L(0); PG8_MMA(1, 0, At, B0); PG8_BAR; PG8_SCHED;
            PG8_STAGE(PG8_SB(1, 1), b3 + hstep, voffB);
            PG8_WAIT_V(6); PG8_BAR; PG8_MMA(1, 1, At, B1); PG8_BAR;
            }
        }
        if constexpr (ALIGN_EPI) { if (wr == 0) PG8_BAR; }
        if constexpr (!Epi::AFTER_DRAIN) { E(acc, cur, wr, wc, fr, fq); S.done(cur); }
        if (!has_next) break;
#pragma unroll
        for (int a = 0; a < 2; ++a)
#pragma unroll
            for (int b = 0; b < 2; ++b)
#pragma unroll
                for (int m = 0; m < 4; ++m)
#pragma unroll
                    for (int n = 0; n < 2; ++n) acc[a][b][m][n] = (f32x4){0.f, 0.f, 0.f, 0.f};
        cur = nxt; cA = nA; cB = nB; ++ui;
        if constexpr (GATHER) { _Pragma("unroll") for (int _h = 0; _h < 2; ++_h) _Pragma("unroll") for (int _i = 0; _i < 2; ++_i) vgc[_h][_i] = vgn[_h][_i]; }
        if constexpr (ALIGN_EPI) { if (wr == 1) PG8_BAR; }
    }
    PG8_WAIT_V(0);
    if constexpr (!ALIGN_EPI) { if (wr == 0) PG8_BAR; }
    PG8_BAR;
    if constexpr (Epi::AFTER_DRAIN) { E.fused(acc, cur, wr, wc, fr, fq, lds, wid, lane); S.done(cur); }
#undef PG8_SA
#undef PG8_STAGE_A
#undef PG8_GSET
#undef PG8_SB
#undef PG8_STAGE
#undef PG8_LDA
#undef PG8_LDB
#undef PG8_MMA
#undef PG8_WAIT_V
#undef PG8_WAIT_L
#undef PG8_BAR
#undef PG8_SCHED
}
}

#ifndef ONE_LAUNCH
#define ONE_LAUNCH 1
#endif
constexpr int NWAVES = 8, NTHR = 512;
constexpr int D = 1024, BATCH = 2, SEQ = 8192, CTXL = 256, GRIDW = 64;
constexpr int MX = BATCH * SEQ, MC = BATCH * CTXL, MALL = MX + MC;
constexpr int NCH = 132;
constexpr int NSLAB = 5632, NS1 = 3584, NS2 = 2048;
constexpr int NZM = 4416;
constexpr int Z_R = 0, Z_K = 1024, Z_V = 2048, Z_KK = 3072, Z_TW = 4096, Z_AD = 4160, Z_GS = 4224;
constexpr int C_R = 0, C_K = 1024, C_V = 2048, C_WD = 3072, C_AD = 3136, C_GD = 3200, C_XB = 0, C_GBR = 1024;
constexpr int NWIN = 7680;
constexpr int NEXP = 32, DEXP = 512, MAXT = 160;
constexpr float LN_EPS = 1e-5f, GN_EPS = 64e-5f;
constexpr float ALPHA = 1.189207115002721f;
constexpr size_t MiB = 1u << 20;
constexpr size_t WS_CTL = 0, CTL_ZERO_BYTES = 1 * MiB;
constexpr size_t WS_STATS = 1 * MiB, WS_TOKE = 1 * MiB + 256 * 1024, WS_TOKSLOT = 1 * MiB + 512 * 1024, WS_TOKW = 1 * MiB + 768 * 1024, WS_ROWW = 2 * MiB;
constexpr size_t WS_RWT = 2 * MiB + 512 * 1024;
constexpr size_t WS_S2T = 3 * MiB, WS_AGGA = 5 * MiB, WS_AGGH = 9 * MiB + 256 * 1024, WS_CIN = 13 * MiB + 512 * 1024;
constexpr size_t WS_PW = 18 * MiB;
constexpr size_t WS_S1 = 24 * MiB;
constexpr size_t WS_S2 = 139 * MiB + 512 * 1024;
constexpr size_t WS_ZM = 139 * MiB + 512 * 1024;
constexpr size_t WS_FB = 206 * MiB;
constexpr size_t WS_YLRU = 282 * MiB, WS_YWF = 24 * MiB, WS_YWB = 56 * MiB;
constexpr size_t WS_GATES = 140 * MiB;
constexpr size_t WS_MBUF = 204 * MiB;
constexpr size_t WS_W13 = 24 * MiB, WS_W2 = 88 * MiB;
constexpr size_t WS_H2 = 120 * MiB;
constexpr size_t WS_XS = 153 * MiB;
constexpr size_t WS_HBUF = 236 * MiB;
constexpr size_t WS_END = 314 * MiB;
static_assert(WS_S1 + (size_t)MALL * NS1 * 2 <= WS_S2 && WS_S2 + (size_t)MALL * NS2 * 2 <= WS_YLRU && WS_ZM + (size_t)MALL * NZM * 2 <= WS_YLRU && WS_YLRU + (size_t)MX * D * 2 <= WS_END, "ws map");
static_assert((WS_YLRU - WS_YWF) % (512 * 1024) == 0 && WS_H2 + (size_t)(MX + 1) * D * 2 <= WS_XS && WS_XS + (size_t)MAXT * 256 * D * 2 <= WS_HBUF && WS_HBUF + (size_t)MAXT * 256 * DEXP * 2 <= WS_END, "ws map 2");
constexpr size_t DO_H = 0, DO_WIN = 34 * MiB;
constexpr int CW_TMO = 0, CW_BAR = 4096, CW_MOD = 8192  , CW_ECNT = 32768  ;
constexpr int LDS_BYTES = 155648;
constexpr int MISC_OFF = LDS_BYTES - 1024;
constexpr int TILE_OFF = MISC_OFF - 2048;

#define GAS __attribute__((address_space(1)))
#define LAS __attribute__((address_space(3)))
typedef unsigned short bf16;
typedef unsigned v4u __attribute__((ext_vector_type(4)));
typedef unsigned v2u __attribute__((ext_vector_type(2)));
typedef float f32x4 __attribute__((ext_vector_type(4)));
typedef GAS unsigned gu32;
typedef short bf16x8 __attribute__((ext_vector_type(8)));
#define RLX_AGENT __ATOMIC_RELAXED, __HIP_MEMORY_SCOPE_AGENT
#define LDS_WAIT() asm volatile("s_waitcnt lgkmcnt(0)" ::: "memory")
#define VM_WAIT() asm volatile("s_waitcnt vmcnt(0)" ::: "memory")
#define DI __device__ __forceinline__
typedef __bf16 bf16x2_t __attribute__((ext_vector_type(2)));
typedef float f32x2 __attribute__((ext_vector_type(2)));
DI unsigned cvtpk_s(float lo, float hi) { const f32x2 v = {lo, hi}; const bf16x2_t b = __builtin_convertvector(v, bf16x2_t); return __builtin_bit_cast(unsigned, b); }
DI unsigned pk2(float lo, float hi) { return cvtpk_s(lo, hi); }
DI unsigned f2bf(float f) { return cvtpk_s(f, 0.f) & 0xffffu; }
DI float bf2f(unsigned short b) { return __builtin_bit_cast(float, ((unsigned)b) << 16); }
DI float bflo(unsigned w) { return __builtin_bit_cast(float, w << 16); }
DI float bfhi(unsigned w) { return __builtin_bit_cast(float, w & 0xffff0000u); }
constexpr float NL2E = -1.4426950408889634f;
DI float frcp(float x) { return __builtin_amdgcn_rcpf(x); }
DI float sigm(float x) { return 1.f / (1.f + __expf(-x)); }
DI float sigm_fast(float x) { return frcp(1.f + __expf(-x)); }
template <int CTRL> DI float dppf(float x) { return __builtin_bit_cast(float, __builtin_amdgcn_update_dpp(0, __builtin_bit_cast(int, x), CTRL, 0xF, 0xF, true)); }
template <int CTRL> DI float dppf_one(float x) { return __builtin_bit_cast(float, __builtin_amdgcn_update_dpp(0x3f800000, __builtin_bit_cast(int, x), CTRL, 0xF, 0xF, false)); }
DI float red4(float x) { x += dppf<0xB1>(x); x += dppf<0x4E>(x); return x; }
DI float red16(float x) { x += dppf<0xB1>(x); x += dppf<0x4E>(x); x += dppf<0x141>(x); x += dppf<0x140>(x); return x; }
DI float rdl(float v, int l) { return __builtin_bit_cast(float, __builtin_amdgcn_readlane(__builtin_bit_cast(int, v), l)); }
DI float wave_sum(float v) { v = red16(v); return (rdl(v, 0) + rdl(v, 16)) + (rdl(v, 32) + rdl(v, 48)); }

#define XB_TMO      128
#define XB_XCNT(j)  (256  + 64 * (j))
#define XB_XSUB(j)  (1280 + 64 * (j))
#define XB_XGEN(j)  (2304 + 64 * (j))
#define XB_TOP      3328
#define XB_TOPGEN   3392
#define XCD_BAR_WORDS 3456
#define XB_SPIN_CAP (1u << 18)

__device__ __forceinline__ unsigned xb_ld(unsigned* p)              { return __hip_atomic_load(p, __ATOMIC_RELAXED, __HIP_MEMORY_SCOPE_AGENT); }
__device__ __forceinline__ unsigned xb_add(unsigned* p, unsigned v) { return __hip_atomic_fetch_add(p, v, __ATOMIC_RELAXED, __HIP_MEMORY_SCOPE_AGENT); }
__device__ __forceinline__ unsigned xb_xcc_id() { return (unsigned)__builtin_amdgcn_s_getreg((3 << 11) | 20) & 0xFu; }
#define XB_SPIN(cond, bar) do { unsigned _sp = 0; while (cond) { __builtin_amdgcn_s_sleep(1); \
    if ((++_sp & 255u) == 0u) { if (xb_ld(&(bar)[XB_TMO])) break; if (_sp > XB_SPIN_CAP) { atomicAdd(&(bar)[XB_TMO], 1u); break; } } } } while (0)

struct XcdBarrier {
    unsigned* bar; unsigned x;
    volatile LAS unsigned* st;
};

__device__ __forceinline__ XcdBarrier xcd_barrier_post(unsigned* bar, volatile LAS unsigned* st) {
    XcdBarrier b; b.bar = bar; b.x = xb_xcc_id(); b.st = st;
    if (threadIdx.x == 0) (void)xb_add(&bar[XB_XCNT(b.x)], 1u);
    return b;
}
__device__ __forceinline__ void xcd_barrier_complete(unsigned* bar, unsigned x, unsigned& nloc, unsigned& nx) {
    const unsigned G = gridDim.x * gridDim.y * gridDim.z;
    unsigned sum, cnt, mine, sp = 0u;
    for (;;) {
        sum = 0u; cnt = 0u; mine = 0u;
#pragma unroll
        for (unsigned j = 0; j < 16; ++j) { const unsigned c = xb_ld(&bar[XB_XCNT(j)]); sum += c; cnt += (c > 0u) ? 1u : 0u; mine = (j == x) ? c : mine; }
        if (sum == G) break;
        __builtin_amdgcn_s_sleep(1);
        if ((++sp & 255u) == 0u) { if (xb_ld(&bar[XB_TMO])) break; if (sp > XB_SPIN_CAP) { atomicAdd(&bar[XB_TMO], 1u); break; } }
    }
    nloc = mine > 0u ? mine : 1u; nx = cnt > 0u ? cnt : 1u;
}

__device__ __forceinline__ void xcd_barrier(const XcdBarrier& b) {
    asm volatile("s_waitcnt vmcnt(0)" ::: "memory");
    __syncthreads();
    if (threadIdx.x == 0) {
        unsigned* bar = b.bar;
        __builtin_amdgcn_s_waitcnt(0);
        unsigned nloc = b.st[0], nx = b.st[1];
        if (nloc == 0u) { xcd_barrier_complete(bar, b.x, nloc, nx); b.st[0] = nloc; b.st[1] = nx; }
        const unsigned old = xb_add(&bar[XB_XSUB(b.x)], 1u);
        const unsigned gen = old / nloc;
        if (old + 1u == (gen + 1u) * nloc) {
            __builtin_amdgcn_fence(__ATOMIC_RELEASE, "agent");
            asm volatile("s_waitcnt vmcnt(0)" ::: "memory");
            const unsigned og = xb_add(&bar[XB_TOP], 1u);
            const unsigned tg = og / nx;
            if (og + 1u == (tg + 1u) * nx) xb_add(&bar[XB_TOPGEN], 1u);
            else XB_SPIN(xb_ld(&bar[XB_TOPGEN]) == tg, bar);
            __builtin_amdgcn_fence(__ATOMIC_ACQUIRE, "agent");
            xb_add(&bar[XB_XGEN(b.x)], 1u);
            asm volatile("s_waitcnt vmcnt(0)" ::: "memory");
        } else {
            XB_SPIN(xb_ld(&bar[XB_XGEN(b.x)]) == gen, bar);
            __builtin_amdgcn_fence(__ATOMIC_ACQUIRE, "agent");
            asm volatile("s_waitcnt vmcnt(0)" ::: "memory");
        }
    }
    __syncthreads();
}

struct Args { const float* in[39]; float* out; unsigned char* ws; int ph_lo, ph_hi; };

struct P {
    const float *x, *c, *ctx, *c_ctx, *w_ada, *b_ada, *w_in, *mu_a, *w0, *w2, *a0, *a2, *g2, *k_k, *k_a, *r_k, *gn_g, *gn_b, *conv_w, *conv_b,
        *lru_wa, *lru_ba, *lru_wx, *lru_bx, *lru_lam, *p_a, *p_b, *w_o, *ln1_g, *ln1_b, *router_g, *router_g_b, *router_e, *router_e_b, *e_w1, *e_w3, *e_w2, *ln2_g, *ln2_b;
    float* out; unsigned char* ws; unsigned char* dob;
    float* ctlf; unsigned* ctl;
};

DI float modv(const P& p, int v, int n) { return p.ctlf[CW_MOD + v * 6144 + n] + p.b_ada[n]; }
DI f32x4 modv4(const P& p, int v, int n) { return *(const f32x4*)(p.ctlf + CW_MOD + v * 6144 + n) + *(const f32x4*)(p.b_ada + n); }

DI void transpose_item(const float* W, int ldw, bf16* WT, int ldt, int k0, int n0, int drow0, LAS float* scr, int lane) {
#pragma unroll 8
    for (int i = 0; i < 32; ++i) { const int kk = 2 * i + (lane >> 5); scr[kk * 33 + (lane & 31)] = W[(size_t)(k0 + kk) * ldw + n0 + (lane & 31)]; }
    LDS_WAIT(); asm volatile("" ::: "memory");
    const int c = lane & 7;
#pragma unroll
    for (int j = 0; j < 4; ++j) { const int n = (lane >> 3) + 8 * j; const LAS float* s = scr + (8 * c) * 33 + n;
        v4u o; o.x = pk2(s[0 * 33], s[1 * 33]); o.y = pk2(s[2 * 33], s[3 * 33]); o.z = pk2(s[4 * 33], s[5 * 33]); o.w = pk2(s[6 * 33], s[7 * 33]);
        *(GAS v4u*)(WT + (size_t)(drow0 + n) * ldt + k0 + 8 * c) = o; }
    LDS_WAIT(); asm volatile("" ::: "memory");
}

DI void phase0(const P& p, LAS unsigned char* lds, int tid, int lane, int wave, int G) {
    LAS float* s3 = (LAS float*)lds;
    for (int item = blockIdx.x; item < 256; item += G) {
        const int kc = item >> 4, nc = item & 15;
        if (tid < 192) { const int v = tid >> 6, k = tid & 63; const float cv = (v < 2) ? p.c[v * D + kc * 64 + k] : p.c_ctx[kc * 64 + k]; s3[v * 64 + k] = cv * sigm(cv); }
        __syncthreads();
        if (tid < 384) { const int n = nc * 384 + tid; float a0 = 0.f, a1 = 0.f, a2 = 0.f;
            for (int k = 0; k < 64; ++k) { const float w = p.w_ada[(size_t)(kc * 64 + k) * 6144 + n]; a0 += s3[k] * w; a1 += s3[64 + k] * w; a2 += s3[128 + k] * w; }
            atomicAdd(p.ctlf + CW_MOD + n, a0); atomicAdd(p.ctlf + CW_MOD + 6144 + n, a1); atomicAdd(p.ctlf + CW_MOD + 2 * 6144 + n, a2); }
        __syncthreads();
    }
}
DI void phase0b(const P& p, LAS unsigned char* lds, int tid, int lane, int wave, int G) {
    LAS float* scr = (LAS float*)(lds + 4096 + wave * 16384);
    const int gw = blockIdx.x * NWAVES + wave, NGW = G * NWAVES;
    bf16* win_t = (bf16*)(p.dob + DO_WIN); bf16* pw = (bf16*)(p.ws + WS_PW);
    constexpr int I_IN = 16 * 233, I_P = 16 * 32;
    for (int it = gw; it < I_IN + 3 * I_P; it += NGW) {
        int r = it;
        if (r < I_IN) { const int kb = r / 233, nb = r % 233, n0 = nb * 32; transpose_item(p.w_in, 7456, win_t, D, kb * 64, n0, n0 + (n0 >= 3360 ? 224 : 0), scr, lane); continue; }
        r -= I_IN; const int wsel = r / I_P; r %= I_P; const int kb = r / 32, nb = r % 32;
        if (wsel == 0) transpose_item(p.p_a, D, pw, D, kb * 64, nb * 32, nb * 32, scr, lane);
        else if (wsel == 1) transpose_item(p.p_b, D, pw + (size_t)D * D, D, kb * 64, nb * 32, nb * 32, scr, lane);
        else transpose_item(p.w_o, D, pw + (size_t)2 * D * D, D, kb * 64, nb * 32, nb * 32, scr, lane);
    }
    { float* rwt = (float*)(p.ws + WS_RWT);
      for (int i = blockIdx.x * NTHR + tid; i < 48 * D; i += G * NTHR) { const int n = i >> 10, k = i & (D - 1); rwt[i] = n < 4 ? p.router_g[k * 4 + n] : (n < 36 ? p.router_e[k * 32 + (n - 4)] : 0.f); } }
    for (int i = blockIdx.x * NTHR + tid; i < 224 * D / 8; i += G * NTHR) ((GAS v4u*)(win_t + (size_t)3360 * D))[i] = (v4u){0u, 0u, 0u, 0u};
}

DI void phase1(const P& p, int lane, int wave, int G) {
    const int gw = blockIdx.x * NWAVES + wave, NGW = G * NWAVES;
    bf16* H = (bf16*)(p.dob + DO_H); float* stats = (float*)(p.ws + WS_STATS);
    f32x4 sc[2][4], sh[2][4]; int cv[2] = {-1, -1};
#pragma unroll
    for (int j = 0; j < 4; ++j) { sc[0][j] = sc[1][j] = sh[0][j] = sh[1][j] = (f32x4){0.f, 0.f, 0.f, 0.f}; }
    for (int m0 = gw; m0 < MALL; m0 += 2 * NGW) {
        f32x4 q[2][4]; float s[2] = {0.f, 0.f}; int mm[2]; mm[0] = m0; mm[1] = (m0 + NGW < MALL) ? m0 + NGW : m0;
#pragma unroll
        for (int rr = 0; rr < 2; ++rr) { const int m = mm[rr]; const float* xrow = (m < MX) ? p.x + (size_t)m * D : p.ctx + (size_t)(m - MX) * D; const GAS f32x4* xr = (const GAS f32x4*)xrow + lane;
#pragma unroll
            for (int j = 0; j < 4; ++j) { q[rr][j] = xr[64 * j]; s[rr] += (q[rr][j].x + q[rr][j].y) + (q[rr][j].z + q[rr][j].w); } }
#pragma unroll
        for (int rr = 0; rr < 2; ++rr) { const int m = mm[rr]; const int v = (m < MX) ? (m >> 13) : 2;
            if (v != cv[rr]) { cv[rr] = v;
#pragma unroll
                for (int j = 0; j < 4; ++j) { const int n = 256 * j + 4 * lane; sc[rr][j] = modv4(p, v, 1024 + n) + 1.f; sh[rr][j] = modv4(p, v, n); } }
            const float mean = wave_sum(s[rr]) * (1.f / D); float s2 = 0.f;
#pragma unroll
            for (int j = 0; j < 4; ++j) { q[rr][j] = q[rr][j] - mean; s2 += (q[rr][j].x * q[rr][j].x + q[rr][j].y * q[rr][j].y) + (q[rr][j].z * q[rr][j].z + q[rr][j].w * q[rr][j].w); }
            const float rstd = 1.f / sqrtf(wave_sum(s2) * (1.f / D) + LN_EPS);
            if (rr == 0 || mm[1] != mm[0]) {
                if (lane == 0) { stats[2 * m] = mean; stats[2 * m + 1] = rstd; }
                GAS v2u* o8 = (GAS v2u*)(H + (size_t)m * D) + lane;
#pragma unroll
                for (int j = 0; j < 4; ++j) { const f32x4 h = q[rr][j] * rstd * sc[rr][j] + sh[rr][j];
                    o8[64 * j] = (v2u){pk2(h[0], h[1]), pk2(h[2], h[3])}; } } }
    }
}

template <int ACT> struct EpiPlain {
    static constexpr bool PERM = true, AFTER_DRAIN = false;
    bf16* O; int ldc; bf16* O2; int ldc2; int split_tile;
    DI void operator()(const pg8::f32x4 (&acc)[2][2][4][2], const pg8::Unit& u, int wr, int wc, int fr, int fq) const {
        const bool second = u.pn >= split_tile; bf16* Ob = second ? O2 : O; const int ld = second ? ldc2 : ldc, pn = second ? u.pn - split_tile : u.pn;
        const int row0 = u.pm * 256 + wr * 64 + fr, col0 = pn * 256 + wc * 32 + 8 * fq;
#pragma unroll
        for (int ai = 0; ai < 2; ++ai)
#pragma unroll
            for (int m = 0; m < 4; ++m) { bf16* rowp = Ob + (size_t)(row0 + ai * 128 + m * 16) * ld + col0;
#pragma unroll
                for (int bj = 0; bj < 2; ++bj) { pg8::f32x4 v0 = acc[ai][bj][m][0], v1 = acc[ai][bj][m][1];
                    if (ACT == 1) {
#pragma unroll
                        for (int i = 0; i < 4; ++i) { v0[i] = sigm_fast(v0[i]); v1[i] = sigm_fast(v1[i]); } }
                    pg8::u32x4 w;
                    if (ACT == 1) { w.x = cvtpk_s(v0[0], v0[1]); w.y = cvtpk_s(v0[2], v0[3]); w.z = cvtpk_s(v1[0], v1[1]); w.w = cvtpk_s(v1[2], v1[3]); }
                    else { w.x = pg8::cvt_pk_bf16(v0[0], v0[1]); w.y = pg8::cvt_pk_bf16(v0[2], v0[3]); w.z = pg8::cvt_pk_bf16(v1[0], v1[1]); w.w = pg8::cvt_pk_bf16(v1[2], v1[3]); }
                    *(pg8::u32x4*)(rowp + bj * 128) = w; } }
    }
};
constexpr int LRU_TOFF = (int)((WS_YLRU - WS_YWF) / (512 * 1024));
struct EpiMix {
    static constexpr bool PERM = true, AFTER_DRAIN = false;
    const bf16* gates; bf16* mbuf;
    DI void operator()(const pg8::f32x4 (&acc)[2][2][4][2], const pg8::Unit& u, int wr, int wc, int fr, int fq) const {
        const bool isa = u.pm < 64; const int row0 = (isa ? u.pm : u.pm - LRU_TOFF) * 256 + wr * 64 + fr, col0 = (u.pn & 3) * 256 + wc * 32 + 8 * fq;
#pragma unroll
        for (int ai = 0; ai < 2; ++ai) {
            pg8::u32x4 gwv[4][2], oldv[4][2];
#pragma unroll
            for (int m = 0; m < 4; ++m)
#pragma unroll
                for (int bj = 0; bj < 2; ++bj) { const int row = row0 + ai * 128 + m * 16, col = col0 + bj * 128;
                    gwv[m][bj] = *(const pg8::u32x4*)(gates + (size_t)row * 2048 + (isa ? 0 : 1024) + col);
                    oldv[m][bj] = (pg8::u32x4){0u, 0u, 0u, 0u}; if (isa) oldv[m][bj] = *(const pg8::u32x4*)(mbuf + (size_t)row * D + col); }
#pragma unroll
            for (int m = 0; m < 4; ++m) { const int row = row0 + ai * 128 + m * 16;
#pragma unroll
                for (int bj = 0; bj < 2; ++bj) { const int col = col0 + bj * 128;
                    const pg8::u32x4 gw = gwv[m][bj];
                    bf16* mp = mbuf + (size_t)row * D + col;
                    const pg8::u32x4 old = oldv[m][bj];
                    const pg8::f32x4 v0 = acc[ai][bj][m][0], v1 = acc[ai][bj][m][1];
                    float r[8];
                    r[0] = v0[0] * bflo(gw.x) + bflo(old.x); r[1] = v0[1] * bfhi(gw.x) + bfhi(old.x); r[2] = v0[2] * bflo(gw.y) + bflo(old.y); r[3] = v0[3] * bfhi(gw.y) + bfhi(old.y);
                    r[4] = v1[0] * bflo(gw.z) + bflo(old.z); r[5] = v1[1] * bfhi(gw.z) + bfhi(old.z); r[6] = v1[2] * bflo(gw.w) + bflo(old.w); r[7] = v1[3] * bfhi(gw.w) + bfhi(old.w);
                    pg8::u32x4 w; w.x = pg8::cvt_pk_bf16(r[0], r[1]); w.y = pg8::cvt_pk_bf16(r[2], r[3]); w.z = pg8::cvt_pk_bf16(r[4], r[5]); w.w = pg8::cvt_pk_bf16(r[6], r[7]);
                    *(pg8::u32x4*)mp = w; } } }
    }
};
struct EpiT1 {
    static constexpr bool PERM = false, AFTER_DRAIN = false;
    const float* x; const float* stats; const float* modp; const float* b_ada; float* T1;
    DI void operator()(const pg8::f32x4 (&acc)[2][2][4][2], const pg8::Unit& u, int wr, int wc, int fr, int fq) const {
        const int row0 = u.pm * 256 + wr * 64 + fr, col0 = u.pn * 256 + wc * 32 + 4 * fq; const int b = (u.pm * 256) >> 13;
        pg8::f32x4 gt[2][2];
#pragma unroll
        for (int bj = 0; bj < 2; ++bj)
#pragma unroll
            for (int n = 0; n < 2; ++n) { const int c = col0 + bj * 128 + n * 16; gt[bj][n] = *(const pg8::f32x4*)(modp + b * 6144 + 2048 + c) + *(const pg8::f32x4*)(b_ada + 2048 + c); }
#pragma unroll
        for (int ai = 0; ai < 2; ++ai)
#pragma unroll
            for (int mh = 0; mh < 2; ++mh) {
                float mean[2], rs[2]; pg8::f32x4 xv[2][2][2];
#pragma unroll
                for (int mm = 0; mm < 2; ++mm) { const int row = row0 + ai * 128 + (2 * mh + mm) * 16; mean[mm] = stats[2 * row]; rs[mm] = stats[2 * row + 1] * ALPHA;
#pragma unroll
                    for (int bj = 0; bj < 2; ++bj)
#pragma unroll
                        for (int n = 0; n < 2; ++n) xv[mm][bj][n] = *(const pg8::f32x4*)(x + (size_t)row * D + col0 + bj * 128 + n * 16); }
#pragma unroll
                for (int mm = 0; mm < 2; ++mm) { const int m = 2 * mh + mm; const int row = row0 + ai * 128 + m * 16;
#pragma unroll
                    for (int bj = 0; bj < 2; ++bj)
#pragma unroll
                        for (int n = 0; n < 2; ++n) *(pg8::f32x4*)(T1 + (size_t)row * D + col0 + bj * 128 + n * 16) = (xv[mm][bj][n] - mean[mm]) * rs[mm] + gt[bj][n] * acc[ai][bj][m][n]; } }
    }
};
struct EpiSwiGLU {
    static constexpr bool PERM = true, AFTER_DRAIN = false;
    bf16* hb;
    DI void operator()(const pg8::f32x4 (&acc)[2][2][4][2], const pg8::Unit& u, int wr, int wc, int fr, int fq) const {
        const int row0 = u.pm * 256 + wr * 64 + fr, col0 = (u.pn & 3) * 128 + wc * 32 + 8 * fq;
#pragma unroll
        for (int ai = 0; ai < 2; ++ai)
#pragma unroll
            for (int m = 0; m < 4; ++m) { float r[8];
#pragma unroll
                for (int n = 0; n < 2; ++n)
#pragma unroll
                    for (int i = 0; i < 4; ++i) { const float a = acc[ai][0][m][n][i], b = acc[ai][1][m][n][i]; r[4 * n + i] = a * sigm_fast(a) * b; }
                pg8::u32x4 w; w.x = pg8::cvt_pk_bf16(r[0], r[1]); w.y = pg8::cvt_pk_bf16(r[2], r[3]); w.z = pg8::cvt_pk_bf16(r[4], r[5]); w.w = pg8::cvt_pk_bf16(r[6], r[7]);
                *(pg8::u32x4*)(hb + (size_t)(row0 + ai * 128 + m * 16) * DEXP + col0) = w; }
    }
};
struct EpiW2 {
    static constexpr bool PERM = true, AFTER_DRAIN = false;
    bf16* yb; const LAS int* tile; const int* s2t; const float* tokw;
    DI void operator()(const pg8::f32x4 (&acc)[2][2][4][2], const pg8::Unit& u, int wr, int wc, int fr, int fq) const {
        const int row0 = u.pm * 256 + wr * 64 + fr, col0 = (u.pn & 3) * 256 + wc * 32 + 8 * fq;
        const int ex = tile[u.pm], slot0 = (u.pm - tile[MAXT + ex]) * 256 + wr * 64 + fr, cnt = tile[MAXT + 64 + ex];
        int si[2][4]; float rwv[2][4];
#pragma unroll
        for (int ai = 0; ai < 2; ++ai)
#pragma unroll
            for (int m = 0; m < 4; ++m) { const int slot = slot0 + ai * 128 + m * 16; si[ai][m] = slot < cnt ? s2t[(size_t)ex * MX + slot] : -1; }
#pragma unroll
        for (int ai = 0; ai < 2; ++ai)
#pragma unroll
            for (int m = 0; m < 4; ++m) rwv[ai][m] = si[ai][m] >= 0 ? tokw[si[ai][m]] : 0.f;
#pragma unroll
        for (int ai = 0; ai < 2; ++ai)
#pragma unroll
            for (int m = 0; m < 4; ++m) { const int row = row0 + ai * 128 + m * 16; const float rw = rwv[ai][m];
#pragma unroll
                for (int bj = 0; bj < 2; ++bj) { const pg8::f32x4 v0 = acc[ai][bj][m][0] * rw, v1 = acc[ai][bj][m][1] * rw;
                    pg8::u32x4 w; w.x = pg8::cvt_pk_bf16(v0[0], v0[1]); w.y = pg8::cvt_pk_bf16(v0[2], v0[3]); w.z = pg8::cvt_pk_bf16(v1[0], v1[1]); w.w = pg8::cvt_pk_bf16(v1[2], v1[3]);
                    *(pg8::u32x4*)(yb + (size_t)row * D + col0 + bj * 128) = w; } }
    }
};
struct SchedMix : pg8::StaticOrder {
    __device__ bool next(int i, pg8::Unit& u) const { pg8::Unit t; if (!pg8::StaticOrder::next(i >> 1, t)) return false; const int w = i & 1; u.pm = w ? t.pm : t.pm + LRU_TOFF; u.pn = w ? t.pn : t.pn + 4; return true; }
};
struct SchedMoE {
    const LAS int* tile; int G, c; const int* s2t;
    DI int src_row(int T, int r) const { const int e = tile[T], slot = (T - tile[MAXT + e]) * 256 + r; return slot < tile[MAXT + 64 + e] ? (s2t[(size_t)e * MX + slot] >> 1) : MX; }
    __device__ bool next(int i, pg8::Unit& u) const { int L = i * G + c; const int U = tile[MAXT + 40] * 4; if (L >= U) return false;
        { const int q = U / pg8::NXCD, r = U % pg8::NXCD, xcd = L % pg8::NXCD, off = L / pg8::NXCD; L = (xcd < r ? xcd * (q + 1) : r * (q + 1) + (xcd - r) * q) + off; }
        const int T = L >> 2; u.pm = T; u.pn = tile[T] * 4 + (L & 3); return true; }
    DI void a_ready(const pg8::Unit&) const {}
    DI void done(const pg8::Unit&) const {}
};

DI int chunk_row0(int b, int ci) { return ci < 4 ? MX + b * CTXL + ci * 64 : b * SEQ + (ci - 4) * 64; }
DI float gelu_tanh(float x) { const float u = 0.7978845608028654f * (x + 0.044715f * x * x * x); const float t = 1.f - 2.f * frcp(1.f + __expf(2.f * u)); return 0.5f * x * (1.f + t); }
constexpr int NHS = 264;
constexpr int LR_WT = 0, LR_CW = 36864, LR_WV = 38400, LR_WVS = 6656;
DI void lru_setup(const P& p, LAS unsigned char* lds, int tid, int hb) {
    LAS bf16* WT = (LAS bf16*)(lds + LR_WT); LAS float* CW = (LAS float*)(lds + LR_CW);
    __syncthreads();
    for (int i = tid; i < 4 * 4096; i += NTHR) { const int m = i >> 12, k = (i >> 6) & 63, n = i & 63; const int e = m & 1;
        const float w = (m < 2 ? p.lru_wa : p.lru_wx)[((size_t)(e * 16 + hb) * 64 + k) * 64 + n]; WT[m * 4608 + n * 72 + k] = (bf16)f2bf(NL2E * w); }
    for (int i = tid; i < 6 * 64; i += NTHR) { const int r = i >> 6, c = i & 63; CW[i] = r < 5 ? p.conv_w[r * D + hb * 64 + c] : p.conv_b[hb * 64 + c]; }
    __syncthreads();
}
struct LruC { float ba[2][4], bx[2][4], sp8[2][4]; };
DI void lru_consts(const P& p, int hb, int l15, LruC& C) {
#pragma unroll
    for (int e = 0; e < 2; ++e)
#pragma unroll
        for (int nt = 0; nt < 4; ++nt) { const int c = hb * 64 + nt * 16 + l15; C.ba[e][nt] = NL2E * p.lru_ba[e * D + c]; C.bx[e][nt] = NL2E * p.lru_bx[e * D + c]; C.sp8[e][nt] = (8.f * NL2E) * log1pf(__expf(-p.lru_lam[e * D + c])); }
}
DI void hs_geom(int b, int hs, int& row0, int& tb, int& tlen) { if (hs < 8) { tb = hs * 32; row0 = MX + b * CTXL + tb; tlen = CTXL; } else { tb = (hs - 8) * 32; row0 = b * SEQ + tb; tlen = SEQ; } }
DI void lru_conv(const bf16* S, LAS unsigned char* lds, LAS unsigned char* wv, int lane, int hb, int rowb, int tb, int tlen) {
    LAS float* CW = (LAS float*)(lds + LR_CW); LAS bf16* XCB = (LAS bf16*)wv; LAS float* XC = (LAS float*)(wv + 2304);
    const int tau = lane >> 2, qd = lane & 3; const unsigned char* Sb = (const unsigned char*)S; const unsigned ob = (unsigned)((rowb + tau) * NS2 + C_XB + hb * 64 + qd * 16) * 2u;
    float a[16];
#pragma unroll
    for (int i4 = 0; i4 < 4; ++i4) { const f32x4 bv = *(const LAS f32x4*)(CW + 5 * 64 + qd * 16 + 4 * i4); a[4 * i4] = bv[0]; a[4 * i4 + 1] = bv[1]; a[4 * i4 + 2] = bv[2]; a[4 * i4 + 3] = bv[3]; }
    v4u w[5][2];
#pragma unroll
    for (int i = 0; i < 5; ++i) { const int t = tb + tau + i - 2; const bool ok = t >= 0 && t < tlen;
        const unsigned oi = ob + (unsigned)((i - 2) * NS2 * 2); w[i][0] = ok ? *(const v4u*)(Sb + oi) : (v4u){0u, 0u, 0u, 0u}; w[i][1] = ok ? *(const v4u*)(Sb + oi + 16) : (v4u){0u, 0u, 0u, 0u}; }
#pragma unroll
    for (int i = 0; i < 5; ++i)
#pragma unroll
        for (int hh = 0; hh < 2; ++hh) { const f32x4 c0 = *(const LAS f32x4*)(CW + i * 64 + qd * 16 + hh * 8), c1 = *(const LAS f32x4*)(CW + i * 64 + qd * 16 + hh * 8 + 4); const v4u x = w[i][hh];
            a[hh * 8 + 0] += c0[0] * bflo(x.x); a[hh * 8 + 1] += c0[1] * bfhi(x.x); a[hh * 8 + 2] += c0[2] * bflo(x.y); a[hh * 8 + 3] += c0[3] * bfhi(x.y);
            a[hh * 8 + 4] += c1[0] * bflo(x.z); a[hh * 8 + 5] += c1[1] * bfhi(x.z); a[hh * 8 + 6] += c1[2] * bflo(x.w); a[hh * 8 + 7] += c1[3] * bfhi(x.w); }
#pragma unroll
    for (int i4 = 0; i4 < 4; ++i4) *(LAS f32x4*)(XC + tau * 68 + qd * 16 + 4 * i4) = (f32x4){a[4 * i4], a[4 * i4 + 1], a[4 * i4 + 2], a[4 * i4 + 3]};
    *(LAS v4u*)(XCB + tau * 72 + qd * 16) = (v4u){pk2(a[0], a[1]), pk2(a[2], a[3]), pk2(a[4], a[5]), pk2(a[6], a[7])};
    *(LAS v4u*)(XCB + tau * 72 + qd * 16 + 8) = (v4u){pk2(a[8], a[9]), pk2(a[10], a[11]), pk2(a[12], a[13]), pk2(a[14], a[15])};
}
DI void lru_gates(LAS unsigned char* lds, LAS unsigned char* wv, int lane, int e, const LruC& C, float (&av)[4][4], float (&uv)[4][4]) {
    LAS bf16* WT = (LAS bf16*)(lds + LR_WT); LAS bf16* XCB = (LAS bf16*)wv; LAS float* XC = (LAS float*)(wv + 2304);
    const int l15 = lane & 15, g = lane >> 4;
    pg8::f32x4 zr[4], zi[4];
#pragma unroll
    for (int nt = 0; nt < 4; ++nt) { zr[nt] = (pg8::f32x4){0.f, 0.f, 0.f, 0.f}; zi[nt] = (pg8::f32x4){0.f, 0.f, 0.f, 0.f}; }
#pragma unroll
    for (int ks = 0; ks < 2; ++ks) { const bf16x8 ax = *(const LAS bf16x8*)(XCB + l15 * 72 + ks * 32 + g * 8);
#pragma unroll
        for (int nt = 0; nt < 4; ++nt) { const bf16x8 br = *(const LAS bf16x8*)(WT + e * 4608 + (nt * 16 + l15) * 72 + ks * 32 + g * 8), bi = *(const LAS bf16x8*)(WT + (2 + e) * 4608 + (nt * 16 + l15) * 72 + ks * 32 + g * 8);
            zr[nt] = __builtin_amdgcn_mfma_f32_16x16x32_bf16(ax, br, zr[nt], 0, 0, 0); zi[nt] = __builtin_amdgcn_mfma_f32_16x16x32_bf16(ax, bi, zi[nt], 0, 0, 0); } }
#pragma unroll
    for (int nt = 0; nt < 4; ++nt) {
        const f32x4 xr = (f32x4){zr[nt][0], zr[nt][1], zr[nt][2], zr[nt][3]} + C.ba[e][nt], xi = (f32x4){zi[nt][0], zi[nt][1], zi[nt][2], zi[nt][3]} + C.bx[e][nt];
        const f32x4 dr = (f32x4){__builtin_amdgcn_exp2f(xr[0]), __builtin_amdgcn_exp2f(xr[1]), __builtin_amdgcn_exp2f(xr[2]), __builtin_amdgcn_exp2f(xr[3])} + 1.f;
        const f32x4 di = (f32x4){__builtin_amdgcn_exp2f(xi[0]), __builtin_amdgcn_exp2f(xi[1]), __builtin_amdgcn_exp2f(xi[2]), __builtin_amdgcn_exp2f(xi[3])} + 1.f;
        const f32x4 la = (f32x4){frcp(dr[0]), frcp(dr[1]), frcp(dr[2]), frcp(dr[3])} * C.sp8[e][nt];
        const f32x4 ig = {frcp(di[0]), frcp(di[1]), frcp(di[2]), frcp(di[3])};
        const f32x4 a = {__builtin_amdgcn_exp2f(la[0]), __builtin_amdgcn_exp2f(la[1]), __builtin_amdgcn_exp2f(la[2]), __builtin_amdgcn_exp2f(la[3])};
        const f32x4 em = 1.f - a * a;
        const f32x4 sq = {__builtin_amdgcn_sqrtf(fmaxf(em[0], 0.f)), __builtin_amdgcn_sqrtf(fmaxf(em[1], 0.f)), __builtin_amdgcn_sqrtf(fmaxf(em[2], 0.f)), __builtin_amdgcn_sqrtf(fmaxf(em[3], 0.f))};
        const f32x4 xc = {XC[(4 * g + 0) * 68 + nt * 16 + l15], XC[(4 * g + 1) * 68 + nt * 16 + l15], XC[(4 * g + 2) * 68 + nt * 16 + l15], XC[(4 * g + 3) * 68 + nt * 16 + l15]};
        const f32x4 u = sq * ig * xc;
#pragma unroll
        for (int i = 0; i < 4; ++i) { av[nt][i] = a[i]; uv[nt][i] = u[i]; } }
}
DI float bperm(int srclane, float v) { return __builtin_bit_cast(float, __builtin_amdgcn_ds_bpermute(srclane * 4, __builtin_bit_cast(int, v))); }
template <int DIR> DI void lru_local(const float (&a)[4], const float (&u)[4], int l15, float (&hl)[4], float (&pl)[4], float (&PG)[4], float (&HG)[4]) {
    float h = 0.f, pr = 1.f;
#pragma unroll
    for (int q = 0; q < 4; ++q) { const int i = DIR ? 3 - q : q; h = a[i] * h + u[i]; pr *= a[i]; hl[i] = h; pl[i] = pr; }
#pragma unroll
    for (int gg = 0; gg < 4; ++gg) { PG[gg] = bperm(gg * 16 + l15, pr); HG[gg] = bperm(gg * 16 + l15, h); }
}
template <int PASS> DI void lru_unit(const P& p, LAS unsigned char* lds, int lane, int wave, int b, int hs, int hb, const LruC& C) {
    const bf16* S = (const bf16*)(p.ws + WS_S2); LAS unsigned char* wv = lds + LR_WV + wave * LR_WVS;
    const int l15 = lane & 15, g = lane >> 4; int row0, tb, tlen; hs_geom(b, hs, row0, tb, tlen);
    const size_t ao0 = ((size_t)(b * NHS + hs) * 2) * D + hb * 64 + l15;
    float av[4][4], uv[4][4], hl[4], pl[4], PG[4], HG[4];
    unsigned* FB = (unsigned*)(p.ws + WS_FB);
    if (PASS == 1) {
        float Af[4], Hf[4], Ab[4], Hb[4];
#pragma unroll
        for (int nt = 0; nt < 4; ++nt) { Af[nt] = 1.f; Hf[nt] = 0.f; Ab[nt] = 1.f; Hb[nt] = 0.f; }
#pragma unroll 1
        for (int band = 0; band < 2; ++band) { lru_conv(S, lds, wv, lane, hb, row0 + band * 16, tb + band * 16, tlen);
            lru_gates(lds, wv, lane, 0, C, av, uv);
#pragma unroll
            for (int nt = 0; nt < 4; ++nt) { lru_local<0>(av[nt], uv[nt], l15, hl, pl, PG, HG); float cc = Hf[nt], Pc = Af[nt], cm = cc, Pm = Pc;
#pragma unroll
                for (int gg = 0; gg < 4; ++gg) { if (gg == g) { cm = cc; Pm = Pc; } cc = PG[gg] * cc + HG[gg]; Pc *= PG[gg]; }
                Hf[nt] = cc; Af[nt] = Pc;
#pragma unroll
                for (int i = 0; i < 4; ++i) FB[(size_t)(row0 + band * 16 + 4 * g + i) * D + hb * 64 + nt * 16 + l15] = pk2(hl[i] + pl[i] * cm, pl[i] * Pm); }
            lru_gates(lds, wv, lane, 1, C, av, uv);
#pragma unroll
            for (int nt = 0; nt < 4; ++nt) { lru_local<1>(av[nt], uv[nt], l15, hl, pl, PG, HG); float A = PG[3], H = HG[3];
#pragma unroll
                for (int gg = 2; gg >= 0; --gg) { H = PG[gg] * H + HG[gg]; A *= PG[gg]; }
                Hb[nt] = Ab[nt] * H + Hb[nt]; Ab[nt] *= A; } }
        if (g == 0) { float* GA = (float*)(p.ws + WS_AGGA); float* GH = (float*)(p.ws + WS_AGGH);
#pragma unroll
            for (int nt = 0; nt < 4; ++nt) { GA[ao0 + nt * 16] = Af[nt]; GH[ao0 + nt * 16] = Hf[nt]; GA[ao0 + D + nt * 16] = Ab[nt]; GH[ao0 + D + nt * 16] = Hb[nt]; } }
    } else {
        const float* CI = (const float*)(p.ws + WS_CIN); bf16* Y = (bf16*)(p.ws + WS_YLRU);
        float Cf[4], Cb[4];
#pragma unroll
        for (int nt = 0; nt < 4; ++nt) { Cf[nt] = CI[ao0 + nt * 16]; Cb[nt] = CI[ao0 + D + nt * 16]; }
#pragma unroll 1
        for (int bq = 0; bq < 2; ++bq) { const int band = 1 - bq; lru_conv(S, lds, wv, lane, hb, row0 + band * 16, tb + band * 16, tlen);
            lru_gates(lds, wv, lane, 1, C, av, uv);
#pragma unroll
            for (int nt = 0; nt < 4; ++nt) { lru_local<1>(av[nt], uv[nt], l15, hl, pl, PG, HG); float c = Cb[nt], cm = c;
#pragma unroll
                for (int gg = 3; gg >= 0; --gg) { if (gg == g) cm = c; c = PG[gg] * c + HG[gg]; }
                Cb[nt] = c;
#pragma unroll
                for (int i = 0; i < 4; ++i) { const size_t yo = (size_t)(row0 + band * 16 + 4 * g + i) * D + hb * 64 + nt * 16 + l15;
                    const float gt = bf2f(S[(size_t)(row0 + band * 16 + 4 * g + i) * NS2 + C_GBR + hb * 64 + nt * 16 + l15]);
                    const unsigned fb = FB[yo];
                    Y[yo] = (bf16)f2bf((bflo(fb) + bfhi(fb) * Cf[nt] + hl[i] + pl[i] * cm) * gelu_tanh(gt)); } } }
    }
}
DI void lru_carry(const P& p, LAS unsigned char* lds, int tid, int G) {
    const float* A = (const float*)(p.ws + WS_AGGA); const float* H = (const float*)(p.ws + WS_AGGH); float* CI = (float*)(p.ws + WS_CIN);
    LAS float* XA = (LAS float*)lds; LAS float* XH = XA + 512;
    for (int wgi = blockIdx.x; wgi < 64; wgi += G) { const int seg = tid >> 6, chain = wgi * 64 + (tid & 63), c = chain & (D - 1), e = (chain >> 10) & 1, b = chain >> 11;
        float a[33], h[33]; float As = 1.f, Hs = 0.f;
#pragma unroll
        for (int k = 0; k < 33; ++k) { const int st = seg * 33 + k, hs = e ? (st < 8 ? 7 - st : 271 - st) : st; const size_t o = ((size_t)(b * NHS + hs) * 2 + e) * D + c; a[k] = A[o]; h[k] = H[o]; }
#pragma unroll
        for (int k = 0; k < 33; ++k) { Hs = a[k] * Hs + h[k]; As *= a[k]; }
        __syncthreads(); XA[tid] = As; XH[tid] = Hs; __syncthreads();
        float cy = 0.f;
        for (int sg = 0; sg < seg; ++sg) cy = XA[sg * 64 + (tid & 63)] * cy + XH[sg * 64 + (tid & 63)];
#pragma unroll
        for (int k = 0; k < 33; ++k) { const int st = seg * 33 + k, hs = e ? (st < 8 ? 7 - st : 271 - st) : st; CI[((size_t)(b * NHS + hs) * 2 + e) * D + c] = cy; cy = a[k] * cy + h[k]; } }
}

DI float tanh_fast(float x) { return 1.f - 2.f * frcp(1.f + __expf(2.f * x)); }
struct MixLd { v4u w; v4u n[4]; };
DI void mix_ld(const bf16* own, const bf16* const (&np)[4], int cb, MixLd& L) {
    L.w = *(const v4u*)(own + cb);
#pragma unroll
    for (int i = 0; i < 4; ++i) L.n[i] = *(const v4u*)(np[i] + cb);
}
DI void mix_do(const MixLd& L, const float (&nv)[4], const float* mu, int cb, float (&o)[8]) {
    const v4u w = L.w;
    const f32x4 m0 = *(const f32x4*)(mu + cb), m1 = *(const f32x4*)(mu + cb + 4);
    const float ow[8] = {bflo(w.x), bfhi(w.x), bflo(w.y), bfhi(w.y), bflo(w.z), bfhi(w.z), bflo(w.w), bfhi(w.w)};
    const float nb[8] = {bflo(L.n[0].x) * nv[0], bfhi(L.n[1].x) * nv[1], bflo(L.n[2].y) * nv[2], bfhi(L.n[3].y) * nv[3], bflo(L.n[0].z) * nv[0], bfhi(L.n[1].z) * nv[1], bflo(L.n[2].w) * nv[2], bfhi(L.n[3].w) * nv[3]};
#pragma unroll
    for (int i = 0; i < 4; ++i) { o[i] = ow[i] + m0[i] * (nb[i] - ow[i]); o[4 + i] = ow[4 + i] + m1[i] * (nb[4 + i] - ow[4 + i]); }
}
DI void mix_do2(const MixLd& L, const float (&nv)[4], const f32x4 m0, const f32x4 m1, float (&o)[8]) {
    const v4u w = L.w;
    const float ow[8] = {bflo(w.x), bfhi(w.x), bflo(w.y), bfhi(w.y), bflo(w.z), bfhi(w.z), bflo(w.w), bfhi(w.w)};
    const float nb[8] = {bflo(L.n[0].x) * nv[0], bfhi(L.n[1].x) * nv[1], bflo(L.n[2].y) * nv[2], bfhi(L.n[3].y) * nv[3], bflo(L.n[0].z) * nv[0], bfhi(L.n[1].z) * nv[1], bflo(L.n[2].w) * nv[2], bfhi(L.n[3].w) * nv[3]};
#pragma unroll
    for (int i = 0; i < 4; ++i) { o[i] = ow[i] + m0[i] * (nb[i] - ow[i]); o[4 + i] = ow[4 + i] + m1[i] * (nb[4 + i] - ow[4 + i]); }
}
DI void mix8(const bf16* own, const bf16* const (&np)[4], const float (&nv)[4], const float* mu, int cb, float (&o)[8]) { MixLd L; mix_ld(own, np, cb, L); mix_do(L, nv, mu, cb, o); }
DI void nbr_rows(const bf16* S, int b, int ci, int j, const bf16*& own, const bf16* (&np)[4], float (&nv)[4]) {
    const int row = chunk_row0(b, ci) + j; own = S + (size_t)row * NS1;
    if (ci >= 4) { const int gr = ci - 4; const bool v0 = j > 0, v1 = j < 63, v2 = gr > 0, v3 = gr < 127;
        np[0] = v0 ? own - NS1 : own; np[1] = v1 ? own + NS1 : own; np[2] = v2 ? own - (size_t)64 * NS1 : own; np[3] = v3 ? own + (size_t)64 * NS1 : own;
        nv[0] = v0 ? 1.f : 0.f; nv[1] = v1 ? 1.f : 0.f; nv[2] = v2 ? 1.f : 0.f; nv[3] = v3 ? 1.f : 0.f; }
    else { const int t = ci * 64 + j; const bool v0 = t > 0, v1 = t < CTXL - 1;
        np[0] = np[2] = v0 ? own - NS1 : own; np[1] = np[3] = v1 ? own + NS1 : own; nv[0] = nv[2] = v0 ? 1.f : 0.f; nv[1] = nv[3] = v1 ? 1.f : 0.f; }
}
DI float red8(float x) { x += dppf<0xB1>(x); x += dppf<0x4E>(x); x += dppf<0x141>(x); return x; }
DI void mix_store(bf16* zr, const f32x4 k0, const f32x4 k1, int it, int gi, int cb, const float (&o)[8]) {
    if (it < 2 || it == 4 || it == 5) { *(v4u*)(zr + cb) = (v4u){pk2(o[0], o[1]), pk2(o[2], o[3]), pk2(o[4], o[5]), pk2(o[6], o[7])}; }
    else if (it == 2 || it == 3) {
        *(v4u*)(zr + cb) = (v4u){pk2(o[0], o[1]), pk2(o[2], o[3]), pk2(o[4], o[5]), pk2(o[6], o[7])};
        float kr[8], ss = 0.f;
#pragma unroll
        for (int i = 0; i < 4; ++i) { kr[i] = o[i] * k0[i]; kr[4 + i] = o[4 + i] * k1[i]; ss += kr[i] * kr[i] + kr[4 + i] * kr[4 + i]; }
        ss = red8(ss); const float inv = __builtin_amdgcn_rsqf(ss + 1e-12f);
        *(v4u*)(zr + Z_KK + cb - C_K) = (v4u){pk2(kr[0] * inv, kr[1] * inv), pk2(kr[2] * inv, kr[3] * inv), pk2(kr[4] * inv, kr[5] * inv), pk2(kr[6] * inv, kr[7] * inv)}; }
    else if (gi < 392) { *(v4u*)(zr + Z_TW + cb - C_WD) = (v4u){pk2(tanh_fast(o[0]), tanh_fast(o[1])), pk2(tanh_fast(o[2]), tanh_fast(o[3])), pk2(tanh_fast(o[4]), tanh_fast(o[5])), pk2(tanh_fast(o[6]), tanh_fast(o[7]))}; }
    else if (gi < 400) { *(v4u*)(zr + Z_AD + cb - C_AD) = (v4u){pk2(o[0], o[1]), pk2(o[2], o[3]), pk2(o[4], o[5]), pk2(o[6], o[7])}; }
    else if (gi < 420) { *(v4u*)(zr + Z_GS + cb - C_GD) = (v4u){pk2(sigm_fast(o[0]), sigm_fast(o[1])), pk2(sigm_fast(o[2]), sigm_fast(o[3])), pk2(sigm_fast(o[4]), sigm_fast(o[5])), pk2(sigm_fast(o[6]), sigm_fast(o[7]))}; }
}
DI void mix_geom(int m, int& b, int& ci, int& j) { if (m < MX) { b = m >> 13; const int t = m & (SEQ - 1); ci = 4 + (t >> 6); j = t & 63; } else { const int t = (m - MX) & (CTXL - 1); b = (m - MX) >> 8; ci = t >> 6; j = t & 63; } }
DI void phase_mix(const P& p, int lane, int wave, int G) {
    const bf16* S = (const bf16*)(p.ws + WS_S1); bf16* Z = (bf16*)(p.ws + WS_ZM);
    const int gw = blockIdx.x * NWAVES + wave, NGW = G * NWAVES;
    f32x4 mu0[7], mu1[7], kk0[2], kk1[2];
#pragma unroll
    for (int it = 0; it < 7; ++it) { const int gi = lane + 64 * it; const int cb = (gi < 420 ? gi : 0) * 8; mu0[it] = *(const f32x4*)(p.mu_a + cb); mu1[it] = *(const f32x4*)(p.mu_a + cb + 4);
        if (it == 2 || it == 3) { kk0[it - 2] = *(const f32x4*)(p.k_k + cb - C_K); kk1[it - 2] = *(const f32x4*)(p.k_k + cb - C_K + 4); } }
    for (int m0 = gw; m0 < MALL; m0 += 2 * NGW) { const int m1 = m0 + NGW; const bool two = m1 < MALL; const int m1c = two ? m1 : m0;
        int b0, ci0, j0, b1, ci1, j1; mix_geom(m0, b0, ci0, j0); mix_geom(m1c, b1, ci1, j1);
        const bf16* own0; const bf16* np0[4]; float nv0[4]; nbr_rows(S, b0, ci0, j0, own0, np0, nv0);
        const bf16* own1; const bf16* np1[4]; float nv1[4]; nbr_rows(S, b1, ci1, j1, own1, np1, nv1);
        bf16* zr0 = Z + (size_t)m0 * NZM; bf16* zr1 = Z + (size_t)m1c * NZM;
#pragma unroll
        for (int it = 0; it < 7; ++it) { const int gi = lane + 64 * it; const int cb = (gi < 420 ? gi : 0) * 8; MixLd L0, L1; float o0[8], o1[8];
            mix_ld(own0, np0, cb, L0); mix_ld(own1, np1, cb, L1);
            mix_do2(L0, nv0, mu0[it], mu1[it], o0); mix_do2(L1, nv1, mu0[it], mu1[it], o1);
            const f32x4 kw0 = (it == 2 || it == 3) ? kk0[it == 3] : mu0[0], kw1 = (it == 2 || it == 3) ? kk1[it == 3] : mu0[0];
            mix_store(zr0, kw0, kw1, it, gi, cb, o0); if (two) mix_store(zr1, kw0, kw1, it, gi, cb, o1); }
    }
}
#define WK_BAR() do { asm volatile("s_waitcnt lgkmcnt(0)" ::: "memory"); __builtin_amdgcn_s_barrier(); asm volatile("" ::: "memory"); } while (0)
constexpr int WB_NB = NCH * 4;
constexpr int WB_AT = 0, WB_RT = 2304, WB_BC = 4608, WB_KC = 6912, WB_P4 = 9216, WB_GKT = 14336, WB_TT = 14848, WB_P5 = 15360, WB_VT = 16640, WB_PP = 17152, WB_MM = 17408, WB_SLOT = 18432;
constexpr int WB_W2T = 7 * WB_SLOT, WB_A2T = WB_W2T + 9216, WB_CST = WB_A2T + 9216, WB_FLG = WB_CST + 1024;
typedef short s16x4 __attribute__((ext_vector_type(4)));
DI v2u cvt2(float a, float b, float c, float d) { return (v2u){cvtpk_s(a, b), cvtpk_s(c, d)}; }
DI bf16x8 frag2(v2u lo, v2u hi) { return __builtin_bit_cast(bf16x8, (v4u){lo.x, lo.y, hi.x, hi.y}); }
DI float pfx16(float x) { x += dppf<0x111>(x); x += dppf<0x112>(x); x += dppf<0x114>(x); x += dppf<0x118>(x); return x; }
#define WB_LOADS(qq) do { const int sidx_ = (qq) >> 2, ci_ = e ? (sidx_ < 4 ? 3 - sidx_ : NCH + 3 - sidx_) : sidx_, pos_ = ((qq) & 3) * 16 + c, j_ = e ? 63 - pos_ : pos_; \
                    const bf16* zr = Z + (size_t)(chunk_row0(b, ci_) + j_) * NZM; \
                    _Pragma("unroll") for (int hh_ = 0; hh_ < 2; ++hh_) { const int c0 = h * 64 + 16 * g + 8 * hh_;     \
                        const v4u vk_ = *(const v4u*)(zr + Z_KK + c0), vr_ = *(const v4u*)(zr + Z_R + c0), vq_ = *(const v4u*)(zr + Z_K + c0); \
                        Lkk[2 * hh_] = (v2u){vk_.x, vk_.y}; Lkk[2 * hh_ + 1] = (v2u){vk_.z, vk_.w}; Lr[2 * hh_] = (v2u){vr_.x, vr_.y}; Lr[2 * hh_ + 1] = (v2u){vr_.z, vr_.w}; Lk[2 * hh_] = (v2u){vq_.x, vq_.y}; Lk[2 * hh_ + 1] = (v2u){vq_.z, vq_.w}; } \
                    Lv = *(const v2u*)(zr + Z_V + h * 64 + rg * 16 + 4 * g); \
                    tw[0] = *(const v4u*)(zr + Z_TW + g * 8); tw[1] = *(const v4u*)(zr + Z_TW + 32 + g * 8); ad[0] = *(const v4u*)(zr + Z_AD + g * 8); ad[1] = *(const v4u*)(zr + Z_AD + 32 + g * 8); } while (0)
DI void lds_wait_ge(volatile LAS int* f, int v, volatile LAS int* abortf) {
    int sp = 0;
    while (__builtin_amdgcn_readfirstlane(*f) < v) { __builtin_amdgcn_s_sleep(1); if (((++sp) & 63) == 0) { if (__builtin_amdgcn_readfirstlane(*abortf)) break; if (sp > (1 << 18)) { *abortf = 1; break; } } }
    asm volatile("" ::: "memory");
}
DI void wkv_blk_wg(const P& p, LAS unsigned char* lds, int tid, int lane, int wave, int unit) {
    const int xx = unit & 7, yy = unit >> 3, rg = yy & 3, scan = xx * 8 + (yy >> 2), e = scan & 1, h = (scan >> 1) & 15, b = scan >> 5;
    const bf16* Z = (const bf16*)(p.ws + WS_ZM);
    LAS bf16* W2T = (LAS bf16*)(lds + WB_W2T); LAS bf16* A2T = (LAS bf16*)(lds + WB_A2T); LAS float* CST = (LAS float*)(lds + WB_CST);
    __syncthreads();
    volatile LAS int* RDY = (volatile LAS int*)(lds + WB_FLG); volatile LAS int* CNS = RDY + 8; volatile LAS int* ABT = RDY + 16;
    if (tid < 32) RDY[tid] = 0;
    if (tid < 64) { const int ch = 16 * ((tid >> 2) & 3) + 4 * (tid >> 4) + (tid & 3);
        const float ka = p.k_a[h * 64 + ch]; CST[tid] = NL2E * p.w0[e * D + h * 64 + ch]; CST[64 + tid] = NL2E * p.a0[e * D + h * 64 + ch]; CST[128 + tid] = ka; CST[192 + tid] = 1.f - ka; }
    for (int i = tid; i < 4096; i += NTHR) { const int k = i >> 6, n = i & 63, pn = 16 * ((n >> 2) & 3) + 4 * (n >> 4) + (n & 3);     W2T[pn * 72 + k] = (bf16)f2bf(NL2E * p.w2[((size_t)e * 64 + k) * D + h * 64 + n]); A2T[pn * 72 + k] = (bf16)f2bf(NL2E * p.a2[((size_t)e * 64 + k) * D + h * 64 + n]); }
    __syncthreads();
    bf16* YW = (bf16*)(p.ws + (e ? WS_YWB : WS_YWF));
    const int c = lane & 15, g = lane >> 4;
    if (wave == 0) {
        __builtin_amdgcn_s_setprio(2);
        pg8::f32x4 Xt[4];
#pragma unroll
        for (int kt = 0; kt < 4; ++kt) Xt[kt] = (pg8::f32x4){0.f, 0.f, 0.f, 0.f};
        bf16* yp = YW + (size_t)(b * SEQ + (e ? SEQ - 1 - 4 * g : 4 * g)) * D + h * 64 + rg * 16 + c;
        int fnext = 0;
        int slot = 0, nblk = 0;
        v2u vtA, gkA, ttA, vtB, gkB, ttB; bf16x8 a1A[2], a2A[2], a1B[2], a2B[2];
#define SC_READS(S, sl_) do { const LAS bf16* AT_ = (const LAS bf16*)((sl_) + WB_AT); const LAS bf16* RT_ = (const LAS bf16*)((sl_) + WB_RT); \
            vt##S = *(const LAS v2u*)((const LAS bf16*)((sl_) + WB_VT) + c * 16 + 4 * g); gk##S = *(const LAS v2u*)((const LAS bf16*)((sl_) + WB_GKT) + c * 16 + 4 * g); \
            _Pragma("unroll") for (int sx = 0; sx < 2; ++sx) { a1##S[sx] = frag2(*(const LAS v2u*)(AT_ + c * 72 + 32 * sx + 4 * g), *(const LAS v2u*)(AT_ + c * 72 + 32 * sx + 16 + 4 * g)); \
                a2##S[sx] = frag2(*(const LAS v2u*)(RT_ + c * 72 + 32 * sx + 4 * g), *(const LAS v2u*)(RT_ + c * 72 + 32 * sx + 16 + 4 * g)); } \
            tt##S = *(const LAS v2u*)((const LAS bf16*)((sl_) + WB_TT) + c * 16 + 4 * g); } while (0)
#define SC_BODY(S, N, tt_) do { const int t = (tt_); LAS unsigned char* sl = lds + slot * WB_SLOT; \
            v2u xb[4]; \
            _Pragma("unroll") for (int kt = 0; kt < 4; ++kt) xb[kt] = cvt2(Xt[kt][0], Xt[kt][1], Xt[kt][2], Xt[kt][3]); \
            pg8::f32x4 C1 = __builtin_amdgcn_mfma_f32_16x16x16bf16_1k(__builtin_bit_cast(s16x4, gk##S), __builtin_bit_cast(s16x4, vt##S), (pg8::f32x4){0.f, 0.f, 0.f, 0.f}, 0, 0, 0); \
            pg8::f32x4 C2 = {0.f, 0.f, 0.f, 0.f}; \
            _Pragma("unroll") for (int sx = 0; sx < 2; ++sx) { const bf16x8 bx = frag2(xb[2 * sx], xb[2 * sx + 1]); C1 = __builtin_amdgcn_mfma_f32_16x16x32_bf16(a1##S[sx], bx, C1, 0, 0, 0); C2 = __builtin_amdgcn_mfma_f32_16x16x32_bf16(a2##S[sx], bx, C2, 0, 0, 0); } \
            __builtin_amdgcn_sched_barrier(0); \
              \
            bf16x8 p4f[4]; pg8::f32x4 xn[4], ppv[4]; const bf16x8 p5f = *(const LAS bf16x8*)((const LAS bf16*)(sl + WB_P5) + c * 40 + 8 * g); \
            _Pragma("unroll") for (int kt = 0; kt < 4; ++kt) p4f[kt] = *(const LAS bf16x8*)((const LAS bf16*)(sl + WB_P4) + (16 * kt + c) * 40 + 8 * g); \
            _Pragma("unroll") for (int kt = 0; kt < 4; ++kt) ppv[kt] = *(const LAS pg8::f32x4*)((const LAS float*)(sl + WB_PP) + 16 * kt + 4 * g); \
            const float v0_ = bflo(vt##S.x), v1_ = bfhi(vt##S.x), v2_ = bflo(vt##S.y), v3_ = bfhi(vt##S.y); \
            __builtin_amdgcn_sched_barrier(0); \
            const pg8::f32x4 SK = __builtin_amdgcn_mfma_f32_16x16x16bf16_1k(__builtin_bit_cast(s16x4, tt##S), __builtin_bit_cast(s16x4, cvt2(C1[0], C1[1], C1[2], C1[3])), (pg8::f32x4){0.f, 0.f, 0.f, 0.f}, 0, 0, 0); \
            const bf16x8 vs = __builtin_bit_cast(bf16x8, (v4u){cvtpk_s(v0_, SK[0]), cvtpk_s(v1_, SK[1]), cvtpk_s(v2_, SK[2]), cvtpk_s(v3_, SK[3])}); \
            _Pragma("unroll") for (int kt = 0; kt < 4; ++kt) xn[kt] = __builtin_amdgcn_mfma_f32_16x16x32_bf16(p4f[kt], vs, Xt[kt], 0, 0, 0); \
            const pg8::f32x4 Yt = __builtin_amdgcn_mfma_f32_16x16x32_bf16(p5f, vs, C2, 0, 0, 0); \
            asm volatile("s_waitcnt lgkmcnt(0)" ::: "memory"); \
            if (lane == 0) CNS[slot] = nblk + 1; \
            if (++slot == 7) { slot = 0; ++nblk; } \
            if (t + 1 < WB_NB) { \
                if (__builtin_amdgcn_readfirstlane(fnext) < nblk + 1) lds_wait_ge(RDY + slot, nblk + 1, ABT); \
                asm volatile("" ::: "memory"); \
                LAS unsigned char* sln = lds + slot * WB_SLOT; SC_READS(N, sln); fnext = RDY[slot == 6 ? 0 : slot + 1]; } \
            _Pragma("unroll") for (int kt = 0; kt < 4; ++kt) Xt[kt] = ppv[kt] * xn[kt]; \
            if (t >= 16) { \
                if (e) { yp[0] = (bf16)f2bf(Yt[0]); yp[-D] = (bf16)f2bf(Yt[1]); yp[-2 * D] = (bf16)f2bf(Yt[2]); yp[-3 * D] = (bf16)f2bf(Yt[3]); yp -= 16 * D; } \
                else { yp[0] = (bf16)f2bf(Yt[0]); yp[D] = (bf16)f2bf(Yt[1]); yp[2 * D] = (bf16)f2bf(Yt[2]); yp[3 * D] = (bf16)f2bf(Yt[3]); yp += 16 * D; } } } while (0)
        lds_wait_ge(RDY + 0, 1, ABT); SC_READS(A, lds); fnext = RDY[1];
        for (int t2 = 0; t2 < WB_NB; t2 += 2) { SC_BODY(A, B, t2); SC_BODY(B, A, t2 + 1); }
#undef SC_READS
#undef SC_BODY
        __builtin_amdgcn_s_setprio(0);
    } else {
        const int pw = wave - 1; LAS unsigned char* sl = lds + pw * WB_SLOT;
        LAS bf16* AT = (LAS bf16*)(sl + WB_AT); LAS bf16* RT = (LAS bf16*)(sl + WB_RT); LAS bf16* BC = (LAS bf16*)(sl + WB_BC); LAS bf16* KC = (LAS bf16*)(sl + WB_KC);
        LAS bf16* P4 = (LAS bf16*)(sl + WB_P4); LAS bf16* GKT = (LAS bf16*)(sl + WB_GKT); LAS bf16* TT = (LAS bf16*)(sl + WB_TT); LAS bf16* P5 = (LAS bf16*)(sl + WB_P5);
        LAS bf16* VT = (LAS bf16*)(sl + WB_VT); LAS float* PP = (LAS float*)(sl + WB_PP); LAS float* MM = (LAS float*)(sl + WB_MM);
        v2u Lkk[4], Lr[4], Lk[4], Lv; v4u tw[2], ad[2];
        { const int q = pw; WB_LOADS(q); }
        f32x4 w0v[4], a0v[4], kav[4], kbv[4];
#pragma unroll
        for (int nt = 0; nt < 4; ++nt) { w0v[nt] = *(const LAS f32x4*)(CST + 16 * nt + 4 * g); a0v[nt] = *(const LAS f32x4*)(CST + 64 + 16 * nt + 4 * g); kav[nt] = *(const LAS f32x4*)(CST + 128 + 16 * nt + 4 * g); kbv[nt] = *(const LAS f32x4*)(CST + 192 + 16 * nt + 4 * g); }
        f32x4 ltm, lem, gtm;
#pragma unroll
        for (int i = 0; i < 4; ++i) { const int ii = 4 * g + i; ltm[i] = ii < c ? 1.f : 0.f; lem[i] = ii <= c ? 1.f : 0.f; gtm[i] = c < ii ? 1.f : 0.f; }
        int nblk = 0;
        for (int q = pw; q < WB_NB; q += 7, ++nblk) {
            pg8::f32x4 zw[4], za[4];
            f32x4 ewv[4], kmv[4], bvv[4], kkf[4], rf[4];
            f32x4 at_[4], rt_[4], bc_[4], kc_[4], pp_[4];
#define WT_PRE(nt) do { zw[nt] = (pg8::f32x4){0.f, 0.f, 0.f, 0.f}; za[nt] = zw[nt]; \
                _Pragma("unroll") for (int ks = 0; ks < 2; ++ks) { const bf16x8 wa = *(const LAS bf16x8*)(W2T + ((nt) * 16 + c) * 72 + ks * 32 + g * 8), aa = *(const LAS bf16x8*)(A2T + ((nt) * 16 + c) * 72 + ks * 32 + g * 8); \
                    zw[nt] = __builtin_amdgcn_mfma_f32_16x16x32_bf16(wa, __builtin_bit_cast(bf16x8, tw[ks]), zw[nt], 0, 0, 0); za[nt] = __builtin_amdgcn_mfma_f32_16x16x32_bf16(aa, __builtin_bit_cast(bf16x8, ad[ks]), za[nt], 0, 0, 0); } \
                } while (0)
#define WT_AV(nt) do { const f32x4 kkv_ = {bflo(Lkk[nt].x), bfhi(Lkk[nt].x), bflo(Lkk[nt].y), bfhi(Lkk[nt].y)}, rv_ = {bflo(Lr[nt].x), bfhi(Lr[nt].x), bflo(Lr[nt].y), bfhi(Lr[nt].y)}, kv_ = {bflo(Lk[nt].x), bfhi(Lk[nt].x), bflo(Lk[nt].y), bfhi(Lk[nt].y)}; \
                const f32x4 xa_ = (f32x4){za[nt][0], za[nt][1], za[nt][2], za[nt][3]} + a0v[nt], xw_ = (f32x4){zw[nt][0], zw[nt][1], zw[nt][2], zw[nt][3]} + w0v[nt]; \
                const f32x4 da_ = (f32x4){__builtin_amdgcn_exp2f(xa_[0]), __builtin_amdgcn_exp2f(xa_[1]), __builtin_amdgcn_exp2f(xa_[2]), __builtin_amdgcn_exp2f(xa_[3])} + 1.f; \
                const f32x4 dw_ = (f32x4){__builtin_amdgcn_exp2f(xw_[0]), __builtin_amdgcn_exp2f(xw_[1]), __builtin_amdgcn_exp2f(xw_[2]), __builtin_amdgcn_exp2f(xw_[3])} + 1.f; \
                const f32x4 av_ = {frcp(da_[0]), frcp(da_[1]), frcp(da_[2]), frcp(da_[3])}; \
                ewv[nt] = (f32x4){frcp(dw_[0]), frcp(dw_[1]), frcp(dw_[2]), frcp(dw_[3])} * (0.6065306597126334f * NL2E);     \
                kmv[nt] = kv_ * (av_ * kav[nt] + kbv[nt]); bvv[nt] = kkv_ * av_; kkf[nt] = kkv_; rf[nt] = rv_; } while (0)
#define WT_BV(nt) do { const f32x4 inc_ = {pfx16(ewv[nt][0]), pfx16(ewv[nt][1]), pfx16(ewv[nt][2]), pfx16(ewv[nt][3])};     \
                const f32x4 E_ = {__builtin_amdgcn_exp2f(inc_[0]), __builtin_amdgcn_exp2f(inc_[1]), __builtin_amdgcn_exp2f(inc_[2]), __builtin_amdgcn_exp2f(inc_[3])};     \
                const f32x4 nEi_ = {frcp(-E_[0]), frcp(-E_[1]), frcp(-E_[2]), frcp(-E_[3])};     \
                const f32x4 Ep_ = {dppf_one<0x111>(E_[0]), dppf_one<0x111>(E_[1]), dppf_one<0x111>(E_[2]), dppf_one<0x111>(E_[3])};     \
                at_[nt] = kkf[nt] * Ep_; rt_[nt] = rf[nt] * E_; bc_[nt] = bvv[nt] * nEi_; kc_[nt] = -(kmv[nt] * nEi_); pp_[nt] = E_; } while (0)
#define WT_POST(nt) do { const int ko_ = c * 72 + 16 * (nt) + 4 * g; \
                *(LAS v2u*)(AT + ko_) = cvt2(at_[nt][0], at_[nt][1], at_[nt][2], at_[nt][3]); *(LAS v2u*)(RT + ko_) = cvt2(rt_[nt][0], rt_[nt][1], rt_[nt][2], rt_[nt][3]); \
                *(LAS v2u*)(BC + ko_) = cvt2(bc_[nt][0], bc_[nt][1], bc_[nt][2], bc_[nt][3]); *(LAS v2u*)(KC + ko_) = cvt2(kc_[nt][0], kc_[nt][1], kc_[nt][2], kc_[nt][3]); \
                const int so_ = 8 * (c >> 2) + 2 * (c & 3);                  \
                _Pragma("unroll") for (int i_ = 0; i_ < 4; ++i_) *(LAS unsigned*)(P4 + (16 * (nt) + 4 * g + i_) * 40 + so_) = cvtpk_s(kc_[nt][i_], bc_[nt][i_]);     \
                if (c == 15) *(LAS f32x4*)(PP + 16 * (nt) + 4 * g) = pp_[nt]; } while (0)
            WT_PRE(0); WT_AV(0); WT_BV(0); WT_PRE(1);
            lds_wait_ge(CNS + pw, nblk, ABT);
            WT_POST(0);
            VT[(4 * g + 0) * 16 + c] = (bf16)(Lv.x & 0xffffu); VT[(4 * g + 1) * 16 + c] = (bf16)(Lv.x >> 16); VT[(4 * g + 2) * 16 + c] = (bf16)(Lv.y & 0xffffu); VT[(4 * g + 3) * 16 + c] = (bf16)(Lv.y >> 16);
            WT_AV(1); WT_BV(1); WT_POST(1); WT_PRE(2); WT_AV(2); WT_BV(2); WT_POST(2); WT_PRE(3); WT_AV(3);
            if (q + 7 < WB_NB) WB_LOADS(q + 7);
            WT_BV(3); WT_POST(3);
#undef WT_PRE
#undef WT_AV
#undef WT_BV
#undef WT_POST
            {
                    __builtin_amdgcn_s_setprio(1);
                    pg8::f32x4 gb = {0.f, 0.f, 0.f, 0.f}, gk = gb, gbr = gb, gkr = gb, gbt = gb;
#pragma unroll
                    for (int ks = 0; ks < 2; ++ks) { const int o = c * 72 + ks * 32 + g * 8;
                        const bf16x8 fb = *(const LAS bf16x8*)(BC + o), fk = *(const LAS bf16x8*)(KC + o), fa = *(const LAS bf16x8*)(AT + o), fr = *(const LAS bf16x8*)(RT + o);
                        gb = __builtin_amdgcn_mfma_f32_16x16x32_bf16(fb, fa, gb, 0, 0, 0); gk = __builtin_amdgcn_mfma_f32_16x16x32_bf16(fk, fa, gk, 0, 0, 0);
                        gbr = __builtin_amdgcn_mfma_f32_16x16x32_bf16(fb, fr, gbr, 0, 0, 0); gkr = __builtin_amdgcn_mfma_f32_16x16x32_bf16(fk, fr, gkr, 0, 0, 0);
                        gbt = __builtin_amdgcn_mfma_f32_16x16x32_bf16(fa, fb, gbt, 0, 0, 0); }
                    const f32x4 m_ = -((f32x4){gb[0], gb[1], gb[2], gb[3]} * ltm), mt_ = -((f32x4){gbt[0], gbt[1], gbt[2], gbt[3]} * gtm), k_ = (f32x4){gk[0], gk[1], gk[2], gk[3]} * ltm,
                        kr_ = (f32x4){gkr[0], gkr[1], gkr[2], gkr[3]} * lem, br_ = (f32x4){gbr[0], gbr[1], gbr[2], gbr[3]} * lem;
                    *(LAS v2u*)(GKT + c * 16 + 4 * g) = cvt2(k_[0], k_[1], k_[2], k_[3]);
                    *(LAS v4u*)(P5 + c * 40 + 8 * g) = (v4u){cvtpk_s(kr_[0], br_[0]), cvtpk_s(kr_[1], br_[1]), cvtpk_s(kr_[2], br_[2]), cvtpk_s(kr_[3], br_[3])};
                    const v2u zq = {0u, 0u}; const pg8::f32x4 z4 = {0.f, 0.f, 0.f, 0.f};
#define MF_(a, b, acc) __builtin_amdgcn_mfma_f32_16x16x32_bf16(frag2(a, zq), frag2(b, zq), acc, 0, 0, 0)
#define CV_(x) cvt2((x)[0], (x)[1], (x)[2], (x)[3])
                    const v2u aM = cvt2(m_[0], m_[1], m_[2], m_[3]), bM = cvt2(mt_[0], mt_[1], mt_[2], mt_[3]);
                    pg8::f32x4 im;
#pragma unroll
                    for (int i = 0; i < 4; ++i) im[i] = ((4 * g + i) == c ? 1.f : 0.f) - m_[i];
                    const v2u aIM = CV_(im);
                    const pg8::f32x4 M2c = MF_(aM, bM, z4), M2a = MF_(bM, aM, z4);
                    const v2u aM2 = CV_(M2a), bM2 = CV_(M2c);
                    const pg8::f32x4 M4c = MF_(aM2, bM2, z4), M4a = MF_(bM2, aM2, z4);
                    const v2u aM4 = CV_(M4a), bM4 = CV_(M4c);
                    const pg8::f32x4 M8c = MF_(aM4, bM4, z4);
                    const v2u bM8 = CV_(M8c);
                    const pg8::f32x4 T1 = MF_(bM2, aIM, im);
                    const pg8::f32x4 T2 = MF_(bM4, CV_(T1), T1);
                    const pg8::f32x4 T3 = MF_(bM8, CV_(T2), T2);
                    *(LAS v2u*)(TT + c * 16 + 4 * g) = CV_(T3);
                    __builtin_amdgcn_s_setprio(0);
#undef MF_
#undef CV_
            }
            asm volatile("s_waitcnt lgkmcnt(0)" ::: "memory");
            if (lane == 0) RDY[pw] = nblk + 1;
        }
    }
}

constexpr int WO_RS = 0, WO_KS = 17408, WO_VS = 34816, WO_A2T = 52224, WO_G2T = 70656, WO_RHO = 92160;
DI void wkv_out_setup(const P& p, LAS unsigned char* lds, int tid, int h) {
    LAS bf16* A2T = (LAS bf16*)(lds + WO_A2T); LAS bf16* G2T = (LAS bf16*)(lds + WO_G2T);
    __syncthreads();
    for (int i = tid; i < 2 * 4096; i += NTHR) { const int e = i >> 12, k = (i >> 6) & 63, n = i & 63; A2T[e * 4608 + n * 72 + k] = (bf16)f2bf(p.a2[((size_t)e * 64 + k) * D + h * 64 + n]); }
    for (int i = tid; i < 160 * 64; i += NTHR) { const int k = i >> 6, n = i & 63; G2T[n * 168 + k] = (bf16)f2bf(p.g2[(size_t)k * D + h * 64 + n]); }
    __syncthreads();
}
struct WoPre { v4u r, k, v, a0, a1, a2, a3, a4; };
struct WoC { float c0[4], c1[4], ka[4], rk[4], gg[4], gb[4]; };
DI void wkv_out_consts(const P& p, int h, int l15, WoC& C) {
#pragma unroll
    for (int nt = 0; nt < 4; ++nt) { const int hc = h * 64 + nt * 16 + l15; C.c0[nt] = p.a0[hc]; C.c1[nt] = p.a0[D + hc]; C.ka[nt] = p.k_a[hc]; C.rk[nt] = p.r_k[hc]; C.gg[nt] = p.gn_g[hc]; C.gb[nt] = p.gn_b[hc]; }
}
DI void wkv_out_load(const P& p, int tid, int lane, int wave, int b, int gr, int h, WoPre& L) {
    const bf16* Z = (const bf16*)(p.ws + WS_ZM); const int row0 = chunk_row0(b, gr + 4);
    const int rb = wave & 3, half = wave >> 2, l15 = lane & 15, g = lane >> 4;
    const bf16* za_ = Z + (size_t)(row0 + rb * 16 + l15) * NZM;
    const v4u zz4 = {0u, 0u, 0u, 0u};
    if (half == 0) { L.a0 = *(const v4u*)(za_ + Z_AD + g * 8); L.a1 = *(const v4u*)(za_ + Z_AD + 32 + g * 8); L.a2 = zz4; L.a3 = zz4; L.a4 = zz4; }
    else { L.a0 = *(const v4u*)(za_ + Z_GS + g * 8); L.a1 = *(const v4u*)(za_ + Z_GS + 32 + g * 8); L.a2 = *(const v4u*)(za_ + Z_GS + 64 + g * 8); L.a3 = *(const v4u*)(za_ + Z_GS + 96 + g * 8); L.a4 = *(const v4u*)(za_ + Z_GS + 128 + g * 8); }
    { const int j = tid >> 3, cg = tid & 7; const bf16* zr = Z + (size_t)(row0 + j) * NZM + h * 64 + cg * 8;
        L.r = *(const v4u*)(zr + Z_R); L.k = *(const v4u*)(zr + Z_K); L.v = *(const v4u*)(zr + Z_V); }
}
DI void wkv_out_unit(const P& p, LAS unsigned char* lds, int tid, int lane, int wave, int b, int gr, int h, const WoC& C, const WoPre& L, bool has_next, int nb, int ngr, WoPre& N) {
    const int row0 = chunk_row0(b, gr + 4);
    LAS float* RS = (LAS float*)(lds + WO_RS); LAS float* KS = (LAS float*)(lds + WO_KS); LAS float* VS = (LAS float*)(lds + WO_VS);
    LAS bf16* A2T = (LAS bf16*)(lds + WO_A2T); LAS bf16* G2T = (LAS bf16*)(lds + WO_G2T); LAS float* RHO = (LAS float*)(lds + WO_RHO);
    const int rb = wave & 3, half = wave >> 2, l15 = lane & 15, g = lane >> 4;
    { const int j = tid >> 3, cg = tid & 7; const v4u r = L.r, k = L.k, v = L.v;
        *(LAS f32x4*)(RS + j * 68 + cg * 8) = (f32x4){bflo(r.x), bfhi(r.x), bflo(r.y), bfhi(r.y)}; *(LAS f32x4*)(RS + j * 68 + cg * 8 + 4) = (f32x4){bflo(r.z), bfhi(r.z), bflo(r.w), bfhi(r.w)};
        *(LAS f32x4*)(KS + j * 68 + cg * 8) = (f32x4){bflo(k.x), bfhi(k.x), bflo(k.y), bfhi(k.y)}; *(LAS f32x4*)(KS + j * 68 + cg * 8 + 4) = (f32x4){bflo(k.z), bfhi(k.z), bflo(k.w), bfhi(k.w)};
        *(LAS f32x4*)(VS + j * 68 + cg * 8) = (f32x4){bflo(v.x), bfhi(v.x), bflo(v.y), bfhi(v.y)}; *(LAS f32x4*)(VS + j * 68 + cg * 8 + 4) = (f32x4){bflo(v.z), bfhi(v.z), bflo(v.w), bfhi(v.w)}; }
    WK_BAR();
    if (has_next) wkv_out_load(p, tid, lane, wave, nb, ngr, h, N);
    bf16* YF = (bf16*)(p.ws + WS_YWF);
    float yn[4][4]; pg8::f32x4 zg[4];
    if (half == 0) {
        pg8::f32x4 z0[4], z1[4];
#pragma unroll
        for (int nt = 0; nt < 4; ++nt) { z0[nt] = (pg8::f32x4){0.f, 0.f, 0.f, 0.f}; z1[nt] = (pg8::f32x4){0.f, 0.f, 0.f, 0.f}; }
#pragma unroll
        for (int ks = 0; ks < 2; ++ks) { const bf16x8 aa = __builtin_bit_cast(bf16x8, ks == 0 ? L.a0 : L.a1);
#pragma unroll
            for (int nt = 0; nt < 4; ++nt) { const bf16x8 b0 = *(const LAS bf16x8*)(A2T + (nt * 16 + l15) * 72 + ks * 32 + g * 8), b1 = *(const LAS bf16x8*)(A2T + 4608 + (nt * 16 + l15) * 72 + ks * 32 + g * 8);
                z0[nt] = __builtin_amdgcn_mfma_f32_16x16x32_bf16(aa, b0, z0[nt], 0, 0, 0); z1[nt] = __builtin_amdgcn_mfma_f32_16x16x32_bf16(aa, b1, z1[nt], 0, 0, 0); } }
        float rho[4] = {0.f, 0.f, 0.f, 0.f};
#pragma unroll
        for (int nt = 0; nt < 4; ++nt) { const float c0 = C.c0[nt], c1 = C.c1[nt], ka = C.ka[nt], rk = C.rk[nt];
#pragma unroll
            for (int i = 0; i < 4; ++i) { const int o = (rb * 16 + 4 * g + i) * 68 + nt * 16 + l15;
                rho[i] += RS[o] * KS[o] * (2.f + (sigm_fast(z0[nt][i] + c0) + sigm_fast(z1[nt][i] + c1) - 2.f) * ka) * rk; } }
#pragma unroll
        for (int i = 0; i < 4; ++i) { const float r = red16(rho[i]); if (l15 == 0) RHO[rb * 16 + 4 * g + i] = r; }
    } else {
        const bf16* YB = (const bf16*)(p.ws + WS_YWB); unsigned short yfv[4][4], ybv[4][4];
#pragma unroll
        for (int nt = 0; nt < 4; ++nt)
#pragma unroll
            for (int i = 0; i < 4; ++i) { const size_t yo = (size_t)(row0 + rb * 16 + 4 * g + i) * D + h * 64 + nt * 16 + l15; yfv[nt][i] = YF[yo]; ybv[nt][i] = YB[yo]; }
#pragma unroll
        for (int nt = 0; nt < 4; ++nt) zg[nt] = (pg8::f32x4){0.f, 0.f, 0.f, 0.f};
#pragma unroll
        for (int ks = 0; ks < 5; ++ks) { const bf16x8 ag = __builtin_bit_cast(bf16x8, ks == 0 ? L.a0 : (ks == 1 ? L.a1 : (ks == 2 ? L.a2 : (ks == 3 ? L.a3 : L.a4))));
#pragma unroll
            for (int nt = 0; nt < 4; ++nt) { const bf16x8 bg = *(const LAS bf16x8*)(G2T + (nt * 16 + l15) * 168 + ks * 32 + g * 8); zg[nt] = __builtin_amdgcn_mfma_f32_16x16x32_bf16(ag, bg, zg[nt], 0, 0, 0); } }
        float sm[4] = {0.f, 0.f, 0.f, 0.f};
#pragma unroll
        for (int nt = 0; nt < 4; ++nt)
#pragma unroll
            for (int i = 0; i < 4; ++i) { yn[nt][i] = bf2f(yfv[nt][i]) + bf2f(ybv[nt][i]); sm[i] += yn[nt][i]; }
#pragma unroll
        for (int i = 0; i < 4; ++i) { const float mu = red16(sm[i]) * (1.f / 64.f); float q2 = 0.f;
#pragma unroll
            for (int nt = 0; nt < 4; ++nt) { yn[nt][i] -= mu; q2 += yn[nt][i] * yn[nt][i]; }
            const float rs = __builtin_amdgcn_rsqf(red16(q2) * (1.f / 64.f) + GN_EPS);
#pragma unroll
            for (int nt = 0; nt < 4; ++nt) yn[nt][i] *= rs; }
    }
    WK_BAR();
    if (half == 1) {
#pragma unroll
        for (int nt = 0; nt < 4; ++nt) { const int hc = h * 64 + nt * 16 + l15; const float gg = C.gg[nt], gb = C.gb[nt];
#pragma unroll
            for (int i = 0; i < 4; ++i) { const int tok = rb * 16 + 4 * g + i; const float ov = (yn[nt][i] * gg + gb + RHO[tok] * VS[tok * 68 + nt * 16 + l15]) * zg[nt][i];
                YF[(size_t)(row0 + tok) * D + hc] = (bf16)f2bf(ov); } }
    }
    WK_BAR();
}

DI void expert_weights(const P& p, LAS unsigned char* lds, int lane, int wave, int G) {
    LAS float* scr = (LAS float*)(lds + wave * 16384);
    const int gw = blockIdx.x * NWAVES + wave, NGW = G * NWAVES;
    bf16* w13 = (bf16*)(p.ws + WS_W13); bf16* w2t = (bf16*)(p.ws + WS_W2);
    constexpr int I13 = 16 * 16, I2 = 8 * 32;
    for (int it = gw; it < NEXP * (2 * I13 + I2); it += NGW) { const int ex = it / (2 * I13 + I2); int r = it % (2 * I13 + I2);
        if (r < 2 * I13) { const int which = r / I13; r %= I13; const int kb = r / 16, nb = r % 16, n0 = nb * 32;
            if (which) transpose_item(p.e_w3 + (size_t)ex * D * DEXP, DEXP, w13 + (size_t)ex * D * D, D, kb * 64, n0, 256 * (n0 >> 7) + 128 + (n0 & 127), scr, lane);
            else transpose_item(p.e_w1 + (size_t)ex * D * DEXP, DEXP, w13 + (size_t)ex * D * D, D, kb * 64, n0, 256 * (n0 >> 7) + (n0 & 127), scr, lane); }
        else { r -= 2 * I13; const int kb = r / 32, nb = r % 32; transpose_item(p.e_w2 + (size_t)ex * DEXP * D, D, w2t + (size_t)ex * D * DEXP, DEXP, kb * 64, nb * 32, nb * 32, scr, lane); } }
}

constexpr int RT_AX = 0, RT_AXS = 1032, RT_PART = 66048, RT_LOG = 90624, RT_RE = 92928, RT_PRM = 93696  ;
DI void phase_route(const P& p, LAS unsigned char* lds, int tid, int lane, int wave, int G) {
    LAS float* AX = (LAS float*)(lds + RT_AX); LAS float* PART = (LAS float*)(lds + RT_PART); LAS float* LOG = (LAS float*)(lds + RT_LOG); LAS int* RE = (LAS int*)(lds + RT_RE);
    float* T1 = p.out; bf16* H2 = (bf16*)(p.ws + WS_H2); float* ST2 = (float*)(p.ws + WS_ROWW);
    int* TOKE = (int*)(p.ws + WS_TOKE); int* TOKSLOT = (int*)(p.ws + WS_TOKSLOT); float* TOKW = (float*)(p.ws + WS_TOKW); int* S2T = (int*)(p.ws + WS_S2T);
    if (blockIdx.x == 0) for (int i = tid; i < D / 8; i += NTHR) ((GAS v4u*)(H2 + (size_t)MX * D))[i] = (v4u){0u, 0u, 0u, 0u};
    const int l15 = lane & 15, g = lane >> 4;
    f32x4 breg[8][3];
    { const float* rwt = (const float*)(p.ws + WS_RWT);
#pragma unroll
      for (int m = 0; m < 8; ++m)
#pragma unroll
          for (int nt = 0; nt < 3; ++nt) breg[m][nt] = *(const f32x4*)(rwt + (size_t)(nt * 16 + l15) * D + 128 * wave + 16 * m + 4 * g); }
    __syncthreads();
    LAS float* PRM = (LAS float*)(lds + RT_PRM);
    for (int blk = blockIdx.x; blk < MX / 64; blk += G) {
        f32x4 q[2][4];
        { const int bsel = (blk * 64) >> 13;
          __syncthreads();
          for (int n = tid; n < D; n += NTHR) { PRM[n] = p.ln1_g[n]; PRM[D + n] = p.ln1_b[n]; PRM[2 * D + n] = modv(p, bsel, 4 * 1024 + n) + 1.f; PRM[3 * D + n] = modv(p, bsel, 3 * 1024 + n); }
          __syncthreads(); }
#pragma unroll
        for (int rr = 0; rr < 2; ++rr) { const GAS f32x4* tr = (const GAS f32x4*)(T1 + (size_t)(blk * 64 + 2 * wave + rr) * D) + lane;
#pragma unroll
            for (int j = 0; j < 4; ++j) q[rr][j] = tr[64 * j]; }
        for (int it = 0; it < 4; ++it) {
#pragma unroll
            for (int rr = 0; rr < 2; ++rr) { const int rl = 2 * wave + rr, m = blk * 64 + it * 16 + rl; const int bsel = m >> 13;
                GAS f32x4* tr = (GAS f32x4*)(T1 + (size_t)m * D) + lane; float s = 0.f;
#pragma unroll
                for (int j = 0; j < 4; ++j) s += (q[rr][j].x + q[rr][j].y) + (q[rr][j].z + q[rr][j].w);
                const float mean = wave_sum(s) * (1.f / D); float s2 = 0.f;
#pragma unroll
                for (int j = 0; j < 4; ++j) { q[rr][j] = q[rr][j] - mean; s2 += (q[rr][j].x * q[rr][j].x + q[rr][j].y * q[rr][j].y) + (q[rr][j].z * q[rr][j].z + q[rr][j].w * q[rr][j].w); }
                const float rstd = 1.f / sqrtf(wave_sum(s2) * (1.f / D) + LN_EPS);
                if (lane == 0) { ST2[2 * m] = mean; ST2[2 * m + 1] = rstd; }
                GAS v2u* o8 = (GAS v2u*)(H2 + (size_t)m * D) + lane;
#pragma unroll
                for (int j = 0; j < 4; ++j) { const int n = 256 * j + 4 * lane; const f32x4 gg = *(const LAS f32x4*)(PRM + n), bb = *(const LAS f32x4*)(PRM + D + n);
                    const f32x4 x1 = q[rr][j] * rstd * gg + bb; const f32x4 hh = x1 * *(const LAS f32x4*)(PRM + 2 * D + n) + *(const LAS f32x4*)(PRM + 3 * D + n);
                    o8[64 * j] = (v2u){pk2(hh[0], hh[1]), pk2(hh[2], hh[3])};
                    *(LAS f32x4*)(AX + rl * RT_AXS + n) = hh; } }
            if (it < 3) {
#pragma unroll
                for (int rr = 0; rr < 2; ++rr) { const GAS f32x4* tr = (const GAS f32x4*)(T1 + (size_t)(blk * 64 + (it + 1) * 16 + 2 * wave + rr) * D) + lane;
#pragma unroll
                    for (int j = 0; j < 4; ++j) q[rr][j] = tr[64 * j]; } }
            WK_BAR();
            { f32x4 acc[3];
#pragma unroll
              for (int nt = 0; nt < 3; ++nt) acc[nt] = (f32x4){0.f, 0.f, 0.f, 0.f};
#pragma unroll
              for (int m = 0; m < 8; ++m) { const f32x4 a4 = *(const LAS f32x4*)(AX + l15 * RT_AXS + 128 * wave + 16 * m + 4 * g);
#pragma unroll
                  for (int sx = 0; sx < 4; ++sx)
#pragma unroll
                      for (int nt = 0; nt < 3; ++nt) acc[nt] = __builtin_amdgcn_mfma_f32_16x16x4f32(a4[sx], breg[m][nt][sx], acc[nt], 0, 0, 0); }
#pragma unroll
              for (int nt = 0; nt < 3; ++nt)
#pragma unroll
                  for (int i = 0; i < 4; ++i) PART[(wave * 16 + 4 * g + i) * 48 + nt * 16 + l15] = acc[nt][i]; }
            WK_BAR();
            for (int i = tid; i < 16 * 36; i += NTHR) { const int row = i / 36, qq = i % 36; float a = qq < 4 ? p.router_g_b[qq] : p.router_e_b[qq - 4];
#pragma unroll
                for (int w = 0; w < 8; ++w) a += PART[(w * 16 + row) * 48 + qq];
                LOG[row * 36 + qq] = a; }
            WK_BAR();
            if (tid < 16) { const int m = blk * 64 + it * 16 + tid; float lg[36];
#pragma unroll
                for (int i = 0; i < 36; ++i) lg[i] = LOG[tid * 36 + i];
                int gs = 0; float gm = lg[0];
#pragma unroll
                for (int i = 1; i < 4; ++i) if (lg[i] > gm) { gm = lg[i]; gs = i; }
                float den = 0.f;
#pragma unroll
                for (int i = 0; i < 4; ++i) den += __expf(lg[i] - gm);
                const float pg = 1.f / den;
                float ev[8];
#pragma unroll
                for (int i = 0; i < 8; ++i) ev[i] = gs == 0 ? lg[4 + i] : (gs == 1 ? lg[12 + i] : (gs == 2 ? lg[20 + i] : lg[28 + i]));
                int i1 = 0; float v1 = ev[0];
#pragma unroll
                for (int i = 1; i < 8; ++i) if (ev[i] > v1) { v1 = ev[i]; i1 = i; }
                int i2 = -1; float v2 = -3.0e38f;
#pragma unroll
                for (int i = 0; i < 8; ++i) if (i != i1 && ev[i] > v2) { v2 = ev[i]; i2 = i; }
                if (i2 < 0) { i2 = (i1 + 1) & 7; v2 = v1; }
                const float e2 = __expf(v2 - v1); const float w1 = pg / (1.f + e2), w2 = pg * e2 / (1.f + e2);
                RE[(it * 16 + tid) * 2] = gs * 8 + i1; RE[(it * 16 + tid) * 2 + 1] = gs * 8 + i2; TOKW[2 * m] = w1; TOKW[2 * m + 1] = w2; TOKE[2 * m] = gs * 8 + i1; TOKE[2 * m + 1] = gs * 8 + i2; }
            WK_BAR();
        }
        if (wave == 0) {
            const int e0 = RE[lane], e1 = RE[lane + 64]; int r0 = 0, r1 = 0, cex = 0;
#pragma unroll 4
            for (int ex = 0; ex < NEXP; ++ex) { const unsigned long long m0 = __builtin_amdgcn_ballot_w64(e0 == ex), m1 = __builtin_amdgcn_ballot_w64(e1 == ex);
                const int n0 = __builtin_popcountll(m0);
                const int b0 = (int)__builtin_amdgcn_mbcnt_hi((unsigned)(m0 >> 32), __builtin_amdgcn_mbcnt_lo((unsigned)m0, 0u)), b1 = (int)__builtin_amdgcn_mbcnt_hi((unsigned)(m1 >> 32), __builtin_amdgcn_mbcnt_lo((unsigned)m1, 0u));
                if (e0 == ex) r0 = b0; if (e1 == ex) r1 = n0 + b1; if (lane == ex) cex = n0 + __builtin_popcountll(m1); }
            int base = 0; if (lane < NEXP && cex) base = (int)atomicAdd(p.ctl + CW_ECNT + lane, (unsigned)cex);
            const int s0 = __builtin_amdgcn_ds_bpermute(e0 * 4, base) + r0, s1 = __builtin_amdgcn_ds_bpermute(e1 * 4, base) + r1;
            const int i0 = lane, i1 = lane + 64, m0r = blk * 64 + (i0 >> 1), m1r = blk * 64 + (i1 >> 1);
            TOKSLOT[2 * m0r + (i0 & 1)] = s0; S2T[(size_t)e0 * MX + s0] = 2 * m0r + (i0 & 1);
            TOKSLOT[2 * m1r + (i1 & 1)] = s1; S2T[(size_t)e1 * MX + s1] = 2 * m1r + (i1 & 1); }
        __syncthreads();
    }
}
DI void build_tiles(const P& p, LAS int* tile, int tid) {
    if (tid == 0) { int T = 0;
        for (int e = 0; e < NEXP; ++e) { tile[MAXT + e] = T; const int c = (int)__hip_atomic_load(p.ctl + CW_ECNT + e, RLX_AGENT); tile[MAXT + 64 + e] = c; const int nt = (c + 255) >> 8; for (int i = 0; i < nt; ++i) tile[T + i] = e; T += nt; }
        tile[MAXT + 32] = T; tile[MAXT + 40] = T; }
    __syncthreads();
}
DI void phase_final(const P& p, LAS int* tile, int lane, int wave, int G) {
    const int gw = blockIdx.x * NWAVES + wave, NGW = G * NWAVES; const bf16* YB = (const bf16*)(p.ws + WS_XS);
    const int* TOKE = (const int*)(p.ws + WS_TOKE); const int* TOKSLOT = (const int*)(p.ws + WS_TOKSLOT); const float* ST2 = (const float*)(p.ws + WS_ROWW);
    f32x4 g1[4], b1[4], g2[4], b2[4], gt[2][4]; int gv[2] = {-1, -1};
#pragma unroll
    for (int j = 0; j < 4; ++j) { const int n = 256 * j + 4 * lane; g1[j] = *(const f32x4*)(p.ln1_g + n); b1[j] = *(const f32x4*)(p.ln1_b + n); g2[j] = *(const f32x4*)(p.ln2_g + n); b2[j] = *(const f32x4*)(p.ln2_b + n); gt[0][j] = gt[1][j] = (f32x4){0.f, 0.f, 0.f, 0.f}; }
    for (int m0 = gw; m0 < MX; m0 += 2 * NGW) { int mm[2]; mm[0] = m0; mm[1] = (m0 + NGW < MX) ? m0 + NGW : m0;
        f32x4 q[2][4]; float s[2] = {0.f, 0.f};
#pragma unroll
        for (int rr = 0; rr < 2; ++rr) { const int m = mm[rr]; const int bsel = m >> 13; const float mean1 = ST2[2 * m], rstd1 = ST2[2 * m + 1];
            if (bsel != gv[rr]) { gv[rr] = bsel;
#pragma unroll
                for (int j = 0; j < 4; ++j) gt[rr][j] = modv4(p, bsel, 5 * 1024 + 256 * j + 4 * lane); }
            const int r0 = tile[MAXT + TOKE[2 * m]] * 256 + TOKSLOT[2 * m], r1 = tile[MAXT + TOKE[2 * m + 1]] * 256 + TOKSLOT[2 * m + 1];
            const GAS f32x4* xr = (const GAS f32x4*)(p.out + (size_t)m * D) + lane; const GAS v2u* y0 = (const GAS v2u*)(YB + (size_t)r0 * D) + lane; const GAS v2u* y1 = (const GAS v2u*)(YB + (size_t)r1 * D) + lane;
#pragma unroll
            for (int j = 0; j < 4; ++j) { const f32x4 x1 = (xr[64 * j] - mean1) * rstd1 * g1[j] + b1[j]; const v2u a = y0[64 * j], b2v = y1[64 * j];
                const f32x4 mo = (f32x4){bflo(a.x) + bflo(b2v.x), bfhi(a.x) + bfhi(b2v.x), bflo(a.y) + bflo(b2v.y), bfhi(a.y) + bfhi(b2v.y)};
                q[rr][j] = x1 * ALPHA + gt[rr][j] * mo;
                s[rr] += (q[rr][j].x + q[rr][j].y) + (q[rr][j].z + q[rr][j].w); } }
#pragma unroll
        for (int rr = 0; rr < 2; ++rr) { const int m = mm[rr]; GAS f32x4* xr = (GAS f32x4*)(p.out + (size_t)m * D) + lane;
            const float mean = wave_sum(s[rr]) * (1.f / D); float s2 = 0.f;
#pragma unroll
            for (int j = 0; j < 4; ++j) { q[rr][j] = q[rr][j] - mean; s2 += (q[rr][j].x * q[rr][j].x + q[rr][j].y * q[rr][j].y) + (q[rr][j].z * q[rr][j].z + q[rr][j].w * q[rr][j].w); }
            const float rstd = 1.f / sqrtf(wave_sum(s2) * (1.f / D) + LN_EPS);
#pragma unroll
            for (int j = 0; j < 4; ++j) xr[64 * j] = q[rr][j] * rstd * g2[j] + b2[j]; }
    }
}
__device__ __forceinline__ int lane_now() { int l; asm volatile("v_and_b32 %0, 63, %1" : "=v"(l) : "v"((int)threadIdx.x)); __builtin_assume(l >= 0 && l < 64); return l; }
#define MKP P p; { const float* const* in = args.in; p.x = in[0]; p.c = in[1]; p.ctx = in[2]; p.c_ctx = in[3]; p.w_ada = in[4]; p.b_ada = in[5]; p.w_in = in[6]; p.mu_a = in[7]; p.w0 = in[8]; p.w2 = in[9]; p.a0 = in[10]; p.a2 = in[11]; p.g2 = in[12]; p.k_k = in[13]; p.k_a = in[14]; p.r_k = in[15]; p.gn_g = in[16]; p.gn_b = in[17]; p.conv_w = in[18]; p.conv_b = in[19]; p.lru_wa = in[20]; p.lru_ba = in[21]; p.lru_wx = in[22]; p.lru_bx = in[23]; p.lru_lam = in[24]; p.p_a = in[25]; p.p_b = in[26]; p.w_o = in[27]; p.ln1_g = in[28]; p.ln1_b = in[29]; p.router_g = in[30]; p.router_g_b = in[31]; p.router_e = in[32]; p.router_e_b = in[33]; p.e_w1 = in[34]; p.e_w3 = in[35]; p.e_w2 = in[36]; p.ln2_g = in[37]; p.ln2_b = in[38]; } p.out = args.out; p.ws = args.ws; p.dob = (unsigned char*)args.out; p.ctlf = (float*)(args.ws + WS_CTL); p.ctl = (unsigned*)(args.ws + WS_CTL);
constexpr int NPHASE = 15;
__global__ void __launch_bounds__(NTHR, 2) fwd_kernel(Args args) {
    extern __shared__ __attribute__((aligned(16))) unsigned char lds_raw[];
    LAS unsigned char* lds = (LAS unsigned char*)lds_raw;
    const int tid = threadIdx.x, wave = __builtin_amdgcn_readfirstlane(tid >> 6), G = gridDim.x;
    volatile LAS unsigned* MISC = (volatile LAS unsigned*)(lds + MISC_OFF);
    LAS int* tile = (LAS int*)(lds + TILE_OFF);
    for (int u = tid; u < 256; u += NTHR) ((LAS unsigned*)(lds + MISC_OFF))[u] = 0u;
    __syncthreads();
#if ONE_LAUNCH
    XcdBarrier bar = xcd_barrier_post((unsigned*)(args.ws + WS_CTL) + CW_BAR, MISC + 8);
#define GRID_BAR() xcd_barrier(bar)
#else
#define GRID_BAR() do {} while (0)
#endif
    const int lo = args.ph_lo, hi = args.ph_hi;
#define IN(k) (lo <= (k) && (k) < hi)
#define SEAM(k) do { if (IN(k) && IN((k) + 1)) GRID_BAR(); } while (0)

    if (IN(0)) { MKP; const int lane = lane_now(); phase0(p, lds, tid, lane, wave, G); } SEAM(0);
    if (IN(1)) { MKP; const int lane = lane_now(); phase0b(p, lds, tid, lane, wave, G); phase1(p, lane, wave, G); } SEAM(1);
    if (IN(2)) { MKP; const int lane = lane_now();
        pg8::Gemm g{(const pg8::bf16_t*)(p.dob + DO_H), (const pg8::bf16_t*)(p.dob + DO_WIN), MALL, NSLAB, D}; pg8::StaticOrder S; S.init(MALL, NSLAB, G, (int)blockIdx.x);
        EpiPlain<0> E{(bf16*)(p.ws + WS_S1), NS1, (bf16*)(p.ws + WS_S2), NS2, NS1 / 256};
        pg8::gemm_phase<EpiPlain<0>, pg8::StaticOrder, true, true>(lds, g, S, E); } SEAM(2);
    if (IN(3)) { MKP; const int lane = lane_now(); const int hb = blockIdx.x & 15; lru_setup(p, lds, tid, hb); LruC C; lru_consts(p, hb, lane & 15, C);
        for (int u = (blockIdx.x >> 4) * NWAVES + wave; u < BATCH * NHS; u += (G >> 4) * NWAVES) { const int hs = u % NHS, b = u / NHS; lru_unit<1>(p, lds, lane, wave, b, hs, hb, C); } } SEAM(3);
    if (IN(4)) { MKP; const int lane = lane_now(); lru_carry(p, lds, tid, G); } SEAM(4);
    if (IN(5)) { MKP; const int lane = lane_now(); const int hb = blockIdx.x & 15; lru_setup(p, lds, tid, hb); LruC C; lru_consts(p, hb, lane & 15, C);
        for (int u = (blockIdx.x >> 4) * NWAVES + wave; u < BATCH * 256; u += (G >> 4) * NWAVES) { const int hs = 8 + (u & 255), b = u >> 8; lru_unit<2>(p, lds, lane, wave, b, hs, hb, C); } } SEAM(5);
    if (IN(6)) { MKP; const int lane = lane_now(); phase_mix(p, lane, wave, G); } SEAM(6);
    if (IN(7)) { MKP; const int lane = lane_now(); for (int u = blockIdx.x; u < 256; u += G) wkv_blk_wg(p, lds, tid, lane, wave, u); } SEAM(7);
    if (IN(8)) { MKP; const int lane = lane_now(); const int h = blockIdx.x & 15; wkv_out_setup(p, lds, tid, h); { WoC WC; wkv_out_consts(p, h, lane & 15, WC); WoPre A, B; const int u0 = blockIdx.x >> 4, du = G >> 4; if (u0 < BATCH * 128) wkv_out_load(p, tid, lane, wave, u0 >> 7, u0 & 127, h, A);
            for (int u = u0; u < BATCH * 128; u += 2 * du) {
                const int u1 = u + du, u2 = u + 2 * du;
                wkv_out_unit(p, lds, tid, lane, wave, u >> 7, u & 127, h, WC, A, u1 < BATCH * 128, u1 >> 7, u1 & 127, B);
                if (u1 < BATCH * 128) wkv_out_unit(p, lds, tid, lane, wave, u1 >> 7, u1 & 127, h, WC, B, u2 < BATCH * 128, u2 >> 7, u2 & 127, A); } } } SEAM(8);
    if (IN(9)) { MKP; const int lane = lane_now();
        pg8::Gemm g{(const pg8::bf16_t*)(p.dob + DO_H), (const pg8::bf16_t*)(p.dob + DO_WIN) + (size_t)NSLAB * D, MX, 2048, D}; pg8::StaticOrder S; S.init(MX, 2048, G, (int)blockIdx.x);
        EpiPlain<1> E{(bf16*)(p.ws + WS_GATES), 2048, nullptr, 0, 1 << 20};
        pg8::gemm_phase<EpiPlain<1>, pg8::StaticOrder, true, true>(lds, g, S, E); } SEAM(9);
    if (IN(10)) { MKP; const int lane = lane_now();
        pg8::Gemm g{(const pg8::bf16_t*)(p.ws + WS_YWF), (const pg8::bf16_t*)(p.ws + WS_PW), 2 * MX, 2 * D, D}; SchedMix S; S.init(MX, D, G, (int)blockIdx.x);
        EpiMix E{(const bf16*)(p.ws + WS_GATES), (bf16*)(p.ws + WS_MBUF)};
        pg8::gemm_phase<EpiMix, SchedMix, true, true>(lds, g, S, E); } SEAM(10);
    if (IN(11)) { MKP; const int lane = lane_now();
        pg8::Gemm g{(const pg8::bf16_t*)(p.ws + WS_MBUF), (const pg8::bf16_t*)(p.ws + WS_PW) + (size_t)2 * D * D, MX, D, D}; pg8::StaticOrder S; S.init(MX, D, G, (int)blockIdx.x);
        EpiT1 E{p.x, (const float*)(p.ws + WS_STATS), p.ctlf + CW_MOD, p.b_ada, p.out};
        const bool wfirst = ((blockIdx.x >> 3) & 1) != 0;
        if (wfirst) { expert_weights(p, lds, lane, wave, G); __syncthreads(); }
        pg8::gemm_phase<EpiT1, pg8::StaticOrder, true, true>(lds, g, S, E);
        if (!wfirst) expert_weights(p, lds, lane, wave, G); } SEAM(11);
    if (IN(12)) { MKP; const int lane = lane_now(); phase_route(p, lds, tid, lane, wave, G); } SEAM(12);
    if (IN(13)) { MKP; const int lane = lane_now();
        build_tiles(p, tile, tid);
        pg8::Gemm g{(const pg8::bf16_t*)(p.ws + WS_H2), (const pg8::bf16_t*)(p.ws + WS_W13), MAXT * 256, NEXP * D, D}; SchedMoE S{tile, G, (int)blockIdx.x, (const int*)(p.ws + WS_S2T)};
        EpiSwiGLU E{(bf16*)(p.ws + WS_HBUF)};
        pg8::gemm_phase<EpiSwiGLU, SchedMoE, true, true, true>(lds, g, S, E); } SEAM(13);
    if (IN(14)) { MKP; const int lane = lane_now();
        build_tiles(p, tile, tid);
        pg8::Gemm g{(const pg8::bf16_t*)(p.ws + WS_HBUF), (const pg8::bf16_t*)(p.ws + WS_W2), MAXT * 256, NEXP * D, DEXP}; SchedMoE S{tile, G, (int)blockIdx.x, (const int*)(p.ws + WS_S2T)};
        EpiW2 E{(bf16*)(p.ws + WS_XS), tile, (const int*)(p.ws + WS_S2T), (const float*)(p.ws + WS_TOKW)};
        pg8::gemm_phase<EpiW2, SchedMoE, true, true>(lds, g, S, E); } SEAM(14);
    if (IN(15)) { MKP; const int lane = lane_now(); build_tiles(p, tile, tid); phase_final(p, tile, lane, wave, G); }
#undef IN
#undef SEAM
}

extern "C" void kernel_launch(void* const* d_in, const int* in_sizes, int n_in, void* d_out, int out_size, void* d_ws, size_t ws_size, hipStream_t stream) {
    static int grid = 0;
    if (grid == 0) {
        if (n_in != 39 || out_size != MX * D || ws_size < WS_END) { fprintf(stderr, "kernel_launch: unexpected shapes (n_in %d out %d ws %zu)\n", n_in, out_size, ws_size); grid = -1; return; }
        int dev = 0, cus = 0, per_cu = 0;
        if (hipGetDevice(&dev) != hipSuccess || hipDeviceGetAttribute(&cus, hipDeviceAttributeMultiprocessorCount, dev) != hipSuccess) { grid = -1; return; }
        if (hipFuncSetAttribute((const void*)fwd_kernel, hipFuncAttributeMaxDynamicSharedMemorySize, LDS_BYTES) != hipSuccess) { fprintf(stderr, "kernel_launch: hipFuncSetAttribute failed\n"); grid = -1; return; }
        if (hipOccupancyMaxActiveBlocksPerMultiprocessor(&per_cu, (const void*)fwd_kernel, NTHR, LDS_BYTES) != hipSuccess || per_cu < 1) fprintf(stderr, "kernel_launch: occupancy query reports %d\n", per_cu);
        (void)hipGetLastError();
        grid = cus;
    }
    if (grid < 0) return;
    if (hipMemsetAsync((char*)d_ws + WS_CTL, 0, CTL_ZERO_BYTES, stream) != hipSuccess) return;
    Args a{};
    for (int i = 0; i < 39; ++i) a.in[i] = (const float*)d_in[i];
    a.out = (float*)d_out; a.ws = (unsigned char*)d_ws;
#if ONE_LAUNCH
    a.ph_lo = 0; a.ph_hi = NPHASE + 1;
    hipLaunchKernelGGL(fwd_kernel, dim3(grid), dim3(NTHR), LDS_BYTES, stream, a);
#else
    for (int ph = 0; ph <= NPHASE; ++ph) { a.ph_lo = ph; a.ph_hi = ph + 1; hipLaunchKernelGGL(fwd_kernel, dim3(grid), dim3(NTHR), LDS_BYTES, stream, a); }
#endif
}
```

```cpp
#include <hip/hip_runtime.h>
#include <cstdio>
#include <cstdint>
namespace pg8 {
#define PG8_LAS __attribute__((address_space(3)))
typedef unsigned short bf16_t;
typedef short bf16x8 __attribute__((ext_vector_type(8)));
typedef float f32x4 __attribute__((ext_vector_type(4)));
typedef unsigned u32x4 __attribute__((ext_vector_type(4)));
constexpr int BM = 256, BK = 64, HALF = 128, HTB = HALF * BK * 2  , STAGE_BYTES = 8 * HTB, NXCD = 8, WGM = 8;

__host__ __device__ __forceinline__ int lds_byte(int r, int c) { const int st = (r >> 4) * 2 + (c >> 5), rr = r & 15, cc = c & 31, ob = rr * 64 + cc * 2; return st * 1024 + (ob ^ (((ob >> 9) & 1) << 5)); }
__host__ __device__ __forceinline__ void stage_rc(int b, int& R, int& C) { const int st = b / 1024, sb = b % 1024, swz = sb ^ (((sb >> 9) & 1) << 5); R = (st >> 1) * 16 + swz / 64; C = (st & 1) * 32 + (swz % 64) / 2; }
__host__ __device__ __forceinline__ int perm32(int rho) { const int n = rho >> 4, i = rho & 15; return 8 * (i >> 2) + 4 * n + (i & 3); }

struct Unit { int pm, pn; };
struct Gemm { const bf16_t* A; const bf16_t* Bt; int M, N, K; };

struct StaticOrder {
    int nM, nN, nwg, G, c;
    __host__ __device__ void init(int M, int N, int G_, int c_) { nM = M / BM; nN = N / BM; nwg = nM * nN; G = G_; c = c_; }
    __host__ __device__ bool next(int i, Unit& u) const {
        const long L = (long)i * G + c; if (L >= nwg) return false;
        int wgid = (int)L; { const int q = nwg / NXCD, r = nwg % NXCD, xcd = wgid % NXCD, off = wgid / NXCD; wgid = (xcd < r ? xcd * (q + 1) : r * (q + 1) + (xcd - r) * q) + off; }
        const int nig = WGM * nN, gid = wgid / nig, fm = gid * WGM, gsz = (nM - fm) < WGM ? (nM - fm) : WGM;
        u.pm = fm + ((wgid % nig) % gsz); u.pn = (wgid % nig) / gsz; return true;
    }
    __device__ __forceinline__ void a_ready(const Unit&) const {}
    __device__ __forceinline__ void done(const Unit&) const {}
};

__device__ __forceinline__ unsigned cvt_pk_bf16(float lo, float hi) { unsigned r; asm volatile("v_cvt_pk_bf16_f32 %0, %1, %2" : "=v"(r) : "v"(lo), "v"(hi)); return r; }
template <class Epi, class Sched, bool ALIGN_EPI = false, bool SP2 = false, bool GATHER = false>
__device__ __forceinline__ void gemm_phase(PG8_LAS unsigned char* lds, const Gemm g, const Sched& S, const Epi& E) {
    static_assert(!GATHER || SP2, "the gathered-A path exists only in the SP2 loop");
    const int tid = threadIdx.x, wid = __builtin_amdgcn_readfirstlane(tid >> 6), lane = tid & 63, wr = wid >> 2, wc = wid & 3, fr = lane & 15, fq = lane >> 4;
    const int K = g.K, nt = K / BK;
    unsigned voffA[2], voffB[2];
#pragma unroll
    for (int i = 0; i < 2; ++i) { int R, C; stage_rc(tid * 16 + i * 8192, R, C); const int Rb = Epi::PERM ? ((R & ~31) + perm32(R & 31)) : R;
        voffA[i] = (unsigned)(R * K + C) * 2u; voffB[i] = (unsigned)(Rb * K + C) * 2u; }
    unsigned vgc[2][2] = {{0u, 0u}, {0u, 0u}}, vgn[2][2] = {{0u, 0u}, {0u, 0u}}; int gR[2] = {0, 0}, gC[2] = {0, 0};
    if constexpr (GATHER) {
#pragma unroll
        for (int i = 0; i < 2; ++i) stage_rc(tid * 16 + i * 8192, gR[i], gC[i]); }
#define PG8_GSET(dst, unit) do { _Pragma("unroll") for (int _h = 0; _h < 2; ++_h) _Pragma("unroll") for (int _i = 0; _i < 2; ++_i) dst[_h][_i] = (unsigned)(S.src_row((unit).pm, _h * 128 + gR[_i]) * K + gC[_i]) * 2u; } while (0)
    const size_t kstep = (size_t)(BK * 2);
    const size_t hstep = (size_t)HALF * K * 2;
    const size_t tstep = 2 * hstep;
    const unsigned ldsw = (unsigned)wid * 1024u;
    const int aoff = lds_byte(wr * 64 + fr, fq * 8), boff = lds_byte(wc * 32 + fr, fq * 8);
#define PG8_SA(b, h) (((b) * 2 + (h)) * HTB)
#define PG8_SB(b, h) ((4 + (b) * 2 + (h)) * HTB)
#define PG8_STAGE(bufoff, gbase, voff) do { _Pragma("unroll") for (int _i = 0; _i < 2; ++_i) \
        __builtin_amdgcn_global_load_lds((const unsigned*)((const char*)(gbase) + (voff)[_i]), (PG8_LAS unsigned*)(lds + (bufoff) + ldsw + _i * 8192), 16, 0, 0); } while (0)
#define PG8_STAGE_A(bufoff, gbase, h, usenext) do { if constexpr (GATHER) { _Pragma("unroll") for (int _i = 0; _i < 2; ++_i) { const unsigned _o = (usenext) ? vgn[h][_i] : vgc[h][_i]; \
        __builtin_amdgcn_global_load_lds((const unsigned*)((const char*)(gbase) + _o), (PG8_LAS unsigned*)(lds + (bufoff) + ldsw + _i * 8192), 16, 0, 0); } } \
        else { PG8_STAGE(bufoff, (gbase) + (h) * hstep, voffA); } } while (0)
#define PG8_LDA(dst, b, h) do { _Pragma("unroll") for (int m = 0; m < 4; ++m) _Pragma("unroll") for (int k = 0; k < 2; ++k) dst[m][k] = *(const PG8_LAS bf16x8*)(lds + PG8_SA(b, h) + aoff + m * 2048 + k * 1024); } while (0)
#define PG8_LDB(dst, b, h) do { _Pragma("unroll") for (int n = 0; n < 2; ++n) _Pragma("unroll") for (int k = 0; k < 2; ++k) dst[n][k] = *(const PG8_LAS bf16x8*)(lds + PG8_SB(b, h) + boff + n * 2048 + k * 1024); } while (0)
#define PG8_MMA(ai, bj, At, Bt) do { __builtin_amdgcn_s_setprio(1); _Pragma("unroll") for (int m = 0; m < 4; ++m) _Pragma("unroll") for (int n = 0; n < 2; ++n) _Pragma("unroll") for (int k = 0; k < 2; ++k) \
        acc[ai][bj][m][n] = __builtin_amdgcn_mfma_f32_16x16x32_bf16(Bt[n][k], At[m][k], acc[ai][bj][m][n], 0, 0, 0); __builtin_amdgcn_s_setprio(0); } while (0)
#define PG8_WAIT_V(n) asm volatile("s_waitcnt vmcnt(" #n ")" ::: "memory")
#define PG8_WAIT_L(n) asm volatile("s_waitcnt lgkmcnt(" #n ")" ::: "memory")
#define PG8_BAR __builtin_amdgcn_s_barrier()
#define PG8_SCHED __builtin_amdgcn_sched_barrier(0)
    Unit cur, nxt; int ui = 0;
    if (!S.next(0, cur)) return;
    f32x4 acc[2][2][4][2];
#pragma unroll
    for (int a = 0; a < 2; ++a)
#pragma unroll
        for (int b = 0; b < 2; ++b)
#pragma unroll
            for (int m = 0; m < 4; ++m)
#pragma unroll
                for (int n = 0; n < 2; ++n) acc[a][b][m][n] = (f32x4){0.f, 0.f, 0.f, 0.f};
    bf16x8 At[4][2], B0[2][2], B1[2][2];
    const char* cA = GATHER ? (const char*)g.A : (const char*)g.A + (size_t)cur.pm * tstep; const char* cB = (const char*)g.Bt + (size_t)cur.pn * tstep;
    if constexpr (GATHER) PG8_GSET(vgc, cur);
    S.a_ready(cur);
    if constexpr (SP2) {
        PG8_STAGE(PG8_SB(0, 0), cB, voffB); PG8_STAGE(PG8_SB(0, 1), cB + hstep, voffB); PG8_STAGE_A(PG8_SA(0, 0), cA, 0, false); PG8_STAGE_A(PG8_SA(0, 1), cA, 1, false);
        if (wr == 1) PG8_BAR;
        PG8_WAIT_V(2); PG8_BAR;
        PG8_STAGE(PG8_SB(1, 0), cB + kstep, voffB); PG8_STAGE_A(PG8_SA(1, 0), cA + kstep, 0, false); PG8_STAGE(PG8_SB(1, 1), cB + hstep + kstep, voffB);
        PG8_WAIT_V(6); PG8_BAR;
    } else {
        PG8_STAGE(PG8_SB(0, 0), cB, voffB); PG8_STAGE(PG8_SA(0, 0), cA, voffA); PG8_STAGE(PG8_SB(0, 1), cB + hstep, voffB); PG8_STAGE(PG8_SA(0, 1), cA + hstep, voffA);
        if (wr == 1) PG8_BAR;
        PG8_WAIT_V(4); PG8_BAR;
        PG8_STAGE(PG8_SB(1, 0), cB + kstep, voffB); PG8_STAGE(PG8_SA(1, 0), cA + kstep, voffA); PG8_STAGE(PG8_SB(1, 1), cB + hstep + kstep, voffB);
        PG8_WAIT_V(6); PG8_BAR;
    }
    for (;;) {
        const bool has_next = S.next(ui + 1, nxt);
        const char* nA = GATHER ? cA : (has_next ? (const char*)g.A + (size_t)nxt.pm * tstep : cA); const char* nB = has_next ? (const char*)g.Bt + (size_t)nxt.pn * tstep : cB;
        if constexpr (GATHER) { if (has_next) PG8_GSET(vgn, nxt); }
        for (int t = 0; t < nt; t += 2) {
            const bool last = (t == nt - 2);
            const char* a1 = cA + (size_t)(t + 1) * kstep;
            const char* a2 = last ? nA : cA + (size_t)(t + 2) * kstep; const char* b2 = last ? nB : cB + (size_t)(t + 2) * kstep;
            const char* a3 = a2 + kstep; const char* b3 = b2 + kstep;
            if (last && has_next) S.a_ready(nxt);
            const bool unx = last && has_next;
            if constexpr (SP2) {
            PG8_LDB(B0, 0, 0); PG8_LDB(B1, 0, 1); PG8_SCHED; PG8_LDA(At, 0, 0); PG8_STAGE_A(PG8_SA(1, 1), a1, 1, false);
            PG8_WAIT_V(8); PG8_WAIT_L(0); PG8_BAR; PG8_MMA(0, 0, At, B0); PG8_MMA(0, 1, At, B1); PG8_BAR; PG8_SCHED;
            PG8_LDA(At, 0, 1); PG8_STAGE(PG8_SB(0, 0), b2, voffB); PG8_STAGE(PG8_SB(0, 1), b2 + hstep, voffB); PG8_STAGE_A(PG8_SA(0, 0), a2, 0, unx);
            PG8_WAIT_V(8); PG8_WAIT_L(0); PG8_BAR; PG8_MMA(1, 0, At, B0); PG8_MMA(1, 1, At, B1); PG8_BAR; PG8_SCHED;
            PG8_LDB(B0, 1, 0); PG8_LDB(B1, 1, 1); PG8_SCHED; PG8_LDA(At, 1, 0); PG8_STAGE_A(PG8_SA(0, 1), a2, 1, unx);
            PG8_WAIT_V(8); PG8_WAIT_L(0); PG8_BAR; PG8_MMA(0, 0, At, B0); PG8_MMA(0, 1, At, B1); PG8_BAR; PG8_SCHED;
            PG8_LDA(At, 1, 1); PG8_STAGE(PG8_SB(1, 0), b3, voffB); PG8_STAGE(PG8_SB(1, 1), b3 + hstep, voffB); PG8_STAGE_A(PG8_SA(1, 0), a3, 0, unx);
            PG8_WAIT_V(8); PG8_WAIT_L(0); PG8_BAR; PG8_MMA(1, 0, At, B0); PG8_MMA(1, 1, At, B1); PG8_BAR; PG8_SCHED;
            } else {
            PG8_LDB(B0, 0, 0); PG8_SCHED; PG8_LDA(At, 0, 0); PG8_STAGE(PG8_SA(1, 1), a1 + hstep, voffA);
            PG8_WAIT_L(8); PG8_BAR; PG8_WAIT_L(0); PG8_MMA(0, 0, At, B0); PG8_BAR; PG8_SCHED;
            PG8_LDB(B1, 0, 1); PG8_STAGE(PG8_SB(0, 0), b2, voffB);
            PG8_BAR; PG8_WAIT_L(0); PG8_MMA(0, 1, At, B1); PG8_BAR;
            PG8_LDA(At, 0, 1); PG8_STAGE(PG8_SA(0, 0), a2, voffA);
            PG8_BAR; PG8_WAIT_L(0); PG8_MMA(1, 0, At, B0); PG8_BAR; PG8_SCHED;
            PG8_STAGE(PG8_SB(0, 1), b2 + hstep, voffB);
            PG8_WAIT_V(6); PG8_BAR; PG8_MMA(1, 1, At, B1); PG8_BAR;
            PG8_LDB(B0, 1, 0); PG8_SCHED; PG8_LDA(At, 1, 0); PG8_STAGE(PG8_SA(0, 1), a2 + hstep, voffA);
            PG8_WAIT_L(8); PG8_BAR; PG8_WAIT_L(0); PG8_MMA(0, 0, At, B0); PG8_BAR; PG8_SCHED;
            PG8_LDB(B1, 1, 1); PG8_STAGE(PG8_SB(1, 0), b3, voffB);
            PG8_BAR; PG8_WAIT_L(0); PG8_MMA(0, 1, At, B1); PG8_BAR;
            PG8_LDA(At, 1, 1); PG8_STAGE(PG8_SA(1, 0), a3, voffA);
            PG8_BAR; PG8_WAIT_L(0); PG8_MMA(1, 0, At, B0); PG8_BAR; PG8_SCHED;
            PG8_STAGE(PG8_SB(1, 1), b3 + hstep, voffB);
            PG8_WAIT_V(6); PG8_BAR; PG8_MMA(1, 1, At, B1); PG8_BAR;
            }
        }
        if constexpr (ALIGN_EPI) { if (wr == 0) PG8_BAR; }
        if constexpr (!Epi::AFTER_DRAIN) { E(acc, cur, wr, wc, fr, fq); S.done(cur); }
        if (!has_next) break;
#pragma unroll
        for (int a = 0; a < 2; ++a)
#pragma unroll
            for (int b = 0; b < 2; ++b)
#pragma unroll
                for (int m = 0; m < 4; ++m)
#pragma unroll
                    for (int n = 0; n < 2; ++n) acc[a][b][m][n] = (f32x4){0.f, 0.f, 0.f, 0.f};
        cur = nxt; cA = nA; cB = nB; ++ui;
        if constexpr (GATHER) { _Pragma("unroll") for (int _h = 0; _h < 2; ++_h) _Pragma("unroll") for (int _i = 0; _i < 2; ++_i) vgc[_h][_i] = vgn[_h][_i]; }
        if constexpr (ALIGN_EPI) { if (wr == 1) PG8_BAR; }
    }
    PG8_WAIT_V(0);
    if constexpr (!ALIGN_EPI) { if (wr == 0) PG8_BAR; }
    PG8_BAR;
    if constexpr (Epi::AFTER_DRAIN) { E.fused(acc, cur, wr, wc, fr, fq, lds, wid, lane); S.done(cur); }
#undef PG8_SA
#undef PG8_STAGE_A
#undef PG8_GSET
#undef PG8_SB
#undef PG8_STAGE
#undef PG8_LDA
#undef PG8_LDB
#undef PG8_MMA
#undef PG8_WAIT_V
#undef PG8_WAIT_L
#undef PG8_BAR
#undef PG8_SCHED
}
}

#ifndef ONE_LAUNCH
#define ONE_LAUNCH 1
#endif
constexpr int NWAVES = 8, NTHR = 512;
constexpr int D = 1024, BATCH = 2, SEQ = 8192, CTXL = 256, GRIDW = 64;
constexpr int MX = BATCH * SEQ, MC = BATCH * CTXL, MALL = MX + MC;
constexpr int NCH = 132;
constexpr int NSLAB = 5632, NS1 = 3584, NS2 = 2048;
constexpr int NZM = 4416;
constexpr int Z_R = 0, Z_K = 1024, Z_V = 2048, Z_KK = 3072, Z_TW = 4096, Z_AD = 4160, Z_GS = 4224;
constexpr int C_R = 0, C_K = 1024, C_V = 2048, C_WD = 3072, C_AD = 3136, C_GD = 3200, C_XB = 0, C_GBR = 1024;
constexpr int NWIN = 7680;
constexpr int NEXP = 32, DEXP = 512, MAXT = 160;
constexpr float LN_EPS = 1e-5f, GN_EPS = 64e-5f;
constexpr float ALPHA = 1.189207115002721f;
constexpr size_t MiB = 1u << 20;
constexpr size_t WS_CTL = 0, CTL_ZERO_BYTES = 1 * MiB;
constexpr size_t WS_STATS = 1 * MiB, WS_TOKE = 1 * MiB + 256 * 1024, WS_TOKSLOT = 1 * MiB + 512 * 1024, WS_TOKW = 1 * MiB + 768 * 1024, WS_ROWW = 2 * MiB;
constexpr size_t WS_RWT = 2 * MiB + 512 * 1024;
constexpr size_t WS_S2T = 3 * MiB, WS_AGGA = 5 * MiB, WS_AGGH = 9 * MiB + 256 * 1024, WS_CIN = 13 * MiB + 512 * 1024;
constexpr size_t WS_PW = 18 * MiB;
constexpr size_t WS_S1 = 24 * MiB;
constexpr size_t WS_S2 = 139 * MiB + 512 * 1024;
constexpr size_t WS_ZM = 139 * MiB + 512 * 1024;
constexpr size_t WS_FB = 206 * MiB;
constexpr size_t WS_BAG = 272 * MiB;
constexpr size_t WS_YLRU = 282 * MiB, WS_YWF = 24 * MiB, WS_YWB = 56 * MiB;
constexpr size_t WS_GATES = 140 * MiB;
constexpr size_t WS_MBUF = 204 * MiB;
constexpr size_t WS_W13 = 24 * MiB, WS_W2 = 88 * MiB;
constexpr size_t WS_H2 = 120 * MiB;
constexpr size_t WS_XS = 153 * MiB;
constexpr size_t WS_HBUF = 236 * MiB;
constexpr size_t WS_END = 314 * MiB;
static_assert(WS_S1 + (size_t)MALL * NS1 * 2 <= WS_S2 && WS_S2 + (size_t)MALL * NS2 * 2 <= WS_YLRU && WS_ZM + (size_t)MALL * NZM * 2 <= WS_YLRU && WS_YLRU + (size_t)MX * D * 2 <= WS_END, "ws map");
static_assert((WS_YLRU - WS_YWF) % (512 * 1024) == 0 && WS_H2 + (size_t)(MX + 1) * D * 2 <= WS_XS && WS_XS + (size_t)MAXT * 256 * D * 2 <= WS_HBUF && WS_HBUF + (size_t)MAXT * 256 * DEXP * 2 <= WS_END, "ws map 2");
constexpr size_t DO_H = 0, DO_WIN = 34 * MiB;
constexpr int CW_TMO = 0, CW_BAR = 4096, CW_MOD = 8192  , CW_ECNT = 32768  ;
constexpr int LDS_BYTES = 155648;
constexpr int MISC_OFF = LDS_BYTES - 1024;
constexpr int TILE_OFF = MISC_OFF - 2048;

#define GAS __attribute__((address_space(1)))
#define LAS __attribute__((address_space(3)))
typedef unsigned short bf16;
typedef unsigned v4u __attribute__((ext_vector_type(4)));
typedef unsigned v2u __attribute__((ext_vector_type(2)));
typedef float f32x4 __attribute__((ext_vector_type(4)));
typedef GAS unsigned gu32;
typedef short bf16x8 __attribute__((ext_vector_type(8)));
#define RLX_AGENT __ATOMIC_RELAXED, __HIP_MEMORY_SCOPE_AGENT
#define LDS_WAIT() asm volatile("s_waitcnt lgkmcnt(0)" ::: "memory")
#define VM_WAIT() asm volatile("s_waitcnt vmcnt(0)" ::: "memory")
#define DI __device__ __forceinline__
typedef __bf16 bf16x2_t __attribute__((ext_vector_type(2)));
typedef float f32x2 __attribute__((ext_vector_type(2)));
DI unsigned cvtpk_s(float lo, float hi) { const f32x2 v = {lo, hi}; const bf16x2_t b = __builtin_convertvector(v, bf16x2_t); return __builtin_bit_cast(unsigned, b); }
DI unsigned pk2(float lo, float hi) { return cvtpk_s(lo, hi); }
DI unsigned f2bf(float f) { return cvtpk_s(f, 0.f) & 0xffffu; }
DI float bf2f(unsigned short b) { return __builtin_bit_cast(float, ((unsigned)b) << 16); }
DI float bflo(unsigned w) { return __builtin_bit_cast(float, w << 16); }
DI float bfhi(unsigned w) { return __builtin_bit_cast(float, w & 0xffff0000u); }
constexpr float NL2E = -1.4426950408889634f;
DI float frcp(float x) { return __builtin_amdgcn_rcpf(x); }
DI float sigm(float x) { return 1.f / (1.f + __expf(-x)); }
DI float sigm_fast(float x) { return frcp(1.f + __expf(-x)); }
template <int CTRL> DI float dppf(float x) { return __builtin_bit_cast(float, __builtin_amdgcn_update_dpp(0, __builtin_bit_cast(int, x), CTRL, 0xF, 0xF, true)); }
template <int CTRL> DI float dppf_one(float x) { return __builtin_bit_cast(float, __builtin_amdgcn_update_dpp(0x3f800000, __builtin_bit_cast(int, x), CTRL, 0xF, 0xF, false)); }
DI float red4(float x) { x += dppf<0xB1>(x); x += dppf<0x4E>(x); return x; }
DI float red16(float x) { x += dppf<0xB1>(x); x += dppf<0x4E>(x); x += dppf<0x141>(x); x += dppf<0x140>(x); return x; }
DI float rdl(float v, int l) { return __builtin_bit_cast(float, __builtin_amdgcn_readlane(__builtin_bit_cast(int, v), l)); }
DI float wave_sum(float v) { v = red16(v); return (rdl(v, 0) + rdl(v, 16)) + (rdl(v, 32) + rdl(v, 48)); }

#define XB_TMO      128
#define XB_XCNT(j)  (256  + 64 * (j))
#define XB_XSUB(j)  (1280 + 64 * (j))
#define XB_XGEN(j)  (2304 + 64 * (j))
#define XB_TOP      3328
#define XB_TOPGEN   3392
#define XCD_BAR_WORDS 3456
#define XB_SPIN_CAP (1u << 18)

__device__ __forceinline__ unsigned xb_ld(unsigned* p)              { return __hip_atomic_load(p, __ATOMIC_RELAXED, __HIP_MEMORY_SCOPE_AGENT); }
__device__ __forceinline__ unsigned xb_add(unsigned* p, unsigned v) { return __hip_atomic_fetch_add(p, v, __ATOMIC_RELAXED, __HIP_MEMORY_SCOPE_AGENT); }
__device__ __forceinline__ unsigned xb_xcc_id() { return (unsigned)__builtin_amdgcn_s_getreg((3 << 11) | 20) & 0xFu; }
#define XB_SPIN(cond, bar) do { unsigned _sp = 0; while (cond) { __builtin_amdgcn_s_sleep(1); \
    if ((++_sp & 255u) == 0u) { if (xb_ld(&(bar)[XB_TMO])) break; if (_sp > XB_SPIN_CAP) { atomicAdd(&(bar)[XB_TMO], 1u); break; } } } } while (0)

struct XcdBarrier {
    unsigned* bar; unsigned x;
    volatile LAS unsigned* st;
};

__device__ __forceinline__ XcdBarrier xcd_barrier_post(unsigned* bar, volatile LAS unsigned* st) {
    XcdBarrier b; b.bar = bar; b.x = xb_xcc_id(); b.st = st;
    if (threadIdx.x == 0) (void)xb_add(&bar[XB_XCNT(b.x)], 1u);
    return b;
}
__device__ __forceinline__ void xcd_barrier_complete(unsigned* bar, unsigned x, unsigned& nloc, unsigned& nx) {
    const unsigned G = gridDim.x * gridDim.y * gridDim.z;
    unsigned sum, cnt, mine, sp = 0u;
    for (;;) {
        sum = 0u; cnt = 0u; mine = 0u;
#pragma unroll
        for (unsigned j = 0; j < 16; ++j) { const unsigned c = xb_ld(&bar[XB_XCNT(j)]); sum += c; cnt += (c > 0u) ? 1u : 0u; mine = (j == x) ? c : mine; }
        if (sum == G) break;
        __builtin_amdgcn_s_sleep(1);
        if ((++sp & 255u) == 0u) { if (xb_ld(&bar[XB_TMO])) break; if (sp > XB_SPIN_CAP) { atomicAdd(&bar[XB_TMO], 1u); break; } }
    }
    nloc = mine > 0u ? mine : 1u; nx = cnt > 0u ? cnt : 1u;
}

__device__ __forceinline__ void xcd_barrier(const XcdBarrier& b) {
    asm volatile("s_waitcnt vmcnt(0)" ::: "memory");
    __syncthreads();
    if (threadIdx.x == 0) {
        unsigned* bar = b.bar;
        __builtin_amdgcn_s_waitcnt(0);
        unsigned nloc = b.st[0], nx = b.st[1];
        if (nloc == 0u) { xcd_barrier_complete(bar, b.x, nloc, nx); b.st[0] = nloc; b.st[1] = nx; }
        const unsigned old = xb_add(&bar[XB_XSUB(b.x)], 1u);
        const unsigned gen = old / nloc;
        if (old + 1u == (gen + 1u) * nloc) {
            __builtin_amdgcn_fence(__ATOMIC_RELEASE, "agent");
            asm volatile("s_waitcnt vmcnt(0)" ::: "memory");
            const unsigned og = xb_add(&bar[XB_TOP], 1u);
            const unsigned tg = og / nx;
            if (og + 1u == (tg + 1u) * nx) xb_add(&bar[XB_TOPGEN], 1u);
            else XB_SPIN(xb_ld(&bar[XB_TOPGEN]) == tg, bar);
            __builtin_amdgcn_fence(__ATOMIC_ACQUIRE, "agent");
            xb_add(&bar[XB_XGEN(b.x)], 1u);
            asm volatile("s_waitcnt vmcnt(0)" ::: "memory");
        } else {
            XB_SPIN(xb_ld(&bar[XB_XGEN(b.x)]) == gen, bar);
            __builtin_amdgcn_fence(__ATOMIC_ACQUIRE, "agent");
            asm volatile("s_waitcnt vmcnt(0)" ::: "memory");
        }
    }
    __syncthreads();
}

struct Args { const float* in[39]; float* out; unsigned char* ws; int ph_lo, ph_hi; };

struct P {
    const float *x, *c, *ctx, *c_ctx, *w_ada, *b_ada, *w_in, *mu_a, *w0, *w2, *a0, *a2, *g2, *k_k, *k_a, *r_k, *gn_g, *gn_b, *conv_w, *conv_b,
        *lru_wa, *lru_ba, *lru_wx, *lru_bx, *lru_lam, *p_a, *p_b, *w_o, *ln1_g, *ln1_b, *router_g, *router_g_b, *router_e, *router_e_b, *e_w1, *e_w3, *e_w2, *ln2_g, *ln2_b;
    float* out; unsigned char* ws; unsigned char* dob;
    float* ctlf; unsigned* ctl;
};

DI float modv(const P& p, int v, int n) { return p.ctlf[CW_MOD + v * 6144 + n] + p.b_ada[n]; }
DI f32x4 modv4(const P& p, int v, int n) { return *(const f32x4*)(p.ctlf + CW_MOD + v * 6144 + n) + *(const f32x4*)(p.b_ada + n); }

DI void transpose_item(const float* W, int ldw, bf16* WT, int ldt, int k0, int n0, int drow0, LAS float* scr, int lane) {
#pragma unroll 8
    for (int i = 0; i < 32; ++i) { const int kk = 2 * i + (lane >> 5); scr[kk * 33 + (lane & 31)] = W[(size_t)(k0 + kk) * ldw + n0 + (lane & 31)]; }
    LDS_WAIT(); asm volatile("" ::: "memory");
    const int c = lane & 7;
#pragma unroll
    for (int j = 0; j < 4; ++j) { const int n = (lane >> 3) + 8 * j; const LAS float* s = scr + (8 * c) * 33 + n;
        v4u o; o.x = pk2(s[0 * 33], s[1 * 33]); o.y = pk2(s[2 * 33], s[3 * 33]); o.z = pk2(s[4 * 33], s[5 * 33]); o.w = pk2(s[6 * 33], s[7 * 33]);
        *(GAS v4u*)(WT + (size_t)(drow0 + n) * ldt + k0 + 8 * c) = o; }
    LDS_WAIT(); asm volatile("" ::: "memory");
}

DI void phase0(const P& p, LAS unsigned char* lds, int tid, int lane, int wave, int G) {
    LAS float* s3 = (LAS float*)lds;
    for (int item = blockIdx.x; item < 256; item += G) {
        const int kc = item >> 4, nc = item & 15;
        if (tid < 192) { const int v = tid >> 6, k = tid & 63; const float cv = (v < 2) ? p.c[v * D + kc * 64 + k] : p.c_ctx[kc * 64 + k]; s3[v * 64 + k] = cv * sigm(cv); }
        __syncthreads();
        if (tid < 384) { const int n = nc * 384 + tid; float a0 = 0.f, a1 = 0.f, a2 = 0.f;
            for (int k = 0; k < 64; ++k) { const float w = p.w_ada[(size_t)(kc * 64 + k) * 6144 + n]; a0 += s3[k] * w; a1 += s3[64 + k] * w; a2 += s3[128 + k] * w; }
            atomicAdd(p.ctlf + CW_MOD + n, a0); atomicAdd(p.ctlf + CW_MOD + 6144 + n, a1); atomicAdd(p.ctlf + CW_MOD + 2 * 6144 + n, a2); }
        __syncthreads();
    }
}
DI void phase0b(const P& p, LAS unsigned char* lds, int tid, int lane, int wave, int G) {
    LAS float* scr = (LAS float*)(lds + 4096 + wave * 16384);
    const int gw = blockIdx.x * NWAVES + wave, NGW = G * NWAVES;
    bf16* win_t = (bf16*)(p.dob + DO_WIN); bf16* pw = (bf16*)(p.ws + WS_PW);
    constexpr int I_IN = 16 * 233, I_P = 16 * 32;
    for (int it = gw; it < I_IN + 3 * I_P; it += NGW) {
        int r = it;
        if (r < I_IN) { const int kb = r / 233, nb = r % 233, n0 = nb * 32; transpose_item(p.w_in, 7456, win_t, D, kb * 64, n0, n0 + (n0 >= 3360 ? 224 : 0), scr, lane); continue; }
        r -= I_IN; const int wsel = r / I_P; r %= I_P; const int kb = r / 32, nb = r % 32;
        if (wsel == 0) transpose_item(p.p_a, D, pw, D, kb * 64, nb * 32, nb * 32, scr, lane);
        else if (wsel == 1) transpose_item(p.p_b, D, pw + (size_t)D * D, D, kb * 64, nb * 32, nb * 32, scr, lane);
        else transpose_item(p.w_o, D, pw + (size_t)2 * D * D, D, kb * 64, nb * 32, nb * 32, scr, lane);
    }
    { float* rwt = (float*)(p.ws + WS_RWT);
      for (int i = blockIdx.x * NTHR + tid; i < 48 * D; i += G * NTHR) { const int n = i >> 10, k = i & (D - 1); rwt[i] = n < 4 ? p.router_g[k * 4 + n] : (n < 36 ? p.router_e[k * 32 + (n - 4)] : 0.f); } }
    for (int i = blockIdx.x * NTHR + tid; i < 224 * D / 8; i += G * NTHR) ((GAS v4u*)(win_t + (size_t)3360 * D))[i] = (v4u){0u, 0u, 0u, 0u};
}

DI void phase1(const P& p, int lane, int wave, int G) {
    const int gw = blockIdx.x * NWAVES + wave, NGW = G * NWAVES;
    bf16* H = (bf16*)(p.dob + DO_H); float* stats = (float*)(p.ws + WS_STATS);
    f32x4 sc[2][4], sh[2][4]; int cv[2] = {-1, -1};
#pragma unroll
    for (int j = 0; j < 4; ++j) { sc[0][j] = sc[1][j] = sh[0][j] = sh[1][j] = (f32x4){0.f, 0.f, 0.f, 0.f}; }
    for (int m0 = gw; m0 < MALL; m0 += 2 * NGW) {
        f32x4 q[2][4]; float s[2] = {0.f, 0.f}; int mm[2]; mm[0] = m0; mm[1] = (m0 + NGW < MALL) ? m0 + NGW : m0;
#pragma unroll
        for (int rr = 0; rr < 2; ++rr) { const int m = mm[rr]; const float* xrow = (m < MX) ? p.x + (size_t)m * D : p.ctx + (size_t)(m - MX) * D; const GAS f32x4* xr = (const GAS f32x4*)xrow + lane;
#pragma unroll
            for (int j = 0; j < 4; ++j) { q[rr][j] = xr[64 * j]; s[rr] += (q[rr][j].x + q[rr][j].y) + (q[rr][j].z + q[rr][j].w); } }
#pragma unroll
        for (int rr = 0; rr < 2; ++rr) { const int m = mm[rr]; const int v = (m < MX) ? (m >> 13) : 2;
            if (v != cv[rr]) { cv[rr] = v;
#pragma unroll
                for (int j = 0; j < 4; ++j) { const int n = 256 * j + 4 * lane; sc[rr][j] = modv4(p, v, 1024 + n) + 1.f; sh[rr][j] = modv4(p, v, n); } }
            const float mean = wave_sum(s[rr]) * (1.f / D); float s2 = 0.f;
#pragma unroll
            for (int j = 0; j < 4; ++j) { q[rr][j] = q[rr][j] - mean; s2 += (q[rr][j].x * q[rr][j].x + q[rr][j].y * q[rr][j].y) + (q[rr][j].z * q[rr][j].z + q[rr][j].w * q[rr][j].w); }
            const float rstd = 1.f / sqrtf(wave_sum(s2) * (1.f / D) + LN_EPS);
            if (rr == 0 || mm[1] != mm[0]) {
                if (lane == 0) { stats[2 * m] = mean; stats[2 * m + 1] = rstd; }
                GAS v2u* o8 = (GAS v2u*)(H + (size_t)m * D) + lane;
#pragma unroll
                for (int j = 0; j < 4; ++j) { const f32x4 h = q[rr][j] * rstd * sc[rr][j] + sh[rr][j];
                    o8[64 * j] = (v2u){pk2(h[0], h[1]), pk2(h[2], h[3])}; } } }
    }
}

template <int ACT> struct EpiPlain {
    static constexpr bool PERM = true, AFTER_DRAIN = false;
    bf16* O; int ldc; bf16* O2; int ldc2; int split_tile;
    DI void operator()(const pg8::f32x4 (&acc)[2][2][4][2], const pg8::Unit& u, int wr, int wc, int fr, int fq) const {
        const bool second = u.pn >= split_tile; bf16* Ob = second ? O2 : O; const int ld = second ? ldc2 : ldc, pn = second ? u.pn - split_tile : u.pn;
        const int row0 = u.pm * 256 + wr * 64 + fr, col0 = pn * 256 + wc * 32 + 8 * fq;
#pragma unroll
        for (int ai = 0; ai < 2; ++ai)
#pragma unroll
            for (int m = 0; m < 4; ++m) { bf16* rowp = Ob + (size_t)(row0 + ai * 128 + m * 16) * ld + col0;
#pragma unroll
                for (int bj = 0; bj < 2; ++bj) { pg8::f32x4 v0 = acc[ai][bj][m][0], v1 = acc[ai][bj][m][1];
                    if (ACT == 1) {
#pragma unroll
                        for (int i = 0; i < 4; ++i) { v0[i] = sigm_fast(v0[i]); v1[i] = sigm_fast(v1[i]); } }
                    pg8::u32x4 w;
                    if (ACT == 1) { w.x = cvtpk_s(v0[0], v0[1]); w.y = cvtpk_s(v0[2], v0[3]); w.z = cvtpk_s(v1[0], v1[1]); w.w = cvtpk_s(v1[2], v1[3]); }
                    else { w.x = pg8::cvt_pk_bf16(v0[0], v0[1]); w.y = pg8::cvt_pk_bf16(v0[2], v0[3]); w.z = pg8::cvt_pk_bf16(v1[0], v1[1]); w.w = pg8::cvt_pk_bf16(v1[2], v1[3]); }
                    *(pg8::u32x4*)(rowp + bj * 128) = w; } }
    }
};
constexpr int LRU_TOFF = (int)((WS_YLRU - WS_YWF) / (512 * 1024));
struct EpiMix {
    static constexpr bool PERM = true, AFTER_DRAIN = false;
    const bf16* gates; bf16* mbuf;
    DI void operator()(const pg8::f32x4 (&acc)[2][2][4][2], const pg8::Unit& u, int wr, int wc, int fr, int fq) const {
        const bool isa = u.pm < 64; const int row0 = (isa ? u.pm : u.pm - LRU_TOFF) * 256 + wr * 64 + fr, col0 = (u.pn & 3) * 256 + wc * 32 + 8 * fq;
#pragma unroll
        for (int ai = 0; ai < 2; ++ai) {
            pg8::u32x4 gwv[4][2], oldv[4][2];
#pragma unroll
            for (int m = 0; m < 4; ++m)
#pragma unroll
                for (int bj = 0; bj < 2; ++bj) { const int row = row0 + ai * 128 + m * 16, col = col0 + bj * 128;
                    gwv[m][bj] = *(const pg8::u32x4*)(gates + (size_t)row * 2048 + (isa ? 0 : 1024) + col);
                    oldv[m][bj] = (pg8::u32x4){0u, 0u, 0u, 0u}; if (isa) oldv[m][bj] = *(const pg8::u32x4*)(mbuf + (size_t)row * D + col); }
#pragma unroll
            for (int m = 0; m < 4; ++m) { const int row = row0 + ai * 128 + m * 16;
#pragma unroll
                for (int bj = 0; bj < 2; ++bj) { const int col = col0 + bj * 128;
                    const pg8::u32x4 gw = gwv[m][bj];
                    bf16* mp = mbuf + (size_t)row * D + col;
                    const pg8::u32x4 old = oldv[m][bj];
                    const pg8::f32x4 v0 = acc[ai][bj][m][0], v1 = acc[ai][bj][m][1];
                    float r[8];
                    r[0] = v0[0] * bflo(gw.x) + bflo(old.x); r[1] = v0[1] * bfhi(gw.x) + bfhi(old.x); r[2] = v0[2] * bflo(gw.y) + bflo(old.y); r[3] = v0[3] * bfhi(gw.y) + bfhi(old.y);
                    r[4] = v1[0] * bflo(gw.z) + bflo(old.z); r[5] = v1[1] * bfhi(gw.z) + bfhi(old.z); r[6] = v1[2] * bflo(gw.w) + bflo(old.w); r[7] = v1[3] * bfhi(gw.w) + bfhi(old.w);
                    pg8::u32x4 w; w.x = pg8::cvt_pk_bf16(r[0], r[1]); w.y = pg8::cvt_pk_bf16(r[2], r[3]); w.z = pg8::cvt_pk_bf16(r[4], r[5]); w.w = pg8::cvt_pk_bf16(r[6], r[7]);
                    *(pg8::u32x4*)mp = w; } } }
    }
};
struct EpiT1 {
    static constexpr bool PERM = false, AFTER_DRAIN = false;
    const float* x; const float* stats; const float* modp; const float* b_ada; float* T1;
    DI void operator()(const pg8::f32x4 (&acc)[2][2][4][2], const pg8::Unit& u, int wr, int wc, int fr, int fq) const {
        const int row0 = u.pm * 256 + wr * 64 + fr, col0 = u.pn * 256 + wc * 32 + 4 * fq; const int b = (u.pm * 256) >> 13;
        pg8::f32x4 gt[2][2];
#pragma unroll
        for (int bj = 0; bj < 2; ++bj)
#pragma unroll
            for (int n = 0; n < 2; ++n) { const int c = col0 + bj * 128 + n * 16; gt[bj][n] = *(const pg8::f32x4*)(modp + b * 6144 + 2048 + c) + *(const pg8::f32x4*)(b_ada + 2048 + c); }
#pragma unroll
        for (int ai = 0; ai < 2; ++ai)
#pragma unroll
            for (int mh = 0; mh < 2; ++mh) {
                float mean[2], rs[2]; pg8::f32x4 xv[2][2][2];
#pragma unroll
                for (int mm = 0; mm < 2; ++mm) { const int row = row0 + ai * 128 + (2 * mh + mm) * 16; mean[mm] = stats[2 * row]; rs[mm] = stats[2 * row + 1] * ALPHA;
#pragma unroll
                    for (int bj = 0; bj < 2; ++bj)
#pragma unroll
                        for (int n = 0; n < 2; ++n) xv[mm][bj][n] = *(const pg8::f32x4*)(x + (size_t)row * D + col0 + bj * 128 + n * 16); }
#pragma unroll
                for (int mm = 0; mm < 2; ++mm) { const int m = 2 * mh + mm; const int row = row0 + ai * 128 + m * 16;
#pragma unroll
                    for (int bj = 0; bj < 2; ++bj)
#pragma unroll
                        for (int n = 0; n < 2; ++n) *(pg8::f32x4*)(T1 + (size_t)row * D + col0 + bj * 128 + n * 16) = (xv[mm][bj][n] - mean[mm]) * rs[mm] + gt[bj][n] * acc[ai][bj][m][n]; } }
    }
};
struct EpiSwiGLU {
    static constexpr bool PERM = true, AFTER_DRAIN = false;
    bf16* hb;
    DI void operator()(const pg8::f32x4 (&acc)[2][2][4][2], const pg8::Unit& u, int wr, int wc, int fr, int fq) const {
        const int row0 = u.pm * 256 + wr * 64 + fr, col0 = (u.pn & 3) * 128 + wc * 32 + 8 * fq;
#pragma unroll
        for (int ai = 0; ai < 2; ++ai)
#pragma unroll
            for (int m = 0; m < 4; ++m) { float r[8];
#pragma unroll
                for (int n = 0; n < 2; ++n)
#pragma unroll
                    for (int i = 0; i < 4; ++i) { const float a = acc[ai][0][m][n][i], b = acc[ai][1][m][n][i]; r[4 * n + i] = a * sigm_fast(a) * b; }
                pg8::u32x4 w; w.x = pg8::cvt_pk_bf16(r[0], r[1]); w.y = pg8::cvt_pk_bf16(r[2], r[3]); w.z = pg8::cvt_pk_bf16(r[4], r[5]); w.w = pg8::cvt_pk_bf16(r[6], r[7]);
                *(pg8::u32x4*)(hb + (size_t)(row0 + ai * 128 + m * 16) * DEXP + col0) = w; }
    }
};
struct EpiW2 {
    static constexpr bool PERM = true, AFTER_DRAIN = false;
    bf16* yb; const LAS int* tile; const int* s2t; const float* tokw;
    DI void operator()(const pg8::f32x4 (&acc)[2][2][4][2], const pg8::Unit& u, int wr, int wc, int fr, int fq) const {
        const int row0 = u.pm * 256 + wr * 64 + fr, col0 = (u.pn & 3) * 256 + wc * 32 + 8 * fq;
        const int ex = tile[u.pm], slot0 = (u.pm - tile[MAXT + ex]) * 256 + wr * 64 + fr, cnt = tile[MAXT + 64 + ex];
        int si[2][4]; float rwv[2][4];
#pragma unroll
        for (int ai = 0; ai < 2; ++ai)
#pragma unroll
            for (int m = 0; m < 4; ++m) { const int slot = slot0 + ai * 128 + m * 16; si[ai][m] = slot < cnt ? s2t[(size_t)ex * MX + slot] : -1; }
#pragma unroll
        for (int ai = 0; ai < 2; ++ai)
#pragma unroll
            for (int m = 0; m < 4; ++m) rwv[ai][m] = si[ai][m] >= 0 ? tokw[si[ai][m]] : 0.f;
#pragma unroll
        for (int ai = 0; ai < 2; ++ai)
#pragma unroll
            for (int m = 0; m < 4; ++m) { const int row = row0 + ai * 128 + m * 16; const float rw = rwv[ai][m];
#pragma unroll
                for (int bj = 0; bj < 2; ++bj) { const pg8::f32x4 v0 = acc[ai][bj][m][0] * rw, v1 = acc[ai][bj][m][1] * rw;
                    pg8::u32x4 w; w.x = pg8::cvt_pk_bf16(v0[0], v0[1]); w.y = pg8::cvt_pk_bf16(v0[2], v0[3]); w.z = pg8::cvt_pk_bf16(v1[0], v1[1]); w.w = pg8::cvt_pk_bf16(v1[2], v1[3]);
                    *(pg8::u32x4*)(yb + (size_t)row * D + col0 + bj * 128) = w; } }
    }
};
struct SchedMix : pg8::StaticOrder {
    __device__ bool next(int i, pg8::Unit& u) const { pg8::Unit t; if (!pg8::StaticOrder::next(i >> 1, t)) return false; const int w = i & 1; u.pm = w ? t.pm : t.pm + LRU_TOFF; u.pn = w ? t.pn : t.pn + 4; return true; }
};
struct SchedMoE {
    const LAS int* tile; int G, c; const int* s2t;
    DI int src_row(int T, int r) const { const int e = tile[T], slot = (T - tile[MAXT + e]) * 256 + r; return slot < tile[MAXT + 64 + e] ? (s2t[(size_t)e * MX + slot] >> 1) : MX; }
    __device__ bool next(int i, pg8::Unit& u) const { int L = i * G + c; const int U = tile[MAXT + 40] * 4; if (L >= U) return false;
        { const int q = U / pg8::NXCD, r = U % pg8::NXCD, xcd = L % pg8::NXCD, off = L / pg8::NXCD; L = (xcd < r ? xcd * (q + 1) : r * (q + 1) + (xcd - r) * q) + off; }
        const int T = L >> 2; u.pm = T; u.pn = tile[T] * 4 + (L & 3); return true; }
    DI void a_ready(const pg8::Unit&) const {}
    DI void done(const pg8::Unit&) const {}
};

DI int chunk_row0(int b, int ci) { return ci < 4 ? MX + b * CTXL + ci * 64 : b * SEQ + (ci - 4) * 64; }
DI float gelu_tanh(float x) { const float u = 0.7978845608028654f * (x + 0.044715f * x * x * x); const float t = 1.f - 2.f * frcp(1.f + __expf(2.f * u)); return 0.5f * x * (1.f + t); }
constexpr int NHS = 264;
constexpr int LR_WT = 0, LR_CW = 36864, LR_WV = 38400, LR_WVS = 6656, LR_GC = LR_WV + NWAVES * LR_WVS;
DI void lru_setup(const P& p, LAS unsigned char* lds, int tid, int hb) {
    LAS bf16* WT = (LAS bf16*)(lds + LR_WT); LAS float* CW = (LAS float*)(lds + LR_CW);
    __syncthreads();
    for (int i = tid; i < 4 * 4096; i += NTHR) { const int m = i >> 12, k = (i >> 6) & 63, n = i & 63; const int e = m & 1;
        const float w = (m < 2 ? p.lru_wa : p.lru_wx)[((size_t)(e * 16 + hb) * 64 + k) * 64 + n]; WT[m * 4608 + n * 72 + k] = (bf16)f2bf(NL2E * w); }
    for (int i = tid; i < 6 * 64; i += NTHR) { const int r = i >> 6, c = i & 63; CW[i] = r < 5 ? p.conv_w[r * D + hb * 64 + c] : p.conv_b[hb * 64 + c]; }
    for (int i = tid; i < 6 * 64; i += NTHR) { const int e = i / 192, k = (i >> 6) % 3, c = hb * 64 + (i & 63);
        ((LAS float*)(lds + LR_GC))[i] = k == 0 ? NL2E * p.lru_ba[e * D + c] : k == 1 ? NL2E * p.lru_bx[e * D + c] : (8.f * NL2E) * log1pf(__expf(-p.lru_lam[e * D + c])); }
    __syncthreads();
}
DI void hs_geom(int b, int hs, int& row0, int& tb, int& tlen) { if (hs < 8) { tb = hs * 32; row0 = MX + b * CTXL + tb; tlen = CTXL; } else { tb = (hs - 8) * 32; row0 = b * SEQ + tb; tlen = SEQ; } }
DI void lru_conv(const bf16* S, LAS unsigned char* lds, LAS unsigned char* wv, int lane, int hb, int rowb, int tb, int tlen) {
    LAS float* CW = (LAS float*)(lds + LR_CW); LAS bf16* XCB = (LAS bf16*)wv; LAS float* XC = (LAS float*)(wv + 2304);
    const int tau = lane >> 2, qd = lane & 3; const unsigned char* Sb = (const unsigned char*)S; const unsigned ob = (unsigned)((rowb + tau) * NS2 + C_XB + hb * 64 + qd * 16) * 2u;
    float a[16];
#pragma unroll
    for (int i4 = 0; i4 < 4; ++i4) { const f32x4 bv = *(const LAS f32x4*)(CW + 5 * 64 + qd * 16 + 4 * i4); a[4 * i4] = bv[0]; a[4 * i4 + 1] = bv[1]; a[4 * i4 + 2] = bv[2]; a[4 * i4 + 3] = bv[3]; }
    v4u w[5][2];
#pragma unroll
    for (int i = 0; i < 5; ++i) { const int t = tb + tau + i - 2; const bool ok = t >= 0 && t < tlen;
        const unsigned oi = ob + (unsigned)((i - 2) * NS2 * 2); w[i][0] = ok ? *(const v4u*)(Sb + oi) : (v4u){0u, 0u, 0u, 0u}; w[i][1] = ok ? *(const v4u*)(Sb + oi + 16) : (v4u){0u, 0u, 0u, 0u}; }
#pragma unroll
    for (int i = 0; i < 5; ++i)
#pragma unroll
        for (int hh = 0; hh < 2; ++hh) { const f32x4 c0 = *(const LAS f32x4*)(CW + i * 64 + qd * 16 + hh * 8), c1 = *(const LAS f32x4*)(CW + i * 64 + qd * 16 + hh * 8 + 4); const v4u x = w[i][hh];
            a[hh * 8 + 0] += c0[0] * bflo(x.x); a[hh * 8 + 1] += c0[1] * bfhi(x.x); a[hh * 8 + 2] += c0[2] * bflo(x.y); a[hh * 8 + 3] += c0[3] * bfhi(x.y);
            a[hh * 8 + 4] += c1[0] * bflo(x.z); a[hh * 8 + 5] += c1[1] * bfhi(x.z); a[hh * 8 + 6] += c1[2] * bflo(x.w); a[hh * 8 + 7] += c1[3] * bfhi(x.w); }
#pragma unroll
    for (int i4 = 0; i4 < 4; ++i4) *(LAS f32x4*)(XC + tau * 68 + qd * 16 + 4 * i4) = (f32x4){a[4 * i4], a[4 * i4 + 1], a[4 * i4 + 2], a[4 * i4 + 3]};
    *(LAS v4u*)(XCB + tau * 72 + qd * 16) = (v4u){pk2(a[0], a[1]), pk2(a[2], a[3]), pk2(a[4], a[5]), pk2(a[6], a[7])};
    *(LAS v4u*)(XCB + tau * 72 + qd * 16 + 8) = (v4u){pk2(a[8], a[9]), pk2(a[10], a[11]), pk2(a[12], a[13]), pk2(a[14], a[15])};
}
DI void lru_gates_nt(LAS unsigned char* lds, LAS unsigned char* wv, int lane, int nt, const bf16x8 (&ax)[2], float (&av)[2][4], float (&uv)[2][4]) {
    LAS bf16* WT = (LAS bf16*)(lds + LR_WT); LAS float* XC = (LAS float*)(wv + 2304);
    const int l15 = lane & 15, g = lane >> 4;
    pg8::f32x4 zr[2], zi[2];
#pragma unroll
    for (int e = 0; e < 2; ++e) { zr[e] = (pg8::f32x4){0.f, 0.f, 0.f, 0.f}; zi[e] = (pg8::f32x4){0.f, 0.f, 0.f, 0.f}; }
#pragma unroll
    for (int ks = 0; ks < 2; ++ks)
#pragma unroll
        for (int e = 0; e < 2; ++e) { const bf16x8 br = *(const LAS bf16x8*)(WT + e * 4608 + (nt * 16 + l15) * 72 + ks * 32 + g * 8), bi = *(const LAS bf16x8*)(WT + (2 + e) * 4608 + (nt * 16 + l15) * 72 + ks * 32 + g * 8);
            zr[e] = __builtin_amdgcn_mfma_f32_16x16x32_bf16(ax[ks], br, zr[e], 0, 0, 0); zi[e] = __builtin_amdgcn_mfma_f32_16x16x32_bf16(ax[ks], bi, zi[e], 0, 0, 0); }
    const f32x4 xc = {XC[(4 * g + 0) * 68 + nt * 16 + l15], XC[(4 * g + 1) * 68 + nt * 16 + l15], XC[(4 * g + 2) * 68 + nt * 16 + l15], XC[(4 * g + 3) * 68 + nt * 16 + l15]};
    const LAS float* GC = (const LAS float*)(lds + LR_GC) + nt * 16 + l15;
#pragma unroll
    for (int e = 0; e < 2; ++e) { const float cba = GC[e * 192], cbx = GC[e * 192 + 64], csp = GC[e * 192 + 128];
        const f32x4 xr = (f32x4){zr[e][0], zr[e][1], zr[e][2], zr[e][3]} + cba, xi = (f32x4){zi[e][0], zi[e][1], zi[e][2], zi[e][3]} + cbx;
        const f32x4 dr = (f32x4){__builtin_amdgcn_exp2f(xr[0]), __builtin_amdgcn_exp2f(xr[1]), __builtin_amdgcn_exp2f(xr[2]), __builtin_amdgcn_exp2f(xr[3])} + 1.f;
        const f32x4 di = (f32x4){__builtin_amdgcn_exp2f(xi[0]), __builtin_amdgcn_exp2f(xi[1]), __builtin_amdgcn_exp2f(xi[2]), __builtin_amdgcn_exp2f(xi[3])} + 1.f;
        const f32x4 la = (f32x4){frcp(dr[0]), frcp(dr[1]), frcp(dr[2]), frcp(dr[3])} * csp;
        const f32x4 ig = {frcp(di[0]), frcp(di[1]), frcp(di[2]), frcp(di[3])};
        const f32x4 a = {__builtin_amdgcn_exp2f(la[0]), __builtin_amdgcn_exp2f(la[1]), __builtin_amdgcn_exp2f(la[2]), __builtin_amdgcn_exp2f(la[3])};
        const f32x4 em = 1.f - a * a;
        const f32x4 sq = {__builtin_amdgcn_sqrtf(fmaxf(em[0], 0.f)), __builtin_amdgcn_sqrtf(fmaxf(em[1], 0.f)), __builtin_amdgcn_sqrtf(fmaxf(em[2], 0.f)), __builtin_amdgcn_sqrtf(fmaxf(em[3], 0.f))};
        const f32x4 u = sq * ig * xc;
#pragma unroll
        for (int i = 0; i < 4; ++i) { av[e][i] = a[i]; uv[e][i] = u[i]; } }
}
DI float bperm(int srclane, float v) { return __builtin_bit_cast(float, __builtin_amdgcn_ds_bpermute(srclane * 4, __builtin_bit_cast(int, v))); }
template <int DIR> DI void lru_local(const float (&a)[4], const float (&u)[4], int l15, float (&hl)[4], float (&pl)[4], float (&PG)[4], float (&HG)[4]) {
    float h = 0.f, pr = 1.f;
#pragma unroll
    for (int q = 0; q < 4; ++q) { const int i = DIR ? 3 - q : q; h = a[i] * h + u[i]; pr *= a[i]; hl[i] = h; pl[i] = pr; }
#pragma unroll
    for (int gg = 0; gg < 4; ++gg) { PG[gg] = bperm(gg * 16 + l15, pr); HG[gg] = bperm(gg * 16 + l15, h); }
}
DI void lru_unit(const P& p, LAS unsigned char* lds, int lane, int wave, int b, int hs, int hb) {
    const bf16* S = (const bf16*)(p.ws + WS_S2); LAS unsigned char* wv = lds + LR_WV + wave * LR_WVS; LAS bf16* XCB = (LAS bf16*)wv;
    const int l15 = lane & 15, g = lane >> 4; int row0, tb, tlen; hs_geom(b, hs, row0, tb, tlen);
    const unsigned ao0 = (unsigned)(((b * NHS + hs) * 2) * D + hb * 64 + l15) * 4u;
    unsigned char* FB = p.ws + WS_FB; unsigned char* SB = p.ws + WS_YLRU; unsigned char* BG = p.ws + WS_BAG;
    const bool mainrow = hs >= 8; const unsigned bg0 = (unsigned)(((b * 256 + (hs - 8)) * 4) * D + hb * 64 + l15) * 4u;
    float Af[4], Hf[4], Ab[4], Hb[4];
#pragma unroll
    for (int nt = 0; nt < 4; ++nt) { Af[nt] = 1.f; Hf[nt] = 0.f; Ab[nt] = 1.f; Hb[nt] = 0.f; }
#pragma unroll 1
    for (int band = 0; band < 2; ++band) { lru_conv(S, lds, wv, lane, hb, row0 + band * 16, tb + band * 16, tlen);
        bf16x8 ax[2]; const unsigned yb = (unsigned)((row0 + band * 16 + 4 * g) * D + hb * 64 + l15);
#pragma unroll
        for (int ks = 0; ks < 2; ++ks) ax[ks] = *(const LAS bf16x8*)(XCB + l15 * 72 + ks * 32 + g * 8);
#pragma unroll
        for (int nt = 0; nt < 4; ++nt) { float av[2][4], uv[2][4], hl[4], pl[4], PG[4], HG[4], sf[4], pf[4];
            __builtin_amdgcn_sched_barrier(0);
            lru_gates_nt(lds, wv, lane, nt, ax, av, uv);
            lru_local<0>(av[0], uv[0], l15, hl, pl, PG, HG); float cc = 0.f, Pc = 1.f, cm = 0.f, Pm = 1.f;
#pragma unroll
            for (int gg = 0; gg < 4; ++gg) { if (gg == g) { cm = cc; Pm = Pc; } cc = PG[gg] * cc + HG[gg]; Pc *= PG[gg]; }
#pragma unroll
            for (int i = 0; i < 4; ++i) { sf[i] = hl[i] + pl[i] * cm; pf[i] = pl[i] * Pm; }
            Hf[nt] = Pc * Hf[nt] + cc; Af[nt] *= Pc;
            if (mainrow && band == 0 && g == 0) { *(float*)(BG + (size_t)bg0 + nt * 64) = Pc; *(float*)((BG + D * 4) + (size_t)bg0 + nt * 64) = cc; }
            lru_local<1>(av[1], uv[1], l15, hl, pl, PG, HG); float c = 0.f, Pb = 1.f, cmb = 0.f, Pmb = 1.f;
#pragma unroll
            for (int gg = 3; gg >= 0; --gg) { if (gg == g) { cmb = c; Pmb = Pb; } c = PG[gg] * c + HG[gg]; Pb *= PG[gg]; }
            Hb[nt] = Ab[nt] * c + Hb[nt]; Ab[nt] *= Pb;
            if (mainrow && band == 1 && g == 0) { *(float*)((BG + 2 * D * 4) + (size_t)bg0 + nt * 64) = Pb; *(float*)((BG + 3 * D * 4) + (size_t)bg0 + nt * 64) = c; }
            if (mainrow) {
#pragma unroll
                for (int i = 0; i < 4; ++i) { *(bf16*)((SB + i * D * 2) + (size_t)(yb * 2u) + nt * 32) = (bf16)f2bf(sf[i] + hl[i] + pl[i] * cmb); *(unsigned*)((FB + i * D * 4) + (size_t)(yb * 4u) + nt * 64) = pk2(pf[i], pl[i] * Pmb); } } } }
    if (g == 0) { unsigned char* GA = p.ws + WS_AGGA; unsigned char* GH = p.ws + WS_AGGH;
#pragma unroll
        for (int nt = 0; nt < 4; ++nt) { *(float*)(GA + (size_t)ao0 + nt * 64) = Af[nt]; *(float*)(GH + (size_t)ao0 + nt * 64) = Hf[nt]; *(float*)((GA + D * 4) + (size_t)ao0 + nt * 64) = Ab[nt]; *(float*)((GH + D * 4) + (size_t)ao0 + nt * 64) = Hb[nt]; } }
}
DI void lru_finish(const P& p, int lane, int wave, int G) {
    const float* CI = (const float*)(p.ws + WS_CIN); const float* BG = (const float*)(p.ws + WS_BAG); const unsigned* FB = (const unsigned*)(p.ws + WS_FB); const bf16* S = (const bf16*)(p.ws + WS_S2); bf16* Y = (bf16*)(p.ws + WS_YLRU);
    for (int item = blockIdx.x * NWAVES + wave; item < (MX / 16) * 2; item += G * NWAVES) { const int bi = item >> 1, ch = (item & 1) * 512 + lane * 8, b = bi / (SEQ / 16), bs = bi % (SEQ / 16), hsm = bs >> 1, band = bs & 1;
        const size_t co = ((size_t)(b * NHS + 8 + hsm) * 2) * D + ch, bg = ((size_t)(b * 256 + hsm) * 4) * D + ch;
        float cf[8], cb[8];
#pragma unroll
        for (int j = 0; j < 2; ++j) { const f32x4 f = *(const f32x4*)(CI + co + 4 * j), q = *(const f32x4*)(CI + co + D + 4 * j);
            if (band) { const f32x4 A = *(const f32x4*)(BG + bg + 4 * j), H = *(const f32x4*)(BG + bg + D + 4 * j);
#pragma unroll
                for (int k = 0; k < 4; ++k) { cf[4 * j + k] = A[k] * f[k] + H[k]; cb[4 * j + k] = q[k]; } }
            else { const f32x4 A = *(const f32x4*)(BG + bg + 2 * D + 4 * j), H = *(const f32x4*)(BG + bg + 3 * D + 4 * j);
#pragma unroll
                for (int k = 0; k < 4; ++k) { cf[4 * j + k] = f[k]; cb[4 * j + k] = A[k] * q[k] + H[k]; } } }
        const size_t r0 = (size_t)b * SEQ + bs * 16;
#pragma unroll 1
        for (int rq = 0; rq < 16; rq += 4) { v4u sv[4], f0[4], f1[4], gv[4];
#pragma unroll
            for (int r = 0; r < 4; ++r) { const size_t row = r0 + rq + r; sv[r] = *(const v4u*)(Y + row * D + ch); f0[r] = *(const v4u*)(FB + row * D + ch); f1[r] = *(const v4u*)(FB + row * D + ch + 4); gv[r] = *(const v4u*)(S + row * NS2 + C_GBR + ch); }
#pragma unroll
            for (int r = 0; r < 4; ++r) { const size_t row = r0 + rq + r; const unsigned sw[4] = {sv[r].x, sv[r].y, sv[r].z, sv[r].w}, gw[4] = {gv[r].x, gv[r].y, gv[r].z, gv[r].w}, fw[8] = {f0[r].x, f0[r].y, f0[r].z, f0[r].w, f1[r].x, f1[r].y, f1[r].z, f1[r].w};
                unsigned o[4];
#pragma unroll
                for (int k = 0; k < 4; ++k) { const float y0 = (bflo(sw[k]) + bflo(fw[2 * k]) * cf[2 * k] + bfhi(fw[2 * k]) * cb[2 * k]) * gelu_tanh(bflo(gw[k])), y1 = (bfhi(sw[k]) + bflo(fw[2 * k + 1]) * cf[2 * k + 1] + bfhi(fw[2 * k + 1]) * cb[2 * k + 1]) * gelu_tanh(bfhi(gw[k]));
                    o[k] = pk2(y0, y1); }
                *(v4u*)(Y + row * D + ch) = (v4u){o[0], o[1], o[2], o[3]}; } } }
}
DI void lru_carry(const P& p, LAS unsigned char* lds, int tid, int G) {
    const float* A = (const float*)(p.ws + WS_AGGA); const float* H = (const float*)(p.ws + WS_AGGH); float* CI = (float*)(p.ws + WS_CIN);
    LAS float* XA = (LAS float*)lds; LAS float* XH = XA + 512;
    for (int wgi = blockIdx.x; wgi < 64; wgi += G) { const int seg = tid >> 6, chain = wgi * 64 + (tid & 63), c = chain & (D - 1), e = (chain >> 10) & 1, b = chain >> 11;
        float a[33], h[33]; float As = 1.f, Hs = 0.f;
#pragma unroll
        for (int k = 0; k < 33; ++k) { const int st = seg * 33 + k, hs = e ? (st < 8 ? 7 - st : 271 - st) : st; const size_t o = ((size_t)(b * NHS + hs) * 2 + e) * D + c; a[k] = A[o]; h[k] = H[o]; }
#pragma unroll
        for (int k = 0; k < 33; ++k) { Hs = a[k] * Hs + h[k]; As *= a[k]; }
        __syncthreads(); XA[tid] = As; XH[tid] = Hs; __syncthreads();
        float cy = 0.f;
        for (int sg = 0; sg < seg; ++sg) cy = XA[sg * 64 + (tid & 63)] * cy + XH[sg * 64 + (tid & 63)];
#pragma unroll
        for (int k = 0; k < 33; ++k) { const int st = seg * 33 + k, hs = e ? (st < 8 ? 7 - st : 271 - st) : st; CI[((size_t)(b * NHS + hs) * 2 + e) * D + c] = cy; cy = a[k] * cy + h[k]; } }
}

DI float tanh_fast(float x) { return 1.f - 2.f * frcp(1.f + __expf(2.f * x)); }
struct MixLd { v4u w; v4u n[4]; };
DI void mix_ld(const bf16* own, const bf16* const (&np)[4], int cb, MixLd& L) {
    L.w = *(const v4u*)(own + cb);
#pragma unroll
    for (int i = 0; i < 4; ++i) L.n[i] = *(const v4u*)(np[i] + cb);
}
DI void mix_do(const MixLd& L, const float (&nv)[4], const float* mu, int cb, float (&o)[8]) {
    const v4u w = L.w;
    const f32x4 m0 = *(const f32x4*)(mu + cb), m1 = *(const f32x4*)(mu + cb + 4);
    const float ow[8] = {bflo(w.x), bfhi(w.x), bflo(w.y), bfhi(w.y), bflo(w.z), bfhi(w.z), bflo(w.w), bfhi(w.w)};
    const float nb[8] = {bflo(L.n[0].x) * nv[0], bfhi(L.n[1].x) * nv[1], bflo(L.n[2].y) * nv[2], bfhi(L.n[3].y) * nv[3], bflo(L.n[0].z) * nv[0], bfhi(L.n[1].z) * nv[1], bflo(L.n[2].w) * nv[2], bfhi(L.n[3].w) * nv[3]};
#pragma unroll
    for (int i = 0; i < 4; ++i) { o[i] = ow[i] + m0[i] * (nb[i] - ow[i]); o[4 + i] = ow[4 + i] + m1[i] * (nb[4 + i] - ow[4 + i]); }
}
DI void mix_do2(const MixLd& L, const float (&nv)[4], const f32x4 m0, const f32x4 m1, float (&o)[8]) {
    const v4u w = L.w;
    const float ow[8] = {bflo(w.x), bfhi(w.x), bflo(w.y), bfhi(w.y), bflo(w.z), bfhi(w.z), bflo(w.w), bfhi(w.w)};
    const float nb[8] = {bflo(L.n[0].x) * nv[0], bfhi(L.n[1].x) * nv[1], bflo(L.n[2].y) * nv[2], bfhi(L.n[3].y) * nv[3], bflo(L.n[0].z) * nv[0], bfhi(L.n[1].z) * nv[1], bflo(L.n[2].w) * nv[2], bfhi(L.n[3].w) * nv[3]};
#pragma unroll
    for (int i = 0; i < 4; ++i) { o[i] = ow[i] + m0[i] * (nb[i] - ow[i]); o[4 + i] = ow[4 + i] + m1[i] * (nb[4 + i] - ow[4 + i]); }
}
DI void mix8(const bf16* own, const bf16* const (&np)[4], const float (&nv)[4], const float* mu, int cb, float (&o)[8]) { MixLd L; mix_ld(own, np, cb, L); mix_do(L, nv, mu, cb, o); }
DI void nbr_rows(const bf16* S, int b, int ci, int j, const bf16*& own, const bf16* (&np)[4], float (&nv)[4]) {
    const int row = chunk_row0(b, ci) + j; own = S + (size_t)row * NS1;
    if (ci >= 4) { const int gr = ci - 4; const bool v0 = j > 0, v1 = j < 63, v2 = gr > 0, v3 = gr < 127;
        np[0] = v0 ? own - NS1 : own; np[1] = v1 ? own + NS1 : own; np[2] = v2 ? own - (size_t)64 * NS1 : own; np[3] = v3 ? own + (size_t)64 * NS1 : own;
        nv[0] = v0 ? 1.f : 0.f; nv[1] = v1 ? 1.f : 0.f; nv[2] = v2 ? 1.f : 0.f; nv[3] = v3 ? 1.f : 0.f; }
    else { const int t = ci * 64 + j; const bool v0 = t > 0, v1 = t < CTXL - 1;
        np[0] = np[2] = v0 ? own - NS1 : own; np[1] = np[3] = v1 ? own + NS1 : own; nv[0] = nv[2] = v0 ? 1.f : 0.f; nv[1] = nv[3] = v1 ? 1.f : 0.f; }
}
DI float red8(float x) { x += dppf<0xB1>(x); x += dppf<0x4E>(x); x += dppf<0x141>(x); return x; }
DI void mix_store(bf16* zr, const f32x4 k0, const f32x4 k1, int it, int gi, int cb, const float (&o)[8]) {
    if (it < 2 || it == 4 || it == 5) { *(v4u*)(zr + cb) = (v4u){pk2(o[0], o[1]), pk2(o[2], o[3]), pk2(o[4], o[5]), pk2(o[6], o[7])}; }
    else if (it == 2 || it == 3) {
        *(v4u*)(zr + cb) = (v4u){pk2(o[0], o[1]), pk2(o[2], o[3]), pk2(o[4], o[5]), pk2(o[6], o[7])};
        float kr[8], ss = 0.f;
#pragma unroll
        for (int i = 0; i < 4; ++i) { kr[i] = o[i] * k0[i]; kr[4 + i] = o[4 + i] * k1[i]; ss += kr[i] * kr[i] + kr[4 + i] * kr[4 + i]; }
        ss = red8(ss); const float inv = __builtin_amdgcn_rsqf(ss + 1e-12f);
        *(v4u*)(zr + Z_KK + cb - C_K) = (v4u){pk2(kr[0] * inv, kr[1] * inv), pk2(kr[2] * inv, kr[3] * inv), pk2(kr[4] * inv, kr[5] * inv), pk2(kr[6] * inv, kr[7] * inv)}; }
    else if (gi < 392) { *(v4u*)(zr + Z_TW + cb - C_WD) = (v4u){pk2(tanh_fast(o[0]), tanh_fast(o[1])), pk2(tanh_fast(o[2]), tanh_fast(o[3])), pk2(tanh_fast(o[4]), tanh_fast(o[5])), pk2(tanh_fast(o[6]), tanh_fast(o[7]))}; }
    else if (gi < 400) { *(v4u*)(zr + Z_AD + cb - C_AD) = (v4u){pk2(o[0], o[1]), pk2(o[2], o[3]), pk2(o[4], o[5]), pk2(o[6], o[7])}; }
    else if (gi < 420) { *(v4u*)(zr + Z_GS + cb - C_GD) = (v4u){pk2(sigm_fast(o[0]), sigm_fast(o[1])), pk2(sigm_fast(o[2]), sigm_fast(o[3])), pk2(sigm_fast(o[4]), sigm_fast(o[5])), pk2(sigm_fast(o[6]), sigm_fast(o[7]))}; }
}
DI void mix_geom(int m, int& b, int& ci, int& j) { if (m < MX) { b = m >> 13; const int t = m & (SEQ - 1); ci = 4 + (t >> 6); j = t & 63; } else { const int t = (m - MX) & (CTXL - 1); b = (m - MX) >> 8; ci = t >> 6; j = t & 63; } }
DI void phase_mix(const P& p, int lane, int wave, int G) {
    const bf16* S = (const bf16*)(p.ws + WS_S1); bf16* Z = (bf16*)(p.ws + WS_ZM);
    const int gw = blockIdx.x * NWAVES + wave, NGW = G * NWAVES;
    f32x4 mu0[7], mu1[7], kk0[2], kk1[2];
#pragma unroll
    for (int it = 0; it < 7; ++it) { const int gi = lane + 64 * it; const int cb = (gi < 420 ? gi : 0) * 8; mu0[it] = *(const f32x4*)(p.mu_a + cb); mu1[it] = *(const f32x4*)(p.mu_a + cb + 4);
        if (it == 2 || it == 3) { kk0[it - 2] = *(const f32x4*)(p.k_k + cb - C_K); kk1[it - 2] = *(const f32x4*)(p.k_k + cb - C_K + 4); } }
    for (int m0 = gw; m0 < MALL; m0 += 2 * NGW) { const int m1 = m0 + NGW; const bool two = m1 < MALL; const int m1c = two ? m1 : m0;
        int b0, ci0, j0, b1, ci1, j1; mix_geom(m0, b0, ci0, j0); mix_geom(m1c, b1, ci1, j1);
        const bf16* own0; const bf16* np0[4]; float nv0[4]; nbr_rows(S, b0, ci0, j0, own0, np0, nv0);
        const bf16* own1; const bf16* np1[4]; float nv1[4]; nbr_rows(S, b1, ci1, j1, own1, np1, nv1);
        bf16* zr0 = Z + (size_t)m0 * NZM; bf16* zr1 = Z + (size_t)m1c * NZM;
#pragma unroll
        for (int it = 0; it < 7; ++it) { const int gi = lane + 64 * it; const int cb = (gi < 420 ? gi : 0) * 8; MixLd L0, L1; float o0[8], o1[8];
            mix_ld(own0, np0, cb, L0); mix_ld(own1, np1, cb, L1);
            mix_do2(L0, nv0, mu0[it], mu1[it], o0); mix_do2(L1, nv1, mu0[it], mu1[it], o1);
            const f32x4 kw0 = (it == 2 || it == 3) ? kk0[it == 3] : mu0[0], kw1 = (it == 2 || it == 3) ? kk1[it == 3] : mu0[0];
            mix_store(zr0, kw0, kw1, it, gi, cb, o0); if (two) mix_store(zr1, kw0, kw1, it, gi, cb, o1); }
    }
}
#define WK_BAR() do { asm volatile("s_waitcnt lgkmcnt(0)" ::: "memory"); __builtin_amdgcn_s_barrier(); asm volatile("" ::: "memory"); } while (0)
constexpr int WB_NB = NCH * 4;
constexpr int WB_AT = 0, WB_RT = 2304, WB_BC = 4608, WB_KC = 6912, WB_P4 = 9216, WB_GKT = 14336, WB_TT = 14848, WB_P5 = 15360, WB_VT = 16640, WB_PP = 17152, WB_MM = 17408, WB_SLOT = 18432;
constexpr int WB_W2T = 7 * WB_SLOT, WB_A2T = WB_W2T + 9216, WB_CST = WB_A2T + 9216, WB_FLG = WB_CST + 1024;
typedef short s16x4 __attribute__((ext_vector_type(4)));
DI v2u cvt2(float a, float b, float c, float d) { return (v2u){cvtpk_s(a, b), cvtpk_s(c, d)}; }
DI bf16x8 frag2(v2u lo, v2u hi) { return __builtin_bit_cast(bf16x8, (v4u){lo.x, lo.y, hi.x, hi.y}); }
DI float pfx16(float x) { x += dppf<0x111>(x); x += dppf<0x112>(x); x += dppf<0x114>(x); x += dppf<0x118>(x); return x; }
#define WB_LOADS(qq) do { const int sidx_ = (qq) >> 2, ci_ = e ? (sidx_ < 4 ? 3 - sidx_ : NCH + 3 - sidx_) : sidx_, pos_ = ((qq) & 3) * 16 + c, j_ = e ? 63 - pos_ : pos_; \
                    const bf16* zr = Z + (size_t)(chunk_row0(b, ci_) + j_) * NZM; \
                    _Pragma("unroll") for (int hh_ = 0; hh_ < 2; ++hh_) { const int c0 = h * 64 + 16 * g + 8 * hh_;     \
                        const v4u vk_ = *(const v4u*)(zr + Z_KK + c0), vr_ = *(const v4u*)(zr + Z_R + c0), vq_ = *(const v4u*)(zr + Z_K + c0); \
                        Lkk[2 * hh_] = (v2u){vk_.x, vk_.y}; Lkk[2 * hh_ + 1] = (v2u){vk_.z, vk_.w}; Lr[2 * hh_] = (v2u){vr_.x, vr_.y}; Lr[2 * hh_ + 1] = (v2u){vr_.z, vr_.w}; Lk[2 * hh_] = (v2u){vq_.x, vq_.y}; Lk[2 * hh_ + 1] = (v2u){vq_.z, vq_.w}; } \
                    Lv = *(const v2u*)(zr + Z_V + h * 64 + rg * 16 + 4 * g); \
                    tw[0] = *(const v4u*)(zr + Z_TW + g * 8); tw[1] = *(const v4u*)(zr + Z_TW + 32 + g * 8); ad[0] = *(const v4u*)(zr + Z_AD + g * 8); ad[1] = *(const v4u*)(zr + Z_AD + 32 + g * 8); } while (0)
DI void lds_wait_ge(volatile LAS int* f, int v, volatile LAS int* abortf) {
    int sp = 0;
    while (__builtin_amdgcn_readfirstlane(*f) < v) { __builtin_amdgcn_s_sleep(1); if (((++sp) & 63) == 0) { if (__builtin_amdgcn_readfirstlane(*abortf)) break; if (sp > (1 << 18)) { *abortf = 1; break; } } }
    asm volatile("" ::: "memory");
}
DI void wkv_blk_wg(const P& p, LAS unsigned char* lds, int tid, int lane, int wave, int unit) {
    const int xx = unit & 7, yy = unit >> 3, rg = yy & 3, scan = xx * 8 + (yy >> 2), e = scan & 1, h = (scan >> 1) & 15, b = scan >> 5;
    const bf16* Z = (const bf16*)(p.ws + WS_ZM);
    LAS bf16* W2T = (LAS bf16*)(lds + WB_W2T); LAS bf16* A2T = (LAS bf16*)(lds + WB_A2T); LAS float* CST = (LAS float*)(lds + WB_CST);
    __syncthreads();
    volatile LAS int* RDY = (volatile LAS int*)(lds + WB_FLG); volatile LAS int* CNS = RDY + 8; volatile LAS int* ABT = RDY + 16;
    if (tid < 32) RDY[tid] = 0;
    if (tid < 64) { const int ch = 16 * ((tid >> 2) & 3) + 4 * (tid >> 4) + (tid & 3);
        const float ka = p.k_a[h * 64 + ch]; CST[tid] = NL2E * p.w0[e * D + h * 64 + ch]; CST[64 + tid] = NL2E * p.a0[e * D + h * 64 + ch]; CST[128 + tid] = ka; CST[192 + tid] = 1.f - ka; }
    for (int i = tid; i < 4096; i += NTHR) { const int k = i >> 6, n = i & 63, pn = 16 * ((n >> 2) & 3) + 4 * (n >> 4) + (n & 3);     W2T[pn * 72 + k] = (bf16)f2bf(NL2E * p.w2[((size_t)e * 64 + k) * D + h * 64 + n]); A2T[pn * 72 + k] = (bf16)f2bf(NL2E * p.a2[((size_t)e * 64 + k) * D + h * 64 + n]); }
    __syncthreads();
    bf16* YW = (bf16*)(p.ws + (e ? WS_YWB : WS_YWF));
    const int c = lane & 15, g = lane >> 4;
    if (wave == 0) {
        __builtin_amdgcn_s_setprio(2);
        pg8::f32x4 Xt[4];
#pragma unroll
        for (int kt = 0; kt < 4; ++kt) Xt[kt] = (pg8::f32x4){0.f, 0.f, 0.f, 0.f};
        bf16* yp = YW + (size_t)(b * SEQ + (e ? SEQ - 1 - 4 * g : 4 * g)) * D + h * 64 + rg * 16 + c;
        int fnext = 0;
        int slot = 0, nblk = 0;
        v2u vtA, gkA, ttA, vtB, gkB, ttB; bf16x8 a1A[2], a2A[2], a1B[2], a2B[2];
#define SC_READS(S, sl_) do { const LAS bf16* AT_ = (const LAS bf16*)((sl_) + WB_AT); const LAS bf16* RT_ = (const LAS bf16*)((sl_) + WB_RT); \
            vt##S = *(const LAS v2u*)((const LAS bf16*)((sl_) + WB_VT) + c * 16 + 4 * g); gk##S = *(const LAS v2u*)((const LAS bf16*)((sl_) + WB_GKT) + c * 16 + 4 * g); \
            _Pragma("unroll") for (int sx = 0; sx < 2; ++sx) { a1##S[sx] = frag2(*(const LAS v2u*)(AT_ + c * 72 + 32 * sx + 4 * g), *(const LAS v2u*)(AT_ + c * 72 + 32 * sx + 16 + 4 * g)); \
                a2##S[sx] = frag2(*(const LAS v2u*)(RT_ + c * 72 + 32 * sx + 4 * g), *(const LAS v2u*)(RT_ + c * 72 + 32 * sx + 16 + 4 * g)); } \
            tt##S = *(const LAS v2u*)((const LAS bf16*)((sl_) + WB_TT) + c * 16 + 4 * g); } while (0)
#define SC_BODY(S, N, tt_) do { const int t = (tt_); LAS unsigned char* sl = lds + slot * WB_SLOT; \
            v2u xb[4]; \
            _Pragma("unroll") for (int kt = 0; kt < 4; ++kt) xb[kt] = cvt2(Xt[kt][0], Xt[kt][1], Xt[kt][2], Xt[kt][3]); \
            pg8::f32x4 C1 = __builtin_amdgcn_mfma_f32_16x16x16bf16_1k(__builtin_bit_cast(s16x4, gk##S), __builtin_bit_cast(s16x4, vt##S), (pg8::f32x4){0.f, 0.f, 0.f, 0.f}, 0, 0, 0); \
            pg8::f32x4 C2 = {0.f, 0.f, 0.f, 0.f}; \
            _Pragma("unroll") for (int sx = 0; sx < 2; ++sx) { const bf16x8 bx = frag2(xb[2 * sx], xb[2 * sx + 1]); C1 = __builtin_amdgcn_mfma_f32_16x16x32_bf16(a1##S[sx], bx, C1, 0, 0, 0); C2 = __builtin_amdgcn_mfma_f32_16x16x32_bf16(a2##S[sx], bx, C2, 0, 0, 0); } \
            __builtin_amdgcn_sched_barrier(0); \
              \
            bf16x8 p4f[4]; pg8::f32x4 xn[4], ppv[4]; const bf16x8 p5f = *(const LAS bf16x8*)((const LAS bf16*)(sl + WB_P5) + c * 40 + 8 * g); \
            _Pragma("unroll") for (int kt = 0; kt < 4; ++kt) p4f[kt] = *(const LAS bf16x8*)((const LAS bf16*)(sl + WB_P4) + (16 * kt + c) * 40 + 8 * g); \
            _Pragma("unroll") for (int kt = 0; kt < 4; ++kt) ppv[kt] = *(const LAS pg8::f32x4*)((const LAS float*)(sl + WB_PP) + 16 * kt + 4 * g); \
            const float v0_ = bflo(vt##S.x), v1_ = bfhi(vt##S.x), v2_ = bflo(vt##S.y), v3_ = bfhi(vt##S.y); \
            __builtin_amdgcn_sched_barrier(0); \
            const pg8::f32x4 SK = __builtin_amdgcn_mfma_f32_16x16x16bf16_1k(__builtin_bit_cast(s16x4, tt##S), __builtin_bit_cast(s16x4, cvt2(C1[0], C1[1], C1[2], C1[3])), (pg8::f32x4){0.f, 0.f, 0.f, 0.f}, 0, 0, 0); \
            const bf16x8 vs = __builtin_bit_cast(bf16x8, (v4u){cvtpk_s(v0_, SK[0]), cvtpk_s(v1_, SK[1]), cvtpk_s(v2_, SK[2]), cvtpk_s(v3_, SK[3])}); \
            _Pragma("unroll") for (int kt = 0; kt < 4; ++kt) xn[kt] = __builtin_amdgcn_mfma_f32_16x16x32_bf16(p4f[kt], vs, Xt[kt], 0, 0, 0); \
            const pg8::f32x4 Yt = __builtin_amdgcn_mfma_f32_16x16x32_bf16(p5f, vs, C2, 0, 0, 0); \
            asm volatile("s_waitcnt lgkmcnt(0)" ::: "memory"); \
            if (lane == 0) CNS[slot] = nblk + 1; \
            if (++slot == 7) { slot = 0; ++nblk; } \
            if (t + 1 < WB_NB) { \
                if (__builtin_amdgcn_readfirstlane(fnext) < nblk + 1) lds_wait_ge(RDY + slot, nblk + 1, ABT); \
                asm volatile("" ::: "memory"); \
                LAS unsigned char* sln = lds + slot * WB_SLOT; SC_READS(N, sln); fnext = RDY[slot == 6 ? 0 : slot + 1]; } \
            _Pragma("unroll") for (int kt = 0; kt < 4; ++kt) Xt[kt] = ppv[kt] * xn[kt]; \
            if (t >= 16) { \
                if (e) { yp[0] = (bf16)f2bf(Yt[0]); yp[-D] = (bf16)f2bf(Yt[1]); yp[-2 * D] = (bf16)f2bf(Yt[2]); yp[-3 * D] = (bf16)f2bf(Yt[3]); yp -= 16 * D; } \
                else { yp[0] = (bf16)f2bf(Yt[0]); yp[D] = (bf16)f2bf(Yt[1]); yp[2 * D] = (bf16)f2bf(Yt[2]); yp[3 * D] = (bf16)f2bf(Yt[3]); yp += 16 * D; } } } while (0)
        lds_wait_ge(RDY + 0, 1, ABT); SC_READS(A, lds); fnext = RDY[1];
        for (int t2 = 0; t2 < WB_NB; t2 += 2) { SC_BODY(A, B, t2); SC_BODY(B, A, t2 + 1); }
#undef SC_READS
#undef SC_BODY
        __builtin_amdgcn_s_setprio(0);
    } else {
        const int pw = wave - 1; LAS unsigned char* sl = lds + pw * WB_SLOT;
        LAS bf16* AT = (LAS bf16*)(sl + WB_AT); LAS bf16* RT = (LAS bf16*)(sl + WB_RT); LAS bf16* BC = (LAS bf16*)(sl + WB_BC); LAS bf16* KC = (LAS bf16*)(sl + WB_KC);
        LAS bf16* P4 = (LAS bf16*)(sl + WB_P4); LAS bf16* GKT = (LAS bf16*)(sl + WB_GKT); LAS bf16* TT = (LAS bf16*)(sl + WB_TT); LAS bf16* P5 = (LAS bf16*)(sl + WB_P5);
        LAS bf16* VT = (LAS bf16*)(sl + WB_VT); LAS float* PP = (LAS float*)(sl + WB_PP); LAS float* MM = (LAS float*)(sl + WB_MM);
        v2u Lkk[4], Lr[4], Lk[4], Lv; v4u tw[2], ad[2];
        { const int q = pw; WB_LOADS(q); }
        f32x4 w0v[4], a0v[4], kav[4], kbv[4];
#pragma unroll
        for (int nt = 0; nt < 4; ++nt) { w0v[nt] = *(const LAS f32x4*)(CST + 16 * nt + 4 * g); a0v[nt] = *(const LAS f32x4*)(CST + 64 + 16 * nt + 4 * g); kav[nt] = *(const LAS f32x4*)(CST + 128 + 16 * nt + 4 * g); kbv[nt] = *(const LAS f32x4*)(CST + 192 + 16 * nt + 4 * g); }
        f32x4 ltm, lem, gtm;
#pragma unroll
        for (int i = 0; i < 4; ++i) { const int ii = 4 * g + i; ltm[i] = ii < c ? 1.f : 0.f; lem[i] = ii <= c ? 1.f : 0.f; gtm[i] = c < ii ? 1.f : 0.f; }
        int nblk = 0;
        for (int q = pw; q < WB_NB; q += 7, ++nblk) {
            pg8::f32x4 zw[4], za[4];
            f32x4 ewv[4], kmv[4], bvv[4], kkf[4], rf[4];
            f32x4 at_[4], rt_[4], bc_[4], kc_[4], pp_[4];
#define WT_PRE(nt) do { zw[nt] = (pg8::f32x4){0.f, 0.f, 0.f, 0.f}; za[nt] = zw[nt]; \
                _Pragma("unroll") for (int ks = 0; ks < 2; ++ks) { const bf16x8 wa = *(const LAS bf16x8*)(W2T + ((nt) * 16 + c) * 72 + ks * 32 + g * 8), aa = *(const LAS bf16x8*)(A2T + ((nt) * 16 + c) * 72 + ks * 32 + g * 8); \
                    zw[nt] = __builtin_amdgcn_mfma_f32_16x16x32_bf16(wa, __builtin_bit_cast(bf16x8, tw[ks]), zw[nt], 0, 0, 0); za[nt] = __builtin_amdgcn_mfma_f32_16x16x32_bf16(aa, __builtin_bit_cast(bf16x8, ad[ks]), za[nt], 0, 0, 0); } \
                } while (0)
#define WT_AV(nt) do { const f32x4 kkv_ = {bflo(Lkk[nt].x), bfhi(Lkk[nt].x), bflo(Lkk[nt].y), bfhi(Lkk[nt].y)}, rv_ = {bflo(Lr[nt].x), bfhi(Lr[nt].x), bflo(Lr[nt].y), bfhi(Lr[nt].y)}, kv_ = {bflo(Lk[nt].x), bfhi(Lk[nt].x), bflo(Lk[nt].y), bfhi(Lk[nt].y)}; \
                const f32x4 xa_ = (f32x4){za[nt][0], za[nt][1], za[nt][2], za[nt][3]} + a0v[nt], xw_ = (f32x4){zw[nt][0], zw[nt][1], zw[nt][2], zw[nt][3]} + w0v[nt]; \
                const f32x4 da_ = (f32x4){__builtin_amdgcn_exp2f(xa_[0]), __builtin_amdgcn_exp2f(xa_[1]), __builtin_amdgcn_exp2f(xa_[2]), __builtin_amdgcn_exp2f(xa_[3])} + 1.f; \
                const f32x4 dw_ = (f32x4){__builtin_amdgcn_exp2f(xw_[0]), __builtin_amdgcn_exp2f(xw_[1]), __builtin_amdgcn_exp2f(xw_[2]), __builtin_amdgcn_exp2f(xw_[3])} + 1.f; \
                const f32x4 av_ = {frcp(da_[0]), frcp(da_[1]), frcp(da_[2]), frcp(da_[3])}; \
                ewv[nt] = (f32x4){frcp(dw_[0]), frcp(dw_[1]), frcp(dw_[2]), frcp(dw_[3])} * (0.6065306597126334f * NL2E);     \
                kmv[nt] = kv_ * (av_ * kav[nt] + kbv[nt]); bvv[nt] = kkv_ * av_; kkf[nt] = kkv_; rf[nt] = rv_; } while (0)
#define WT_BV(nt) do { const f32x4 inc_ = {pfx16(ewv[nt][0]), pfx16(ewv[nt][1]), pfx16(ewv[nt][2]), pfx16(ewv[nt][3])};     \
                const f32x4 E_ = {__builtin_amdgcn_exp2f(inc_[0]), __builtin_amdgcn_exp2f(inc_[1]), __builtin_amdgcn_exp2f(inc_[2]), __builtin_amdgcn_exp2f(inc_[3])};     \
                const f32x4 nEi_ = {frcp(-E_[0]), frcp(-E_[1]), frcp(-E_[2]), frcp(-E_[3])};     \
                const f32x4 Ep_ = {dppf_one<0x111>(E_[0]), dppf_one<0x111>(E_[1]), dppf_one<0x111>(E_[2]), dppf_one<0x111>(E_[3])};     \
                at_[nt] = kkf[nt] * Ep_; rt_[nt] = rf[nt] * E_; bc_[nt] = bvv[nt] * nEi_; kc_[nt] = -(kmv[nt] * nEi_); pp_[nt] = E_; } while (0)
#define WT_POST(nt) do { const int ko_ = c * 72 + 16 * (nt) + 4 * g; \
                *(LAS v2u*)(AT + ko_) = cvt2(at_[nt][0], at_[nt][1], at_[nt][2], at_[nt][3]); *(LAS v2u*)(RT + ko_) = cvt2(rt_[nt][0], rt_[nt][1], rt_[nt][2], rt_[nt][3]); \
                *(LAS v2u*)(BC + ko_) = cvt2(bc_[nt][0], bc_[nt][1], bc_[nt][2], bc_[nt][3]); *(LAS v2u*)(KC + ko_) = cvt2(kc_[nt][0], kc_[nt][1], kc_[nt][2], kc_[nt][3]); \
                const int so_ = 8 * (c >> 2) + 2 * (c & 3);                  \
                _Pragma("unroll") for (int i_ = 0; i_ < 4; ++i_) *(LAS unsigned*)(P4 + (16 * (nt) + 4 * g + i_) * 40 + so_) = cvtpk_s(kc_[nt][i_], bc_[nt][i_]);     \
                if (c == 15) *(LAS f32x4*)(PP + 16 * (nt) + 4 * g) = pp_[nt]; } while (0)
            WT_PRE(0); WT_AV(0); WT_BV(0); WT_PRE(1);
            lds_wait_ge(CNS + pw, nblk, ABT);
            WT_POST(0);
            VT[(4 * g + 0) * 16 + c] = (bf16)(Lv.x & 0xffffu); VT[(4 * g + 1) * 16 + c] = (bf16)(Lv.x >> 16); VT[(4 * g + 2) * 16 + c] = (bf16)(Lv.y & 0xffffu); VT[(4 * g + 3) * 16 + c] = (bf16)(Lv.y >> 16);
            WT_AV(1); WT_BV(1); WT_POST(1); WT_PRE(2); WT_AV(2); WT_BV(2); WT_POST(2); WT_PRE(3); WT_AV(3);
            if (q + 7 < WB_NB) WB_LOADS(q + 7);
            WT_BV(3); WT_POST(3);
#undef WT_PRE
#undef WT_AV
#undef WT_BV
#undef WT_POST
            {
                    __builtin_amdgcn_s_setprio(1);
                    pg8::f32x4 gb = {0.f, 0.f, 0.f, 0.f}, gk = gb, gbr = gb, gkr = gb, gbt = gb;
#pragma unroll
                    for (int ks = 0; ks < 2; ++ks) { const int o = c * 72 + ks * 32 + g * 8;
                        const bf16x8 fb = *(const LAS bf16x8*)(BC + o), fk = *(const LAS bf16x8*)(KC + o), fa = *(const LAS bf16x8*)(AT + o), fr = *(const LAS bf16x8*)(RT + o);
                        gb = __builtin_amdgcn_mfma_f32_16x16x32_bf16(fb, fa, gb, 0, 0, 0); gk = __builtin_amdgcn_mfma_f32_16x16x32_bf16(fk, fa, gk, 0, 0, 0);
                        gbr = __builtin_amdgcn_mfma_f32_16x16x32_bf16(fb, fr, gbr, 0, 0, 0); gkr = __builtin_amdgcn_mfma_f32_16x16x32_bf16(fk, fr, gkr, 0, 0, 0);
                        gbt = __builtin_amdgcn_mfma_f32_16x16x32_bf16(fa, fb, gbt, 0, 0, 0); }
                    const f32x4 m_ = -((f32x4){gb[0], gb[1], gb[2], gb[3]} * ltm), mt_ = -((f32x4){gbt[0], gbt[1], gbt[2], gbt[3]} * gtm), k_ = (f32x4){gk[0], gk[1], gk[2], gk[3]} * ltm,
                        kr_ = (f32x4){gkr[0], gkr[1], gkr[2], gkr[3]} * lem, br_ = (f32x4){gbr[0], gbr[1], gbr[2], gbr[3]} * lem;
                    *(LAS v2u*)(GKT + c * 16 + 4 * g) = cvt2(k_[0], k_[1], k_[2], k_[3]);
                    *(LAS v4u*)(P5 + c * 40 + 8 * g) = (v4u){cvtpk_s(kr_[0], br_[0]), cvtpk_s(kr_[1], br_[1]), cvtpk_s(kr_[2], br_[2]), cvtpk_s(kr_[3], br_[3])};
                    const v2u zq = {0u, 0u}; const pg8::f32x4 z4 = {0.f, 0.f, 0.f, 0.f};
#define MF_(a, b, acc) __builtin_amdgcn_mfma_f32_16x16x32_bf16(frag2(a, zq), frag2(b, zq), acc, 0, 0, 0)
#define CV_(x) cvt2((x)[0], (x)[1], (x)[2], (x)[3])
                    const v2u aM = cvt2(m_[0], m_[1], m_[2], m_[3]), bM = cvt2(mt_[0], mt_[1], mt_[2], mt_[3]);
                    pg8::f32x4 im;
#pragma unroll
                    for (int i = 0; i < 4; ++i) im[i] = ((4 * g + i) == c ? 1.f : 0.f) - m_[i];
                    const v2u aIM = CV_(im);
                    const pg8::f32x4 M2c = MF_(aM, bM, z4), M2a = MF_(bM, aM, z4);
                    const v2u aM2 = CV_(M2a), bM2 = CV_(M2c);
                    const pg8::f32x4 M4c = MF_(aM2, bM2, z4), M4a = MF_(bM2, aM2, z4);
                    const v2u aM4 = CV_(M4a), bM4 = CV_(M4c);
                    const pg8::f32x4 M8c = MF_(aM4, bM4, z4);
                    const v2u bM8 = CV_(M8c);
                    const pg8::f32x4 T1 = MF_(bM2, aIM, im);
                    const pg8::f32x4 T2 = MF_(bM4, CV_(T1), T1);
                    const pg8::f32x4 T3 = MF_(bM8, CV_(T2), T2);
                    *(LAS v2u*)(TT + c * 16 + 4 * g) = CV_(T3);
                    __builtin_amdgcn_s_setprio(0);
#undef MF_
#undef CV_
            }
            asm volatile("s_waitcnt lgkmcnt(0)" ::: "memory");
            if (lane == 0) RDY[pw] = nblk + 1;
        }
    }
}

constexpr int WO_RS = 0, WO_KS = 17408, WO_VS = 34816, WO_A2T = 52224, WO_G2T = 70656, WO_RHO = 92160;
DI void wkv_out_setup(const P& p, LAS unsigned char* lds, int tid, int h) {
    LAS bf16* A2T = (LAS bf16*)(lds + WO_A2T); LAS bf16* G2T = (LAS bf16*)(lds + WO_G2T);
    __syncthreads();
    for (int i = tid; i < 2 * 4096; i += NTHR) { const int e = i >> 12, k = (i >> 6) & 63, n = i & 63; A2T[e * 4608 + n * 72 + k] = (bf16)f2bf(p.a2[((size_t)e * 64 + k) * D + h * 64 + n]); }
    for (int i = tid; i < 160 * 64; i += NTHR) { const int k = i >> 6, n = i & 63; G2T[n * 168 + k] = (bf16)f2bf(p.g2[(size_t)k * D + h * 64 + n]); }
    __syncthreads();
}
struct WoPre { v4u r, k, v, a0, a1, a2, a3, a4; };
struct WoC { float c0[4], c1[4], ka[4], rk[4], gg[4], gb[4]; };
DI void wkv_out_consts(const P& p, int h, int l15, WoC& C) {
#pragma unroll
    for (int nt = 0; nt < 4; ++nt) { const int hc = h * 64 + nt * 16 + l15; C.c0[nt] = p.a0[hc]; C.c1[nt] = p.a0[D + hc]; C.ka[nt] = p.k_a[hc]; C.rk[nt] = p.r_k[hc]; C.gg[nt] = p.gn_g[hc]; C.gb[nt] = p.gn_b[hc]; }
}
DI void wkv_out_load(const P& p, int tid, int lane, int wave, int b, int gr, int h, WoPre& L) {
    const bf16* Z = (const bf16*)(p.ws + WS_ZM); const int row0 = chunk_row0(b, gr + 4);
    const int rb = wave & 3, half = wave >> 2, l15 = lane & 15, g = lane >> 4;
    const bf16* za_ = Z + (size_t)(row0 + rb * 16 + l15) * NZM;
    const v4u zz4 = {0u, 0u, 0u, 0u};
    if (half == 0) { L.a0 = *(const v4u*)(za_ + Z_AD + g * 8); L.a1 = *(const v4u*)(za_ + Z_AD + 32 + g * 8); L.a2 = zz4; L.a3 = zz4; L.a4 = zz4; }
    else { L.a0 = *(const v4u*)(za_ + Z_GS + g * 8); L.a1 = *(const v4u*)(za_ + Z_GS + 32 + g * 8); L.a2 = *(const v4u*)(za_ + Z_GS + 64 + g * 8); L.a3 = *(const v4u*)(za_ + Z_GS + 96 + g * 8); L.a4 = *(const v4u*)(za_ + Z_GS + 128 + g * 8); }
    { const int j = tid >> 3, cg = tid & 7; const bf16* zr = Z + (size_t)(row0 + j) * NZM + h * 64 + cg * 8;
        L.r = *(const v4u*)(zr + Z_R); L.k = *(const v4u*)(zr + Z_K); L.v = *(const v4u*)(zr + Z_V); }
}
DI void wkv_out_unit(const P& p, LAS unsigned char* lds, int tid, int lane, int wave, int b, int gr, int h, const WoC& C, const WoPre& L, bool has_next, int nb, int ngr, WoPre& N) {
    const int row0 = chunk_row0(b, gr + 4);
    LAS float* RS = (LAS float*)(lds + WO_RS); LAS float* KS = (LAS float*)(lds + WO_KS); LAS float* VS = (LAS float*)(lds + WO_VS);
    LAS bf16* A2T = (LAS bf16*)(lds + WO_A2T); LAS bf16* G2T = (LAS bf16*)(lds + WO_G2T); LAS float* RHO = (LAS float*)(lds + WO_RHO);
    const int rb = wave & 3, half = wave >> 2, l15 = lane & 15, g = lane >> 4;
    { const int j = tid >> 3, cg = tid & 7; const v4u r = L.r, k = L.k, v = L.v;
        *(LAS f32x4*)(RS + j * 68 + cg * 8) = (f32x4){bflo(r.x), bfhi(r.x), bflo(r.y), bfhi(r.y)}; *(LAS f32x4*)(RS + j * 68 + cg * 8 + 4) = (f32x4){bflo(r.z), bfhi(r.z), bflo(r.w), bfhi(r.w)};
        *(LAS f32x4*)(KS + j * 68 + cg * 8) = (f32x4){bflo(k.x), bfhi(k.x), bflo(k.y), bfhi(k.y)}; *(LAS f32x4*)(KS + j * 68 + cg * 8 + 4) = (f32x4){bflo(k.z), bfhi(k.z), bflo(k.w), bfhi(k.w)};
        *(LAS f32x4*)(VS + j * 68 + cg * 8) = (f32x4){bflo(v.x), bfhi(v.x), bflo(v.y), bfhi(v.y)}; *(LAS f32x4*)(VS + j * 68 + cg * 8 + 4) = (f32x4){bflo(v.z), bfhi(v.z), bflo(v.w), bfhi(v.w)}; }
    WK_BAR();
    if (has_next) wkv_out_load(p, tid, lane, wave, nb, ngr, h, N);
    bf16* YF = (bf16*)(p.ws + WS_YWF);
    float yn[4][4]; pg8::f32x4 zg[4];
    if (half == 0) {
        pg8::f32x4 z0[4], z1[4];
#pragma unroll
        for (int nt = 0; nt < 4; ++nt) { z0[nt] = (pg8::f32x4){0.f, 0.f, 0.f, 0.f}; z1[nt] = (pg8::f32x4){0.f, 0.f, 0.f, 0.f}; }
#pragma unroll
        for (int ks = 0; ks < 2; ++ks) { const bf16x8 aa = __builtin_bit_cast(bf16x8, ks == 0 ? L.a0 : L.a1);
#pragma unroll
            for (int nt = 0; nt < 4; ++nt) { const bf16x8 b0 = *(const LAS bf16x8*)(A2T + (nt * 16 + l15) * 72 + ks * 32 + g * 8), b1 = *(const LAS bf16x8*)(A2T + 4608 + (nt * 16 + l15) * 72 + ks * 32 + g * 8);
                z0[nt] = __builtin_amdgcn_mfma_f32_16x16x32_bf16(aa, b0, z0[nt], 0, 0, 0); z1[nt] = __builtin_amdgcn_mfma_f32_16x16x32_bf16(aa, b1, z1[nt], 0, 0, 0); } }
        float rho[4] = {0.f, 0.f, 0.f, 0.f};
#pragma unroll
        for (int nt = 0; nt < 4; ++nt) { const float c0 = C.c0[nt], c1 = C.c1[nt], ka = C.ka[nt], rk = C.rk[nt];
#pragma unroll
            for (int i = 0; i < 4; ++i) { const int o = (rb * 16 + 4 * g + i) * 68 + nt * 16 + l15;
                rho[i] += RS[o] * KS[o] * (2.f + (sigm_fast(z0[nt][i] + c0) + sigm_fast(z1[nt][i] + c1) - 2.f) * ka) * rk; } }
#pragma unroll
        for (int i = 0; i < 4; ++i) { const float r = red16(rho[i]); if (l15 == 0) RHO[rb * 16 + 4 * g + i] = r; }
    } else {
        const bf16* YB = (const bf16*)(p.ws + WS_YWB); unsigned short yfv[4][4], ybv[4][4];
#pragma unroll
        for (int nt = 0; nt < 4; ++nt)
#pragma unroll
            for (int i = 0; i < 4; ++i) { const size_t yo = (size_t)(row0 + rb * 16 + 4 * g + i) * D + h * 64 + nt * 16 + l15; yfv[nt][i] = YF[yo]; ybv[nt][i] = YB[yo]; }
#pragma unroll
        for (int nt = 0; nt < 4; ++nt) zg[nt] = (pg8::f32x4){0.f, 0.f, 0.f, 0.f};
#pragma unroll
        for (int ks = 0; ks < 5; ++ks) { const bf16x8 ag = __builtin_bit_cast(bf16x8, ks == 0 ? L.a0 : (ks == 1 ? L.a1 : (ks == 2 ? L.a2 : (ks == 3 ? L.a3 : L.a4))));
#pragma unroll
            for (int nt = 0; nt < 4; ++nt) { const bf16x8 bg = *(const LAS bf16x8*)(G2T + (nt * 16 + l15) * 168 + ks * 32 + g * 8); zg[nt] = __builtin_amdgcn_mfma_f32_16x16x32_bf16(ag, bg, zg[nt], 0, 0, 0); } }
        float sm[4] = {0.f, 0.f, 0.f, 0.f};
#pragma unroll
        for (int nt = 0; nt < 4; ++nt)
#pragma unroll
            for (int i = 0; i < 4; ++i) { yn[nt][i] = bf2f(yfv[nt][i]) + bf2f(ybv[nt][i]); sm[i] += yn[nt][i]; }
#pragma unroll
        for (int i = 0; i < 4; ++i) { const float mu = red16(sm[i]) * (1.f / 64.f); float q2 = 0.f;
#pragma unroll
            for (int nt = 0; nt < 4; ++nt) { yn[nt][i] -= mu; q2 += yn[nt][i] * yn[nt][i]; }
            const float rs = __builtin_amdgcn_rsqf(red16(q2) * (1.f / 64.f) + GN_EPS);
#pragma unroll
            for (int nt = 0; nt < 4; ++nt) yn[nt][i] *= rs; }
    }
    WK_BAR();
    if (half == 1) {
#pragma unroll
        for (int nt = 0; nt < 4; ++nt) { const int hc = h * 64 + nt * 16 + l15; const float gg = C.gg[nt], gb = C.gb[nt];
#pragma unroll
            for (int i = 0; i < 4; ++i) { const int tok = rb * 16 + 4 * g + i; const float ov = (yn[nt][i] * gg + gb + RHO[tok] * VS[tok * 68 + nt * 16 + l15]) * zg[nt][i];
                YF[(size_t)(row0 + tok) * D + hc] = (bf16)f2bf(ov); } }
    }
    WK_BAR();
}

DI void expert_weights(const P& p, LAS unsigned char* lds, int lane, int wave, int G) {
    LAS float* scr = (LAS float*)(lds + wave * 16384);
    const int gw = blockIdx.x * NWAVES + wave, NGW = G * NWAVES;
    bf16* w13 = (bf16*)(p.ws + WS_W13); bf16* w2t = (bf16*)(p.ws + WS_W2);
    constexpr int I13 = 16 * 16, I2 = 8 * 32;
    for (int it = gw; it < NEXP * (2 * I13 + I2); it += NGW) { const int ex = it / (2 * I13 + I2); int r = it % (2 * I13 + I2);
        if (r < 2 * I13) { const int which = r / I13; r %= I13; const int kb = r / 16, nb = r % 16, n0 = nb * 32;
            if (which) transpose_item(p.e_w3 + (size_t)ex * D * DEXP, DEXP, w13 + (size_t)ex * D * D, D, kb * 64, n0, 256 * (n0 >> 7) + 128 + (n0 & 127), scr, lane);
            else transpose_item(p.e_w1 + (size_t)ex * D * DEXP, DEXP, w13 + (size_t)ex * D * D, D, kb * 64, n0, 256 * (n0 >> 7) + (n0 & 127), scr, lane); }
        else { r -= 2 * I13; const int kb = r / 32, nb = r % 32; transpose_item(p.e_w2 + (size_t)ex * DEXP * D, D, w2t + (size_t)ex * D * DEXP, DEXP, kb * 64, nb * 32, nb * 32, scr, lane); } }
}

constexpr int RT_AX = 0, RT_AXS = 1032, RT_PART = 66048, RT_LOG = 90624, RT_RE = 92928, RT_PRM = 93696  ;
DI void phase_route(const P& p, LAS unsigned char* lds, int tid, int lane, int wave, int G) {
    LAS float* AX = (LAS float*)(lds + RT_AX); LAS float* PART = (LAS float*)(lds + RT_PART); LAS float* LOG = (LAS float*)(lds + RT_LOG); LAS int* RE = (LAS int*)(lds + RT_RE);
    float* T1 = p.out; bf16* H2 = (bf16*)(p.ws + WS_H2); float* ST2 = (float*)(p.ws + WS_ROWW);
    int* TOKE = (int*)(p.ws + WS_TOKE); int* TOKSLOT = (int*)(p.ws + WS_TOKSLOT); float* TOKW = (float*)(p.ws + WS_TOKW); int* S2T = (int*)(p.ws + WS_S2T);
    if (blockIdx.x == 0) for (int i = tid; i < D / 8; i += NTHR) ((GAS v4u*)(H2 + (size_t)MX * D))[i] = (v4u){0u, 0u, 0u, 0u};
    const int l15 = lane & 15, g = lane >> 4;
    f32x4 breg[8][3];
    { const float* rwt = (const float*)(p.ws + WS_RWT);
#pragma unroll
      for (int m = 0; m < 8; ++m)
#pragma unroll
          for (int nt = 0; nt < 3; ++nt) breg[m][nt] = *(const f32x4*)(rwt + (size_t)(nt * 16 + l15) * D + 128 * wave + 16 * m + 4 * g); }
    __syncthreads();
    LAS float* PRM = (LAS float*)(lds + RT_PRM);
    for (int blk = blockIdx.x; blk < MX / 64; blk += G) {
        f32x4 q[2][4];
        { const int bsel = (blk * 64) >> 13;
          __syncthreads();
          for (int n = tid; n < D; n += NTHR) { PRM[n] = p.ln1_g[n]; PRM[D + n] = p.ln1_b[n]; PRM[2 * D + n] = modv(p, bsel, 4 * 1024 + n) + 1.f; PRM[3 * D + n] = modv(p, bsel, 3 * 1024 + n); }
          __syncthreads(); }
#pragma unroll
        for (int rr = 0; rr < 2; ++rr) { const GAS f32x4* tr = (const GAS f32x4*)(T1 + (size_t)(blk * 64 + 2 * wave + rr) * D) + lane;
#pragma unroll
            for (int j = 0; j < 4; ++j) q[rr][j] = tr[64 * j]; }
        for (int it = 0; it < 4; ++it) {
#pragma unroll
            for (int rr = 0; rr < 2; ++rr) { const int rl = 2 * wave + rr, m = blk * 64 + it * 16 + rl; const int bsel = m >> 13;
                GAS f32x4* tr = (GAS f32x4*)(T1 + (size_t)m * D) + lane; float s = 0.f;
#pragma unroll
                for (int j = 0; j < 4; ++j) s += (q[rr][j].x + q[rr][j].y) + (q[rr][j].z + q[rr][j].w);
                const float mean = wave_sum(s) * (1.f / D); float s2 = 0.f;
#pragma unroll
                for (int j = 0; j < 4; ++j) { q[rr][j] = q[rr][j] - mean; s2 += (q[rr][j].x * q[rr][j].x + q[rr][j].y * q[rr][j].y) + (q[rr][j].z * q[rr][j].z + q[rr][j].w * q[rr][j].w); }
                const float rstd = 1.f / sqrtf(wave_sum(s2) * (1.f / D) + LN_EPS);
                if (lane == 0) { ST2[2 * m] = mean; ST2[2 * m + 1] = rstd; }
                GAS v2u* o8 = (GAS v2u*)(H2 + (size_t)m * D) + lane;
#pragma unroll
                for (int j = 0; j < 4; ++j) { const int n = 256 * j + 4 * lane; const f32x4 gg = *(const LAS f32x4*)(PRM + n), bb = *(const LAS f32x4*)(PRM + D + n);
                    const f32x4 x1 = q[rr][j] * rstd * gg + bb; const f32x4 hh = x1 * *(const LAS f32x4*)(PRM + 2 * D + n) + *(const LAS f32x4*)(PRM + 3 * D + n);
                    o8[64 * j] = (v2u){pk2(hh[0], hh[1]), pk2(hh[2], hh[3])};
                    *(LAS f32x4*)(AX + rl * RT_AXS + n) = hh; } }
            if (it < 3) {
#pragma unroll
                for (int rr = 0; rr < 2; ++rr) { const GAS f32x4* tr = (const GAS f32x4*)(T1 + (size_t)(blk * 64 + (it + 1) * 16 + 2 * wave + rr) * D) + lane;
#pragma unroll
                    for (int j = 0; j < 4; ++j) q[rr][j] = tr[64 * j]; } }
            WK_BAR();
            { f32x4 acc[3];
#pragma unroll
              for (int nt = 0; nt < 3; ++nt) acc[nt] = (f32x4){0.f, 0.f, 0.f, 0.f};
#pragma unroll
              for (int m = 0; m < 8; ++m) { const f32x4 a4 = *(const LAS f32x4*)(AX + l15 * RT_AXS + 128 * wave + 16 * m + 4 * g);
#pragma unroll
                  for (int sx = 0; sx < 4; ++sx)
#pragma unroll
                      for (int nt = 0; nt < 3; ++nt) acc[nt] = __builtin_amdgcn_mfma_f32_16x16x4f32(a4[sx], breg[m][nt][sx], acc[nt], 0, 0, 0); }
#pragma unroll
              for (int nt = 0; nt < 3; ++nt)
#pragma unroll
                  for (int i = 0; i < 4; ++i) PART[(wave * 16 + 4 * g + i) * 48 + nt * 16 + l15] = acc[nt][i]; }
            WK_BAR();
            for (int i = tid; i < 16 * 36; i += NTHR) { const int row = i / 36, qq = i % 36; float a = qq < 4 ? p.router_g_b[qq] : p.router_e_b[qq - 4];
#pragma unroll
                for (int w = 0; w < 8; ++w) a += PART[(w * 16 + row) * 48 + qq];
                LOG[row * 36 + qq] = a; }
            WK_BAR();
            if (tid < 16) { const int m = blk * 64 + it * 16 + tid; float lg[36];
#pragma unroll
                for (int i = 0; i < 36; ++i) lg[i] = LOG[tid * 36 + i];
                int gs = 0; float gm = lg[0];
#pragma unroll
                for (int i = 1; i < 4; ++i) if (lg[i] > gm) { gm = lg[i]; gs = i; }
                float den = 0.f;
#pragma unroll
                for (int i = 0; i < 4; ++i) den += __expf(lg[i] - gm);
                const float pg = 1.f / den;
                float ev[8];
#pragma unroll
                for (int i = 0; i < 8; ++i) ev[i] = gs == 0 ? lg[4 + i] : (gs == 1 ? lg[12 + i] : (gs == 2 ? lg[20 + i] : lg[28 + i]));
                int i1 = 0; float v1 = ev[0];
#pragma unroll
                for (int i = 1; i < 8; ++i) if (ev[i] > v1) { v1 = ev[i]; i1 = i; }
                int i2 = -1; float v2 = -3.0e38f;
#pragma unroll
                for (int i = 0; i < 8; ++i) if (i != i1 && ev[i] > v2) { v2 = ev[i]; i2 = i; }
                if (i2 < 0) { i2 = (i1 + 1) & 7; v2 = v1; }
                const float e2 = __expf(v2 - v1); const float w1 = pg / (1.f + e2), w2 = pg * e2 / (1.f + e2);
                RE[(it * 16 + tid) * 2] = gs * 8 + i1; RE[(it * 16 + tid) * 2 + 1] = gs * 8 + i2; TOKW[2 * m] = w1; TOKW[2 * m + 1] = w2; TOKE[2 * m] = gs * 8 + i1; TOKE[2 * m + 1] = gs * 8 + i2; }
            WK_BAR();
        }
        if (wave == 0) {
            const int e0 = RE[lane], e1 = RE[lane + 64]; int r0 = 0, r1 = 0, cex = 0;
#pragma unroll 4
            for (int ex = 0; ex < NEXP; ++ex) { const unsigned long long m0 = __builtin_amdgcn_ballot_w64(e0 == ex), m1 = __builtin_amdgcn_ballot_w64(e1 == ex);
                const int n0 = __builtin_popcountll(m0);
                const int b0 = (int)__builtin_amdgcn_mbcnt_hi((unsigned)(m0 >> 32), __builtin_amdgcn_mbcnt_lo((unsigned)m0, 0u)), b1 = (int)__builtin_amdgcn_mbcnt_hi((unsigned)(m1 >> 32), __builtin_amdgcn_mbcnt_lo((unsigned)m1, 0u));
                if (e0 == ex) r0 = b0; if (e1 == ex) r1 = n0 + b1; if (lane == ex) cex = n0 + __builtin_popcountll(m1); }
            int base = 0; if (lane < NEXP && cex) base = (int)atomicAdd(p.ctl + CW_ECNT + lane, (unsigned)cex);
            const int s0 = __builtin_amdgcn_ds_bpermute(e0 * 4, base) + r0, s1 = __builtin_amdgcn_ds_bpermute(e1 * 4, base) + r1;
            const int i0 = lane, i1 = lane + 64, m0r = blk * 64 + (i0 >> 1), m1r = blk * 64 + (i1 >> 1);
            TOKSLOT[2 * m0r + (i0 & 1)] = s0; S2T[(size_t)e0 * MX + s0] = 2 * m0r + (i0 & 1);
            TOKSLOT[2 * m1r + (i1 & 1)] = s1; S2T[(size_t)e1 * MX + s1] = 2 * m1r + (i1 & 1); }
        __syncthreads();
    }
}
DI void build_tiles(const P& p, LAS int* tile, int tid) {
    if (tid == 0) { int T = 0;
        for (int e = 0; e < NEXP; ++e) { tile[MAXT + e] = T; const int c = (int)__hip_atomic_load(p.ctl + CW_ECNT + e, RLX_AGENT); tile[MAXT + 64 + e] = c; const int nt = (c + 255) >> 8; for (int i = 0; i < nt; ++i) tile[T + i] = e; T += nt; }
        tile[MAXT + 32] = T; tile[MAXT + 40] = T; }
    __syncthreads();
}
DI void phase_final(const P& p, LAS int* tile, int lane, int wave, int G) {
    const int gw = blockIdx.x * NWAVES + wave, NGW = G * NWAVES; const bf16* YB = (const bf16*)(p.ws + WS_XS);
    const int* TOKE = (const int*)(p.ws + WS_TOKE); const int* TOKSLOT = (const int*)(p.ws + WS_TOKSLOT); const float* ST2 = (const float*)(p.ws + WS_ROWW);
    f32x4 g1[4], b1[4], g2[4], b2[4], gt[2][4]; int gv[2] = {-1, -1};
#pragma unroll
    for (int j = 0; j < 4; ++j) { const int n = 256 * j + 4 * lane; g1[j] = *(const f32x4*)(p.ln1_g + n); b1[j] = *(const f32x4*)(p.ln1_b + n); g2[j] = *(const f32x4*)(p.ln2_g + n); b2[j] = *(const f32x4*)(p.ln2_b + n); gt[0][j] = gt[1][j] = (f32x4){0.f, 0.f, 0.f, 0.f}; }
    for (int m0 = gw; m0 < MX; m0 += 2 * NGW) { int mm[2]; mm[0] = m0; mm[1] = (m0 + NGW < MX) ? m0 + NGW : m0;
        f32x4 q[2][4]; float s[2] = {0.f, 0.f};
#pragma unroll
        for (int rr = 0; rr < 2; ++rr) { const int m = mm[rr]; const int bsel = m >> 13; const float mean1 = ST2[2 * m], rstd1 = ST2[2 * m + 1];
            if (bsel != gv[rr]) { gv[rr] = bsel;
#pragma unroll
                for (int j = 0; j < 4; ++j) gt[rr][j] = modv4(p, bsel, 5 * 1024 + 256 * j + 4 * lane); }
            const int r0 = tile[MAXT + TOKE[2 * m]] * 256 + TOKSLOT[2 * m], r1 = tile[MAXT + TOKE[2 * m + 1]] * 256 + TOKSLOT[2 * m + 1];
            const GAS f32x4* xr = (const GAS f32x4*)(p.out + (size_t)m * D) + lane; const GAS v2u* y0 = (const GAS v2u*)(YB + (size_t)r0 * D) + lane; const GAS v2u* y1 = (const GAS v2u*)(YB + (size_t)r1 * D) + lane;
#pragma unroll
            for (int j = 0; j < 4; ++j) { const f32x4 x1 = (xr[64 * j] - mean1) * rstd1 * g1[j] + b1[j]; const v2u a = y0[64 * j], b2v = y1[64 * j];
                const f32x4 mo = (f32x4){bflo(a.x) + bflo(b2v.x), bfhi(a.x) + bfhi(b2v.x), bflo(a.y) + bflo(b2v.y), bfhi(a.y) + bfhi(b2v.y)};
                q[rr][j] = x1 * ALPHA + gt[rr][j] * mo;
                s[rr] += (q[rr][j].x + q[rr][j].y) + (q[rr][j].z + q[rr][j].w); } }
#pragma unroll
        for (int rr = 0; rr < 2; ++rr) { const int m = mm[rr]; GAS f32x4* xr = (GAS f32x4*)(p.out + (size_t)m * D) + lane;
            const float mean = wave_sum(s[rr]) * (1.f / D); float s2 = 0.f;
#pragma unroll
            for (int j = 0; j < 4; ++j) { q[rr][j] = q[rr][j] - mean; s2 += (q[rr][j].x * q[rr][j].x + q[rr][j].y * q[rr][j].y) + (q[rr][j].z * q[rr][j].z + q[rr][j].w * q[rr][j].w); }
            const float rstd = 1.f / sqrtf(wave_sum(s2) * (1.f / D) + LN_EPS);
#pragma unroll
            for (int j = 0; j < 4; ++j) xr[64 * j] = q[rr][j] * rstd * g2[j] + b2[j]; }
    }
}
__device__ __forceinline__ int lane_now() { int l; asm volatile("v_and_b32 %0, 63, %1" : "=v"(l) : "v"((int)threadIdx.x)); __builtin_assume(l >= 0 && l < 64); return l; }
#define MKP P p; { const float* const* in = args.in; p.x = in[0]; p.c = in[1]; p.ctx = in[2]; p.c_ctx = in[3]; p.w_ada = in[4]; p.b_ada = in[5]; p.w_in = in[6]; p.mu_a = in[7]; p.w0 = in[8]; p.w2 = in[9]; p.a0 = in[10]; p.a2 = in[11]; p.g2 = in[12]; p.k_k = in[13]; p.k_a = in[14]; p.r_k = in[15]; p.gn_g = in[16]; p.gn_b = in[17]; p.conv_w = in[18]; p.conv_b = in[19]; p.lru_wa = in[20]; p.lru_ba = in[21]; p.lru_wx = in[22]; p.lru_bx = in[23]; p.lru_lam = in[24]; p.p_a = in[25]; p.p_b = in[26]; p.w_o = in[27]; p.ln1_g = in[28]; p.ln1_b = in[29]; p.router_g = in[30]; p.router_g_b = in[31]; p.router_e = in[32]; p.router_e_b = in[33]; p.e_w1 = in[34]; p.e_w3 = in[35]; p.e_w2 = in[36]; p.ln2_g = in[37]; p.ln2_b = in[38]; } p.out = args.out; p.ws = args.ws; p.dob = (unsigned char*)args.out; p.ctlf = (float*)(args.ws + WS_CTL); p.ctl = (unsigned*)(args.ws + WS_CTL);
constexpr int NPHASE = 15;
__global__ void __launch_bounds__(NTHR, 2) fwd_kernel(Args args) {
    extern __shared__ __attribute__((aligned(16))) unsigned char lds_raw[];
    LAS unsigned char* lds = (LAS unsigned char*)lds_raw;
    const int tid = threadIdx.x, wave = __builtin_amdgcn_readfirstlane(tid >> 6), G = gridDim.x;
    volatile LAS unsigned* MISC = (volatile LAS unsigned*)(lds + MISC_OFF);
    LAS int* tile = (LAS int*)(lds + TILE_OFF);
    for (int u = tid; u < 256; u += NTHR) ((LAS unsigned*)(lds + MISC_OFF))[u] = 0u;
    __syncthreads();
#if ONE_LAUNCH
    XcdBarrier bar = xcd_barrier_post((unsigned*)(args.ws + WS_CTL) + CW_BAR, MISC + 8);
#define GRID_BAR() xcd_barrier(bar)
#else
#define GRID_BAR() do {} while (0)
#endif
    const int lo = args.ph_lo, hi = args.ph_hi;
#define IN(k) (lo <= (k) && (k) < hi)
#define SEAM(k) do { if (IN(k) && IN((k) + 1)) GRID_BAR(); } while (0)

    if (IN(0)) { MKP; const int lane = lane_now(); phase0(p, lds, tid, lane, wave, G); } SEAM(0);
    if (IN(1)) { MKP; const int lane = lane_now(); phase0b(p, lds, tid, lane, wave, G); phase1(p, lane, wave, G); } SEAM(1);
    if (IN(2)) { MKP; const int lane = lane_now();
        pg8::Gemm g{(const pg8::bf16_t*)(p.dob + DO_H), (const pg8::bf16_t*)(p.dob + DO_WIN), MALL, NSLAB, D}; pg8::StaticOrder S; S.init(MALL, NSLAB, G, (int)blockIdx.x);
        EpiPlain<0> E{(bf16*)(p.ws + WS_S1), NS1, (bf16*)(p.ws + WS_S2), NS2, NS1 / 256};
        pg8::gemm_phase<EpiPlain<0>, pg8::StaticOrder, true, true>(lds, g, S, E); } SEAM(2);
    if (IN(3)) { MKP; const int lane = lane_now(); const int hb = blockIdx.x & 15; lru_setup(p, lds, tid, hb);
        for (int u = (blockIdx.x >> 4) * NWAVES + wave; u < BATCH * NHS; u += (G >> 4) * NWAVES) { const int hs = u % NHS, b = u / NHS; lru_unit(p, lds, lane, wave, b, hs, hb); } } SEAM(3);
    if (IN(4)) { MKP; const int lane = lane_now(); lru_carry(p, lds, tid, G); } SEAM(4);
    if (IN(5)) { MKP; const int lane = lane_now(); lru_finish(p, lane, wave, G); } SEAM(5);
    if (IN(6)) { MKP; const int lane = lane_now(); phase_mix(p, lane, wave, G); } SEAM(6);
    if (IN(7)) { MKP; const int lane = lane_now(); for (int u = blockIdx.x; u < 256; u += G) wkv_blk_wg(p, lds, tid, lane, wave, u); } SEAM(7);
    if (IN(8)) { MKP; const int lane = lane_now(); const int h = blockIdx.x & 15; wkv_out_setup(p, lds, tid, h); { WoC WC; wkv_out_consts(p, h, lane & 15, WC); WoPre A, B; const int u0 = blockIdx.x >> 4, du = G >> 4; if (u0 < BATCH * 128) wkv_out_load(p, tid, lane, wave, u0 >> 7, u0 & 127, h, A);
            for (int u = u0; u < BATCH * 128; u += 2 * du) {
                const int u1 = u + du, u2 = u + 2 * du;
                wkv_out_unit(p, lds, tid, lane, wave, u >> 7, u & 127, h, WC, A, u1 < BATCH * 128, u1 >> 7, u1 & 127, B);
                if (u1 < BATCH * 128) wkv_out_unit(p, lds, tid, lane, wave, u1 >> 7, u1 & 127, h, WC, B, u2 < BATCH * 128, u2 >> 7, u2 & 127, A); } } } SEAM(8);
    if (IN(9)) { MKP; const int lane = lane_now();
        pg8::Gemm g{(const pg8::bf16_t*)(p.dob + DO_H), (const pg8::bf16_t*)(p.dob + DO_WIN) + (size_t)NSLAB * D, MX, 2048, D}; pg8::StaticOrder S; S.init(MX, 2048, G, (int)blockIdx.x);
        EpiPlain<1> E{(bf16*)(p.ws + WS_GATES), 2048, nullptr, 0, 1 << 20};
        pg8::gemm_phase<EpiPlain<1>, pg8::StaticOrder, true, true>(lds, g, S, E); } SEAM(9);
    if (IN(10)) { MKP; const int lane = lane_now();
        pg8::Gemm g{(const pg8::bf16_t*)(p.ws + WS_YWF), (const pg8::bf16_t*)(p.ws + WS_PW), 2 * MX, 2 * D, D}; SchedMix S; S.init(MX, D, G, (int)blockIdx.x);
        EpiMix E{(const bf16*)(p.ws + WS_GATES), (bf16*)(p.ws + WS_MBUF)};
        pg8::gemm_phase<EpiMix, SchedMix, true, true>(lds, g, S, E); } SEAM(10);
    if (IN(11)) { MKP; const int lane = lane_now();
        pg8::Gemm g{(const pg8::bf16_t*)(p.ws + WS_MBUF), (const pg8::bf16_t*)(p.ws + WS_PW) + (size_t)2 * D * D, MX, D, D}; pg8::StaticOrder S; S.init(MX, D, G, (int)blockIdx.x);
        EpiT1 E{p.x, (const float*)(p.ws + WS_STATS), p.ctlf + CW_MOD, p.b_ada, p.out};
        const bool wfirst = ((blockIdx.x >> 3) & 1) != 0;
        if (wfirst) { expert_weights(p, lds, lane, wave, G); __syncthreads(); }
        pg8::gemm_phase<EpiT1, pg8::StaticOrder, true, true>(lds, g, S, E);
        if (!wfirst) expert_weights(p, lds, lane, wave, G); } SEAM(11);
    if (IN(12)) { MKP; const int lane = lane_now(); phase_route(p, lds, tid, lane, wave, G); } SEAM(12);
    if (IN(13)) { MKP; const int lane = lane_now();
        build_tiles(p, tile, tid);
        pg8::Gemm g{(const pg8::bf16_t*)(p.ws + WS_H2), (const pg8::bf16_t*)(p.ws + WS_W13), MAXT * 256, NEXP * D, D}; SchedMoE S{tile, G, (int)blockIdx.x, (const int*)(p.ws + WS_S2T)};
        EpiSwiGLU E{(bf16*)(p.ws + WS_HBUF)};
        pg8::gemm_phase<EpiSwiGLU, SchedMoE, true, true, true>(lds, g, S, E); } SEAM(13);
    if (IN(14)) { MKP; const int lane = lane_now();
        build_tiles(p, tile, tid);
        pg8::Gemm g{(const pg8::bf16_t*)(p.ws + WS_HBUF), (const pg8::bf16_t*)(p.ws + WS_W2), MAXT * 256, NEXP * D, DEXP}; SchedMoE S{tile, G, (int)blockIdx.x, (const int*)(p.ws + WS_S2T)};
        EpiW2 E{(bf16*)(p.ws + WS_XS), tile, (const int*)(p.ws + WS_S2T), (const float*)(p.ws + WS_TOKW)};
        pg8::gemm_phase<EpiW2, SchedMoE, true, true>(lds, g, S, E); } SEAM(14);
    if (IN(15)) { MKP; const int lane = lane_now(); build_tiles(p, tile, tid); phase_final(p, tile, lane, wave, G); }
#undef IN
#undef SEAM
}

extern "C" void kernel_launch(void* const* d_in, const int* in_sizes, int n_in, void* d_out, int out_size, void* d_ws, size_t ws_size, hipStream_t stream) {
    static int grid = 0;
    if (grid == 0) {
        if (n_in != 39 || out_size != MX * D || ws_size < WS_END) { fprintf(stderr, "kernel_launch: unexpected shapes (n_in %d out %d ws %zu)\n", n_in, out_size, ws_size); grid = -1; return; }
        int dev = 0, cus = 0, per_cu = 0;
        if (hipGetDevice(&dev) != hipSuccess || hipDeviceGetAttribute(&cus, hipDeviceAttributeMultiprocessorCount, dev) != hipSuccess) { grid = -1; return; }
        if (hipFuncSetAttribute((const void*)fwd_kernel, hipFuncAttributeMaxDynamicSharedMemorySize, LDS_BYTES) != hipSuccess) { fprintf(stderr, "kernel_launch: hipFuncSetAttribute failed\n"); grid = -1; return; }
        if (hipOccupancyMaxActiveBlocksPerMultiprocessor(&per_cu, (const void*)fwd_kernel, NTHR, LDS_BYTES) != hipSuccess || per_cu < 1) fprintf(stderr, "kernel_launch: occupancy query reports %d\n", per_cu);
        (void)hipGetLastError();
        grid = cus;
    }
    if (grid < 0) return;
    if (hipMemsetAsync((char*)d_ws + WS_CTL, 0, CTL_ZERO_BYTES, stream) != hipSuccess) return;
    Args a{};
    for (int i = 0; i < 39; ++i) a.in[i] = (const float*)d_in[i];
    a.out = (float*)d_out; a.ws = (unsigned char*)d_ws;
#if ONE_LAUNCH
    a.ph_lo = 0; a.ph_hi = NPHASE + 1;
    hipLaunchKernelGGL(fwd_kernel, dim3(grid), dim3(NTHR), LDS_BYTES, stream, a);
#else
    for (int ph = 0; ph <= NPHASE; ++ph) { a.ph_lo = ph; a.ph_hi = ph + 1; hipLaunchKernelGGL(fwd_kernel, dim3(grid), dim3(NTHR), LDS_BYTES, stream, a); }
#endif
}
```

```cpp
#include <hip/hip_runtime.h>
#include <cstdio>
#include <cstdint>
namespace pg8 {
#define PG8_LAS __attribute__((address_space(3)))
typedef unsigned short bf16_t;
typedef short bf16x8 __attribute__((ext_vector_type(8)));
typedef float f32x4 __attribute__((ext_vector_type(4)));
typedef unsigned u32x4 __attribute__((ext_vector_type(4)));
constexpr int BM = 256, BK = 64, HALF = 128, HTB = HALF * BK * 2  , STAGE_BYTES = 8 * HTB, NXCD = 8, WGM = 8;

__host__ __device__ __forceinline__ int lds_byte(int r, int c) { const int st = (r >> 4) * 2 + (c >> 5), rr = r & 15, cc = c & 31, ob = rr * 64 + cc * 2; return st * 1024 + (ob ^ (((ob >> 9) & 1) << 5)); }
__host__ __device__ __forceinline__ void stage_rc(int b, int& R, int& C) { const int st = b / 1024, sb = b % 1024, swz = sb ^ (((sb >> 9) & 1) << 5); R = (st >> 1) * 16 + swz / 64; C = (st & 1) * 32 + (swz % 64) / 2; }
__host__ __device__ __forceinline__ int perm32(int rho) { const int n = rho >> 4, i = rho & 15; return 8 * (i >> 2) + 4 * n + (i & 3); }

struct Unit { int pm, pn; };
struct Gemm { const bf16_t* A; const bf16_t* Bt; int M, N, K; };

struct StaticOrder {
    int nM, nN, nwg, G, c;
    __host__ __device__ void init(int M, int N, int G_, int c_) { nM = M / BM; nN = N / BM; nwg = nM * nN; G = G_; c = c_; }
    __host__ __device__ bool next(int i, Unit& u) const {
        const long L = (long)i * G + c; if (L >= nwg) return false;
        int wgid = (int)L; { const int q = nwg / NXCD, r = nwg % NXCD, xcd = wgid % NXCD, off = wgid / NXCD; wgid = (xcd < r ? xcd * (q + 1) : r * (q + 1) + (xcd - r) * q) + off; }
        const int nig = WGM * nN, gid = wgid / nig, fm = gid * WGM, gsz = (nM - fm) < WGM ? (nM - fm) : WGM;
        u.pm = fm + ((wgid % nig) % gsz); u.pn = (wgid % nig) / gsz; return true;
    }
    __device__ __forceinline__ void a_ready(const Unit&) const {}
    __device__ __forceinline__ void done(const Unit&) const {}
};

__device__ __forceinline__ unsigned cvt_pk_bf16(float lo, float hi) { unsigned r; asm volatile("v_cvt_pk_bf16_f32 %0, %1, %2" : "=v"(r) : "v"(lo), "v"(hi)); return r; }
template <class Epi, class Sched, bool ALIGN_EPI = false, bool SP2 = false, bool GATHER = false>
__device__ __forceinline__ void gemm_phase(PG8_LAS unsigned char* lds, const Gemm g, const Sched& S, const Epi& E) {
    static_assert(!GATHER || SP2, "the gathered-A path exists only in the SP2 loop");
    const int tid = threadIdx.x, wid = __builtin_amdgcn_readfirstlane(tid >> 6), lane = tid & 63, wr = wid >> 2, wc = wid & 3, fr = lane & 15, fq = lane >> 4;
    const int K = g.K, nt = K / BK;
    unsigned voffA[2], voffB[2];
#pragma unroll
    for (int i = 0; i < 2; ++i) { int R, C; stage_rc(tid * 16 + i * 8192, R, C); const int Rb = Epi::PERM ? ((R & ~31) + perm32(R & 31)) : R;
        voffA[i] = (unsigned)(R * K + C) * 2u; voffB[i] = (unsigned)(Rb * K + C) * 2u; }
    unsigned vgc[2][2] = {{0u, 0u}, {0u, 0u}}, vgn[2][2] = {{0u, 0u}, {0u, 0u}}; int gR[2] = {0, 0}, gC[2] = {0, 0};
    if constexpr (GATHER) {
#pragma unroll
        for (int i = 0; i < 2; ++i) stage_rc(tid * 16 + i * 8192, gR[i], gC[i]); }
#define PG8_GSET(dst, unit) do { _Pragma("unroll") for (int _h = 0; _h < 2; ++_h) _Pragma("unroll") for (int _i = 0; _i < 2; ++_i) dst[_h][_i] = (unsigned)(S.src_row((unit).pm, _h * 128 + gR[_i]) * K + gC[_i]) * 2u; } while (0)
    const size_t kstep = (size_t)(BK * 2);
    const size_t hstep = (size_t)HALF * K * 2;
    const size_t tstep = 2 * hstep;
    const unsigned ldsw = (unsigned)wid * 1024u;
    const int aoff = lds_byte(wr * 64 + fr, fq * 8), boff = lds_byte(wc * 32 + fr, fq * 8);
#define PG8_SA(b, h) (((b) * 2 + (h)) * HTB)
#define PG8_SB(b, h) ((4 + (b) * 2 + (h)) * HTB)
#define PG8_STAGE(bufoff, gbase, voff) do { _Pragma("unroll") for (int _i = 0; _i < 2; ++_i) \
        __builtin_amdgcn_global_load_lds((const unsigned*)((const char*)(gbase) + (voff)[_i]), (PG8_LAS unsigned*)(lds + (bufoff) + ldsw + _i * 8192), 16, 0, 0); } while (0)
#define PG8_STAGE_A(bufoff, gbase, h, usenext) do { if constexpr (GATHER) { _Pragma("unroll") for (int _i = 0; _i < 2; ++_i) { const unsigned _o = (usenext) ? vgn[h][_i] : vgc[h][_i]; \
        __builtin_amdgcn_global_load_lds((const unsigned*)((const char*)(gbase) + _o), (PG8_LAS unsigned*)(lds + (bufoff) + ldsw + _i * 8192), 16, 0, 0); } } \
        else { PG8_STAGE(bufoff, (gbase) + (h) * hstep, voffA); } } while (0)
#define PG8_LDA(dst, b, h) do { _Pragma("unroll") for (int m = 0; m < 4; ++m) _Pragma("unroll") for (int k = 0; k < 2; ++k) dst[m][k] = *(const PG8_LAS bf16x8*)(lds + PG8_SA(b, h) + aoff + m * 2048 + k * 1024); } while (0)
#define PG8_LDB(dst, b, h) do { _Pragma("unroll") for (int n = 0; n < 2; ++n) _Pragma("unroll") for (int k = 0; k < 2; ++k) dst[n][k] = *(const PG8_LAS bf16x8*)(lds + PG8_SB(b, h) + boff + n * 2048 + k * 1024); } while (0)
#define PG8_MMA(ai, bj, At, Bt) do { __builtin_amdgcn_s_setprio(1); _Pragma("unroll") for (int m = 0; m < 4; ++m) _Pragma("unroll") for (int n = 0; n < 2; ++n) _Pragma("unroll") for (int k = 0; k < 2; ++k) \
        acc[ai][bj][m][n] = __builtin_amdgcn_mfma_f32_16x16x32_bf16(Bt[n][k], At[m][k], acc[ai][bj][m][n], 0, 0, 0); __builtin_amdgcn_s_setprio(0); } while (0)
#define PG8_WAIT_V(n) asm volatile("s_waitcnt vmcnt(" #n ")" ::: "memory")
#define PG8_WAIT_L(n) asm volatile("s_waitcnt lgkmcnt(" #n ")" ::: "memory")
#define PG8_BAR __builtin_amdgcn_s_barrier()
#define PG8_SCHED __builtin_amdgcn_sched_barrier(0)
    Unit cur, nxt; int ui = 0;
    if (!S.next(0, cur)) return;
    f32x4 acc[2][2][4][2];
#pragma unroll
    for (int a = 0; a < 2; ++a)
#pragma unroll
        for (int b = 0; b < 2; ++b)
#pragma unroll
            for (int m = 0; m < 4; ++m)
#pragma unroll
                for (int n = 0; n < 2; ++n) acc[a][b][m][n] = (f32x4){0.f, 0.f, 0.f, 0.f};
    bf16x8 At[4][2], B0[2][2], B1[2][2];
    const char* cA = GATHER ? (const char*)g.A : (const char*)g.A + (size_t)cur.pm * tstep; const char* cB = (const char*)g.Bt + (size_t)cur.pn * tstep;
    if constexpr (GATHER) PG8_GSET(vgc, cur);
    S.a_ready(cur);
    if constexpr (SP2) {
        PG8_STAGE(PG8_SB(0, 0), cB, voffB); PG8_STAGE(PG8_SB(0, 1), cB + hstep, voffB); PG8_STAGE_A(PG8_SA(0, 0), cA, 0, false); PG8_STAGE_A(PG8_SA(0, 1), cA, 1, false);
        if (wr == 1) PG8_BAR;
        PG8_WAIT_V(2); PG8_BAR;
        PG8_STAGE(PG8_SB(1, 0), cB + kstep, voffB); PG8_STAGE_A(PG8_SA(1, 0), cA + kstep, 0, false); PG8_STAGE(PG8_SB(1, 1), cB + hstep + kstep, voffB);
        PG8_WAIT_V(6); PG8_BAR;
    } else {
        PG8_STAGE(PG8_SB(0, 0), cB, voffB); PG8_STAGE(PG8_SA(0, 0), cA, voffA); PG8_STAGE(PG8_SB(0, 1), cB + hstep, voffB); PG8_STAGE(PG8_SA(0, 1), cA + hstep, voffA);
        if (wr == 1) PG8_BAR;
        PG8_WAIT_V(4); PG8_BAR;
        PG8_STAGE(PG8_SB(1, 0), cB + kstep, voffB); PG8_STAGE(PG8_SA(1, 0), cA + kstep, voffA); PG8_STAGE(PG8_SB(1, 1), cB + hstep + kstep, voffB);
        PG8_WAIT_V(6); PG8_BAR;
    }
    for (;;) {
        const bool has_next = S.next(ui + 1, nxt);
        const char* nA = GATHER ? cA : (has_next ? (const char*)g.A + (size_t)nxt.pm * tstep : cA); const char* nB = has_next ? (const char*)g.Bt + (size_t)nxt.pn * tstep : cB;
        if constexpr (GATHER) { if (has_next) PG8_GSET(vgn, nxt); }
        for (int t = 0; t < nt; t += 2) {
            const bool last = (t == nt - 2);
            const char* a1 = cA + (size_t)(t + 1) * kstep;
            const char* a2 = last ? nA : cA + (size_t)(t + 2) * kstep; const char* b2 = last ? nB : cB + (size_t)(t + 2) * kstep;
            const char* a3 = a2 + kstep; const char* b3 = b2 + kstep;
            if (last && has_next) S.a_ready(nxt);
            const bool unx = last && has_next;
            if constexpr (SP2) {
            PG8_LDB(B0, 0, 0); PG8_LDB(B1, 0, 1); PG8_SCHED; PG8_LDA(At, 0, 0); PG8_STAGE_A(PG8_SA(1, 1), a1, 1, false);
            PG8_WAIT_V(8); PG8_WAIT_L(0); PG8_BAR; PG8_MMA(0, 0, At, B0); PG8_MMA(0, 1, At, B1); PG8_BAR; PG8_SCHED;
            PG8_LDA(At, 0, 1); PG8_STAGE(PG8_SB(0, 0), b2, voffB); PG8_STAGE(PG8_SB(0, 1), b2 + hstep, voffB); PG8_STAGE_A(PG8_SA(0, 0), a2, 0, unx);
            PG8_WAIT_V(8); PG8_WAIT_L(0); PG8_BAR; PG8_MMA(1, 0, At, B0); PG8_MMA(1, 1, At, B1); PG8_BAR; PG8_SCHED;
            PG8_LDB(B0, 1, 0); PG8_LDB(B1, 1, 1); PG8_SCHED; PG8_LDA(At, 1, 0); PG8_STAGE_A(PG8_SA(0, 1), a2, 1, unx);
            PG8_WAIT_V(8); PG8_WAIT_L(0); PG8_BAR; PG8_MMA(0, 0, At, B0); PG8_MMA(0, 1, At, B1); PG8_BAR; PG8_SCHED;
            PG8_LDA(At, 1, 1); PG8_STAGE(PG8_SB(1, 0), b3, voffB); PG8_STAGE(PG8_SB(1, 1), b3 + hstep, voffB); PG8_STAGE_A(PG8_SA(1, 0), a3, 0, unx);
            PG8_WAIT_V(8); PG8_WAIT_L(0); PG8_BAR; PG8_MMA(1, 0, At, B0); PG8_MMA(1, 1, At, B1); PG8_BAR; PG8_SCHED;
            } else {
            PG8_LDB(B0, 0, 0); PG8_SCHED; PG8_LDA(At, 0, 0); PG8_STAGE(PG8_SA(1, 1), a1 + hstep, voffA);
            PG8_WAIT_L(8); PG8_BAR; PG8_WAIT_L(0); PG8_MMA(0, 0, At, B0); PG8_BAR; PG8_SCHED;
            PG8_LDB(B1, 0, 1); PG8_STAGE(PG8_SB(0, 0), b2, voffB);
            PG8_BAR; PG8_WAIT_L(0); PG8_MMA(0, 1, At, B1); PG8_BAR;
            PG8_LDA(At, 0, 1); PG8_STAGE(PG8_SA(0, 0), a2, voffA);
            PG8_BAR; PG8_WAIT_L(0); PG8_MMA(1, 0, At, B0); PG8_BAR; PG8_SCHED;
            PG8_STAGE(PG8_SB(0, 1), b2 + hstep, voffB);
            PG8_WAIT_V(6); PG8_BAR; PG8_MMA(1, 1, At, B1); PG8_BAR;
            PG8_LDB(B0, 1, 0); PG8_SCHED; PG8_LDA(At, 1, 0); PG8_STAGE(PG8_SA(0, 1), a2 + hstep, voffA);
            PG8_WAIT_L(8); PG8_BAR; PG8_WAIT_L(0); PG8_MMA(0, 0, At, B0); PG8_BAR; PG8_SCHED;
            PG8_LDB(B1, 1, 1); PG8_STAGE(PG8_SB(1, 0), b3, voffB);
            PG8_BAR; PG8_WAIT_L(0); PG8_MMA(0, 1, At, B1); PG8_BAR;
            PG8_LDA(At, 1, 1); PG8_STAGE(PG8_SA(1, 0), a3, voffA);
            PG8_BAR; PG8_WAIT_L(0); PG8_MMA(1, 0, At, B0); PG8_BAR; PG8_SCHED;
            PG8_STAGE(PG8_SB(1, 1), b3 + hstep, voffB);
            PG8_WAIT_V(6); PG8_BAR; PG8_MMA(1, 1, At, B1); PG8_BAR;
            }
        }
        if constexpr (ALIGN_EPI) { if (wr == 0) PG8_BAR; }
        if constexpr (!Epi::AFTER_DRAIN) { E(acc, cur, wr, wc, fr, fq); S.done(cur); }
        if (!has_next) break;
#pragma unroll
        for (int a = 0; a < 2; ++a)
#pragma unroll
            for (int b = 0; b < 2; ++b)
#pragma unroll
                for (int m = 0; m < 4; ++m)
#pragma unroll
                    for (int n = 0; n < 2; ++n) acc[a][b][m][n] = (f32x4){0.f, 0.f, 0.f, 0.f};
        cur = nxt; cA = nA; cB = nB; ++ui;
        if constexpr (GATHER) { _Pragma("unroll") for (int _h = 0; _h < 2; ++_h) _Pragma("unroll") for (int _i = 0; _i < 2; ++_i) vgc[_h][_i] = vgn[_h][_i]; }
        if constexpr (ALIGN_EPI) { if (wr == 1) PG8_BAR; }
    }
    PG8_WAIT_V(0);
    if constexpr (!ALIGN_EPI) { if (wr == 0) PG8_BAR; }
    PG8_BAR;
    if constexpr (Epi::AFTER_DRAIN) { E.fused(acc, cur, wr, wc, fr, fq, lds, wid, lane); S.done(cur); }
#undef PG8_SA
#undef PG8_STAGE_A
#undef PG8_GSET
#undef PG8_SB
#undef PG8_STAGE
#undef PG8_LDA
#undef PG8_LDB
#undef PG8_MMA
#undef PG8_WAIT_V
#undef PG8_WAIT_L
#undef PG8_BAR
#undef PG8_SCHED
}
}

#ifndef ONE_LAUNCH
#define ONE_LAUNCH 1
#endif
constexpr int NWAVES = 8, NTHR = 512;
constexpr int D = 1024, BATCH = 2, SEQ = 8192, CTXL = 256, GRIDW = 64;
constexpr int MX = BATCH * SEQ, MC = BATCH * CTXL, MALL = MX + MC;
constexpr int NCH = 132;
constexpr int NSLAB = 5632, NS1 = 3584, NS2 = 2048;
constexpr int NZM = 4416;
constexpr int Z_R = 0, Z_K = 1024, Z_V = 2048, Z_KK = 3072, Z_TW = 4096, Z_AD = 4160, Z_GS = 4224;
constexpr int C_R = 0, C_K = 1024, C_V = 2048, C_WD = 3072, C_AD = 3136, C_GD = 3200, C_XB = 0, C_GBR = 1024;
constexpr int NWIN = 7680;
constexpr int NEXP = 32, DEXP = 512, MAXT = 160;
constexpr float LN_EPS = 1e-5f, GN_EPS = 64e-5f;
constexpr float ALPHA = 1.189207115002721f;
constexpr size_t MiB = 1u << 20;
constexpr size_t WS_CTL = 0, CTL_ZERO_BYTES = 1 * MiB;
constexpr size_t WS_STATS = 1 * MiB, WS_TOKE = 1 * MiB + 256 * 1024, WS_TOKSLOT = 1 * MiB + 512 * 1024, WS_TOKW = 1 * MiB + 768 * 1024, WS_ROWW = 2 * MiB;
constexpr size_t WS_RWT = 2 * MiB + 512 * 1024;
constexpr size_t WS_S2T = 3 * MiB, WS_AGGA = 5 * MiB, WS_AGGH = 9 * MiB + 256 * 1024, WS_CIN = 13 * MiB + 512 * 1024;
constexpr size_t WS_PW = 18 * MiB;
constexpr size_t WS_S1 = 24 * MiB;
constexpr size_t WS_S2 = 139 * MiB + 512 * 1024;
constexpr size_t WS_ZM = 139 * MiB + 512 * 1024;
constexpr size_t WS_FB = 206 * MiB;
constexpr size_t WS_BAG = 272 * MiB;
constexpr size_t WS_YLRU = 282 * MiB, WS_YWF = 24 * MiB, WS_YWB = 56 * MiB;
constexpr size_t WS_GATES = 140 * MiB;
constexpr size_t WS_MBUF = 204 * MiB;
constexpr size_t WS_W13 = 24 * MiB, WS_W2 = 88 * MiB;
constexpr size_t WS_H2 = 120 * MiB;
constexpr size_t WS_XS = 153 * MiB;
constexpr size_t WS_HBUF = 236 * MiB;
constexpr size_t WS_END = 314 * MiB;
static_assert(WS_S1 + (size_t)MALL * NS1 * 2 <= WS_S2 && WS_S2 + (size_t)MALL * NS2 * 2 <= WS_YLRU && WS_ZM + (size_t)MALL * NZM * 2 <= WS_YLRU && WS_YLRU + (size_t)MX * D * 2 <= WS_END, "ws map");
static_assert((WS_YLRU - WS_YWF) % (512 * 1024) == 0 && WS_H2 + (size_t)(MX + 1) * D * 2 <= WS_XS && WS_XS + (size_t)MAXT * 256 * D * 2 <= WS_HBUF && WS_HBUF + (size_t)MAXT * 256 * DEXP * 2 <= WS_END, "ws map 2");
constexpr size_t DO_H = 0, DO_WIN = 34 * MiB;
constexpr int CW_TMO = 0, CW_BAR = 4096, CW_MOD = 8192  , CW_ECNT = 32768  ;
constexpr int LDS_BYTES = 155648;
constexpr int MISC_OFF = LDS_BYTES - 1024;
constexpr int TILE_OFF = MISC_OFF - 2048;

#define GAS __attribute__((address_space(1)))
#define LAS __attribute__((address_space(3)))
typedef unsigned short bf16;
typedef unsigned v4u __attribute__((ext_vector_type(4)));
typedef unsigned v2u __attribute__((ext_vector_type(2)));
typedef float f32x4 __attribute__((ext_vector_type(4)));
typedef GAS unsigned gu32;
typedef short bf16x8 __attribute__((ext_vector_type(8)));
#define RLX_AGENT __ATOMIC_RELAXED, __HIP_MEMORY_SCOPE_AGENT
#define LDS_WAIT() asm volatile("s_waitcnt lgkmcnt(0)" ::: "memory")
#define VM_WAIT() asm volatile("s_waitcnt vmcnt(0)" ::: "memory")
#define DI __device__ __forceinline__
typedef __bf16 bf16x2_t __attribute__((ext_vector_type(2)));
typedef float f32x2 __attribute__((ext_vector_type(2)));
DI unsigned cvtpk_s(float lo, float hi) { const f32x2 v = {lo, hi}; const bf16x2_t b = __builtin_convertvector(v, bf16x2_t); return __builtin_bit_cast(unsigned, b); }
DI unsigned pk2(float lo, float hi) { return cvtpk_s(lo, hi); }
DI unsigned f2bf(float f) { return cvtpk_s(f, 0.f) & 0xffffu; }
DI float bf2f(unsigned short b) { return __builtin_bit_cast(float, ((unsigned)b) << 16); }
DI float bflo(unsigned w) { return __builtin_bit_cast(float, w << 16); }
DI float bfhi(unsigned w) { return __builtin_bit_cast(float, w & 0xffff0000u); }
constexpr float NL2E = -1.4426950408889634f;
DI float frcp(float x) { return __builtin_amdgcn_rcpf(x); }
DI float sigm(float x) { return 1.f / (1.f + __expf(-x)); }
DI float sigm_fast(float x) { return frcp(1.f + __expf(-x)); }
template <int CTRL> DI float dppf(float x) { return __builtin_bit_cast(float, __builtin_amdgcn_update_dpp(0, __builtin_bit_cast(int, x), CTRL, 0xF, 0xF, true)); }
template <int CTRL> DI float dppf_one(float x) { return __builtin_bit_cast(float, __builtin_amdgcn_update_dpp(0x3f800000, __builtin_bit_cast(int, x), CTRL, 0xF, 0xF, false)); }
DI float red4(float x) { x += dppf<0xB1>(x); x += dppf<0x4E>(x); return x; }
DI float red16(float x) { x += dppf<0xB1>(x); x += dppf<0x4E>(x); x += dppf<0x141>(x); x += dppf<0x140>(x); return x; }
DI float rdl(float v, int l) { return __builtin_bit_cast(float, __builtin_amdgcn_readlane(__builtin_bit_cast(int, v), l)); }
DI float wave_sum(float v) { v = red16(v); return (rdl(v, 0) + rdl(v, 16)) + (rdl(v, 32) + rdl(v, 48)); }

#define XB_TMO      128
#define XB_XCNT(j)  (256  + 64 * (j))
#define XB_XSUB(j)  (1280 + 64 * (j))
#define XB_XGEN(j)  (2304 + 64 * (j))
#define XB_TOP      3328
#define XB_TOPGEN   3392
#define XCD_BAR_WORDS 3456
#define XB_SPIN_CAP (1u << 18)

__device__ __forceinline__ unsigned xb_ld(unsigned* p)              { return __hip_atomic_load(p, __ATOMIC_RELAXED, __HIP_MEMORY_SCOPE_AGENT); }
__device__ __forceinline__ unsigned xb_add(unsigned* p, unsigned v) { return __hip_atomic_fetch_add(p, v, __ATOMIC_RELAXED, __HIP_MEMORY_SCOPE_AGENT); }
__device__ __forceinline__ unsigned xb_xcc_id() { return (unsigned)__builtin_amdgcn_s_getreg((3 << 11) | 20) & 0xFu; }
#define XB_SPIN(cond, bar) do { unsigned _sp = 0; while (cond) { __builtin_amdgcn_s_sleep(1); \
    if ((++_sp & 255u) == 0u) { if (xb_ld(&(bar)[XB_TMO])) break; if (_sp > XB_SPIN_CAP) { atomicAdd(&(bar)[XB_TMO], 1u); break; } } } } while (0)

struct XcdBarrier {
    unsigned* bar; unsigned x;
    volatile LAS unsigned* st;
};

__device__ __forceinline__ XcdBarrier xcd_barrier_post(unsigned* bar, volatile LAS unsigned* st) {
    XcdBarrier b; b.bar = bar; b.x = xb_xcc_id(); b.st = st;
    if (threadIdx.x == 0) (void)xb_add(&bar[XB_XCNT(b.x)], 1u);
    return b;
}
__device__ __forceinline__ void xcd_barrier_complete(unsigned* bar, unsigned x, unsigned& nloc, unsigned& nx) {
    const unsigned G = gridDim.x * gridDim.y * gridDim.z;
    unsigned sum, cnt, mine, sp = 0u;
    for (;;) {
        sum = 0u; cnt = 0u; mine = 0u;
#pragma unroll
        for (unsigned j = 0; j < 16; ++j) { const unsigned c = xb_ld(&bar[XB_XCNT(j)]); sum += c; cnt += (c > 0u) ? 1u : 0u; mine = (j == x) ? c : mine; }
        if (sum == G) break;
        __builtin_amdgcn_s_sleep(1);
        if ((++sp & 255u) == 0u) { if (xb_ld(&bar[XB_TMO])) break; if (sp > XB_SPIN_CAP) { atomicAdd(&bar[XB_TMO], 1u); break; } }
    }
    nloc = mine > 0u ? mine : 1u; nx = cnt > 0u ? cnt : 1u;
}

__device__ __forceinline__ void xcd_barrier(const XcdBarrier& b) {
    asm volatile("s_waitcnt vmcnt(0)" ::: "memory");
    __syncthreads();
    if (threadIdx.x == 0) {
        unsigned* bar = b.bar;
        __builtin_amdgcn_s_waitcnt(0);
        unsigned nloc = b.st[0], nx = b.st[1];
        if (nloc == 0u) { xcd_barrier_complete(bar, b.x, nloc, nx); b.st[0] = nloc; b.st[1] = nx; }
        const unsigned old = xb_add(&bar[XB_XSUB(b.x)], 1u);
        const unsigned gen = old / nloc;
        if (old + 1u == (gen + 1u) * nloc) {
            __builtin_amdgcn_fence(__ATOMIC_RELEASE, "agent");
            asm volatile("s_waitcnt vmcnt(0)" ::: "memory");
            const unsigned og = xb_add(&bar[XB_TOP], 1u);
            const unsigned tg = og / nx;
            if (og + 1u == (tg + 1u) * nx) xb_add(&bar[XB_TOPGEN], 1u);
            else XB_SPIN(xb_ld(&bar[XB_TOPGEN]) == tg, bar);
            __builtin_amdgcn_fence(__ATOMIC_ACQUIRE, "agent");
            xb_add(&bar[XB_XGEN(b.x)], 1u);
            asm volatile("s_waitcnt vmcnt(0)" ::: "memory");
        } else {
            XB_SPIN(xb_ld(&bar[XB_XGEN(b.x)]) == gen, bar);
            __builtin_amdgcn_fence(__ATOMIC_ACQUIRE, "agent");
            asm volatile("s_waitcnt vmcnt(0)" ::: "memory");
        }
    }
    __syncthreads();
}

struct Args { const float* in[39]; float* out; unsigned char* ws; int ph_lo, ph_hi; };

struct P {
    const float *x, *c, *ctx, *c_ctx, *w_ada, *b_ada, *w_in, *mu_a, *w0, *w2, *a0, *a2, *g2, *k_k, *k_a, *r_k, *gn_g, *gn_b, *conv_w, *conv_b,
        *lru_wa, *lru_ba, *lru_wx, *lru_bx, *lru_lam, *p_a, *p_b, *w_o, *ln1_g, *ln1_b, *router_g, *router_g_b, *router_e, *router_e_b, *e_w1, *e_w3, *e_w2, *ln2_g, *ln2_b;
    float* out; unsigned char* ws; unsigned char* dob;
    float* ctlf; unsigned* ctl;
};

DI float modv(const P& p, int v, int n) { return p.ctlf[CW_MOD + v * 6144 + n] + p.b_ada[n]; }
DI f32x4 modv4(const P& p, int v, int n) { return *(const f32x4*)(p.ctlf + CW_MOD + v * 6144 + n) + *(const f32x4*)(p.b_ada + n); }

DI void transpose_item(const float* W, int ldw, bf16* WT, int ldt, int k0, int n0, int drow0, LAS float* scr, int lane) {
#pragma unroll 8
    for (int i = 0; i < 32; ++i) { const int kk = 2 * i + (lane >> 5); scr[kk * 33 + (lane & 31)] = W[(size_t)(k0 + kk) * ldw + n0 + (lane & 31)]; }
    LDS_WAIT(); asm volatile("" ::: "memory");
    const int c = lane & 7;
#pragma unroll
    for (int j = 0; j < 4; ++j) { const int n = (lane >> 3) + 8 * j; const LAS float* s = scr + (8 * c) * 33 + n;
        v4u o; o.x = pk2(s[0 * 33], s[1 * 33]); o.y = pk2(s[2 * 33], s[3 * 33]); o.z = pk2(s[4 * 33], s[5 * 33]); o.w = pk2(s[6 * 33], s[7 * 33]);
        *(GAS v4u*)(WT + (size_t)(drow0 + n) * ldt + k0 + 8 * c) = o; }
    LDS_WAIT(); asm volatile("" ::: "memory");
}

DI void phase0(const P& p, LAS unsigned char* lds, int tid, int lane, int wave, int G) {
    LAS float* s3 = (LAS float*)lds;
    for (int item = blockIdx.x; item < 256; item += G) {
        const int kc = item >> 4, nc = item & 15;
        if (tid < 192) { const int v = tid >> 6, k = tid & 63; const float cv = (v < 2) ? p.c[v * D + kc * 64 + k] : p.c_ctx[kc * 64 + k]; s3[v * 64 + k] = cv * sigm(cv); }
        __syncthreads();
        if (tid < 384) { const int n = nc * 384 + tid; float a0 = 0.f, a1 = 0.f, a2 = 0.f;
            for (int k = 0; k < 64; ++k) { const float w = p.w_ada[(size_t)(kc * 64 + k) * 6144 + n]; a0 += s3[k] * w; a1 += s3[64 + k] * w; a2 += s3[128 + k] * w; }
            atomicAdd(p.ctlf + CW_MOD + n, a0); atomicAdd(p.ctlf + CW_MOD + 6144 + n, a1); atomicAdd(p.ctlf + CW_MOD + 2 * 6144 + n, a2); }
        __syncthreads();
    }
}
DI void phase0b(const P& p, LAS unsigned char* lds, int tid, int lane, int wave, int G) {
    LAS float* scr = (LAS float*)(lds + 4096 + wave * 16384);
    const int gw = blockIdx.x * NWAVES + wave, NGW = G * NWAVES;
    bf16* win_t = (bf16*)(p.dob + DO_WIN); bf16* pw = (bf16*)(p.ws + WS_PW);
    constexpr int I_IN = 16 * 233, I_P = 16 * 32;
    for (int it = gw; it < I_IN + 3 * I_P; it += NGW) {
        int r = it;
        if (r < I_IN) { const int kb = r / 233, nb = r % 233, n0 = nb * 32; transpose_item(p.w_in, 7456, win_t, D, kb * 64, n0, n0 + (n0 >= 3360 ? 224 : 0), scr, lane); continue; }
        r -= I_IN; const int wsel = r / I_P; r %= I_P; const int kb = r / 32, nb = r % 32;
        if (wsel == 0) transpose_item(p.p_a, D, pw, D, kb * 64, nb * 32, nb * 32, scr, lane);
        else if (wsel == 1) transpose_item(p.p_b, D, pw + (size_t)D * D, D, kb * 64, nb * 32, nb * 32, scr, lane);
        else transpose_item(p.w_o, D, pw + (size_t)2 * D * D, D, kb * 64, nb * 32, nb * 32, scr, lane);
    }
    { float* rwt = (float*)(p.ws + WS_RWT);
      for (int i = blockIdx.x * NTHR + tid; i < 48 * D; i += G * NTHR) { const int n = i >> 10, k = i & (D - 1); rwt[i] = n < 4 ? p.router_g[k * 4 + n] : (n < 36 ? p.router_e[k * 32 + (n - 4)] : 0.f); } }
    for (int i = blockIdx.x * NTHR + tid; i < 224 * D / 8; i += G * NTHR) ((GAS v4u*)(win_t + (size_t)3360 * D))[i] = (v4u){0u, 0u, 0u, 0u};
}

DI void phase1(const P& p, int lane, int wave, int G) {
    const int gw = blockIdx.x * NWAVES + wave, NGW = G * NWAVES;
    bf16* H = (bf16*)(p.dob + DO_H); float* stats = (float*)(p.ws + WS_STATS);
    f32x4 sc[2][4], sh[2][4]; int cv[2] = {-1, -1};
#pragma unroll
    for (int j = 0; j < 4; ++j) { sc[0][j] = sc[1][j] = sh[0][j] = sh[1][j] = (f32x4){0.f, 0.f, 0.f, 0.f}; }
    for (int m0 = gw; m0 < MALL; m0 += 2 * NGW) {
        f32x4 q[2][4]; float s[2] = {0.f, 0.f}; int mm[2]; mm[0] = m0; mm[1] = (m0 + NGW < MALL) ? m0 + NGW : m0;
#pragma unroll
        for (int rr = 0; rr < 2; ++rr) { const int m = mm[rr]; const float* xrow = (m < MX) ? p.x + (size_t)m * D : p.ctx + (size_t)(m - MX) * D; const GAS f32x4* xr = (const GAS f32x4*)xrow + lane;
#pragma unroll
            for (int j = 0; j < 4; ++j) { q[rr][j] = xr[64 * j]; s[rr] += (q[rr][j].x + q[rr][j].y) + (q[rr][j].z + q[rr][j].w); } }
#pragma unroll
        for (int rr = 0; rr < 2; ++rr) { const int m = mm[rr]; const int v = (m < MX) ? (m >> 13) : 2;
            if (v != cv[rr]) { cv[rr] = v;
#pragma unroll
                for (int j = 0; j < 4; ++j) { const int n = 256 * j + 4 * lane; sc[rr][j] = modv4(p, v, 1024 + n) + 1.f; sh[rr][j] = modv4(p, v, n); } }
            const float mean = wave_sum(s[rr]) * (1.f / D); float s2 = 0.f;
#pragma unroll
            for (int j = 0; j < 4; ++j) { q[rr][j] = q[rr][j] - mean; s2 += (q[rr][j].x * q[rr][j].x + q[rr][j].y * q[rr][j].y) + (q[rr][j].z * q[rr][j].z + q[rr][j].w * q[rr][j].w); }
            const float rstd = 1.f / sqrtf(wave_sum(s2) * (1.f / D) + LN_EPS);
            if (rr == 0 || mm[1] != mm[0]) {
                if (lane == 0) { stats[2 * m] = mean; stats[2 * m + 1] = rstd; }
                GAS v2u* o8 = (GAS v2u*)(H + (size_t)m * D) + lane;
#pragma unroll
                for (int j = 0; j < 4; ++j) { const f32x4 h = q[rr][j] * rstd * sc[rr][j] + sh[rr][j];
                    o8[64 * j] = (v2u){pk2(h[0], h[1]), pk2(h[2], h[3])}; } } }
    }
}

template <int ACT> struct EpiPlain {
    static constexpr bool PERM = true, AFTER_DRAIN = false;
    bf16* O; int ldc; bf16* O2; int ldc2; int split_tile;
    DI void operator()(const pg8::f32x4 (&acc)[2][2][4][2], const pg8::Unit& u, int wr, int wc, int fr, int fq) const {
        const bool second = u.pn >= split_tile; bf16* Ob = second ? O2 : O; const int ld = second ? ldc2 : ldc, pn = second ? u.pn - split_tile : u.pn;
        const int row0 = u.pm * 256 + wr * 64 + fr, col0 = pn * 256 + wc * 32 + 8 * fq;
#pragma unroll
        for (int ai = 0; ai < 2; ++ai)
#pragma unroll
            for (int m = 0; m < 4; ++m) { bf16* rowp = Ob + (size_t)(row0 + ai * 128 + m * 16) * ld + col0;
#pragma unroll
                for (int bj = 0; bj < 2; ++bj) { pg8::f32x4 v0 = acc[ai][bj][m][0], v1 = acc[ai][bj][m][1];
                    if (ACT == 1) {
#pragma unroll
                        for (int i = 0; i < 4; ++i) { v0[i] = sigm_fast(v0[i]); v1[i] = sigm_fast(v1[i]); } }
                    pg8::u32x4 w;
                    if (ACT == 1) { w.x = cvtpk_s(v0[0], v0[1]); w.y = cvtpk_s(v0[2], v0[3]); w.z = cvtpk_s(v1[0], v1[1]); w.w = cvtpk_s(v1[2], v1[3]); }
                    else { w.x = pg8::cvt_pk_bf16(v0[0], v0[1]); w.y = pg8::cvt_pk_bf16(v0[2], v0[3]); w.z = pg8::cvt_pk_bf16(v1[0], v1[1]); w.w = pg8::cvt_pk_bf16(v1[2], v1[3]); }
                    *(pg8::u32x4*)(rowp + bj * 128) = w; } }
    }
};
constexpr int LRU_TOFF = (int)((WS_YLRU - WS_YWF) / (512 * 1024));
struct EpiMix {
    static constexpr bool PERM = true, AFTER_DRAIN = false;
    const bf16* gates; bf16* mbuf;
    DI void operator()(const pg8::f32x4 (&acc)[2][2][4][2], const pg8::Unit& u, int wr, int wc, int fr, int fq) const {
        const bool isa = u.pm < 64; const int row0 = (isa ? u.pm : u.pm - LRU_TOFF) * 256 + wr * 64 + fr, col0 = (u.pn & 3) * 256 + wc * 32 + 8 * fq;
#pragma unroll
        for (int ai = 0; ai < 2; ++ai) {
            pg8::u32x4 gwv[4][2], oldv[4][2];
#pragma unroll
            for (int m = 0; m < 4; ++m)
#pragma unroll
                for (int bj = 0; bj < 2; ++bj) { const int row = row0 + ai * 128 + m * 16, col = col0 + bj * 128;
                    gwv[m][bj] = *(const pg8::u32x4*)(gates + (size_t)row * 2048 + (isa ? 0 : 1024) + col);
                    oldv[m][bj] = (pg8::u32x4){0u, 0u, 0u, 0u}; if (isa) oldv[m][bj] = *(const pg8::u32x4*)(mbuf + (size_t)row * D + col); }
#pragma unroll
            for (int m = 0; m < 4; ++m) { const int row = row0 + ai * 128 + m * 16;
#pragma unroll
                for (int bj = 0; bj < 2; ++bj) { const int col = col0 + bj * 128;
                    const pg8::u32x4 gw = gwv[m][bj];
                    bf16* mp = mbuf + (size_t)row * D + col;
                    const pg8::u32x4 old = oldv[m][bj];
                    const pg8::f32x4 v0 = acc[ai][bj][m][0], v1 = acc[ai][bj][m][1];
                    float r[8];
                    r[0] = v0[0] * bflo(gw.x) + bflo(old.x); r[1] = v0[1] * bfhi(gw.x) + bfhi(old.x); r[2] = v0[2] * bflo(gw.y) + bflo(old.y); r[3] = v0[3] * bfhi(gw.y) + bfhi(old.y);
                    r[4] = v1[0] * bflo(gw.z) + bflo(old.z); r[5] = v1[1] * bfhi(gw.z) + bfhi(old.z); r[6] = v1[2] * bflo(gw.w) + bflo(old.w); r[7] = v1[3] * bfhi(gw.w) + bfhi(old.w);
                    pg8::u32x4 w; w.x = pg8::cvt_pk_bf16(r[0], r[1]); w.y = pg8::cvt_pk_bf16(r[2], r[3]); w.z = pg8::cvt_pk_bf16(r[4], r[5]); w.w = pg8::cvt_pk_bf16(r[6], r[7]);
                    *(pg8::u32x4*)mp = w; } } }
    }
};
struct EpiT1 {
    static constexpr bool PERM = false, AFTER_DRAIN = false;
    const float* x; const float* stats; const float* modp; const float* b_ada; float* T1;
    DI void operator()(const pg8::f32x4 (&acc)[2][2][4][2], const pg8::Unit& u, int wr, int wc, int fr, int fq) const {
        const int row0 = u.pm * 256 + wr * 64 + fr, col0 = u.pn * 256 + wc * 32 + 4 * fq; const int b = (u.pm * 256) >> 13;
        pg8::f32x4 gt[2][2];
#pragma unroll
        for (int bj = 0; bj < 2; ++bj)
#pragma unroll
            for (int n = 0; n < 2; ++n) { const int c = col0 + bj * 128 + n * 16; gt[bj][n] = *(const pg8::f32x4*)(modp + b * 6144 + 2048 + c) + *(const pg8::f32x4*)(b_ada + 2048 + c); }
#pragma unroll
        for (int ai = 0; ai < 2; ++ai)
#pragma unroll
            for (int mh = 0; mh < 2; ++mh) {
                float mean[2], rs[2]; pg8::f32x4 xv[2][2][2];
#pragma unroll
                for (int mm = 0; mm < 2; ++mm) { const int row = row0 + ai * 128 + (2 * mh + mm) * 16; mean[mm] = stats[2 * row]; rs[mm] = stats[2 * row + 1] * ALPHA;
#pragma unroll
                    for (int bj = 0; bj < 2; ++bj)
#pragma unroll
                        for (int n = 0; n < 2; ++n) xv[mm][bj][n] = *(const pg8::f32x4*)(x + (size_t)row * D + col0 + bj * 128 + n * 16); }
#pragma unroll
                for (int mm = 0; mm < 2; ++mm) { const int m = 2 * mh + mm; const int row = row0 + ai * 128 + m * 16;
#pragma unroll
                    for (int bj = 0; bj < 2; ++bj)
#pragma unroll
                        for (int n = 0; n < 2; ++n) *(pg8::f32x4*)(T1 + (size_t)row * D + col0 + bj * 128 + n * 16) = (xv[mm][bj][n] - mean[mm]) * rs[mm] + gt[bj][n] * acc[ai][bj][m][n]; } }
    }
};
struct EpiSwiGLU {
    static constexpr bool PERM = true, AFTER_DRAIN = false;
    bf16* hb;
    DI void operator()(const pg8::f32x4 (&acc)[2][2][4][2], const pg8::Unit& u, int wr, int wc, int fr, int fq) const {
        const int row0 = u.pm * 256 + wr * 64 + fr, col0 = (u.pn & 3) * 128 + wc * 32 + 8 * fq;
#pragma unroll
        for (int ai = 0; ai < 2; ++ai)
#pragma unroll
            for (int m = 0; m < 4; ++m) { float r[8];
#pragma unroll
                for (int n = 0; n < 2; ++n)
#pragma unroll
                    for (int i = 0; i < 4; ++i) { const float a = acc[ai][0][m][n][i], b = acc[ai][1][m][n][i]; r[4 * n + i] = a * sigm_fast(a) * b; }
                pg8::u32x4 w; w.x = pg8::cvt_pk_bf16(r[0], r[1]); w.y = pg8::cvt_pk_bf16(r[2], r[3]); w.z = pg8::cvt_pk_bf16(r[4], r[5]); w.w = pg8::cvt_pk_bf16(r[6], r[7]);
                *(pg8::u32x4*)(hb + (size_t)(row0 + ai * 128 + m * 16) * DEXP + col0) = w; }
    }
};
struct EpiW2 {
    static constexpr bool PERM = true, AFTER_DRAIN = false;
    bf16* yb; const LAS int* tile; const int* s2t; const float* tokw;
    DI void operator()(const pg8::f32x4 (&acc)[2][2][4][2], const pg8::Unit& u, int wr, int wc, int fr, int fq) const {
        const int row0 = u.pm * 256 + wr * 64 + fr, col0 = (u.pn & 3) * 256 + wc * 32 + 8 * fq;
        const int ex = tile[u.pm], slot0 = (u.pm - tile[MAXT + ex]) * 256 + wr * 64 + fr, cnt = tile[MAXT + 64 + ex];
        int si[2][4]; float rwv[2][4];
#pragma unroll
        for (int ai = 0; ai < 2; ++ai)
#pragma unroll
            for (int m = 0; m < 4; ++m) { const int slot = slot0 + ai * 128 + m * 16; si[ai][m] = slot < cnt ? s2t[(size_t)ex * MX + slot] : -1; }
#pragma unroll
        for (int ai = 0; ai < 2; ++ai)
#pragma unroll
            for (int m = 0; m < 4; ++m) rwv[ai][m] = si[ai][m] >= 0 ? tokw[si[ai][m]] : 0.f;
#pragma unroll
        for (int ai = 0; ai < 2; ++ai)
#pragma unroll
            for (int m = 0; m < 4; ++m) { const int row = row0 + ai * 128 + m * 16; const float rw = rwv[ai][m];
#pragma unroll
                for (int bj = 0; bj < 2; ++bj) { const pg8::f32x4 v0 = acc[ai][bj][m][0] * rw, v1 = acc[ai][bj][m][1] * rw;
                    pg8::u32x4 w; w.x = pg8::cvt_pk_bf16(v0[0], v0[1]); w.y = pg8::cvt_pk_bf16(v0[2], v0[3]); w.z = pg8::cvt_pk_bf16(v1[0], v1[1]); w.w = pg8::cvt_pk_bf16(v1[2], v1[3]);
                    *(pg8::u32x4*)(yb + (size_t)row * D + col0 + bj * 128) = w; } }
    }
};
struct SchedMix : pg8::StaticOrder {
    __device__ bool next(int i, pg8::Unit& u) const { pg8::Unit t; if (!pg8::StaticOrder::next(i >> 1, t)) return false; const int w = i & 1; u.pm = w ? t.pm : t.pm + LRU_TOFF; u.pn = w ? t.pn : t.pn + 4; return true; }
};
struct SchedMoE {
    const LAS int* tile; int G, c; const int* s2t;
    DI int src_row(int T, int r) const { const int e = tile[T], slot = (T - tile[MAXT + e]) * 256 + r; return slot < tile[MAXT + 64 + e] ? (s2t[(size_t)e * MX + slot] >> 1) : MX; }
    __device__ bool next(int i, pg8::Unit& u) const { int L = i * G + c; const int U = tile[MAXT + 40] * 4; if (L >= U) return false;
        { const int q = U / pg8::NXCD, r = U % pg8::NXCD, xcd = L % pg8::NXCD, off = L / pg8::NXCD; L = (xcd < r ? xcd * (q + 1) : r * (q + 1) + (xcd - r) * q) + off; }
        const int T = L >> 2; u.pm = T; u.pn = tile[T] * 4 + (L & 3); return true; }
    DI void a_ready(const pg8::Unit&) const {}
    DI void done(const pg8::Unit&) const {}
};

DI int chunk_row0(int b, int ci) { return ci < 4 ? MX + b * CTXL + ci * 64 : b * SEQ + (ci - 4) * 64; }
DI float gelu_tanh(float x) { const float u = 0.7978845608028654f * (x + 0.044715f * x * x * x); const float t = 1.f - 2.f * frcp(1.f + __expf(2.f * u)); return 0.5f * x * (1.f + t); }
constexpr int NHS = 264;
constexpr int LR_WT = 0, LR_CW = 36864, LR_WV = 38400, LR_WVS = 6656, LR_GC = LR_WV + NWAVES * LR_WVS;
DI void lru_setup(const P& p, LAS unsigned char* lds, int tid, int hb) {
    LAS bf16* WT = (LAS bf16*)(lds + LR_WT); LAS float* CW = (LAS float*)(lds + LR_CW);
    __syncthreads();
    for (int i = tid; i < 4 * 4096; i += NTHR) { const int m = i >> 12, k = (i >> 6) & 63, n = i & 63; const int e = m & 1;
        const float w = (m < 2 ? p.lru_wa : p.lru_wx)[((size_t)(e * 16 + hb) * 64 + k) * 64 + n]; WT[m * 4608 + n * 72 + k] = (bf16)f2bf(NL2E * w); }
    for (int i = tid; i < 6 * 64; i += NTHR) { const int r = i >> 6, c = i & 63; CW[i] = r < 5 ? p.conv_w[r * D + hb * 64 + c] : p.conv_b[hb * 64 + c]; }
    for (int i = tid; i < 6 * 64; i += NTHR) { const int e = i / 192, k = (i >> 6) % 3, c = hb * 64 + (i & 63);
        ((LAS float*)(lds + LR_GC))[i] = k == 0 ? NL2E * p.lru_ba[e * D + c] : k == 1 ? NL2E * p.lru_bx[e * D + c] : (8.f * NL2E) * log1pf(__expf(-p.lru_lam[e * D + c])); }
    __syncthreads();
}
DI void hs_geom(int b, int hs, int& row0, int& tb, int& tlen) { if (hs < 8) { tb = hs * 32; row0 = MX + b * CTXL + tb; tlen = CTXL; } else { tb = (hs - 8) * 32; row0 = b * SEQ + tb; tlen = SEQ; } }
DI void lru_conv(const bf16* S, LAS unsigned char* lds, LAS unsigned char* wv, int lane, int hb, int rowb, int tb, int tlen) {
    LAS float* CW = (LAS float*)(lds + LR_CW); LAS bf16* XCB = (LAS bf16*)wv; LAS float* XC = (LAS float*)(wv + 2304);
    const int tau = lane >> 2, qd = lane & 3; const unsigned char* Sb = (const unsigned char*)S; const unsigned ob = (unsigned)((rowb + tau) * NS2 + C_XB + hb * 64 + qd * 16) * 2u;
    float a[16];
#pragma unroll
    for (int i4 = 0; i4 < 4; ++i4) { const f32x4 bv = *(const LAS f32x4*)(CW + 5 * 64 + qd * 16 + 4 * i4); a[4 * i4] = bv[0]; a[4 * i4 + 1] = bv[1]; a[4 * i4 + 2] = bv[2]; a[4 * i4 + 3] = bv[3]; }
    v4u w[5][2];
#pragma unroll
    for (int i = 0; i < 5; ++i) { const int t = tb + tau + i - 2; const bool ok = t >= 0 && t < tlen;
        const unsigned oi = ob + (unsigned)((i - 2) * NS2 * 2); w[i][0] = ok ? *(const v4u*)(Sb + oi) : (v4u){0u, 0u, 0u, 0u}; w[i][1] = ok ? *(const v4u*)(Sb + oi + 16) : (v4u){0u, 0u, 0u, 0u}; }
#pragma unroll
    for (int i = 0; i < 5; ++i)
#pragma unroll
        for (int hh = 0; hh < 2; ++hh) { const f32x4 c0 = *(const LAS f32x4*)(CW + i * 64 + qd * 16 + hh * 8), c1 = *(const LAS f32x4*)(CW + i * 64 + qd * 16 + hh * 8 + 4); const v4u x = w[i][hh];
            a[hh * 8 + 0] += c0[0] * bflo(x.x); a[hh * 8 + 1] += c0[1] * bfhi(x.x); a[hh * 8 + 2] += c0[2] * bflo(x.y); a[hh * 8 + 3] += c0[3] * bfhi(x.y);
            a[hh * 8 + 4] += c1[0] * bflo(x.z); a[hh * 8 + 5] += c1[1] * bfhi(x.z); a[hh * 8 + 6] += c1[2] * bflo(x.w); a[hh * 8 + 7] += c1[3] * bfhi(x.w); }
#pragma unroll
    for (int i4 = 0; i4 < 4; ++i4) *(LAS f32x4*)(XC + tau * 68 + qd * 16 + 4 * i4) = (f32x4){a[4 * i4], a[4 * i4 + 1], a[4 * i4 + 2], a[4 * i4 + 3]};
    *(LAS v4u*)(XCB + tau * 72 + qd * 16) = (v4u){pk2(a[0], a[1]), pk2(a[2], a[3]), pk2(a[4], a[5]), pk2(a[6], a[7])};
    *(LAS v4u*)(XCB + tau * 72 + qd * 16 + 8) = (v4u){pk2(a[8], a[9]), pk2(a[10], a[11]), pk2(a[12], a[13]), pk2(a[14], a[15])};
}
DI void lru_gates_nt(LAS unsigned char* lds, LAS unsigned char* wv, int lane, int nt, const bf16x8 (&ax)[2], float (&av)[2][4], float (&uv)[2][4]) {
    LAS bf16* WT = (LAS bf16*)(lds + LR_WT); LAS float* XC = (LAS float*)(wv + 2304);
    const int l15 = lane & 15, g = lane >> 4;
    pg8::f32x4 zr[2], zi[2];
#pragma unroll
    for (int e = 0; e < 2; ++e) { zr[e] = (pg8::f32x4){0.f, 0.f, 0.f, 0.f}; zi[e] = (pg8::f32x4){0.f, 0.f, 0.f, 0.f}; }
#pragma unroll
    for (int ks = 0; ks < 2; ++ks)
#pragma unroll
        for (int e = 0; e < 2; ++e) { const bf16x8 br = *(const LAS bf16x8*)(WT + e * 4608 + (nt * 16 + l15) * 72 + ks * 32 + g * 8), bi = *(const LAS bf16x8*)(WT + (2 + e) * 4608 + (nt * 16 + l15) * 72 + ks * 32 + g * 8);
            zr[e] = __builtin_amdgcn_mfma_f32_16x16x32_bf16(ax[ks], br, zr[e], 0, 0, 0); zi[e] = __builtin_amdgcn_mfma_f32_16x16x32_bf16(ax[ks], bi, zi[e], 0, 0, 0); }
    const f32x4 xc = {XC[(4 * g + 0) * 68 + nt * 16 + l15], XC[(4 * g + 1) * 68 + nt * 16 + l15], XC[(4 * g + 2) * 68 + nt * 16 + l15], XC[(4 * g + 3) * 68 + nt * 16 + l15]};
    const LAS float* GC = (const LAS float*)(lds + LR_GC) + nt * 16 + l15;
#pragma unroll
    for (int e = 0; e < 2; ++e) { const float cba = GC[e * 192], cbx = GC[e * 192 + 64], csp = GC[e * 192 + 128];
        const f32x4 xr = (f32x4){zr[e][0], zr[e][1], zr[e][2], zr[e][3]} + cba, xi = (f32x4){zi[e][0], zi[e][1], zi[e][2], zi[e][3]} + cbx;
        const f32x4 dr = (f32x4){__builtin_amdgcn_exp2f(xr[0]), __builtin_amdgcn_exp2f(xr[1]), __builtin_amdgcn_exp2f(xr[2]), __builtin_amdgcn_exp2f(xr[3])} + 1.f;
        const f32x4 di = (f32x4){__builtin_amdgcn_exp2f(xi[0]), __builtin_amdgcn_exp2f(xi[1]), __builtin_amdgcn_exp2f(xi[2]), __builtin_amdgcn_exp2f(xi[3])} + 1.f;
        const f32x4 dd = dr * di, rr = {frcp(dd[0]), frcp(dd[1]), frcp(dd[2]), frcp(dd[3])};
        const f32x4 la = rr * di * csp, ig = rr * dr;
        const f32x4 a = {__builtin_amdgcn_exp2f(la[0]), __builtin_amdgcn_exp2f(la[1]), __builtin_amdgcn_exp2f(la[2]), __builtin_amdgcn_exp2f(la[3])};
        const f32x4 em = 1.f - a * a;
        const f32x4 sq = {__builtin_amdgcn_sqrtf(fmaxf(em[0], 0.f)), __builtin_amdgcn_sqrtf(fmaxf(em[1], 0.f)), __builtin_amdgcn_sqrtf(fmaxf(em[2], 0.f)), __builtin_amdgcn_sqrtf(fmaxf(em[3], 0.f))};
        const f32x4 u = sq * ig * xc;
#pragma unroll
        for (int i = 0; i < 4; ++i) { av[e][i] = a[i]; uv[e][i] = u[i]; } }
}
DI float bperm(int srclane, float v) { return __builtin_bit_cast(float, __builtin_amdgcn_ds_bpermute(srclane * 4, __builtin_bit_cast(int, v))); }
template <int DIR> DI void lru_local(const float (&a)[4], const float (&u)[4], int l15, float (&hl)[4], float (&pl)[4], float (&PG)[4], float (&HG)[4]) {
    float h = 0.f, pr = 1.f;
#pragma unroll
    for (int q = 0; q < 4; ++q) { const int i = DIR ? 3 - q : q; h = a[i] * h + u[i]; pr *= a[i]; hl[i] = h; pl[i] = pr; }
#pragma unroll
    for (int gg = 0; gg < 4; ++gg) { PG[gg] = bperm(gg * 16 + l15, pr); HG[gg] = bperm(gg * 16 + l15, h); }
}
DI void lru_unit(const P& p, LAS unsigned char* lds, int lane, int wave, int b, int hs, int hb) {
    const bf16* S = (const bf16*)(p.ws + WS_S2); LAS unsigned char* wv = lds + LR_WV + wave * LR_WVS; LAS bf16* XCB = (LAS bf16*)wv;
    const int l15 = lane & 15, g = lane >> 4; int row0, tb, tlen; hs_geom(b, hs, row0, tb, tlen);
    const unsigned ao0 = (unsigned)(((b * NHS + hs) * 2) * D + hb * 64 + l15) * 4u;
    unsigned char* FB = p.ws + WS_FB; unsigned char* SB = p.ws + WS_YLRU; unsigned char* BG = p.ws + WS_BAG;
    const bool mainrow = hs >= 8; const unsigned bg0 = (unsigned)(((b * 256 + (hs - 8)) * 4) * D + hb * 64 + l15) * 4u;
    float Af[4], Hf[4], Ab[4], Hb[4];
#pragma unroll
    for (int nt = 0; nt < 4; ++nt) { Af[nt] = 1.f; Hf[nt] = 0.f; Ab[nt] = 1.f; Hb[nt] = 0.f; }
#pragma unroll 1
    for (int band = 0; band < 2; ++band) { lru_conv(S, lds, wv, lane, hb, row0 + band * 16, tb + band * 16, tlen);
        bf16x8 ax[2]; const unsigned yb = (unsigned)((row0 + band * 16 + 4 * g) * D + hb * 64 + l15);
#pragma unroll
        for (int ks = 0; ks < 2; ++ks) ax[ks] = *(const LAS bf16x8*)(XCB + l15 * 72 + ks * 32 + g * 8);
#pragma unroll
        for (int nt = 0; nt < 4; ++nt) { float av[2][4], uv[2][4], hl[4], pl[4], PG[4], HG[4], sf[4], pf[4];
            __builtin_amdgcn_sched_barrier(0);
            lru_gates_nt(lds, wv, lane, nt, ax, av, uv);
            lru_local<0>(av[0], uv[0], l15, hl, pl, PG, HG); float cc = 0.f, Pc = 1.f, cm = 0.f, Pm = 1.f;
#pragma unroll
            for (int gg = 0; gg < 4; ++gg) { if (gg == g) { cm = cc; Pm = Pc; } cc = PG[gg] * cc + HG[gg]; Pc *= PG[gg]; }
#pragma unroll
            for (int i = 0; i < 4; ++i) { sf[i] = hl[i] + pl[i] * cm; pf[i] = pl[i] * Pm; }
            Hf[nt] = Pc * Hf[nt] + cc; Af[nt] *= Pc;
            if (mainrow && band == 0 && g == 0) { *(float*)(BG + (size_t)bg0 + nt * 64) = Pc; *(float*)((BG + D * 4) + (size_t)bg0 + nt * 64) = cc; }
            lru_local<1>(av[1], uv[1], l15, hl, pl, PG, HG); float c = 0.f, Pb = 1.f, cmb = 0.f, Pmb = 1.f;
#pragma unroll
            for (int gg = 3; gg >= 0; --gg) { if (gg == g) { cmb = c; Pmb = Pb; } c = PG[gg] * c + HG[gg]; Pb *= PG[gg]; }
            Hb[nt] = Ab[nt] * c + Hb[nt]; Ab[nt] *= Pb;
            if (mainrow && band == 1 && g == 0) { *(float*)((BG + 2 * D * 4) + (size_t)bg0 + nt * 64) = Pb; *(float*)((BG + 3 * D * 4) + (size_t)bg0 + nt * 64) = c; }
            if (mainrow) {
#pragma unroll
                for (int i = 0; i < 4; ++i) { *(bf16*)((SB + i * D * 2) + (size_t)(yb * 2u) + nt * 32) = (bf16)f2bf(sf[i] + hl[i] + pl[i] * cmb); *(unsigned*)((FB + i * D * 4) + (size_t)(yb * 4u) + nt * 64) = pk2(pf[i], pl[i] * Pmb); } } } }
    if (g == 0) { unsigned char* GA = p.ws + WS_AGGA; unsigned char* GH = p.ws + WS_AGGH;
#pragma unroll
        for (int nt = 0; nt < 4; ++nt) { *(float*)(GA + (size_t)ao0 + nt * 64) = Af[nt]; *(float*)(GH + (size_t)ao0 + nt * 64) = Hf[nt]; *(float*)((GA + D * 4) + (size_t)ao0 + nt * 64) = Ab[nt]; *(float*)((GH + D * 4) + (size_t)ao0 + nt * 64) = Hb[nt]; } }
}
DI void lru_finish(const P& p, int lane, int wave, int G) {
    const float* CI = (const float*)(p.ws + WS_CIN); const float* BG = (const float*)(p.ws + WS_BAG); const unsigned* FB = (const unsigned*)(p.ws + WS_FB); const bf16* S = (const bf16*)(p.ws + WS_S2); bf16* Y = (bf16*)(p.ws + WS_YLRU);
    for (int item = blockIdx.x * NWAVES + wave; item < (MX / 16) * 2; item += G * NWAVES) { const int bi = item >> 1, ch = (item & 1) * 512 + lane * 8, b = bi / (SEQ / 16), bs = bi % (SEQ / 16), hsm = bs >> 1, band = bs & 1;
        const size_t co = ((size_t)(b * NHS + 8 + hsm) * 2) * D + ch, bg = ((size_t)(b * 256 + hsm) * 4) * D + ch;
        float cf[8], cb[8];
#pragma unroll
        for (int j = 0; j < 2; ++j) { const f32x4 f = *(const f32x4*)(CI + co + 4 * j), q = *(const f32x4*)(CI + co + D + 4 * j);
            if (band) { const f32x4 A = *(const f32x4*)(BG + bg + 4 * j), H = *(const f32x4*)(BG + bg + D + 4 * j);
#pragma unroll
                for (int k = 0; k < 4; ++k) { cf[4 * j + k] = A[k] * f[k] + H[k]; cb[4 * j + k] = q[k]; } }
            else { const f32x4 A = *(const f32x4*)(BG + bg + 2 * D + 4 * j), H = *(const f32x4*)(BG + bg + 3 * D + 4 * j);
#pragma unroll
                for (int k = 0; k < 4; ++k) { cf[4 * j + k] = f[k]; cb[4 * j + k] = A[k] * q[k] + H[k]; } } }
        const size_t r0 = (size_t)b * SEQ + bs * 16;
#pragma unroll 1
        for (int rq = 0; rq < 16; rq += 4) { v4u sv[4], f0[4], f1[4], gv[4];
#pragma unroll
            for (int r = 0; r < 4; ++r) { const size_t row = r0 + rq + r; sv[r] = *(const v4u*)(Y + row * D + ch); f0[r] = *(const v4u*)(FB + row * D + ch); f1[r] = *(const v4u*)(FB + row * D + ch + 4); gv[r] = *(const v4u*)(S + row * NS2 + C_GBR + ch); }
#pragma unroll
            for (int r = 0; r < 4; ++r) { const size_t row = r0 + rq + r; const unsigned sw[4] = {sv[r].x, sv[r].y, sv[r].z, sv[r].w}, gw[4] = {gv[r].x, gv[r].y, gv[r].z, gv[r].w}, fw[8] = {f0[r].x, f0[r].y, f0[r].z, f0[r].w, f1[r].x, f1[r].y, f1[r].z, f1[r].w};
                unsigned o[4];
#pragma unroll
                for (int k = 0; k < 4; ++k) { const float y0 = (bflo(sw[k]) + bflo(fw[2 * k]) * cf[2 * k] + bfhi(fw[2 * k]) * cb[2 * k]) * gelu_tanh(bflo(gw[k])), y1 = (bfhi(sw[k]) + bflo(fw[2 * k + 1]) * cf[2 * k + 1] + bfhi(fw[2 * k + 1]) * cb[2 * k + 1]) * gelu_tanh(bfhi(gw[k]));
                    o[k] = pk2(y0, y1); }
                *(v4u*)(Y + row * D + ch) = (v4u){o[0], o[1], o[2], o[3]}; } } }
}
DI void lru_carry(const P& p, LAS unsigned char* lds, int tid, int G) {
    const float* A = (const float*)(p.ws + WS_AGGA); const float* H = (const float*)(p.ws + WS_AGGH); float* CI = (float*)(p.ws + WS_CIN);
    LAS float* XA = (LAS float*)lds; LAS float* XH = XA + 512;
    for (int wgi = blockIdx.x; wgi < 64; wgi += G) { const int seg = tid >> 6, chain = wgi * 64 + (tid & 63), c = chain & (D - 1), e = (chain >> 10) & 1, b = chain >> 11;
        float a[33], h[33]; float As = 1.f, Hs = 0.f;
#pragma unroll
        for (int k = 0; k < 33; ++k) { const int st = seg * 33 + k, hs = e ? (st < 8 ? 7 - st : 271 - st) : st; const size_t o = ((size_t)(b * NHS + hs) * 2 + e) * D + c; a[k] = A[o]; h[k] = H[o]; }
#pragma unroll
        for (int k = 0; k < 33; ++k) { Hs = a[k] * Hs + h[k]; As *= a[k]; }
        __syncthreads(); XA[tid] = As; XH[tid] = Hs; __syncthreads();
        float cy = 0.f;
        for (int sg = 0; sg < seg; ++sg) cy = XA[sg * 64 + (tid & 63)] * cy + XH[sg * 64 + (tid & 63)];
#pragma unroll
        for (int k = 0; k < 33; ++k) { const int st = seg * 33 + k, hs = e ? (st < 8 ? 7 - st : 271 - st) : st; CI[((size_t)(b * NHS + hs) * 2 + e) * D + c] = cy; cy = a[k] * cy + h[k]; } }
}

DI float tanh_fast(float x) { return 1.f - 2.f * frcp(1.f + __expf(2.f * x)); }
struct MixLd { v4u w; v4u n[4]; };
DI void mix_ld(const bf16* own, const bf16* const (&np)[4], int cb, MixLd& L) {
    L.w = *(const v4u*)(own + cb);
#pragma unroll
    for (int i = 0; i < 4; ++i) L.n[i] = *(const v4u*)(np[i] + cb);
}
DI void mix_do(const MixLd& L, const float (&nv)[4], const float* mu, int cb, float (&o)[8]) {
    const v4u w = L.w;
    const f32x4 m0 = *(const f32x4*)(mu + cb), m1 = *(const f32x4*)(mu + cb + 4);
    const float ow[8] = {bflo(w.x), bfhi(w.x), bflo(w.y), bfhi(w.y), bflo(w.z), bfhi(w.z), bflo(w.w), bfhi(w.w)};
    const float nb[8] = {bflo(L.n[0].x) * nv[0], bfhi(L.n[1].x) * nv[1], bflo(L.n[2].y) * nv[2], bfhi(L.n[3].y) * nv[3], bflo(L.n[0].z) * nv[0], bfhi(L.n[1].z) * nv[1], bflo(L.n[2].w) * nv[2], bfhi(L.n[3].w) * nv[3]};
#pragma unroll
    for (int i = 0; i < 4; ++i) { o[i] = ow[i] + m0[i] * (nb[i] - ow[i]); o[4 + i] = ow[4 + i] + m1[i] * (nb[4 + i] - ow[4 + i]); }
}
DI void mix_do2(const MixLd& L, const float (&nv)[4], const f32x4 m0, const f32x4 m1, float (&o)[8]) {
    const v4u w = L.w;
    const float ow[8] = {bflo(w.x), bfhi(w.x), bflo(w.y), bfhi(w.y), bflo(w.z), bfhi(w.z), bflo(w.w), bfhi(w.w)};
    const float nb[8] = {bflo(L.n[0].x) * nv[0], bfhi(L.n[1].x) * nv[1], bflo(L.n[2].y) * nv[2], bfhi(L.n[3].y) * nv[3], bflo(L.n[0].z) * nv[0], bfhi(L.n[1].z) * nv[1], bflo(L.n[2].w) * nv[2], bfhi(L.n[3].w) * nv[3]};
#pragma unroll
    for (int i = 0; i < 4; ++i) { o[i] = ow[i] + m0[i] * (nb[i] - ow[i]); o[4 + i] = ow[4 + i] + m1[i] * (nb[4 + i] - ow[4 + i]); }
}
DI void mix8(const bf16* own, const bf16* const (&np)[4], const float (&nv)[4], const float* mu, int cb, float (&o)[8]) { MixLd L; mix_ld(own, np, cb, L); mix_do(L, nv, mu, cb, o); }
DI void nbr_rows(const bf16* S, int b, int ci, int j, const bf16*& own, const bf16* (&np)[4], float (&nv)[4]) {
    const int row = chunk_row0(b, ci) + j; own = S + (size_t)row * NS1;
    if (ci >= 4) { const int gr = ci - 4; const bool v0 = j > 0, v1 = j < 63, v2 = gr > 0, v3 = gr < 127;
        np[0] = v0 ? own - NS1 : own; np[1] = v1 ? own + NS1 : own; np[2] = v2 ? own - (size_t)64 * NS1 : own; np[3] = v3 ? own + (size_t)64 * NS1 : own;
        nv[0] = v0 ? 1.f : 0.f; nv[1] = v1 ? 1.f : 0.f; nv[2] = v2 ? 1.f : 0.f; nv[3] = v3 ? 1.f : 0.f; }
    else { const int t = ci * 64 + j; const bool v0 = t > 0, v1 = t < CTXL - 1;
        np[0] = np[2] = v0 ? own - NS1 : own; np[1] = np[3] = v1 ? own + NS1 : own; nv[0] = nv[2] = v0 ? 1.f : 0.f; nv[1] = nv[3] = v1 ? 1.f : 0.f; }
}
DI float red8(float x) { x += dppf<0xB1>(x); x += dppf<0x4E>(x); x += dppf<0x141>(x); return x; }
DI void mix_store(bf16* zr, const f32x4 k0, const f32x4 k1, int it, int gi, int cb, const float (&o)[8]) {
    if (it < 2 || it == 4 || it == 5) { *(v4u*)(zr + cb) = (v4u){pk2(o[0], o[1]), pk2(o[2], o[3]), pk2(o[4], o[5]), pk2(o[6], o[7])}; }
    else if (it == 2 || it == 3) {
        *(v4u*)(zr + cb) = (v4u){pk2(o[0], o[1]), pk2(o[2], o[3]), pk2(o[4], o[5]), pk2(o[6], o[7])};
        float kr[8], ss = 0.f;
#pragma unroll
        for (int i = 0; i < 4; ++i) { kr[i] = o[i] * k0[i]; kr[4 + i] = o[4 + i] * k1[i]; ss += kr[i] * kr[i] + kr[4 + i] * kr[4 + i]; }
        ss = red8(ss); const float inv = __builtin_amdgcn_rsqf(ss + 1e-12f);
        *(v4u*)(zr + Z_KK + cb - C_K) = (v4u){pk2(kr[0] * inv, kr[1] * inv), pk2(kr[2] * inv, kr[3] * inv), pk2(kr[4] * inv, kr[5] * inv), pk2(kr[6] * inv, kr[7] * inv)}; }
    else if (gi < 392) { *(v4u*)(zr + Z_TW + cb - C_WD) = (v4u){pk2(tanh_fast(o[0]), tanh_fast(o[1])), pk2(tanh_fast(o[2]), tanh_fast(o[3])), pk2(tanh_fast(o[4]), tanh_fast(o[5])), pk2(tanh_fast(o[6]), tanh_fast(o[7]))}; }
    else if (gi < 400) { *(v4u*)(zr + Z_AD + cb - C_AD) = (v4u){pk2(o[0], o[1]), pk2(o[2], o[3]), pk2(o[4], o[5]), pk2(o[6], o[7])}; }
    else if (gi < 420) { *(v4u*)(zr + Z_GS + cb - C_GD) = (v4u){pk2(sigm_fast(o[0]), sigm_fast(o[1])), pk2(sigm_fast(o[2]), sigm_fast(o[3])), pk2(sigm_fast(o[4]), sigm_fast(o[5])), pk2(sigm_fast(o[6]), sigm_fast(o[7]))}; }
}
DI void mix_geom(int m, int& b, int& ci, int& j) { if (m < MX) { b = m >> 13; const int t = m & (SEQ - 1); ci = 4 + (t >> 6); j = t & 63; } else { const int t = (m - MX) & (CTXL - 1); b = (m - MX) >> 8; ci = t >> 6; j = t & 63; } }
DI void phase_mix(const P& p, int lane, int wave, int G) {
    const bf16* S = (const bf16*)(p.ws + WS_S1); bf16* Z = (bf16*)(p.ws + WS_ZM);
    const int gw = blockIdx.x * NWAVES + wave, NGW = G * NWAVES;
    f32x4 mu0[7], mu1[7], kk0[2], kk1[2];
#pragma unroll
    for (int it = 0; it < 7; ++it) { const int gi = lane + 64 * it; const int cb = (gi < 420 ? gi : 0) * 8; mu0[it] = *(const f32x4*)(p.mu_a + cb); mu1[it] = *(const f32x4*)(p.mu_a + cb + 4);
        if (it == 2 || it == 3) { kk0[it - 2] = *(const f32x4*)(p.k_k + cb - C_K); kk1[it - 2] = *(const f32x4*)(p.k_k + cb - C_K + 4); } }
    for (int m0 = gw; m0 < MALL; m0 += 2 * NGW) { const int m1 = m0 + NGW; const bool two = m1 < MALL; const int m1c = two ? m1 : m0;
        int b0, ci0, j0, b1, ci1, j1; mix_geom(m0, b0, ci0, j0); mix_geom(m1c, b1, ci1, j1);
        const bf16* own0; const bf16* np0[4]; float nv0[4]; nbr_rows(S, b0, ci0, j0, own0, np0, nv0);
        const bf16* own1; const bf16* np1[4]; float nv1[4]; nbr_rows(S, b1, ci1, j1, own1, np1, nv1);
        bf16* zr0 = Z + (size_t)m0 * NZM; bf16* zr1 = Z + (size_t)m1c * NZM;
#pragma unroll
        for (int it = 0; it < 7; ++it) { const int gi = lane + 64 * it; const int cb = (gi < 420 ? gi : 0) * 8; MixLd L0, L1; float o0[8], o1[8];
            mix_ld(own0, np0, cb, L0); mix_ld(own1, np1, cb, L1);
            mix_do2(L0, nv0, mu0[it], mu1[it], o0); mix_do2(L1, nv1, mu0[it], mu1[it], o1);
            const f32x4 kw0 = (it == 2 || it == 3) ? kk0[it == 3] : mu0[0], kw1 = (it == 2 || it == 3) ? kk1[it == 3] : mu0[0];
            mix_store(zr0, kw0, kw1, it, gi, cb, o0); if (two) mix_store(zr1, kw0, kw1, it, gi, cb, o1); }
    }
}
#define WK_BAR() do { asm volatile("s_waitcnt lgkmcnt(0)" ::: "memory"); __builtin_amdgcn_s_barrier(); asm volatile("" ::: "memory"); } while (0)
constexpr int WB_NB = NCH * 4;
constexpr int WB_AT = 0, WB_RT = 2304, WB_BC = 4608, WB_KC = 6912, WB_P4 = 9216, WB_GKT = 14336, WB_TT = 14848, WB_P5 = 15360, WB_VT = 16640, WB_PP = 17152, WB_MM = 17408, WB_SLOT = 18432;
constexpr int WB_W2T = 7 * WB_SLOT, WB_A2T = WB_W2T + 9216, WB_CST = WB_A2T + 9216, WB_FLG = WB_CST + 1024;
typedef short s16x4 __attribute__((ext_vector_type(4)));
DI v2u cvt2(float a, float b, float c, float d) { return (v2u){cvtpk_s(a, b), cvtpk_s(c, d)}; }
DI bf16x8 frag2(v2u lo, v2u hi) { return __builtin_bit_cast(bf16x8, (v4u){lo.x, lo.y, hi.x, hi.y}); }
DI float pfx16(float x) { x += dppf<0x111>(x); x += dppf<0x112>(x); x += dppf<0x114>(x); x += dppf<0x118>(x); return x; }
#define WB_LOADS(qq) do { const int sidx_ = (qq) >> 2, ci_ = e ? (sidx_ < 4 ? 3 - sidx_ : NCH + 3 - sidx_) : sidx_, pos_ = ((qq) & 3) * 16 + c, j_ = e ? 63 - pos_ : pos_; \
                    const bf16* zr = Z + (size_t)(chunk_row0(b, ci_) + j_) * NZM; \
                    _Pragma("unroll") for (int hh_ = 0; hh_ < 2; ++hh_) { const int c0 = h * 64 + 16 * g + 8 * hh_;     \
                        const v4u vk_ = *(const v4u*)(zr + Z_KK + c0), vr_ = *(const v4u*)(zr + Z_R + c0), vq_ = *(const v4u*)(zr + Z_K + c0); \
                        Lkk[2 * hh_] = (v2u){vk_.x, vk_.y}; Lkk[2 * hh_ + 1] = (v2u){vk_.z, vk_.w}; Lr[2 * hh_] = (v2u){vr_.x, vr_.y}; Lr[2 * hh_ + 1] = (v2u){vr_.z, vr_.w}; Lk[2 * hh_] = (v2u){vq_.x, vq_.y}; Lk[2 * hh_ + 1] = (v2u){vq_.z, vq_.w}; } \
                    Lv = *(const v2u*)(zr + Z_V + h * 64 + rg * 16 + 4 * g); \
                    tw[0] = *(const v4u*)(zr + Z_TW + g * 8); tw[1] = *(const v4u*)(zr + Z_TW + 32 + g * 8); ad[0] = *(const v4u*)(zr + Z_AD + g * 8); ad[1] = *(const v4u*)(zr + Z_AD + 32 + g * 8); } while (0)
DI void lds_wait_ge(volatile LAS int* f, int v, volatile LAS int* abortf) {
    int sp = 0;
    while (__builtin_amdgcn_readfirstlane(*f) < v) { __builtin_amdgcn_s_sleep(1); if (((++sp) & 63) == 0) { if (__builtin_amdgcn_readfirstlane(*abortf)) break; if (sp > (1 << 18)) { *abortf = 1; break; } } }
    asm volatile("" ::: "memory");
}
DI void wkv_blk_wg(const P& p, LAS unsigned char* lds, int tid, int lane, int wave, int unit) {
    const int xx = unit & 7, yy = unit >> 3, rg = yy & 3, scan = xx * 8 + (yy >> 2), e = scan & 1, h = (scan >> 1) & 15, b = scan >> 5;
    const bf16* Z = (const bf16*)(p.ws + WS_ZM);
    LAS bf16* W2T = (LAS bf16*)(lds + WB_W2T); LAS bf16* A2T = (LAS bf16*)(lds + WB_A2T); LAS float* CST = (LAS float*)(lds + WB_CST);
    __syncthreads();
    volatile LAS int* RDY = (volatile LAS int*)(lds + WB_FLG); volatile LAS int* CNS = RDY + 8; volatile LAS int* ABT = RDY + 16;
    if (tid < 32) RDY[tid] = 0;
    if (tid < 64) { const int ch = 16 * ((tid >> 2) & 3) + 4 * (tid >> 4) + (tid & 3);
        const float ka = p.k_a[h * 64 + ch]; CST[tid] = NL2E * p.w0[e * D + h * 64 + ch]; CST[64 + tid] = NL2E * p.a0[e * D + h * 64 + ch]; CST[128 + tid] = ka; CST[192 + tid] = 1.f - ka; }
    for (int i = tid; i < 4096; i += NTHR) { const int k = i >> 6, n = i & 63, pn = 16 * ((n >> 2) & 3) + 4 * (n >> 4) + (n & 3);     W2T[pn * 72 + k] = (bf16)f2bf(NL2E * p.w2[((size_t)e * 64 + k) * D + h * 64 + n]); A2T[pn * 72 + k] = (bf16)f2bf(NL2E * p.a2[((size_t)e * 64 + k) * D + h * 64 + n]); }
    __syncthreads();
    bf16* YW = (bf16*)(p.ws + (e ? WS_YWB : WS_YWF));
    const int c = lane & 15, g = lane >> 4;
    if (wave == 0) {
        __builtin_amdgcn_s_setprio(2);
        pg8::f32x4 Xt[4];
#pragma unroll
        for (int kt = 0; kt < 4; ++kt) Xt[kt] = (pg8::f32x4){0.f, 0.f, 0.f, 0.f};
        bf16* yp = YW + (size_t)(b * SEQ + (e ? SEQ - 1 - 4 * g : 4 * g)) * D + h * 64 + rg * 16 + c;
        int fnext = 0;
        int slot = 0, nblk = 0;
        v2u vtA, gkA, ttA, vtB, gkB, ttB; bf16x8 a1A[2], a2A[2], a1B[2], a2B[2];
#define SC_READS(S, sl_) do { const LAS bf16* AT_ = (const LAS bf16*)((sl_) + WB_AT); const LAS bf16* RT_ = (const LAS bf16*)((sl_) + WB_RT); \
            vt##S = *(const LAS v2u*)((const LAS bf16*)((sl_) + WB_VT) + c * 16 + 4 * g); gk##S = *(const LAS v2u*)((const LAS bf16*)((sl_) + WB_GKT) + c * 16 + 4 * g); \
            _Pragma("unroll") for (int sx = 0; sx < 2; ++sx) { a1##S[sx] = frag2(*(const LAS v2u*)(AT_ + c * 72 + 32 * sx + 4 * g), *(const LAS v2u*)(AT_ + c * 72 + 32 * sx + 16 + 4 * g)); \
                a2##S[sx] = frag2(*(const LAS v2u*)(RT_ + c * 72 + 32 * sx + 4 * g), *(const LAS v2u*)(RT_ + c * 72 + 32 * sx + 16 + 4 * g)); } \
            tt##S = *(const LAS v2u*)((const LAS bf16*)((sl_) + WB_TT) + c * 16 + 4 * g); } while (0)
#define SC_BODY(S, N, tt_) do { const int t = (tt_); LAS unsigned char* sl = lds + slot * WB_SLOT; \
            v2u xb[4]; \
            _Pragma("unroll") for (int kt = 0; kt < 4; ++kt) xb[kt] = cvt2(Xt[kt][0], Xt[kt][1], Xt[kt][2], Xt[kt][3]); \
            pg8::f32x4 C1 = __builtin_amdgcn_mfma_f32_16x16x16bf16_1k(__builtin_bit_cast(s16x4, gk##S), __builtin_bit_cast(s16x4, vt##S), (pg8::f32x4){0.f, 0.f, 0.f, 0.f}, 0, 0, 0); \
            pg8::f32x4 C2 = {0.f, 0.f, 0.f, 0.f}; \
            _Pragma("unroll") for (int sx = 0; sx < 2; ++sx) { const bf16x8 bx = frag2(xb[2 * sx], xb[2 * sx + 1]); C1 = __builtin_amdgcn_mfma_f32_16x16x32_bf16(a1##S[sx], bx, C1, 0, 0, 0); C2 = __builtin_amdgcn_mfma_f32_16x16x32_bf16(a2##S[sx], bx, C2, 0, 0, 0); } \
            __builtin_amdgcn_sched_barrier(0); \
              \
            bf16x8 p4f[4]; pg8::f32x4 xn[4], ppv[4]; const bf16x8 p5f = *(const LAS bf16x8*)((const LAS bf16*)(sl + WB_P5) + c * 40 + 8 * g); \
            _Pragma("unroll") for (int kt = 0; kt < 4; ++kt) p4f[kt] = *(const LAS bf16x8*)((const LAS bf16*)(sl + WB_P4) + (16 * kt + c) * 40 + 8 * g); \
            _Pragma("unroll") for (int kt = 0; kt < 4; ++kt) ppv[kt] = *(const LAS pg8::f32x4*)((const LAS float*)(sl + WB_PP) + 16 * kt + 4 * g); \
            const float v0_ = bflo(vt##S.x), v1_ = bfhi(vt##S.x), v2_ = bflo(vt##S.y), v3_ = bfhi(vt##S.y); \
            __builtin_amdgcn_sched_barrier(0); \
            const pg8::f32x4 SK = __builtin_amdgcn_mfma_f32_16x16x16bf16_1k(__builtin_bit_cast(s16x4, tt##S), __builtin_bit_cast(s16x4, cvt2(C1[0], C1[1], C1[2], C1[3])), (pg8::f32x4){0.f, 0.f, 0.f, 0.f}, 0, 0, 0); \
            const bf16x8 vs = __builtin_bit_cast(bf16x8, (v4u){cvtpk_s(v0_, SK[0]), cvtpk_s(v1_, SK[1]), cvtpk_s(v2_, SK[2]), cvtpk_s(v3_, SK[3])}); \
            _Pragma("unroll") for (int kt = 0; kt < 4; ++kt) xn[kt] = __builtin_amdgcn_mfma_f32_16x16x32_bf16(p4f[kt], vs, Xt[kt], 0, 0, 0); \
            const pg8::f32x4 Yt = __builtin_amdgcn_mfma_f32_16x16x32_bf16(p5f, vs, C2, 0, 0, 0); \
            asm volatile("s_waitcnt lgkmcnt(0)" ::: "memory"); \
            if (lane == 0) CNS[slot] = nblk + 1; \
            if (++slot == 7) { slot = 0; ++nblk; } \
            if (t + 1 < WB_NB) { \
                if (__builtin_amdgcn_readfirstlane(fnext) < nblk + 1) lds_wait_ge(RDY + slot, nblk + 1, ABT); \
                asm volatile("" ::: "memory"); \
                LAS unsigned char* sln = lds + slot * WB_SLOT; SC_READS(N, sln); fnext = RDY[slot == 6 ? 0 : slot + 1]; } \
            _Pragma("unroll") for (int kt = 0; kt < 4; ++kt) Xt[kt] = ppv[kt] * xn[kt]; \
            if (t >= 16) { \
                if (e) { yp[0] = (bf16)f2bf(Yt[0]); yp[-D] = (bf16)f2bf(Yt[1]); yp[-2 * D] = (bf16)f2bf(Yt[2]); yp[-3 * D] = (bf16)f2bf(Yt[3]); yp -= 16 * D; } \
                else { yp[0] = (bf16)f2bf(Yt[0]); yp[D] = (bf16)f2bf(Yt[1]); yp[2 * D] = (bf16)f2bf(Yt[2]); yp[3 * D] = (bf16)f2bf(Yt[3]); yp += 16 * D; } } } while (0)
        lds_wait_ge(RDY + 0, 1, ABT); SC_READS(A, lds); fnext = RDY[1];
        for (int t2 = 0; t2 < WB_NB; t2 += 2) { SC_BODY(A, B, t2); SC_BODY(B, A, t2 + 1); }
#undef SC_READS
#undef SC_BODY
        __builtin_amdgcn_s_setprio(0);
    } else {
        const int pw = wave - 1; LAS unsigned char* sl = lds + pw * WB_SLOT;
        LAS bf16* AT = (LAS bf16*)(sl + WB_AT); LAS bf16* RT = (LAS bf16*)(sl + WB_RT); LAS bf16* BC = (LAS bf16*)(sl + WB_BC); LAS bf16* KC = (LAS bf16*)(sl + WB_KC);
        LAS bf16* P4 = (LAS bf16*)(sl + WB_P4); LAS bf16* GKT = (LAS bf16*)(sl + WB_GKT); LAS bf16* TT = (LAS bf16*)(sl + WB_TT); LAS bf16* P5 = (LAS bf16*)(sl + WB_P5);
        LAS bf16* VT = (LAS bf16*)(sl + WB_VT); LAS float* PP = (LAS float*)(sl + WB_PP); LAS float* MM = (LAS float*)(sl + WB_MM);
        v2u Lkk[4], Lr[4], Lk[4], Lv; v4u tw[2], ad[2];
        { const int q = pw; WB_LOADS(q); }
        f32x4 w0v[4], a0v[4], kav[4], kbv[4];
#pragma unroll
        for (int nt = 0; nt < 4; ++nt) { w0v[nt] = *(const LAS f32x4*)(CST + 16 * nt + 4 * g); a0v[nt] = *(const LAS f32x4*)(CST + 64 + 16 * nt + 4 * g); kav[nt] = *(const LAS f32x4*)(CST + 128 + 16 * nt + 4 * g); kbv[nt] = *(const LAS f32x4*)(CST + 192 + 16 * nt + 4 * g); }
        f32x4 ltm, lem, gtm;
#pragma unroll
        for (int i = 0; i < 4; ++i) { const int ii = 4 * g + i; ltm[i] = ii < c ? 1.f : 0.f; lem[i] = ii <= c ? 1.f : 0.f; gtm[i] = c < ii ? 1.f : 0.f; }
        int nblk = 0;
        for (int q = pw; q < WB_NB; q += 7, ++nblk) {
            pg8::f32x4 zw[4], za[4];
            f32x4 ewv[4], kmv[4], bvv[4], kkf[4], rf[4];
            f32x4 at_[4], rt_[4], bc_[4], kc_[4], pp_[4];
#define WT_PRE(nt) do { zw[nt] = (pg8::f32x4){0.f, 0.f, 0.f, 0.f}; za[nt] = zw[nt]; \
                _Pragma("unroll") for (int ks = 0; ks < 2; ++ks) { const bf16x8 wa = *(const LAS bf16x8*)(W2T + ((nt) * 16 + c) * 72 + ks * 32 + g * 8), aa = *(const LAS bf16x8*)(A2T + ((nt) * 16 + c) * 72 + ks * 32 + g * 8); \
                    zw[nt] = __builtin_amdgcn_mfma_f32_16x16x32_bf16(wa, __builtin_bit_cast(bf16x8, tw[ks]), zw[nt], 0, 0, 0); za[nt] = __builtin_amdgcn_mfma_f32_16x16x32_bf16(aa, __builtin_bit_cast(bf16x8, ad[ks]), za[nt], 0, 0, 0); } \
                } while (0)
#define WT_AV(nt) do { const f32x4 kkv_ = {bflo(Lkk[nt].x), bfhi(Lkk[nt].x), bflo(Lkk[nt].y), bfhi(Lkk[nt].y)}, rv_ = {bflo(Lr[nt].x), bfhi(Lr[nt].x), bflo(Lr[nt].y), bfhi(Lr[nt].y)}, kv_ = {bflo(Lk[nt].x), bfhi(Lk[nt].x), bflo(Lk[nt].y), bfhi(Lk[nt].y)}; \
                const f32x4 xa_ = (f32x4){za[nt][0], za[nt][1], za[nt][2], za[nt][3]} + a0v[nt], xw_ = (f32x4){zw[nt][0], zw[nt][1], zw[nt][2], zw[nt][3]} + w0v[nt]; \
                const f32x4 da_ = (f32x4){__builtin_amdgcn_exp2f(xa_[0]), __builtin_amdgcn_exp2f(xa_[1]), __builtin_amdgcn_exp2f(xa_[2]), __builtin_amdgcn_exp2f(xa_[3])} + 1.f; \
                const f32x4 dw_ = (f32x4){__builtin_amdgcn_exp2f(xw_[0]), __builtin_amdgcn_exp2f(xw_[1]), __builtin_amdgcn_exp2f(xw_[2]), __builtin_amdgcn_exp2f(xw_[3])} + 1.f; \
                const f32x4 av_ = {frcp(da_[0]), frcp(da_[1]), frcp(da_[2]), frcp(da_[3])}; \
                ewv[nt] = (f32x4){frcp(dw_[0]), frcp(dw_[1]), frcp(dw_[2]), frcp(dw_[3])} * (0.6065306597126334f * NL2E);     \
                kmv[nt] = kv_ * (av_ * kav[nt] + kbv[nt]); bvv[nt] = kkv_ * av_; kkf[nt] = kkv_; rf[nt] = rv_; } while (0)
#define WT_BV(nt) do { const f32x4 inc_ = {pfx16(ewv[nt][0]), pfx16(ewv[nt][1]), pfx16(ewv[nt][2]), pfx16(ewv[nt][3])};     \
                const f32x4 E_ = {__builtin_amdgcn_exp2f(inc_[0]), __builtin_amdgcn_exp2f(inc_[1]), __builtin_amdgcn_exp2f(inc_[2]), __builtin_amdgcn_exp2f(inc_[3])};     \
                const f32x4 nEi_ = {frcp(-E_[0]), frcp(-E_[1]), frcp(-E_[2]), frcp(-E_[3])};     \
                const f32x4 Ep_ = {dppf_one<0x111>(E_[0]), dppf_one<0x111>(E_[1]), dppf_one<0x111>(E_[2]), dppf_one<0x111>(E_[3])};     \
                at_[nt] = kkf[nt] * Ep_; rt_[nt] = rf[nt] * E_; bc_[nt] = bvv[nt] * nEi_; kc_[nt] = -(kmv[nt] * nEi_); pp_[nt] = E_; } while (0)
#define WT_POST(nt) do { const int ko_ = c * 72 + 16 * (nt) + 4 * g; \
                *(LAS v2u*)(AT + ko_) = cvt2(at_[nt][0], at_[nt][1], at_[nt][2], at_[nt][3]); *(LAS v2u*)(RT + ko_) = cvt2(rt_[nt][0], rt_[nt][1], rt_[nt][2], rt_[nt][3]); \
                *(LAS v2u*)(BC + ko_) = cvt2(bc_[nt][0], bc_[nt][1], bc_[nt][2], bc_[nt][3]); *(LAS v2u*)(KC + ko_) = cvt2(kc_[nt][0], kc_[nt][1], kc_[nt][2], kc_[nt][3]); \
                const int so_ = 8 * (c >> 2) + 2 * (c & 3);                  \
                _Pragma("unroll") for (int i_ = 0; i_ < 4; ++i_) *(LAS unsigned*)(P4 + (16 * (nt) + 4 * g + i_) * 40 + so_) = cvtpk_s(kc_[nt][i_], bc_[nt][i_]);     \
                if (c == 15) *(LAS f32x4*)(PP + 16 * (nt) + 4 * g) = pp_[nt]; } while (0)
            WT_PRE(0); WT_AV(0); WT_BV(0); WT_PRE(1);
            lds_wait_ge(CNS + pw, nblk, ABT);
            WT_POST(0);
            VT[(4 * g + 0) * 16 + c] = (bf16)(Lv.x & 0xffffu); VT[(4 * g + 1) * 16 + c] = (bf16)(Lv.x >> 16); VT[(4 * g + 2) * 16 + c] = (bf16)(Lv.y & 0xffffu); VT[(4 * g + 3) * 16 + c] = (bf16)(Lv.y >> 16);
            WT_AV(1); WT_BV(1); WT_POST(1); WT_PRE(2); WT_AV(2); WT_BV(2); WT_POST(2); WT_PRE(3); WT_AV(3);
            if (q + 7 < WB_NB) WB_LOADS(q + 7);
            WT_BV(3); WT_POST(3);
#undef WT_PRE
#undef WT_AV
#undef WT_BV
#undef WT_POST
            {
                    __builtin_amdgcn_s_setprio(1);
                    pg8::f32x4 gb = {0.f, 0.f, 0.f, 0.f}, gk = gb, gbr = gb, gkr = gb, gbt = gb;
#pragma unroll
                    for (int ks = 0; ks < 2; ++ks) { const int o = c * 72 + ks * 32 + g * 8;
                        const bf16x8 fb = *(const LAS bf16x8*)(BC + o), fk = *(const LAS bf16x8*)(KC + o), fa = *(const LAS bf16x8*)(AT + o), fr = *(const LAS bf16x8*)(RT + o);
                        gb = __builtin_amdgcn_mfma_f32_16x16x32_bf16(fb, fa, gb, 0, 0, 0); gk = __builtin_amdgcn_mfma_f32_16x16x32_bf16(fk, fa, gk, 0, 0, 0);
                        gbr = __builtin_amdgcn_mfma_f32_16x16x32_bf16(fb, fr, gbr, 0, 0, 0); gkr = __builtin_amdgcn_mfma_f32_16x16x32_bf16(fk, fr, gkr, 0, 0, 0);
                        gbt = __builtin_amdgcn_mfma_f32_16x16x32_bf16(fa, fb, gbt, 0, 0, 0); }
                    const f32x4 m_ = -((f32x4){gb[0], gb[1], gb[2], gb[3]} * ltm), mt_ = -((f32x4){gbt[0], gbt[1], gbt[2], gbt[3]} * gtm), k_ = (f32x4){gk[0], gk[1], gk[2], gk[3]} * ltm,
                        kr_ = (f32x4){gkr[0], gkr[1], gkr[2], gkr[3]} * lem, br_ = (f32x4){gbr[0], gbr[1], gbr[2], gbr[3]} * lem;
                    *(LAS v2u*)(GKT + c * 16 + 4 * g) = cvt2(k_[0], k_[1], k_[2], k_[3]);
                    *(LAS v4u*)(P5 + c * 40 + 8 * g) = (v4u){cvtpk_s(kr_[0], br_[0]), cvtpk_s(kr_[1], br_[1]), cvtpk_s(kr_[2], br_[2]), cvtpk_s(kr_[3], br_[3])};
                    const v2u zq = {0u, 0u}; const pg8::f32x4 z4 = {0.f, 0.f, 0.f, 0.f};
#define MF_(a, b, acc) __builtin_amdgcn_mfma_f32_16x16x32_bf16(frag2(a, zq), frag2(b, zq), acc, 0, 0, 0)
#define CV_(x) cvt2((x)[0], (x)[1], (x)[2], (x)[3])
                    const v2u aM = cvt2(m_[0], m_[1], m_[2], m_[3]), bM = cvt2(mt_[0], mt_[1], mt_[2], mt_[3]);
                    pg8::f32x4 im;
#pragma unroll
                    for (int i = 0; i < 4; ++i) im[i] = ((4 * g + i) == c ? 1.f : 0.f) - m_[i];
                    const v2u aIM = CV_(im);
                    const pg8::f32x4 M2c = MF_(aM, bM, z4), M2a = MF_(bM, aM, z4);
                    const v2u aM2 = CV_(M2a), bM2 = CV_(M2c);
                    const pg8::f32x4 M4c = MF_(aM2, bM2, z4), M4a = MF_(bM2, aM2, z4);
                    const v2u aM4 = CV_(M4a), bM4 = CV_(M4c);
                    const pg8::f32x4 M8c = MF_(aM4, bM4, z4);
                    const v2u bM8 = CV_(M8c);
                    const pg8::f32x4 T1 = MF_(bM2, aIM, im);
                    const pg8::f32x4 T2 = MF_(bM4, CV_(T1), T1);
                    const pg8::f32x4 T3 = MF_(bM8, CV_(T2), T2);
                    *(LAS v2u*)(TT + c * 16 + 4 * g) = CV_(T3);
                    __builtin_amdgcn_s_setprio(0);
#undef MF_
#undef CV_
            }
            asm volatile("s_waitcnt lgkmcnt(0)" ::: "memory");
            if (lane == 0) RDY[pw] = nblk + 1;
        }
    }
}

constexpr int WO_RS = 0, WO_KS = 17408, WO_VS = 34816, WO_A2T = 52224, WO_G2T = 70656, WO_RHO = 92160;
DI void wkv_out_setup(const P& p, LAS unsigned char* lds, int tid, int h) {
    LAS bf16* A2T = (LAS bf16*)(lds + WO_A2T); LAS bf16* G2T = (LAS bf16*)(lds + WO_G2T);
    __syncthreads();
    for (int i = tid; i < 2 * 4096; i += NTHR) { const int e = i >> 12, k = (i >> 6) & 63, n = i & 63; A2T[e * 4608 + n * 72 + k] = (bf16)f2bf(p.a2[((size_t)e * 64 + k) * D + h * 64 + n]); }
    for (int i = tid; i < 160 * 64; i += NTHR) { const int k = i >> 6, n = i & 63; G2T[n * 168 + k] = (bf16)f2bf(p.g2[(size_t)k * D + h * 64 + n]); }
    __syncthreads();
}
struct WoPre { v4u r, k, v, a0, a1, a2, a3, a4; };
struct WoC { float c0[4], c1[4], ka[4], rk[4], gg[4], gb[4]; };
DI void wkv_out_consts(const P& p, int h, int l15, WoC& C) {
#pragma unroll
    for (int nt = 0; nt < 4; ++nt) { const int hc = h * 64 + nt * 16 + l15; C.c0[nt] = p.a0[hc]; C.c1[nt] = p.a0[D + hc]; C.ka[nt] = p.k_a[hc]; C.rk[nt] = p.r_k[hc]; C.gg[nt] = p.gn_g[hc]; C.gb[nt] = p.gn_b[hc]; }
}
DI void wkv_out_load(const P& p, int tid, int lane, int wave, int b, int gr, int h, WoPre& L) {
    const bf16* Z = (const bf16*)(p.ws + WS_ZM); const int row0 = chunk_row0(b, gr + 4);
    const int rb = wave & 3, half = wave >> 2, l15 = lane & 15, g = lane >> 4;
    const bf16* za_ = Z + (size_t)(row0 + rb * 16 + l15) * NZM;
    const v4u zz4 = {0u, 0u, 0u, 0u};
    if (half == 0) { L.a0 = *(const v4u*)(za_ + Z_AD + g * 8); L.a1 = *(const v4u*)(za_ + Z_AD + 32 + g * 8); L.a2 = zz4; L.a3 = zz4; L.a4 = zz4; }
    else { L.a0 = *(const v4u*)(za_ + Z_GS + g * 8); L.a1 = *(const v4u*)(za_ + Z_GS + 32 + g * 8); L.a2 = *(const v4u*)(za_ + Z_GS + 64 + g * 8); L.a3 = *(const v4u*)(za_ + Z_GS + 96 + g * 8); L.a4 = *(const v4u*)(za_ + Z_GS + 128 + g * 8); }
    { const int j = tid >> 3, cg = tid & 7; const bf16* zr = Z + (size_t)(row0 + j) * NZM + h * 64 + cg * 8;
        L.r = *(const v4u*)(zr + Z_R); L.k = *(const v4u*)(zr + Z_K); L.v = *(const v4u*)(zr + Z_V); }
}
DI void wkv_out_unit(const P& p, LAS unsigned char* lds, int tid, int lane, int wave, int b, int gr, int h, const WoC& C, const WoPre& L, bool has_next, int nb, int ngr, WoPre& N) {
    const int row0 = chunk_row0(b, gr + 4);
    LAS float* RS = (LAS float*)(lds + WO_RS); LAS float* KS = (LAS float*)(lds + WO_KS); LAS float* VS = (LAS float*)(lds + WO_VS);
    LAS bf16* A2T = (LAS bf16*)(lds + WO_A2T); LAS bf16* G2T = (LAS bf16*)(lds + WO_G2T); LAS float* RHO = (LAS float*)(lds + WO_RHO);
    const int rb = wave & 3, half = wave >> 2, l15 = lane & 15, g = lane >> 4;
    { const int j = tid >> 3, cg = tid & 7; const v4u r = L.r, k = L.k, v = L.v;
        *(LAS f32x4*)(RS + j * 68 + cg * 8) = (f32x4){bflo(r.x), bfhi(r.x), bflo(r.y), bfhi(r.y)}; *(LAS f32x4*)(RS + j * 68 + cg * 8 + 4) = (f32x4){bflo(r.z), bfhi(r.z), bflo(r.w), bfhi(r.w)};
        *(LAS f32x4*)(KS + j * 68 + cg * 8) = (f32x4){bflo(k.x), bfhi(k.x), bflo(k.y), bfhi(k.y)}; *(LAS f32x4*)(KS + j * 68 + cg * 8 + 4) = (f32x4){bflo(k.z), bfhi(k.z), bflo(k.w), bfhi(k.w)};
        *(LAS f32x4*)(VS + j * 68 + cg * 8) = (f32x4){bflo(v.x), bfhi(v.x), bflo(v.y), bfhi(v.y)}; *(LAS f32x4*)(VS + j * 68 + cg * 8 + 4) = (f32x4){bflo(v.z), bfhi(v.z), bflo(v.w), bfhi(v.w)}; }
    WK_BAR();
    if (has_next) wkv_out_load(p, tid, lane, wave, nb, ngr, h, N);
    bf16* YF = (bf16*)(p.ws + WS_YWF);
    float yn[4][4]; pg8::f32x4 zg[4];
    if (half == 0) {
        pg8::f32x4 z0[4], z1[4];
#pragma unroll
        for (int nt = 0; nt < 4; ++nt) { z0[nt] = (pg8::f32x4){0.f, 0.f, 0.f, 0.f}; z1[nt] = (pg8::f32x4){0.f, 0.f, 0.f, 0.f}; }
#pragma unroll
        for (int ks = 0; ks < 2; ++ks) { const bf16x8 aa = __builtin_bit_cast(bf16x8, ks == 0 ? L.a0 : L.a1);
#pragma unroll
            for (int nt = 0; nt < 4; ++nt) { const bf16x8 b0 = *(const LAS bf16x8*)(A2T + (nt * 16 + l15) * 72 + ks * 32 + g * 8), b1 = *(const LAS bf16x8*)(A2T + 4608 + (nt * 16 + l15) * 72 + ks * 32 + g * 8);
                z0[nt] = __builtin_amdgcn_mfma_f32_16x16x32_bf16(aa, b0, z0[nt], 0, 0, 0); z1[nt] = __builtin_amdgcn_mfma_f32_16x16x32_bf16(aa, b1, z1[nt], 0, 0, 0); } }
        float rho[4] = {0.f, 0.f, 0.f, 0.f};
#pragma unroll
        for (int nt = 0; nt < 4; ++nt) { const float c0 = C.c0[nt], c1 = C.c1[nt], ka = C.ka[nt], rk = C.rk[nt];
#pragma unroll
            for (int i = 0; i < 4; ++i) { const int o = (rb * 16 + 4 * g + i) * 68 + nt * 16 + l15;
                rho[i] += RS[o] * KS[o] * (2.f + (sigm_fast(z0[nt][i] + c0) + sigm_fast(z1[nt][i] + c1) - 2.f) * ka) * rk; } }
#pragma unroll
        for (int i = 0; i < 4; ++i) { const float r = red16(rho[i]); if (l15 == 0) RHO[rb * 16 + 4 * g + i] = r; }
    } else {
        const bf16* YB = (const bf16*)(p.ws + WS_YWB); unsigned short yfv[4][4], ybv[4][4];
#pragma unroll
        for (int nt = 0; nt < 4; ++nt)
#pragma unroll
            for (int i = 0; i < 4; ++i) { const size_t yo = (size_t)(row0 + rb * 16 + 4 * g + i) * D + h * 64 + nt * 16 + l15; yfv[nt][i] = YF[yo]; ybv[nt][i] = YB[yo]; }
#pragma unroll
        for (int nt = 0; nt < 4; ++nt) zg[nt] = (pg8::f32x4){0.f, 0.f, 0.f, 0.f};
#pragma unroll
        for (int ks = 0; ks < 5; ++ks) { const bf16x8 ag = __builtin_bit_cast(bf16x8, ks == 0 ? L.a0 : (ks == 1 ? L.a1 : (ks == 2 ? L.a2 : (ks == 3 ? L.a3 : L.a4))));
#pragma unroll
            for (int nt = 0; nt < 4; ++nt) { const bf16x8 bg = *(const LAS bf16x8*)(G2T + (nt * 16 + l15) * 168 + ks * 32 + g * 8); zg[nt] = __builtin_amdgcn_mfma_f32_16x16x32_bf16(ag, bg, zg[nt], 0, 0, 0); } }
        float sm[4] = {0.f, 0.f, 0.f, 0.f};
#pragma unroll
        for (int nt = 0; nt < 4; ++nt)
#pragma unroll
            for (int i = 0; i < 4; ++i) { yn[nt][i] = bf2f(yfv[nt][i]) + bf2f(ybv[nt][i]); sm[i] += yn[nt][i]; }
#pragma unroll
        for (int i = 0; i < 4; ++i) { const float mu = red16(sm[i]) * (1.f / 64.f); float q2 = 0.f;
#pragma unroll
            for (int nt = 0; nt < 4; ++nt) { yn[nt][i] -= mu; q2 += yn[nt][i] * yn[nt][i]; }
            const float rs = __builtin_amdgcn_rsqf(red16(q2) * (1.f / 64.f) + GN_EPS);
#pragma unroll
            for (int nt = 0; nt < 4; ++nt) yn[nt][i] *= rs; }
    }
    WK_BAR();
    if (half == 1) {
#pragma unroll
        for (int nt = 0; nt < 4; ++nt) { const int hc = h * 64 + nt * 16 + l15; const float gg = C.gg[nt], gb = C.gb[nt];
#pragma unroll
            for (int i = 0; i < 4; ++i) { const int tok = rb * 16 + 4 * g + i; const float ov = (yn[nt][i] * gg + gb + RHO[tok] * VS[tok * 68 + nt * 16 + l15]) * zg[nt][i];
                YF[(size_t)(row0 + tok) * D + hc] = (bf16)f2bf(ov); } }
    }
    WK_BAR();
}

DI void expert_weights(const P& p, LAS unsigned char* lds, int lane, int wave, int G) {
    LAS float* scr = (LAS float*)(lds + wave * 16384);
    const int gw = blockIdx.x * NWAVES + wave, NGW = G * NWAVES;
    bf16* w13 = (bf16*)(p.ws + WS_W13); bf16* w2t = (bf16*)(p.ws + WS_W2);
    constexpr int I13 = 16 * 16, I2 = 8 * 32;
    for (int it = gw; it < NEXP * (2 * I13 + I2); it += NGW) { const int ex = it / (2 * I13 + I2); int r = it % (2 * I13 + I2);
        if (r < 2 * I13) { const int which = r / I13; r %= I13; const int kb = r / 16, nb = r % 16, n0 = nb * 32;
            if (which) transpose_item(p.e_w3 + (size_t)ex * D * DEXP, DEXP, w13 + (size_t)ex * D * D, D, kb * 64, n0, 256 * (n0 >> 7) + 128 + (n0 & 127), scr, lane);
            else transpose_item(p.e_w1 + (size_t)ex * D * DEXP, DEXP, w13 + (size_t)ex * D * D, D, kb * 64, n0, 256 * (n0 >> 7) + (n0 & 127), scr, lane); }
        else { r -= 2 * I13; const int kb = r / 32, nb = r % 32; transpose_item(p.e_w2 + (size_t)ex * DEXP * D, D, w2t + (size_t)ex * D * DEXP, DEXP, kb * 64, nb * 32, nb * 32, scr, lane); } }
}

constexpr int RT_AX = 0, RT_AXS = 1032, RT_PART = 66048, RT_LOG = 90624, RT_RE = 92928, RT_PRM = 93696  ;
DI void phase_route(const P& p, LAS unsigned char* lds, int tid, int lane, int wave, int G) {
    LAS float* AX = (LAS float*)(lds + RT_AX); LAS float* PART = (LAS float*)(lds + RT_PART); LAS float* LOG = (LAS float*)(lds + RT_LOG); LAS int* RE = (LAS int*)(lds + RT_RE);
    float* T1 = p.out; bf16* H2 = (bf16*)(p.ws + WS_H2); float* ST2 = (float*)(p.ws + WS_ROWW);
    int* TOKE = (int*)(p.ws + WS_TOKE); int* TOKSLOT = (int*)(p.ws + WS_TOKSLOT); float* TOKW = (float*)(p.ws + WS_TOKW); int* S2T = (int*)(p.ws + WS_S2T);
    if (blockIdx.x == 0) for (int i = tid; i < D / 8; i += NTHR) ((GAS v4u*)(H2 + (size_t)MX * D))[i] = (v4u){0u, 0u, 0u, 0u};
    const int l15 = lane & 15, g = lane >> 4;
    f32x4 breg[8][3];
    { const float* rwt = (const float*)(p.ws + WS_RWT);
#pragma unroll
      for (int m = 0; m < 8; ++m)
#pragma unroll
          for (int nt = 0; nt < 3; ++nt) breg[m][nt] = *(const f32x4*)(rwt + (size_t)(nt * 16 + l15) * D + 128 * wave + 16 * m + 4 * g); }
    __syncthreads();
    LAS float* PRM = (LAS float*)(lds + RT_PRM);
    for (int blk = blockIdx.x; blk < MX / 64; blk += G) {
        f32x4 q[2][4];
        { const int bsel = (blk * 64) >> 13;
          __syncthreads();
          for (int n = tid; n < D; n += NTHR) { PRM[n] = p.ln1_g[n]; PRM[D + n] = p.ln1_b[n]; PRM[2 * D + n] = modv(p, bsel, 4 * 1024 + n) + 1.f; PRM[3 * D + n] = modv(p, bsel, 3 * 1024 + n); }
          __syncthreads(); }
#pragma unroll
        for (int rr = 0; rr < 2; ++rr) { const GAS f32x4* tr = (const GAS f32x4*)(T1 + (size_t)(blk * 64 + 2 * wave + rr) * D) + lane;
#pragma unroll
            for (int j = 0; j < 4; ++j) q[rr][j] = tr[64 * j]; }
        for (int it = 0; it < 4; ++it) {
#pragma unroll
            for (int rr = 0; rr < 2; ++rr) { const int rl = 2 * wave + rr, m = blk * 64 + it * 16 + rl; const int bsel = m >> 13;
                GAS f32x4* tr = (GAS f32x4*)(T1 + (size_t)m * D) + lane; float s = 0.f;
#pragma unroll
                for (int j = 0; j < 4; ++j) s += (q[rr][j].x + q[rr][j].y) + (q[rr][j].z + q[rr][j].w);
                const float mean = wave_sum(s) * (1.f / D); float s2 = 0.f;
#pragma unroll
                for (int j = 0; j < 4; ++j) { q[rr][j] = q[rr][j] - mean; s2 += (q[rr][j].x * q[rr][j].x + q[rr][j].y * q[rr][j].y) + (q[rr][j].z * q[rr][j].z + q[rr][j].w * q[rr][j].w); }
                const float rstd = 1.f / sqrtf(wave_sum(s2) * (1.f / D) + LN_EPS);
                if (lane == 0) { ST2[2 * m] = mean; ST2[2 * m + 1] = rstd; }
                GAS v2u* o8 = (GAS v2u*)(H2 + (size_t)m * D) + lane;
#pragma unroll
                for (int j = 0; j < 4; ++j) { const int n = 256 * j + 4 * lane; const f32x4 gg = *(const LAS f32x4*)(PRM + n), bb = *(const LAS f32x4*)(PRM + D + n);
                    const f32x4 x1 = q[rr][j] * rstd * gg + bb; const f32x4 hh = x1 * *(const LAS f32x4*)(PRM + 2 * D + n) + *(const LAS f32x4*)(PRM + 3 * D + n);
                    o8[64 * j] = (v2u){pk2(hh[0], hh[1]), pk2(hh[2], hh[3])};
                    *(LAS f32x4*)(AX + rl * RT_AXS + n) = hh; } }
            if (it < 3) {
#pragma unroll
                for (int rr = 0; rr < 2; ++rr) { const GAS f32x4* tr = (const GAS f32x4*)(T1 + (size_t)(blk * 64 + (it + 1) * 16 + 2 * wave + rr) * D) + lane;
#pragma unroll
                    for (int j = 0; j < 4; ++j) q[rr][j] = tr[64 * j]; } }
            WK_BAR();
            { f32x4 acc[3];
#pragma unroll
              for (int nt = 0; nt < 3; ++nt) acc[nt] = (f32x4){0.f, 0.f, 0.f, 0.f};
#pragma unroll
              for (int m = 0; m < 8; ++m) { const f32x4 a4 = *(const LAS f32x4*)(AX + l15 * RT_AXS + 128 * wave + 16 * m + 4 * g);
#pragma unroll
                  for (int sx = 0; sx < 4; ++sx)
#pragma unroll
                      for (int nt = 0; nt < 3; ++nt) acc[nt] = __builtin_amdgcn_mfma_f32_16x16x4f32(a4[sx], breg[m][nt][sx], acc[nt], 0, 0, 0); }
#pragma unroll
              for (int nt = 0; nt < 3; ++nt)
#pragma unroll
                  for (int i = 0; i < 4; ++i) PART[(wave * 16 + 4 * g + i) * 48 + nt * 16 + l15] = acc[nt][i]; }
            WK_BAR();
            for (int i = tid; i < 16 * 36; i += NTHR) { const int row = i / 36, qq = i % 36; float a = qq < 4 ? p.router_g_b[qq] : p.router_e_b[qq - 4];
#pragma unroll
                for (int w = 0; w < 8; ++w) a += PART[(w * 16 + row) * 48 + qq];
                LOG[row * 36 + qq] = a; }
            WK_BAR();
            if (tid < 16) { const int m = blk * 64 + it * 16 + tid; float lg[36];
#pragma unroll
                for (int i = 0; i < 36; ++i) lg[i] = LOG[tid * 36 + i];
                int gs = 0; float gm = lg[0];
#pragma unroll
                for (int i = 1; i < 4; ++i) if (lg[i] > gm) { gm = lg[i]; gs = i; }
                float den = 0.f;
#pragma unroll
                for (int i = 0; i < 4; ++i) den += __expf(lg[i] - gm);
                const float pg = 1.f / den;
                float ev[8];
#pragma unroll
                for (int i = 0; i < 8; ++i) ev[i] = gs == 0 ? lg[4 + i] : (gs == 1 ? lg[12 + i] : (gs == 2 ? lg[20 + i] : lg[28 + i]));
                int i1 = 0; float v1 = ev[0];
#pragma unroll
                for (int i = 1; i < 8; ++i) if (ev[i] > v1) { v1 = ev[i]; i1 = i; }
                int i2 = -1; float v2 = -3.0e38f;
#pragma unroll
                for (int i = 0; i < 8; ++i) if (i != i1 && ev[i] > v2) { v2 = ev[i]; i2 = i; }
                if (i2 < 0) { i2 = (i1 + 1) & 7; v2 = v1; }
                const float e2 = __expf(v2 - v1); const float w1 = pg / (1.f + e2), w2 = pg * e2 / (1.f + e2);
                RE[(it * 16 + tid) * 2] = gs * 8 + i1; RE[(it * 16 + tid) * 2 + 1] = gs * 8 + i2; TOKW[2 * m] = w1; TOKW[2 * m + 1] = w2; TOKE[2 * m] = gs * 8 + i1; TOKE[2 * m + 1] = gs * 8 + i2; }
            WK_BAR();
        }
        if (wave == 0) {
            const int e0 = RE[lane], e1 = RE[lane + 64]; int r0 = 0, r1 = 0, cex = 0;
#pragma unroll 4
            for (int ex = 0; ex < NEXP; ++ex) { const unsigned long long m0 = __builtin_amdgcn_ballot_w64(e0 == ex), m1 = __builtin_amdgcn_ballot_w64(e1 == ex);
                const int n0 = __builtin_popcountll(m0);
                const int b0 = (int)__builtin_amdgcn_mbcnt_hi((unsigned)(m0 >> 32), __builtin_amdgcn_mbcnt_lo((unsigned)m0, 0u)), b1 = (int)__builtin_amdgcn_mbcnt_hi((unsigned)(m1 >> 32), __builtin_amdgcn_mbcnt_lo((unsigned)m1, 0u));
                if (e0 == ex) r0 = b0; if (e1 == ex) r1 = n0 + b1; if (lane == ex) cex = n0 + __builtin_popcountll(m1); }
            int base = 0; if (lane < NEXP && cex) base = (int)atomicAdd(p.ctl + CW_ECNT + lane, (unsigned)cex);
            const int s0 = __builtin_amdgcn_ds_bpermute(e0 * 4, base) + r0, s1 = __builtin_amdgcn_ds_bpermute(e1 * 4, base) + r1;
            const int i0 = lane, i1 = lane + 64, m0r = blk * 64 + (i0 >> 1), m1r = blk * 64 + (i1 >> 1);
            TOKSLOT[2 * m0r + (i0 & 1)] = s0; S2T[(size_t)e0 * MX + s0] = 2 * m0r + (i0 & 1);
            TOKSLOT[2 * m1r + (i1 & 1)] = s1; S2T[(size_t)e1 * MX + s1] = 2 * m1r + (i1 & 1); }
        __syncthreads();
    }
}
DI void build_tiles(const P& p, LAS int* tile, int tid) {
    if (tid == 0) { int T = 0;
        for (int e = 0; e < NEXP; ++e) { tile[MAXT + e] = T; const int c = (int)__hip_atomic_load(p.ctl + CW_ECNT + e, RLX_AGENT); tile[MAXT + 64 + e] = c; const int nt = (c + 255) >> 8; for (int i = 0; i < nt; ++i) tile[T + i] = e; T += nt; }
        tile[MAXT + 32] = T; tile[MAXT + 40] = T; }
    __syncthreads();
}
DI void phase_final(const P& p, LAS int* tile, int lane, int wave, int G) {
    const int gw = blockIdx.x * NWAVES + wave, NGW = G * NWAVES; const bf16* YB = (const bf16*)(p.ws + WS_XS);
    const int* TOKE = (const int*)(p.ws + WS_TOKE); const int* TOKSLOT = (const int*)(p.ws + WS_TOKSLOT); const float* ST2 = (const float*)(p.ws + WS_ROWW);
    f32x4 g1[4], b1[4], g2[4], b2[4], gt[2][4]; int gv[2] = {-1, -1};
#pragma unroll
    for (int j = 0; j < 4; ++j) { const int n = 256 * j + 4 * lane; g1[j] = *(const f32x4*)(p.ln1_g + n); b1[j] = *(const f32x4*)(p.ln1_b + n); g2[j] = *(const f32x4*)(p.ln2_g + n); b2[j] = *(const f32x4*)(p.ln2_b + n); gt[0][j] = gt[1][j] = (f32x4){0.f, 0.f, 0.f, 0.f}; }
    for (int m0 = gw; m0 < MX; m0 += 2 * NGW) { int mm[2]; mm[0] = m0; mm[1] = (m0 + NGW < MX) ? m0 + NGW : m0;
        f32x4 q[2][4]; float s[2] = {0.f, 0.f};
#pragma unroll
        for (int rr = 0; rr < 2; ++rr) { const int m = mm[rr]; const int bsel = m >> 13; const float mean1 = ST2[2 * m], rstd1 = ST2[2 * m + 1];
            if (bsel != gv[rr]) { gv[rr] = bsel;
#pragma unroll
                for (int j = 0; j < 4; ++j) gt[rr][j] = modv4(p, bsel, 5 * 1024 + 256 * j + 4 * lane); }
            const int r0 = tile[MAXT + TOKE[2 * m]] * 256 + TOKSLOT[2 * m], r1 = tile[MAXT + TOKE[2 * m + 1]] * 256 + TOKSLOT[2 * m + 1];
            const GAS f32x4* xr = (const GAS f32x4*)(p.out + (size_t)m * D) + lane; const GAS v2u* y0 = (const GAS v2u*)(YB + (size_t)r0 * D) + lane; const GAS v2u* y1 = (const GAS v2u*)(YB + (size_t)r1 * D) + lane;
#pragma unroll
            for (int j = 0; j < 4; ++j) { const f32x4 x1 = (xr[64 * j] - mean1) * rstd1 * g1[j] + b1[j]; const v2u a = y0[64 * j], b2v = y1[64 * j];
                const f32x4 mo = (f32x4){bflo(a.x) + bflo(b2v.x), bfhi(a.x) + bfhi(b2v.x), bflo(a.y) + bflo(b2v.y), bfhi(a.y) + bfhi(b2v.y)};
                q[rr][j] = x1 * ALPHA + gt[rr][j] * mo;
                s[rr] += (q[rr][j].x + q[rr][j].y) + (q[rr][j].z + q[rr][j].w); } }
#pragma unroll
        for (int rr = 0; rr < 2; ++rr) { const int m = mm[rr]; GAS f32x4* xr = (GAS f32x4*)(p.out + (size_t)m * D) + lane;
            const float mean = wave_sum(s[rr]) * (1.f / D); float s2 = 0.f;
#pragma unroll
            for (int j = 0; j < 4; ++j) { q[rr][j] = q[rr][j] - mean; s2 += (q[rr][j].x * q[rr][j].x + q[rr][j].y * q[rr][j].y) + (q[rr][j].z * q[rr][j].z + q[rr][j].w * q[rr][j].w); }
            const float rstd = 1.f / sqrtf(wave_sum(s2) * (1.f / D) + LN_EPS);
#pragma unroll
            for (int j = 0; j < 4; ++j) xr[64 * j] = q[rr][j] * rstd * g2[j] + b2[j]; }
    }
}
__device__ __forceinline__ int lane_now() { int l; asm volatile("v_and_b32 %0, 63, %1" : "=v"(l) : "v"((int)threadIdx.x)); __builtin_assume(l >= 0 && l < 64); return l; }
#define MKP P p; { const float* const* in = args.in; p.x = in[0]; p.c = in[1]; p.ctx = in[2]; p.c_ctx = in[3]; p.w_ada = in[4]; p.b_ada = in[5]; p.w_in = in[6]; p.mu_a = in[7]; p.w0 = in[8]; p.w2 = in[9]; p.a0 = in[10]; p.a2 = in[11]; p.g2 = in[12]; p.k_k = in[13]; p.k_a = in[14]; p.r_k = in[15]; p.gn_g = in[16]; p.gn_b = in[17]; p.conv_w = in[18]; p.conv_b = in[19]; p.lru_wa = in[20]; p.lru_ba = in[21]; p.lru_wx = in[22]; p.lru_bx = in[23]; p.lru_lam = in[24]; p.p_a = in[25]; p.p_b = in[26]; p.w_o = in[27]; p.ln1_g = in[28]; p.ln1_b = in[29]; p.router_g = in[30]; p.router_g_b = in[31]; p.router_e = in[32]; p.router_e_b = in[33]; p.e_w1 = in[34]; p.e_w3 = in[35]; p.e_w2 = in[36]; p.ln2_g = in[37]; p.ln2_b = in[38]; } p.out = args.out; p.ws = args.ws; p.dob = (unsigned char*)args.out; p.ctlf = (float*)(args.ws + WS_CTL); p.ctl = (unsigned*)(args.ws + WS_CTL);
constexpr int NPHASE = 15;
__global__ void __launch_bounds__(NTHR, 2) fwd_kernel(Args args) {
    extern __shared__ __attribute__((aligned(16))) unsigned char lds_raw[];
    LAS unsigned char* lds = (LAS unsigned char*)lds_raw;
    const int tid = threadIdx.x, wave = __builtin_amdgcn_readfirstlane(tid >> 6), G = gridDim.x;
    volatile LAS unsigned* MISC = (volatile LAS unsigned*)(lds + MISC_OFF);
    LAS int* tile = (LAS int*)(lds + TILE_OFF);
    for (int u = tid; u < 256; u += NTHR) ((LAS unsigned*)(lds + MISC_OFF))[u] = 0u;
    __syncthreads();
#if ONE_LAUNCH
    XcdBarrier bar = xcd_barrier_post((unsigned*)(args.ws + WS_CTL) + CW_BAR, MISC + 8);
#define GRID_BAR() xcd_barrier(bar)
#else
#define GRID_BAR() do {} while (0)
#endif
    const int lo = args.ph_lo, hi = args.ph_hi;
#define IN(k) (lo <= (k) && (k) < hi)
#define SEAM(k) do { if (IN(k) && IN((k) + 1)) GRID_BAR(); } while (0)

    if (IN(0)) { MKP; const int lane = lane_now(); phase0(p, lds, tid, lane, wave, G); } SEAM(0);
    if (IN(1)) { MKP; const int lane = lane_now(); phase0b(p, lds, tid, lane, wave, G); phase1(p, lane, wave, G); } SEAM(1);
    if (IN(2)) { MKP; const int lane = lane_now();
        pg8::Gemm g{(const pg8::bf16_t*)(p.dob + DO_H), (const pg8::bf16_t*)(p.dob + DO_WIN), MALL, NSLAB, D}; pg8::StaticOrder S; S.init(MALL, NSLAB, G, (int)blockIdx.x);
        EpiPlain<0> E{(bf16*)(p.ws + WS_S1), NS1, (bf16*)(p.ws + WS_S2), NS2, NS1 / 256};
        pg8::gemm_phase<EpiPlain<0>, pg8::StaticOrder, true, true>(lds, g, S, E); } SEAM(2);
    if (IN(3)) { MKP; const int lane = lane_now(); const int hb = blockIdx.x & 15; lru_setup(p, lds, tid, hb);
        for (int u = (blockIdx.x >> 4) * NWAVES + wave; u < BATCH * NHS; u += (G >> 4) * NWAVES) { const int hs = u % NHS, b = u / NHS; lru_unit(p, lds, lane, wave, b, hs, hb); } } SEAM(3);
    if (IN(4)) { MKP; const int lane = lane_now(); lru_carry(p, lds, tid, G); } SEAM(4);
    if (IN(5)) { MKP; const int lane = lane_now(); lru_finish(p, lane, wave, G); } SEAM(5);
    if (IN(6)) { MKP; const int lane = lane_now(); phase_mix(p, lane, wave, G); } SEAM(6);
    if (IN(7)) { MKP; const int lane = lane_now(); for (int u = blockIdx.x; u < 256; u += G) wkv_blk_wg(p, lds, tid, lane, wave, u); } SEAM(7);
    if (IN(8)) { MKP; const int lane = lane_now(); const int h = blockIdx.x & 15; wkv_out_setup(p, lds, tid, h); { WoC WC; wkv_out_consts(p, h, lane & 15, WC); WoPre A, B; const int u0 = blockIdx.x >> 4, du = G >> 4; if (u0 < BATCH * 128) wkv_out_load(p, tid, lane, wave, u0 >> 7, u0 & 127, h, A);
            for (int u = u0; u < BATCH * 128; u += 2 * du) {
                const int u1 = u + du, u2 = u + 2 * du;
                wkv_out_unit(p, lds, tid, lane, wave, u >> 7, u & 127, h, WC, A, u1 < BATCH * 128, u1 >> 7, u1 & 127, B);
                if (u1 < BATCH * 128) wkv_out_unit(p, lds, tid, lane, wave, u1 >> 7, u1 & 127, h, WC, B, u2 < BATCH * 128, u2 >> 7, u2 & 127, A); } } } SEAM(8);
    if (IN(9)) { MKP; const int lane = lane_now();
        pg8::Gemm g{(const pg8::bf16_t*)(p.dob + DO_H), (const pg8::bf16_t*)(p.dob + DO_WIN) + (size_t)NSLAB * D, MX, 2048, D}; pg8::StaticOrder S; S.init(MX, 2048, G, (int)blockIdx.x);
        EpiPlain<1> E{(bf16*)(p.ws + WS_GATES), 2048, nullptr, 0, 1 << 20};
        pg8::gemm_phase<EpiPlain<1>, pg8::StaticOrder, true, true>(lds, g, S, E); } SEAM(9);
    if (IN(10)) { MKP; const int lane = lane_now();
        pg8::Gemm g{(const pg8::bf16_t*)(p.ws + WS_YWF), (const pg8::bf16_t*)(p.ws + WS_PW), 2 * MX, 2 * D, D}; SchedMix S; S.init(MX, D, G, (int)blockIdx.x);
        EpiMix E{(const bf16*)(p.ws + WS_GATES), (bf16*)(p.ws + WS_MBUF)};
        pg8::gemm_phase<EpiMix, SchedMix, true, true>(lds, g, S, E); } SEAM(10);
    if (IN(11)) { MKP; const int lane = lane_now();
        pg8::Gemm g{(const pg8::bf16_t*)(p.ws + WS_MBUF), (const pg8::bf16_t*)(p.ws + WS_PW) + (size_t)2 * D * D, MX, D, D}; pg8::StaticOrder S; S.init(MX, D, G, (int)blockIdx.x);
        EpiT1 E{p.x, (const float*)(p.ws + WS_STATS), p.ctlf + CW_MOD, p.b_ada, p.out};
        const bool wfirst = ((blockIdx.x >> 3) & 1) != 0;
        if (wfirst) { expert_weights(p, lds, lane, wave, G); __syncthreads(); }
        pg8::gemm_phase<EpiT1, pg8::StaticOrder, true, true>(lds, g, S, E);
        if (!wfirst) expert_weights(p, lds, lane, wave, G); } SEAM(11);
    if (IN(12)) { MKP; const int lane = lane_now(); phase_route(p, lds, tid, lane, wave, G); } SEAM(12);
    if (IN(13)) { MKP; const int lane = lane_now();
        build_tiles(p, tile, tid);
        pg8::Gemm g{(const pg8::bf16_t*)(p.ws + WS_H2), (const pg8::bf16_t*)(p.ws + WS_W13), MAXT * 256, NEXP * D, D}; SchedMoE S{tile, G, (int)blockIdx.x, (const int*)(p.ws + WS_S2T)};
        EpiSwiGLU E{(bf16*)(p.ws + WS_HBUF)};
        pg8::gemm_phase<EpiSwiGLU, SchedMoE, true, true, true>(lds, g, S, E); } SEAM(13);
    if (IN(14)) { MKP; const int lane = lane_now();
        build_tiles(p, tile, tid);
        pg8::Gemm g{(const pg8::bf16_t*)(p.ws + WS_HBUF), (const pg8::bf16_t*)(p.ws + WS_W2), MAXT * 256, NEXP * D, DEXP}; SchedMoE S{tile, G, (int)blockIdx.x, (const int*)(p.ws + WS_S2T)};
        EpiW2 E{(bf16*)(p.ws + WS_XS), tile, (const int*)(p.ws + WS_S2T), (const float*)(p.ws + WS_TOKW)};
        pg8::gemm_phase<EpiW2, SchedMoE, true, true>(lds, g, S, E); } SEAM(14);
    if (IN(15)) { MKP; const int lane = lane_now(); build_tiles(p, tile, tid); phase_final(p, tile, lane, wave, G); }
#undef IN
#undef SEAM
}

extern "C" void kernel_launch(void* const* d_in, const int* in_sizes, int n_in, void* d_out, int out_size, void* d_ws, size_t ws_size, hipStream_t stream) {
    static int grid = 0;
    if (grid == 0) {
        if (n_in != 39 || out_size != MX * D || ws_size < WS_END) { fprintf(stderr, "kernel_launch: unexpected shapes (n_in %d out %d ws %zu)\n", n_in, out_size, ws_size); grid = -1; return; }
        int dev = 0, cus = 0, per_cu = 0;
        if (hipGetDevice(&dev) != hipSuccess || hipDeviceGetAttribute(&cus, hipDeviceAttributeMultiprocessorCount, dev) != hipSuccess) { grid = -1; return; }
        if (hipFuncSetAttribute((const void*)fwd_kernel, hipFuncAttributeMaxDynamicSharedMemorySize, LDS_BYTES) != hipSuccess) { fprintf(stderr, "kernel_launch: hipFuncSetAttribute failed\n"); grid = -1; return; }
        if (hipOccupancyMaxActiveBlocksPerMultiprocessor(&per_cu, (const void*)fwd_kernel, NTHR, LDS_BYTES) != hipSuccess || per_cu < 1) fprintf(stderr, "kernel_launch: occupancy query reports %d\n", per_cu);
        (void)hipGetLastError();
        grid = cus;
    }
    if (grid < 0) return;
    if (hipMemsetAsync((char*)d_ws + WS_CTL, 0, CTL_ZERO_BYTES, stream) != hipSuccess) return;
    Args a{};
    for (int i = 0; i < 39; ++i) a.in[i] = (const float*)d_in[i];
    a.out = (float*)d_out; a.ws = (unsigned char*)d_ws;
#if ONE_LAUNCH
    a.ph_lo = 0; a.ph_hi = NPHASE + 1;
    hipLaunchKernelGGL(fwd_kernel, dim3(grid), dim3(NTHR), LDS_BYTES, stream, a);
#else
    for (int ph = 0; ph <= NPHASE; ++ph) { a.ph_lo = ph; a.ph_hi = ph + 1; hipLaunchKernelGGL(fwd_kernel, dim3(grid), dim3(NTHR), LDS_BYTES, stream, a); }
#endif
}
```
